# Optimizing an MI355X kernel written in HIP

```python
import jax, jax.numpy as jnp
from jax import lax
import numpy as np

D_MODEL = 2048
BATCH = 1
SEQ = 8192
DEPTH = 1

POOL_GROUPS = 4
POOL_WINDOWS = (2, 4, 8, 16)
POOL_GROUP_W = 192
POOL_W = POOL_GROUPS * POOL_GROUP_W
ATTN_HEADS = 6
HEAD_DIM = 128
ATTN_W = ATTN_HEADS * HEAD_DIM
IDX_HEADS = 4
IDX_DIM = 64
TOPK_MAX = 256
Q_BLOCK = 128
MEM_LEN = 256
XATTN_HEADS = 4
XATTN_W = XATTN_HEADS * HEAD_DIM
N_BRANCH = 3
N_GROUPS = 4
EXPERTS_PER_GROUP = 4
N_EXPERTS = N_GROUPS * EXPERTS_PER_GROUP
EXPERT_FF = 512
TOPK_EXPERT = 2
ROPE_THETA = 10000.0
NORM_EPS = 1e-6
IN_COLS = POOL_W + 3 * ATTN_W + IDX_HEADS * IDX_DIM + IDX_DIM + IDX_HEADS + XATTN_W + N_BRANCH * D_MODEL

kernel_name = "hybrid_pool_dsa_memxattn_hmoe_block"


def rms_norm(x, g):
    xf = x.astype(jnp.float32)
    y = xf * lax.rsqrt(jnp.mean(xf * xf, axis=-1, keepdims=True) + NORM_EPS)
    return (y * g.astype(jnp.float32)).astype(x.dtype)


def rotary(x, positions):
    d = x.shape[-1]
    inv_freq = ROPE_THETA ** (-jnp.arange(0, d, 2, dtype=jnp.float32) / d)
    ang = positions.astype(jnp.float32)[..., None] * inv_freq
    cos = jnp.cos(ang)[:, :, None, :]
    sin = jnp.sin(ang)[:, :, None, :]
    xf = x.astype(jnp.float32)
    x1, x2 = xf[..., : d // 2], xf[..., d // 2:]
    out = jnp.concatenate([x1 * cos - x2 * sin, x2 * cos + x1 * sin], axis=-1)
    return out.astype(x.dtype)


def causal_multiscale_pool(u):
    B, S, G, C = u.shape
    uf = u.astype(jnp.float32)
    cs = jnp.concatenate([jnp.zeros((B, 1, G, C), jnp.float32), jnp.cumsum(uf, axis=1)], axis=1)
    t = jnp.arange(S)
    outs = []
    for g, w in enumerate(POOL_WINDOWS):
        lo = jnp.maximum(t + 1 - w, 0)
        total = cs[:, 1:, g] - cs[:, lo, g]
        cnt = jnp.minimum(t + 1, w).astype(jnp.float32)
        outs.append(total / cnt[None, :, None])
    pooled = jnp.stack(outs, axis=2)
    return (pooled - uf).astype(u.dtype)


def dsa_attention(q, k, v, qi, ki, wi, k_sel):
    B, S, H, dh = q.shape
    n_blocks = S // Q_BLOCK
    key_pos = jnp.arange(S)
    scale = HEAD_DIM ** -0.5

    def one_block(i):
        start = i * Q_BLOCK
        q_b = lax.dynamic_slice_in_dim(q, start, Q_BLOCK, axis=1)
        qi_b = lax.dynamic_slice_in_dim(qi, start, Q_BLOCK, axis=1)
        wi_b = lax.dynamic_slice_in_dim(wi, start, Q_BLOCK, axis=1)
        t = start + jnp.arange(Q_BLOCK)
        dots = jnp.einsum('bqhd,bsd->bqhs', qi_b, ki).astype(jnp.float32)
        score = jnp.einsum('bqhs,bqh->bqs', jax.nn.relu(dots), wi_b.astype(jnp.float32))
        causal = key_pos[None, None, :] <= t[None, :, None]
        score = jnp.where(causal, score, -jnp.inf)
        _, idx = lax.top_k(score, k_sel)
        k_g = jax.vmap(lambda kb, ib: kb[ib])(k, idx)
        v_g = jax.vmap(lambda vb, ib: vb[ib])(v, idx)
        logits = jnp.einsum('bqhd,bqkhd->bhqk', q_b, k_g).astype(jnp.float32) * scale
        valid = idx <= t[None, :, None]
        logits = jnp.where(valid[:, None], logits, -jnp.inf)
        p = jax.nn.softmax(logits, axis=-1).astype(v.dtype)
        return jnp.einsum('bhqk,bqkhd->bqhd', p, v_g)

    outs = lax.map(one_block, jnp.arange(n_blocks))
    return jnp.transpose(outs, (1, 0, 2, 3, 4)).reshape(B, S, H * dh)


def hierarchical_moe(h, w_router_group, w_router_expert, w_e_gate, w_e_up, w_e_down):
    B, S, _ = h.shape
    lg = jnp.einsum('bsd,dg->bsg', h, w_router_group).astype(jnp.float32)
    pg = jax.nn.softmax(lg, axis=-1)
    g_top = jnp.argmax(lg, axis=-1)
    pg_top = jnp.take_along_axis(pg, g_top[..., None], axis=-1)
    le = jnp.einsum('bsd,de->bse', h, w_router_expert).astype(jnp.float32)
    le = le.reshape(B, S, N_GROUPS, EXPERTS_PER_GROUP)
    le_sel = jnp.take_along_axis(le, g_top[..., None, None], axis=2)[:, :, 0]
    pe = jax.nn.softmax(le_sel, axis=-1)
    pe_top, e_local = lax.top_k(pe, TOPK_EXPERT)
    w = pg_top * pe_top / jnp.sum(pe_top, axis=-1, keepdims=True)
    e_id = g_top[..., None] * EXPERTS_PER_GROUP + e_local
    combine = jnp.einsum('bsk,bske->bse', w, jax.nn.one_hot(e_id, N_EXPERTS, dtype=jnp.float32))
    a = jnp.einsum('bsd,edf->bsef', h, w_e_gate)
    b = jnp.einsum('bsd,edf->bsef', h, w_e_up)
    act = jax.nn.silu(a) * b * combine[..., None].astype(h.dtype)
    return jnp.einsum('bsef,efd->bsd', act, w_e_down)


def hybrid_layer(x, mem, positions, g_mix, w_in, b_gate, w_pool_grp, pool_scale,
                 q_norm_g, k_norm_g, g_mem, w_mem_kv, xq_norm_g, xk_norm_g,
                 w_pool_out, w_attn_out, w_cross_out, w_o, g_ffn,
                 w_router_group, w_router_expert, w_e_gate, w_e_up, w_e_down):
    B, S, D = x.shape
    k_sel = min(TOPK_MAX, S // 4)
    h = rms_norm(x, g_mix)
    proj = h @ w_in
    sizes = (POOL_W, ATTN_W, ATTN_W, ATTN_W, IDX_HEADS * IDX_DIM, IDX_DIM, IDX_HEADS, XATTN_W)
    split_pts = [int(p) for p in np.cumsum(sizes)]
    u_pool, q, k, v, qi, ki, wi, xq, gate_logits = jnp.split(proj, split_pts, axis=-1)

    u = u_pool.reshape(B, S, POOL_GROUPS, POOL_GROUP_W)
    p = causal_multiscale_pool(u)
    p = jnp.einsum('bsgc,gcd->bsgd', p, w_pool_grp).reshape(B, S, POOL_W) * pool_scale
    pool_out = p @ w_pool_out

    q = rotary(rms_norm(q.reshape(B, S, ATTN_HEADS, HEAD_DIM), q_norm_g), positions)
    k = rotary(rms_norm(k.reshape(B, S, ATTN_HEADS, HEAD_DIM), k_norm_g), positions)
    v = v.reshape(B, S, ATTN_HEADS, HEAD_DIM)
    qi = rotary(qi.reshape(B, S, IDX_HEADS, IDX_DIM), positions)
    ki = rotary(ki[:, :, None, :], positions)[:, :, 0]
    wi = wi * (IDX_HEADS ** -0.5) * (IDX_DIM ** -0.5)
    attn = dsa_attention(q, k, v, qi, ki, wi, k_sel)
    attn_out = attn @ w_attn_out

    mem_h = rms_norm(mem, g_mem)
    kv_m = mem_h @ w_mem_kv
    M = mem.shape[1]
    k_m = rms_norm(kv_m[..., :XATTN_W].reshape(B, M, XATTN_HEADS, HEAD_DIM), xk_norm_g)
    v_m = kv_m[..., XATTN_W:].reshape(B, M, XATTN_HEADS, HEAD_DIM)
    xq = rms_norm(xq.reshape(B, S, XATTN_HEADS, HEAD_DIM), xq_norm_g)
    xl = jnp.einsum('bshd,bmhd->bhsm', xq, k_m).astype(jnp.float32) * (HEAD_DIM ** -0.5)
    xp = jax.nn.softmax(xl, axis=-1).astype(v_m.dtype)
    cross = jnp.einsum('bhsm,bmhd->bshd', xp, v_m).reshape(B, S, XATTN_W)
    cross_out = cross @ w_cross_out

    gates = jax.nn.sigmoid((gate_logits + b_gate).astype(jnp.float32)).astype(x.dtype)
    gates = gates.reshape(B, S, N_BRANCH, D)
    merged = gates[:, :, 0] * pool_out + gates[:, :, 1] * attn_out + gates[:, :, 2] * cross_out
    x = x + merged @ w_o

    x = x + hierarchical_moe(rms_norm(x, g_ffn), w_router_group, w_router_expert, w_e_gate, w_e_up, w_e_down)
    return x


def setup_inputs(seed: int = 0) -> dict:
    key = jax.random.key(seed)
    ks = jax.random.split(key, 24)
    f32 = jnp.float32
    L = DEPTH

    def nrm(k, shape, fan_in):
        return jax.random.normal(k, shape, f32) * (fan_in ** -0.5)

    def gain(k, shape):
        return 1.0 + 0.05 * jax.random.normal(k, shape, f32)

    return {
        "x": jax.random.normal(ks[0], (BATCH, SEQ, D_MODEL), f32),
        "mem": jax.random.normal(ks[1], (BATCH, MEM_LEN, D_MODEL), f32),
        "positions": jnp.broadcast_to(jnp.arange(SEQ, dtype=jnp.int32), (BATCH, SEQ)),
        "g_mix": gain(ks[2], (L, D_MODEL)),
        "w_in": nrm(ks[3], (L, D_MODEL, IN_COLS), D_MODEL),
        "b_gate": 0.02 * jax.random.normal(ks[4], (L, N_BRANCH * D_MODEL), f32),
        "w_pool_grp": nrm(ks[5], (L, POOL_GROUPS, POOL_GROUP_W, POOL_GROUP_W), POOL_GROUP_W),
        "pool_scale": gain(ks[6], (L, POOL_W)),
        "q_norm_g": gain(ks[7], (L, HEAD_DIM)),
        "k_norm_g": gain(ks[8], (L, HEAD_DIM)),
        "g_mem": gain(ks[9], (L, D_MODEL)),
        "w_mem_kv": nrm(ks[10], (L, D_MODEL, 2 * XATTN_W), D_MODEL),
        "xq_norm_g": gain(ks[11], (L, HEAD_DIM)),
        "xk_norm_g": gain(ks[12], (L, HEAD_DIM)),
        "w_pool_out": nrm(ks[13], (L, POOL_W, D_MODEL), POOL_W),
        "w_attn_out": nrm(ks[14], (L, ATTN_W, D_MODEL), ATTN_W),
        "w_cross_out": nrm(ks[15], (L, XATTN_W, D_MODEL), XATTN_W),
        "w_o": nrm(ks[16], (L, D_MODEL, D_MODEL), D_MODEL),
        "g_ffn": gain(ks[17], (L, D_MODEL)),
        "w_router_group": nrm(ks[18], (L, D_MODEL, N_GROUPS), D_MODEL),
        "w_router_expert": nrm(ks[19], (L, D_MODEL, N_EXPERTS), D_MODEL),
        "w_e_gate": nrm(ks[20], (L, N_EXPERTS, D_MODEL, EXPERT_FF), D_MODEL),
        "w_e_up": nrm(ks[21], (L, N_EXPERTS, D_MODEL, EXPERT_FF), D_MODEL),
        "w_e_down": nrm(ks[22], (L, N_EXPERTS, EXPERT_FF, D_MODEL), EXPERT_FF),
    }


def reference(x, mem, positions, g_mix, w_in, b_gate, w_pool_grp, pool_scale,
              q_norm_g, k_norm_g, g_mem, w_mem_kv, xq_norm_g, xk_norm_g,
              w_pool_out, w_attn_out, w_cross_out, w_o, g_ffn,
              w_router_group, w_router_expert, w_e_gate, w_e_up, w_e_down):
    for l in range(DEPTH):
        x = hybrid_layer(x, mem, positions, g_mix[l], w_in[l], b_gate[l], w_pool_grp[l], pool_scale[l],
                         q_norm_g[l], k_norm_g[l], g_mem[l], w_mem_kv[l], xq_norm_g[l], xk_norm_g[l],
                         w_pool_out[l], w_attn_out[l], w_cross_out[l], w_o[l], g_ffn[l],
                         w_router_group[l], w_router_expert[l], w_e_gate[l], w_e_up[l], w_e_down[l])
    return x
```

```cpp
#include <hip/hip_runtime.h>
#include <cstdio>
#include <cstdint>

#define LAS __attribute__((address_space(3)))
#define GAS __attribute__((address_space(1)))
typedef unsigned short bf16_t;
typedef short bf16x8 __attribute__((ext_vector_type(8)));
typedef short bf16x4 __attribute__((ext_vector_type(4)));
typedef float f32x4 __attribute__((ext_vector_type(4)));
typedef float f32x16 __attribute__((ext_vector_type(16)));
typedef unsigned u32x4 __attribute__((ext_vector_type(4)));
typedef unsigned u32x2 __attribute__((ext_vector_type(2)));

constexpr int SEQ = 8192, DM = 2048, INC = 10052, MEML = 256;
constexpr int NWAVES = 8, NTHR = 512;
constexpr float NORM_EPS = 1e-6f;
constexpr float LOG2E = 1.4426950408889634f;
constexpr float ATT_SCALE = 0.08838834764831845f;

constexpr size_t MiB = 1u << 20, KiB = 1u << 10;
constexpr size_t WS_CTL = 0, CTL_ZERO_BYTES = 1 * MiB;
constexpr size_t WS_SMALL = 1 * MiB;
constexpr size_t WS_RSTD1 = WS_SMALL + 0, WS_RSTDM = WS_SMALL + 32 * KiB, WS_THRKEY = WS_SMALL + 64 * KiB, WS_THRIDX = WS_SMALL + 96 * KiB;
constexpr size_t WS_WIF = WS_SMALL + 128 * KiB, WS_RSTD2 = WS_SMALL + 256 * KiB, WS_TOKCLS = WS_SMALL + 288 * KiB, WS_TOKSLOT = WS_SMALL + 320 * KiB;
constexpr size_t WS_TOKWA = WS_SMALL + 352 * KiB, WS_TOKWB = WS_SMALL + 384 * KiB, WS_ROWTOK = WS_SMALL + 416 * KiB, WS_ROWRS = WS_SMALL + 480 * KiB;
constexpr size_t WS_ROWWA = WS_SMALL + 544 * KiB, WS_ROWWB = WS_SMALL + 608 * KiB, WS_WR = WS_SMALL + 1 * MiB;
constexpr size_t WS_BTMRG = 4 * MiB, WS_WOT = 12 * MiB;
constexpr size_t WS_XB = 20 * MiB, WS_WINT = 52 * MiB, WS_WVT = 89 * MiB, WS_WMKVT = 92 * MiB, WS_MEMB = 96 * MiB;
constexpr size_t WS_WGUT = 20 * MiB, WS_QIB = 84 * MiB, WS_KIB = 88 * MiB, WS_KMB = 89 * MiB, WS_VMT = 89 * MiB + 512 * KiB;
constexpr size_t WS_WDT = 97 * MiB;
constexpr size_t WS_EG = 129 * MiB, WS_XG = 129 * MiB, WS_ACT = 185 * MiB;
constexpr size_t WS_AMRG = 225 * MiB, WS_X1B = 225 * MiB;
constexpr size_t WS_Q = 257 * MiB, WS_K = 269 * MiB, WS_VT = 281 * MiB, WS_XQ = 293 * MiB, WS_MRG = 257 * MiB;
constexpr size_t WS_U = 301 * MiB, WS_IDXF = 313 * MiB, WS_OPX = 301 * MiB;
constexpr size_t WS_KVM = 329 * MiB, WS_MASK = 330 * MiB, WS_END = 338 * MiB;
constexpr int MAXROWS = 14336;
constexpr int CW_BAR = 4096;
constexpr int CW_CLS = 16384;
constexpr int CW_QUEUE = 16512;

#define LDS_WAIT() asm volatile("s_waitcnt lgkmcnt(0)" ::: "memory")
#define VM_WAIT() asm volatile("s_waitcnt vmcnt(0)" ::: "memory")
__device__ __forceinline__ unsigned f2bf(float f) { unsigned u = __builtin_bit_cast(unsigned, f); return (u + 0x7fffu + ((u >> 16) & 1u)) >> 16; }
__device__ __forceinline__ unsigned pk2(float lo, float hi) { return f2bf(lo) | (f2bf(hi) << 16); }
__device__ __forceinline__ float bf2f(unsigned short b) { return __builtin_bit_cast(float, (unsigned)b << 16); }
__device__ __forceinline__ float bflo(unsigned w) { return __builtin_bit_cast(float, w << 16); }
__device__ __forceinline__ float bfhi(unsigned w) { return __builtin_bit_cast(float, w & 0xffff0000u); }
__device__ __forceinline__ float wave_sum(float v) {
#pragma unroll
    for (int o = 1; o < 64; o <<= 1) v += __shfl_xor(v, o);
    return v;
}
__device__ __forceinline__ int crow(int r, int hi) { return (r & 3) + 8 * (r >> 2) + 4 * hi; }

#define XB_TMO      128
#define XB_XCNT(j)  (256  + 64 * (j))
#define XB_XSUB(j)  (1280 + 64 * (j))
#define XB_XGEN(j)  (2304 + 64 * (j))
#define XB_TOP      3328
#define XB_TOPGEN   3392
#define XCD_BAR_WORDS 3456
#define XB_SPIN_CAP (1u << 20)
__device__ __forceinline__ unsigned xb_ld(unsigned* p)              { return __hip_atomic_load(p, __ATOMIC_RELAXED, __HIP_MEMORY_SCOPE_AGENT); }
__device__ __forceinline__ unsigned xb_add(unsigned* p, unsigned v) { return __hip_atomic_fetch_add(p, v, __ATOMIC_RELAXED, __HIP_MEMORY_SCOPE_AGENT); }
__device__ __forceinline__ unsigned xb_xcc_id() { return (unsigned)__builtin_amdgcn_s_getreg((3 << 11) | 20) & 0xFu; }
#define XB_SPIN(cond, bar) do { unsigned _sp = 0; while (cond) { __builtin_amdgcn_s_sleep(1); \
    if ((++_sp & 255u) == 0u) { if (xb_ld(&(bar)[XB_TMO])) break; if (_sp > XB_SPIN_CAP) { atomicAdd(&(bar)[XB_TMO], 1u); break; } } } } while (0)
struct XcdBarrier { unsigned* bar; unsigned x; volatile LAS unsigned* st; };
__device__ __forceinline__ XcdBarrier xcd_barrier_post(unsigned* bar, volatile LAS unsigned* st) {
    XcdBarrier b; b.bar = bar; b.x = xb_xcc_id(); b.st = st;
    if (threadIdx.x == 0) (void)xb_add(&bar[XB_XCNT(b.x)], 1u);
    return b;
}
__device__ __forceinline__ void xcd_barrier_complete(unsigned* bar, unsigned x, unsigned& nloc, unsigned& nx) {
    const unsigned G = gridDim.x * gridDim.y * gridDim.z;
    unsigned sum, cnt, mine, sp = 0u;
    for (;;) {
        sum = 0u; cnt = 0u; mine = 0u;
#pragma unroll
        for (unsigned j = 0; j < 16; ++j) { const unsigned c = xb_ld(&bar[XB_XCNT(j)]); sum += c; cnt += (c > 0u) ? 1u : 0u; mine = (j == x) ? c : mine; }
        if (sum == G) break;
        __builtin_amdgcn_s_sleep(1);
        if ((++sp & 255u) == 0u) { if (xb_ld(&bar[XB_TMO])) break; if (sp > XB_SPIN_CAP) { atomicAdd(&bar[XB_TMO], 1u); break; } }
    }
    nloc = mine > 0u ? mine : 1u; nx = cnt > 0u ? cnt : 1u;
}
__device__ __forceinline__ void xcd_barrier(const XcdBarrier& b) {
    asm volatile("s_waitcnt vmcnt(0)" ::: "memory");
    __syncthreads();
    if (threadIdx.x == 0) {
        unsigned* bar = b.bar;
        __builtin_amdgcn_s_waitcnt(0);
        unsigned nloc = b.st[0], nx = b.st[1];
        if (nloc == 0u) { xcd_barrier_complete(bar, b.x, nloc, nx); b.st[0] = nloc; b.st[1] = nx; }
        const unsigned old = xb_add(&bar[XB_XSUB(b.x)], 1u);
        const unsigned gen = old / nloc;
        if (old + 1u == (gen + 1u) * nloc) {
            __builtin_amdgcn_fence(__ATOMIC_RELEASE, "agent");
            asm volatile("s_waitcnt vmcnt(0)" ::: "memory");
            const unsigned og = xb_add(&bar[XB_TOP], 1u);
            const unsigned tg = og / nx;
            if (og + 1u == (tg + 1u) * nx) xb_add(&bar[XB_TOPGEN], 1u);
            else XB_SPIN(xb_ld(&bar[XB_TOPGEN]) == tg, bar);
            __builtin_amdgcn_fence(__ATOMIC_ACQUIRE, "agent");
            xb_add(&bar[XB_XGEN(b.x)], 1u);
            asm volatile("s_waitcnt vmcnt(0)" ::: "memory");
        } else {
            XB_SPIN(xb_ld(&bar[XB_XGEN(b.x)]) == gen, bar);
            __builtin_amdgcn_fence(__ATOMIC_ACQUIRE, "agent");
            asm volatile("s_waitcnt vmcnt(0)" ::: "memory");
        }
    }
    __syncthreads();
}

namespace pg8 {
constexpr int BM = 256, BK = 64, HALF = 128, HTB = HALF * BK * 2, STAGE_BYTES = 8 * HTB, NXCD = 8, WGM = 8;
__host__ __device__ __forceinline__ int lds_byte(int r, int c) { const int st = (r >> 4) * 2 + (c >> 5), rr = r & 15, cc = c & 31, ob = rr * 64 + cc * 2; return st * 1024 + (ob ^ (((ob >> 9) & 1) << 5)); }
__host__ __device__ __forceinline__ void stage_rc(int b, int& R, int& C) { const int st = b / 1024, sb = b % 1024, swz = sb ^ (((sb >> 9) & 1) << 5); R = (st >> 1) * 16 + swz / 64; C = (st & 1) * 32 + (swz % 64) / 2; }
__host__ __device__ __forceinline__ int perm32(int rho) { const int n = rho >> 4, i = rho & 15; return 8 * (i >> 2) + 4 * n + (i & 3); }

struct Unit { const char* A; const char* B; const char* Bhi; int kind; int row0; int col0; int aux; };
struct Geom { int lda, ldb, nt, ksplit; };

__device__ __forceinline__ void tile_order(int L, int nM, int nN, int& pm, int& pn) {
    const int nwg = nM * nN; int wgid = L;
    { const int q = nwg / NXCD, r = nwg % NXCD, xcd = wgid % NXCD, off = wgid / NXCD; wgid = (xcd < r ? xcd * (q + 1) : r * (q + 1) + (xcd - r) * q) + off; }
    const int nig = WGM * nN, gid = wgid / nig, fm = gid * WGM, gsz = (nM - fm) < WGM ? (nM - fm) : WGM;
    pm = fm + ((wgid % nig) % gsz); pn = (wgid % nig) / gsz;
}

template <class Epi, class Sched, bool ALIGN_EPI, bool SP2>
__device__ __forceinline__ void gemm_phase(LAS unsigned char* lds, const Geom g, const Sched& S, const Epi& E) {
    const int tid = threadIdx.x, wid = __builtin_amdgcn_readfirstlane(tid >> 6), lane = tid & 63, wr = wid >> 2, wc = wid & 3, fr = lane & 15, fq = lane >> 4;
    const int nt = g.nt;
    unsigned voffA[2], voffB[2];
#pragma unroll
    for (int i = 0; i < 2; ++i) { int R, C; stage_rc(tid * 16 + i * 8192, R, C); const int Rb = (R & ~31) + perm32(R & 31);
        voffA[i] = (unsigned)(R * g.lda + C) * 2u; voffB[i] = (unsigned)(Rb * g.ldb + C) * 2u; }
    const size_t kstep = (size_t)(BK * 2);
    const size_t hstepA = (size_t)HALF * g.lda * 2, hstepB = (size_t)HALF * g.ldb * 2;
    const unsigned ldsw = (unsigned)wid * 1024u;
    const int aoff = lds_byte(wr * 64 + fr, fq * 8), boff = lds_byte(wc * 32 + fr, fq * 8);
#define PG8_SA(b, h) (((b) * 2 + (h)) * HTB)
#define PG8_SB(b, h) ((4 + (b) * 2 + (h)) * HTB)
#define PG8_STAGE(bufoff, gbase, voff) do { _Pragma("unroll") for (int _i = 0; _i < 2; ++_i) \
        __builtin_amdgcn_global_load_lds((const unsigned*)((const char*)(gbase) + (voff)[_i]), (LAS unsigned*)(lds + (bufoff) + ldsw + _i * 8192), 16, 0, 0); } while (0)
#define PG8_LDA(dst, b, h) do { _Pragma("unroll") for (int m = 0; m < 4; ++m) _Pragma("unroll") for (int k = 0; k < 2; ++k) dst[m][k] = *(const LAS bf16x8*)(lds + PG8_SA(b, h) + aoff + m * 2048 + k * 1024); } while (0)
#define PG8_LDB(dst, b, h) do { _Pragma("unroll") for (int n = 0; n < 2; ++n) _Pragma("unroll") for (int k = 0; k < 2; ++k) dst[n][k] = *(const LAS bf16x8*)(lds + PG8_SB(b, h) + boff + n * 2048 + k * 1024); } while (0)
#define PG8_MMA(ai, bj, At, Bt) do { __builtin_amdgcn_s_setprio(1); _Pragma("unroll") for (int m = 0; m < 4; ++m) _Pragma("unroll") for (int n = 0; n < 2; ++n) _Pragma("unroll") for (int k = 0; k < 2; ++k) \
        acc[ai][bj][m][n] = __builtin_amdgcn_mfma_f32_16x16x32_bf16(Bt[n][k], At[m][k], acc[ai][bj][m][n], 0, 0, 0); __builtin_amdgcn_s_setprio(0); } while (0)
#define PG8_WAIT_V(n) asm volatile("s_waitcnt vmcnt(" #n ")" ::: "memory")
#define PG8_WAIT_L(n) asm volatile("s_waitcnt lgkmcnt(" #n ")" ::: "memory")
#define PG8_BAR __builtin_amdgcn_s_barrier()
#define PG8_SCHED __builtin_amdgcn_sched_barrier(0)
    Unit cur, nxt; int ui = 0;
    if (!S.next(0, cur)) return;
    f32x4 acc[2][2][4][2];
#pragma unroll
    for (int a = 0; a < 2; ++a)
#pragma unroll
        for (int b = 0; b < 2; ++b)
#pragma unroll
            for (int m = 0; m < 4; ++m)
#pragma unroll
                for (int n = 0; n < 2; ++n) acc[a][b][m][n] = (f32x4){0.f, 0.f, 0.f, 0.f};
    bf16x8 At[4][2], B0[2][2], B1[2][2];
    const char* cA = cur.A; const char* cB = cur.B; const char* cBhi = cur.Bhi;
    if constexpr (SP2) {
        PG8_STAGE(PG8_SB(0, 0), cB, voffB); PG8_STAGE(PG8_SB(0, 1), cB + hstepB, voffB); PG8_STAGE(PG8_SA(0, 0), cA, voffA); PG8_STAGE(PG8_SA(0, 1), cA + hstepA, voffA);
        if (wr == 1) PG8_BAR;
        PG8_WAIT_V(2); PG8_BAR;
        PG8_STAGE(PG8_SB(1, 0), cB + kstep, voffB); PG8_STAGE(PG8_SA(1, 0), cA + kstep, voffA); PG8_STAGE(PG8_SB(1, 1), cB + hstepB + kstep, voffB);
        PG8_WAIT_V(6); PG8_BAR;
    } else {
        PG8_STAGE(PG8_SB(0, 0), cB, voffB); PG8_STAGE(PG8_SA(0, 0), cA, voffA); PG8_STAGE(PG8_SB(0, 1), cB + hstepB, voffB); PG8_STAGE(PG8_SA(0, 1), cA + hstepA, voffA);
        if (wr == 1) PG8_BAR;
        PG8_WAIT_V(4); PG8_BAR;
        PG8_STAGE(PG8_SB(1, 0), cB + kstep, voffB); PG8_STAGE(PG8_SA(1, 0), cA + kstep, voffA); PG8_STAGE(PG8_SB(1, 1), cB + hstepB + kstep, voffB);
        PG8_WAIT_V(6); PG8_BAR;
    }
    for (;;) {
        const bool has_next = S.next(ui + 1, nxt);
        const char* nA = has_next ? nxt.A : cA; const char* nB = has_next ? nxt.B : cB;
        for (int t = 0; t < nt; t += 2) {
            const bool last = (t == nt - 2);
            if constexpr (Epi::HOOK) { if (t == Epi::HOOK_T1 || t == Epi::HOOK_T2) E.hook(acc, cur, t, wr, wc, fr, fq); }
            const char* a1 = cA + (size_t)(t + 1) * kstep;
            const char* a2 = last ? nA : cA + (size_t)(t + 2) * kstep;
            const char* b2 = last ? nB : ((t + 2) < g.ksplit ? cB : cBhi) + (size_t)(t + 2) * kstep;
            const char* a3 = a2 + kstep; const char* b3 = b2 + kstep;
            if constexpr (SP2) {
            PG8_LDB(B0, 0, 0); PG8_LDB(B1, 0, 1); PG8_SCHED; PG8_LDA(At, 0, 0); PG8_STAGE(PG8_SA(1, 1), a1 + hstepA, voffA);
            PG8_WAIT_V(8); PG8_WAIT_L(0); PG8_BAR; PG8_MMA(0, 0, At, B0); PG8_MMA(0, 1, At, B1); PG8_BAR; PG8_SCHED;
            PG8_LDA(At, 0, 1); PG8_STAGE(PG8_SB(0, 0), b2, voffB); PG8_STAGE(PG8_SB(0, 1), b2 + hstepB, voffB); PG8_STAGE(PG8_SA(0, 0), a2, voffA);
            PG8_WAIT_V(8); PG8_WAIT_L(0); PG8_BAR; PG8_MMA(1, 0, At, B0); PG8_MMA(1, 1, At, B1); PG8_BAR; PG8_SCHED;
            PG8_LDB(B0, 1, 0); PG8_LDB(B1, 1, 1); PG8_SCHED; PG8_LDA(At, 1, 0); PG8_STAGE(PG8_SA(0, 1), a2 + hstepA, voffA);
            PG8_WAIT_V(8); PG8_WAIT_L(0); PG8_BAR; PG8_MMA(0, 0, At, B0); PG8_MMA(0, 1, At, B1); PG8_BAR; PG8_SCHED;
            PG8_LDA(At, 1, 1); PG8_STAGE(PG8_SB(1, 0), b3, voffB); PG8_STAGE(PG8_SB(1, 1), b3 + hstepB, voffB); PG8_STAGE(PG8_SA(1, 0), a3, voffA);
            PG8_WAIT_V(8); PG8_WAIT_L(0); PG8_BAR; PG8_MMA(1, 0, At, B0); PG8_MMA(1, 1, At, B1); PG8_BAR; PG8_SCHED;
            } else {
            PG8_LDB(B0, 0, 0); PG8_SCHED; PG8_LDA(At, 0, 0); PG8_STAGE(PG8_SA(1, 1), a1 + hstepA, voffA);
            PG8_WAIT_L(8); PG8_BAR; PG8_WAIT_L(0); PG8_MMA(0, 0, At, B0); PG8_BAR; PG8_SCHED;
            PG8_LDB(B1, 0, 1); PG8_STAGE(PG8_SB(0, 0), b2, voffB);
            PG8_BAR; PG8_WAIT_L(0); PG8_MMA(0, 1, At, B1); PG8_BAR;
            PG8_LDA(At, 0, 1); PG8_STAGE(PG8_SA(0, 0), a2, voffA);
            PG8_BAR; PG8_WAIT_L(0); PG8_MMA(1, 0, At, B0); PG8_BAR; PG8_SCHED;
            PG8_STAGE(PG8_SB(0, 1), b2 + hstepB, voffB);
            PG8_WAIT_V(6); PG8_BAR; PG8_MMA(1, 1, At, B1); PG8_BAR;
            PG8_LDB(B0, 1, 0); PG8_SCHED; PG8_LDA(At, 1, 0); PG8_STAGE(PG8_SA(0, 1), a2 + hstepA, voffA);
            PG8_WAIT_L(8); PG8_BAR; PG8_WAIT_L(0); PG8_MMA(0, 0, At, B0); PG8_BAR; PG8_SCHED;
            PG8_LDB(B1, 1, 1); PG8_STAGE(PG8_SB(1, 0), b3, voffB);
            PG8_BAR; PG8_WAIT_L(0); PG8_MMA(0, 1, At, B1); PG8_BAR;
            PG8_LDA(At, 1, 1); PG8_STAGE(PG8_SA(1, 0), a3, voffA);
            PG8_BAR; PG8_WAIT_L(0); PG8_MMA(1, 0, At, B0); PG8_BAR; PG8_SCHED;
            PG8_STAGE(PG8_SB(1, 1), b3 + hstepB, voffB);
            PG8_WAIT_V(6); PG8_BAR; PG8_MMA(1, 1, At, B1); PG8_BAR;
            }
        }
        if constexpr (ALIGN_EPI) { if (wr == 0) PG8_BAR; }
        E(acc, cur, wr, wc, fr, fq);
        if (!has_next) break;
#pragma unroll
        for (int a = 0; a < 2; ++a)
#pragma unroll
            for (int b = 0; b < 2; ++b)
#pragma unroll
                for (int m = 0; m < 4; ++m)
#pragma unroll
                    for (int n = 0; n < 2; ++n) acc[a][b][m][n] = (f32x4){0.f, 0.f, 0.f, 0.f};
        cur = nxt; cA = nA; cB = nB; cBhi = nxt.Bhi; ++ui;
        if constexpr (ALIGN_EPI) { if (wr == 1) PG8_BAR; }
    }
    PG8_WAIT_V(0);
    if constexpr (!ALIGN_EPI) { if (wr == 0) PG8_BAR; }
    PG8_BAR;
#undef PG8_SA
#undef PG8_SB
#undef PG8_STAGE
#undef PG8_LDA
#undef PG8_LDB
#undef PG8_MMA
#undef PG8_WAIT_V
#undef PG8_WAIT_L
#undef PG8_BAR
#undef PG8_SCHED
}
}

constexpr int RING_BYTES = 131072, LDSCTL_OFF = RING_BYTES, MISC_OFF = LDSCTL_OFF + 320, LDS_BYTES = 147456;
struct KArgs { const void* in[24]; float* out; unsigned char* ws; int ph_lo, ph_hi; };
struct Frame {
    LAS unsigned char* lds; volatile LAS unsigned* MISC; unsigned* ctl; unsigned char* ws; float* out;
    int tid, lane, wave, vcu, G;
    const float *x, *mem, *g_mix, *w_in, *b_gate, *w_pool_grp, *pool_scale, *q_norm_g, *k_norm_g, *g_mem, *w_mem_kv, *xq_norm_g, *xk_norm_g,
                *w_pool_out, *w_attn_out, *w_cross_out, *w_o, *g_ffn, *w_rg, *w_re, *w_eg, *w_eu, *w_ed;
    const int* positions;
};
template <class T> __device__ __forceinline__ T* wsp(const Frame& F, size_t off) { return (T*)(F.ws + off); }

__device__ __forceinline__ void tr_item(const float* W, int ldw, int k0, int n0, int nvalid, const float* gain, bf16_t* dst, int ldd, int dk0, LAS float* scr, int lane) {
    const int nn = lane & 31; const bool ok = nn < nvalid;
#pragma unroll 8
    for (int i = 0; i < 32; ++i) { const int kk = 2 * i + (lane >> 5); float v = ok ? W[(size_t)(k0 + kk) * ldw + n0 + nn] : 0.f; if (gain) v *= gain[k0 + kk]; scr[kk * 33 + nn] = v; }
    LDS_WAIT(); asm volatile("" ::: "memory");
    const int c = lane & 7;
#pragma unroll
    for (int j = 0; j < 4; ++j) { const int n = (lane >> 3) + 8 * j; const LAS float* s = scr + (8 * c) * 33 + n;
        u32x4 o; o.x = pk2(s[0 * 33], s[1 * 33]); o.y = pk2(s[2 * 33], s[3 * 33]); o.z = pk2(s[4 * 33], s[5 * 33]); o.w = pk2(s[6 * 33], s[7 * 33]);
        *(u32x4*)(dst + (size_t)n * ldd + dk0 + k0 + 8 * c) = o; }
    LDS_WAIT(); asm volatile("" ::: "memory");
}
__device__ __forceinline__ void row_to_bf16(const float* xrow, bf16_t* orow, float* rstd_out, int lane) {
    const f32x4* xr = (const f32x4*)xrow + lane;
    f32x4 v[8]; float s = 0.f;
#pragma unroll
    for (int j = 0; j < 8; ++j) { v[j] = xr[64 * j]; s += (v[j].x * v[j].x + v[j].y * v[j].y) + (v[j].z * v[j].z + v[j].w * v[j].w); }
    s = wave_sum(s);
    u32x2* o8 = (u32x2*)orow + lane;
#pragma unroll
    for (int j = 0; j < 8; ++j) { u32x2 w; w.x = pk2(v[j].x, v[j].y); w.y = pk2(v[j].z, v[j].w); o8[64 * j] = w; }
    if (lane == 0) *rstd_out = 1.0f / sqrtf(s * (1.0f / DM) + NORM_EPS);
}
__device__ __forceinline__ void p0_prologue(Frame& F) {
    LAS float* scr = (LAS float*)(F.lds + F.wave * 16384);
    const int gw = F.vcu * NWAVES + F.wave, NGW = F.G * NWAVES;
    bf16_t* WINT = wsp<bf16_t>(F, WS_WINT); bf16_t* WVT = wsp<bf16_t>(F, WS_WVT); bf16_t* WMKVT = wsp<bf16_t>(F, WS_WMKVT);
    bf16_t* BTMRG = wsp<bf16_t>(F, WS_BTMRG); bf16_t* WOT = wsp<bf16_t>(F, WS_WOT);
    for (int it = F.vcu; it < 4 * 24 * 4; it += F.G) {
        const int g = it / 96, r = it % 96, cb = r / 4, db = r % 4, c0 = cb * 8, d = db * 512 + F.tid;
        float acc[8];
#pragma unroll
        for (int c = 0; c < 8; ++c) acc[c] = 0.f;
        const float* wpg = F.w_pool_grp + (size_t)g * 192 * 192 + (size_t)c0 * 192;
        for (int j = 0; j < 192; ++j) {
            const float wv = F.w_pool_out[(size_t)(g * 192 + j) * DM + d] * F.pool_scale[g * 192 + j];
#pragma unroll
            for (int c = 0; c < 8; ++c) acc[c] += wpg[c * 192 + j] * wv;
        }
        u32x4 o; o.x = pk2(acc[0], acc[1]); o.y = pk2(acc[2], acc[3]); o.z = pk2(acc[4], acc[5]); o.w = pk2(acc[6], acc[7]);
        *(u32x4*)(BTMRG + (size_t)d * DM + g * 192 + c0) = o;
    }
    constexpr int NB_IN = 315, I_IN = 32 * NB_IN, I_MKV = 32 * 32, I_WO = 32 * 64, I_AO = 12 * 64, I_CO = 8 * 64;
    constexpr int NITEMS = I_IN + I_MKV + I_WO + I_AO + I_CO;
    for (int it = gw; it < NITEMS; it += NGW) {
        int r = it;
        if (r < I_IN) {
            const int kb = r / NB_IN, nb = r % NB_IN; int sc0, drow, nv = 32; bf16_t* dm = WINT; int j;
            if (nb < 24) { j = nb; sc0 = 0; drow = 0; }
            else if (nb < 48) { j = nb - 24; sc0 = 768; drow = 768; }
            else if (nb < 72) { j = nb - 48; sc0 = 1536; drow = 1536; }
            else if (nb < 96) { j = nb - 72; sc0 = 2304; drow = 0; dm = WVT; }
            else if (nb < 104) { j = nb - 96; sc0 = 3072; drow = 2304; }
            else if (nb < 107) { j = nb - 104; sc0 = 3328; drow = 2560; if (j == 2) nv = 4; }
            else if (nb < 123) { j = nb - 107; sc0 = 3396; drow = 2816; }
            else { j = nb - 123; sc0 = 3908; drow = 3328; }
            tr_item(F.w_in, INC, kb * 64, sc0 + 32 * j, nv, F.g_mix, dm + (size_t)(drow + 32 * j) * DM, DM, 0, scr, F.lane); continue; }
        r -= I_IN;
        if (r < I_MKV) { const int kb = r / 32, nb = r % 32; tr_item(F.w_mem_kv, 1024, kb * 64, nb * 32, 32, F.g_mem, WMKVT + (size_t)(nb * 32) * DM, DM, 0, scr, F.lane); continue; }
        r -= I_MKV;
        if (r < I_WO) { const int kb = r / 64, nb = r % 64; tr_item(F.w_o, DM, kb * 64, nb * 32, 32, nullptr, WOT + (size_t)(nb * 32) * DM, DM, 0, scr, F.lane); continue; }
        r -= I_WO;
        if (r < I_AO) { const int kb = r / 64, nb = r % 64; tr_item(F.w_attn_out, DM, kb * 64, nb * 32, 32, nullptr, BTMRG + (size_t)(nb * 32) * DM, DM, 768, scr, F.lane); continue; }
        r -= I_AO;
        { const int kb = r / 64, nb = r % 64; tr_item(F.w_cross_out, DM, kb * 64, nb * 32, 32, nullptr, BTMRG + (size_t)(nb * 32) * DM, DM, 1536, scr, F.lane); }
    }
    { u32x4* z = (u32x4*)(WINT + (size_t)2656 * DM); const int n16 = 160 * DM * 2 / 16;
      for (int i = F.vcu * NTHR + F.tid; i < n16; i += F.G * NTHR) z[i] = (u32x4){0u, 0u, 0u, 0u}; }
    { float* WR = wsp<float>(F, WS_WR);
      for (int i = F.vcu * NTHR + F.tid; i < DM * 32; i += F.G * NTHR) { const int k = i >> 5, j = i & 31;
          float v = 0.f; if (j < 4) v = F.w_rg[k * 4 + j]; else if (j < 20) v = F.w_re[k * 16 + (j - 4)];
          WR[i] = v * F.g_ffn[k]; } }
    { bf16_t* XB = wsp<bf16_t>(F, WS_XB); float* R1 = wsp<float>(F, WS_RSTD1); bf16_t* MB = wsp<bf16_t>(F, WS_MEMB); float* RM = wsp<float>(F, WS_RSTDM);
      for (int m = gw; m < SEQ + MEML; m += NGW) {
          if (m < SEQ) row_to_bf16(F.x + (size_t)m * DM, XB + (size_t)m * DM, R1 + m, F.lane);
          else { const int mm = m - SEQ; row_to_bf16(F.mem + (size_t)mm * DM, MB + (size_t)mm * DM, RM + mm, F.lane); } } }
}

struct SchedP1 {
    int c, G; unsigned char* ws;
    __device__ __forceinline__ bool next(int i, pg8::Unit& u) const {
        const int L = i * G + c; const size_t tstep = (size_t)256 * DM * 2;
        const char* XB = (const char*)(ws + WS_XB); const char* WINT = (const char*)(ws + WS_WINT); const char* WVT = (const char*)(ws + WS_WVT); const char* MEMB = (const char*)(ws + WS_MEMB); const char* WMKVT = (const char*)(ws + WS_WMKVT);
        if (L < 1184) { int pm, pn; pg8::tile_order(L, 32, 37, pm, pn);
            u.A = XB + (size_t)pm * tstep; u.B = WINT + (size_t)pn * tstep; u.Bhi = u.B; u.row0 = pm * 256;
            if (pn < 3) { u.kind = 0; u.col0 = pn * 256; u.aux = 0; }
            else if (pn < 6) { u.kind = 0; u.col0 = (pn - 3) * 256; u.aux = 1; }
            else if (pn < 9) { u.kind = 0; u.col0 = (pn - 6) * 256; u.aux = 2; }
            else if (pn < 11) { u.kind = 1; u.col0 = (pn - 9) * 256; u.aux = 0; }
            else if (pn < 13) { u.kind = 0; u.col0 = (pn - 11) * 256; u.aux = 3; }
            else { u.kind = 2; u.col0 = (pn - 13) * 256; u.aux = 0; }
            return true; }
        if (L < 1280) { const int idx = L - 1184, pm = idx / 32, pn = idx % 32;
            u.A = WVT + (size_t)pm * tstep; u.B = XB + (size_t)pn * tstep; u.Bhi = u.B; u.kind = 3; u.row0 = pm * 256; u.col0 = pn * 256; u.aux = 0; return true; }
        if (L < 1284) { const int pn = L - 1280;
            u.A = MEMB; u.B = WMKVT + (size_t)pn * tstep; u.Bhi = u.B; u.kind = 4; u.row0 = 0; u.col0 = pn * 256; u.aux = 0; return true; }
        return false;
    }
};
struct EpiP1 {
    static constexpr bool HOOK = false; static constexpr int HOOK_T1 = -1, HOOK_T2 = -1;
    unsigned char* ws; const float* rstd1; const float* rstdm; const float* bgate;
    __device__ __forceinline__ void hook(f32x4 (&)[2][2][4][2], const pg8::Unit&, int, int, int, int, int) const {}
    __device__ __forceinline__ void operator()(const f32x4 (&acc)[2][2][4][2], const pg8::Unit& u, int wr, int wc, int fr, int fq) const {
        const int rbase = u.row0 + wr * 64 + fr, cbase = u.col0 + wc * 32 + 8 * fq;
        if (u.kind == 0) {
            bf16_t* C; int ldc;
            if (u.aux == 0) { C = (bf16_t*)(ws + WS_U); ldc = 768; } else if (u.aux == 1) { C = (bf16_t*)(ws + WS_Q); ldc = 768; }
            else if (u.aux == 2) { C = (bf16_t*)(ws + WS_K); ldc = 768; } else { C = (bf16_t*)(ws + WS_XQ); ldc = 512; }
#pragma unroll
            for (int ai = 0; ai < 2; ++ai)
#pragma unroll
                for (int m = 0; m < 4; ++m) { const int row = rbase + ai * 128 + m * 16; const float s = rstd1[row];
#pragma unroll
                    for (int bj = 0; bj < 2; ++bj) { const f32x4 v0 = acc[ai][bj][m][0] * s, v1 = acc[ai][bj][m][1] * s;
                        u32x4 w; w.x = pk2(v0[0], v0[1]); w.y = pk2(v0[2], v0[3]); w.z = pk2(v1[0], v1[1]); w.w = pk2(v1[2], v1[3]);
                        *(u32x4*)(C + (size_t)row * ldc + cbase + bj * 128) = w; } }
        } else if (u.kind == 1 || u.kind == 4) {
            float* C; int ldc; const float* rs;
            if (u.kind == 1) { C = (float*)(ws + WS_IDXF); ldc = 512; rs = rstd1; } else { C = (float*)(ws + WS_KVM); ldc = 1024; rs = rstdm; }
#pragma unroll
            for (int ai = 0; ai < 2; ++ai)
#pragma unroll
                for (int m = 0; m < 4; ++m) { const int row = rbase + ai * 128 + m * 16; const float s = rs[row];
#pragma unroll
                    for (int bj = 0; bj < 2; ++bj) { float* p = C + (size_t)row * ldc + cbase + bj * 128;
                        *(f32x4*)p = acc[ai][bj][m][0] * s; *(f32x4*)(p + 4) = acc[ai][bj][m][1] * s; } }
        } else if (u.kind == 2) {
            bf16_t* C = (bf16_t*)(ws + WS_EG);
            f32x4 bv[2][2];
#pragma unroll
            for (int bj = 0; bj < 2; ++bj) { bv[bj][0] = *(const f32x4*)(bgate + cbase + bj * 128); bv[bj][1] = *(const f32x4*)(bgate + cbase + bj * 128 + 4); }
#pragma unroll
            for (int ai = 0; ai < 2; ++ai)
#pragma unroll
                for (int m = 0; m < 4; ++m) { const int row = rbase + ai * 128 + m * 16; const float s = rstd1[row];
#pragma unroll
                    for (int bj = 0; bj < 2; ++bj) { f32x4 v0 = acc[ai][bj][m][0] * s + bv[bj][0], v1 = acc[ai][bj][m][1] * s + bv[bj][1];
#pragma unroll
                        for (int e = 0; e < 4; ++e) { v0[e] = 1.0f + __builtin_amdgcn_exp2f(fminf(-v0[e] * LOG2E, 60.f)); v1[e] = 1.0f + __builtin_amdgcn_exp2f(fminf(-v1[e] * LOG2E, 60.f)); }
                        u32x4 w; w.x = pk2(v0[0], v0[1]); w.y = pk2(v0[2], v0[3]); w.z = pk2(v1[0], v1[1]); w.w = pk2(v1[2], v1[3]);
                        *(u32x4*)(C + (size_t)row * 6144 + cbase + bj * 128) = w; } }
        } else {
            bf16_t* C = (bf16_t*)(ws + WS_VT);
            f32x4 sv[2][2];
#pragma unroll
            for (int bj = 0; bj < 2; ++bj) { sv[bj][0] = *(const f32x4*)(rstd1 + cbase + bj * 128); sv[bj][1] = *(const f32x4*)(rstd1 + cbase + bj * 128 + 4); }
#pragma unroll
            for (int ai = 0; ai < 2; ++ai)
#pragma unroll
                for (int m = 0; m < 4; ++m) { const int row = rbase + ai * 128 + m * 16;
#pragma unroll
                    for (int bj = 0; bj < 2; ++bj) { const f32x4 v0 = acc[ai][bj][m][0] * sv[bj][0], v1 = acc[ai][bj][m][1] * sv[bj][1];
                        u32x4 w; w.x = pk2(v0[0], v0[1]); w.y = pk2(v0[2], v0[3]); w.z = pk2(v1[0], v1[1]); w.w = pk2(v1[2], v1[3]);
                        *(u32x4*)(C + (size_t)row * SEQ + cbase + bj * 128) = w; } }
        }
    }
};

__device__ __forceinline__ void rot_cs(float pos, float inv_freq, float& c, float& s) {
    const float ang = pos * inv_freq;
    const double rev = (double)ang * 0.15915494309189535;
    const float fr = (float)(rev - __builtin_rint(rev));
    c = __builtin_amdgcn_cosf(fr); s = __builtin_amdgcn_sinf(fr);
}
__device__ __forceinline__ void p2_rowpass(Frame& F) {
    const int gw = F.vcu * NWAVES + F.wave, NGW = F.G * NWAVES, lane = F.lane;
    const bf16_t* U = wsp<bf16_t>(F, WS_U); bf16_t* AM = wsp<bf16_t>(F, WS_AMRG);
    bf16_t* Q = wsp<bf16_t>(F, WS_Q); bf16_t* K = wsp<bf16_t>(F, WS_K); bf16_t* XQ = wsp<bf16_t>(F, WS_XQ);
    const float* IDXF = wsp<float>(F, WS_IDXF); bf16_t* QIB = wsp<bf16_t>(F, WS_QIB); bf16_t* KIB = wsp<bf16_t>(F, WS_KIB); float* WIF = wsp<float>(F, WS_WIF);
    const float if128 = __builtin_amdgcn_exp2f(-(float)(2 * lane) * (13.287712379549449f / 128.0f));
    const float if64 = __builtin_amdgcn_exp2f(-(float)(2 * (lane & 31)) * (13.287712379549449f / 64.0f));
    const float gq0 = F.q_norm_g[lane], gq1 = F.q_norm_g[lane + 64], gk0 = F.k_norm_g[lane], gk1 = F.k_norm_g[lane + 64], gx0 = F.xq_norm_g[lane], gx1 = F.xq_norm_g[lane + 64];
    for (int t = gw; t < SEQ; t += NGW) {
#pragma unroll
        for (int pass = 0; pass < 2; ++pass) {
            const int col = pass * 512 + 8 * lane;
            if (col < 768) {
                const int g = col / 192, w = 2 << g; const int cnt = (t + 1 < w) ? (t + 1) : w;
                float sum[8];
#pragma unroll
                for (int e = 0; e < 8; ++e) sum[e] = 0.f;
                u32x4 cur = (u32x4){0u, 0u, 0u, 0u};
                for (int j = 0; j < cnt; ++j) { const u32x4 v = *(const u32x4*)(U + (size_t)(t - j) * 768 + col); if (j == 0) cur = v;
                    sum[0] += bflo(v.x); sum[1] += bfhi(v.x); sum[2] += bflo(v.y); sum[3] += bfhi(v.y); sum[4] += bflo(v.z); sum[5] += bfhi(v.z); sum[6] += bflo(v.w); sum[7] += bfhi(v.w); }
                const float inv = 1.0f / (float)cnt;
                u32x4 o;
                o.x = pk2(sum[0] * inv - bflo(cur.x), sum[1] * inv - bfhi(cur.x)); o.y = pk2(sum[2] * inv - bflo(cur.y), sum[3] * inv - bfhi(cur.y));
                o.z = pk2(sum[4] * inv - bflo(cur.z), sum[5] * inv - bfhi(cur.z)); o.w = pk2(sum[6] * inv - bflo(cur.w), sum[7] * inv - bfhi(cur.w));
                *(u32x4*)(AM + (size_t)t * DM + col) = o;
            }
        }
        const float pos = (float)F.positions[t];
        float c128, s128, c64, s64; rot_cs(pos, if128, c128, s128); rot_cs(pos, if64, c64, s64);
#pragma unroll
        for (int h = 0; h < 6; ++h) {
            bf16_t* qp = Q + (size_t)t * 768 + h * 128; bf16_t* kp = K + (size_t)t * 768 + h * 128;
            const float q0 = bf2f(qp[lane]), q1 = bf2f(qp[lane + 64]), k0 = bf2f(kp[lane]), k1 = bf2f(kp[lane + 64]);
            const float qs = wave_sum(q0 * q0 + q1 * q1), ks = wave_sum(k0 * k0 + k1 * k1);
            const float qr = (1.0f / sqrtf(qs * (1.0f / 128.0f) + NORM_EPS)) * (ATT_SCALE * LOG2E), kr = 1.0f / sqrtf(ks * (1.0f / 128.0f) + NORM_EPS);
            const float a0 = q0 * qr * gq0, a1 = q1 * qr * gq1, b0 = k0 * kr * gk0, b1 = k1 * kr * gk1;
            qp[lane] = (bf16_t)f2bf(a0 * c128 - a1 * s128); qp[lane + 64] = (bf16_t)f2bf(a1 * c128 + a0 * s128);
            kp[lane] = (bf16_t)f2bf(b0 * c128 - b1 * s128); kp[lane + 64] = (bf16_t)f2bf(b1 * c128 + b0 * s128);
        }
#pragma unroll
        for (int h = 0; h < 4; ++h) {
            bf16_t* xp = XQ + (size_t)t * 512 + h * 128;
            const float x0 = bf2f(xp[lane]), x1 = bf2f(xp[lane + 64]);
            const float xs = wave_sum(x0 * x0 + x1 * x1);
            const float xr = (1.0f / sqrtf(xs * (1.0f / 128.0f) + NORM_EPS)) * (ATT_SCALE * LOG2E);
            xp[lane] = (bf16_t)f2bf(x0 * xr * gx0); xp[lane + 64] = (bf16_t)f2bf(x1 * xr * gx1);
        }
        const float* ip = IDXF + (size_t)t * 512;
#pragma unroll
        for (int pp = 0; pp < 2; ++pp) { const int p = lane + 64 * pp, hh = p >> 5, i = p & 31;
            const float a0 = ip[hh * 64 + i], a1 = ip[hh * 64 + i + 32];
            QIB[(size_t)t * 256 + hh * 64 + i] = (bf16_t)f2bf(a0 * c64 - a1 * s64); QIB[(size_t)t * 256 + hh * 64 + i + 32] = (bf16_t)f2bf(a1 * c64 + a0 * s64); }
        if (lane < 32) { const float a0 = ip[256 + lane], a1 = ip[256 + lane + 32];
            KIB[(size_t)t * 64 + lane] = (bf16_t)f2bf(a0 * c64 - a1 * s64); KIB[(size_t)t * 64 + lane + 32] = (bf16_t)f2bf(a1 * c64 + a0 * s64); }
        if (lane < 4) WIF[t * 4 + lane] = ip[320 + lane] * 0.0625f;
    }
    { const float* KVM = wsp<float>(F, WS_KVM); bf16_t* KMB = wsp<bf16_t>(F, WS_KMB); bf16_t* VMT = wsp<bf16_t>(F, WS_VMT);
      const float g0 = F.xk_norm_g[lane], g1 = F.xk_norm_g[lane + 64];
      for (int m = gw; m < MEML; m += NGW) {
#pragma unroll
          for (int h = 0; h < 4; ++h) { const float k0 = KVM[(size_t)m * 1024 + h * 128 + lane], k1 = KVM[(size_t)m * 1024 + h * 128 + lane + 64];
              const float ks = wave_sum(k0 * k0 + k1 * k1), kr = 1.0f / sqrtf(ks * (1.0f / 128.0f) + NORM_EPS);
              KMB[(size_t)m * 512 + h * 128 + lane] = (bf16_t)f2bf(k0 * kr * g0); KMB[(size_t)m * 512 + h * 128 + lane + 64] = (bf16_t)f2bf(k1 * kr * g1); }
#pragma unroll
          for (int j = 0; j < 8; ++j) { const int c = j * 64 + lane; VMT[(size_t)c * 256 + m] = (bf16_t)f2bf(KVM[(size_t)m * 1024 + 512 + c]); }
      } }
    { LAS float* scr = (LAS float*)(F.lds + F.wave * 16384);
      bf16_t* WGUT = wsp<bf16_t>(F, WS_WGUT); bf16_t* WDT = wsp<bf16_t>(F, WS_WDT);
      constexpr int I_GU = 16 * 2 * 32 * 16, I_D = 16 * 8 * 64;
      for (int it = gw; it < I_GU + I_D; it += NGW) {
          if (it < I_GU) { const int e = it / 1024, r = it % 1024, up = r / 512, r2 = r % 512, kb = r2 / 16, nb = r2 % 16, f0 = nb * 32;
              const float* W = (up ? F.w_eu : F.w_eg) + (size_t)e * DM * 512;
              const int drow = (f0 / 128) * 256 + up * 128 + (f0 % 128);
              tr_item(W, 512, kb * 64, f0, 32, F.g_ffn, WGUT + ((size_t)e * 1024 + drow) * DM, DM, 0, scr, lane); }
          else { const int r = it - I_GU, e = r / 512, r2 = r % 512, kb = r2 / 64, nb = r2 % 64;
              tr_item(F.w_ed + (size_t)e * 512 * DM, DM, kb * 64, nb * 32, 32, nullptr, WDT + ((size_t)e * DM + nb * 32) * 512, 512, 0, scr, lane); }
      } }
}

constexpr int HS = 1025;
constexpr int P3_HIST = 0, P3_LMASK = 16 * HS * 4, P3_PART = P3_LMASK + 16 * 256 * 4, P3_STATE = P3_PART + 16 * 32 * 4;
template <int MODE> __device__ __forceinline__ void p3_sweep(Frame& F, int b, const bf16x8 (&Bq)[4][2], const float (&wq)[4], unsigned pref, unsigned thr, unsigned idxs, bool part) {
    const bf16_t* KIB = wsp<bf16_t>(F, WS_KIB);
    LAS unsigned* hist = (LAS unsigned*)(F.lds + P3_HIST); LAS unsigned* lmask = (LAS unsigned*)(F.lds + P3_LMASK);
    const int lane = F.lane, q = lane & 15, fq = lane >> 4;
    for (int kt = F.wave; kt <= b; kt += NWAVES) {
        const int s0 = 16 * kt;
        const bf16x8 A0 = *(const bf16x8*)(KIB + (size_t)(s0 + q) * 64 + 8 * fq), A1 = *(const bf16x8*)(KIB + (size_t)(s0 + q) * 64 + 32 + 8 * fq);
        float sc[4] = {0.f, 0.f, 0.f, 0.f};
#pragma unroll
        for (int h = 0; h < 4; ++h) { f32x4 d = (f32x4){0.f, 0.f, 0.f, 0.f};
            d = __builtin_amdgcn_mfma_f32_16x16x32_bf16(A0, Bq[h][0], d, 0, 0, 0); d = __builtin_amdgcn_mfma_f32_16x16x32_bf16(A1, Bq[h][1], d, 0, 0, 0);
#pragma unroll
            for (int i = 0; i < 4; ++i) sc[i] = __builtin_fmaf(wq[h], fmaxf(d[i], 0.f), sc[i]); }
        unsigned nib = 0u;
#pragma unroll
        for (int i = 0; i < 4; ++i) {
            const unsigned bits = __builtin_bit_cast(unsigned, sc[i]);
            const unsigned key = bits ^ ((unsigned)((int)bits >> 31) | 0x80000000u);
            const bool valid = (kt < b) || (4 * fq + i <= q);
            const unsigned s = (unsigned)(s0 + 4 * fq + i);
            if constexpr (MODE == 0) { if (valid && part) { const unsigned dg = key >> 21; __hip_atomic_fetch_add(&hist[q * HS + (dg >> 1)], 1u << (16 * (dg & 1u)), __ATOMIC_RELAXED, __HIP_MEMORY_SCOPE_WORKGROUP); } }
            else if constexpr (MODE == 1) { if (valid && part && (key >> 21) == pref) { const unsigned dg = (key >> 10) & 2047u; __hip_atomic_fetch_add(&hist[q * HS + (dg >> 1)], 1u << (16 * (dg & 1u)), __ATOMIC_RELAXED, __HIP_MEMORY_SCOPE_WORKGROUP); } }
            else if constexpr (MODE == 2) { if (valid && part && (key >> 10) == pref) { const unsigned dg = key & 1023u; __hip_atomic_fetch_add(&hist[q * HS + (dg >> 1)], 1u << (16 * (dg & 1u)), __ATOMIC_RELAXED, __HIP_MEMORY_SCOPE_WORKGROUP); } }
            else if constexpr (MODE == 3) { if (valid && part && key == thr) { const unsigned dg = s >> 2; __hip_atomic_fetch_add(&hist[q * HS + (dg >> 1)], 1u << (16 * (dg & 1u)), __ATOMIC_RELAXED, __HIP_MEMORY_SCOPE_WORKGROUP); } }
            else if constexpr (MODE == 4) { if (valid && part && key == thr && (s >> 2) == pref) { const unsigned dg = s & 3u; __hip_atomic_fetch_add(&hist[q * HS + (dg >> 1)], 1u << (16 * (dg & 1u)), __ATOMIC_RELAXED, __HIP_MEMORY_SCOPE_WORKGROUP); } }
            else { const bool sel = valid && (key > thr || (key == thr && s <= idxs)); nib |= sel ? (1u << i) : 0u; }
        }
        if constexpr (MODE == 5) { if (nib) __hip_atomic_fetch_or(&lmask[q * 256 + (kt >> 1)], nib << (16 * (kt & 1) + 4 * fq), __ATOMIC_RELAXED, __HIP_MEMORY_SCOPE_WORKGROUP); }
    }
}
__device__ __forceinline__ void p3_scan(Frame& F, bool fromtop) {
    LAS unsigned* hist = (LAS unsigned*)(F.lds + P3_HIST); LAS unsigned* partb = (LAS unsigned*)(F.lds + P3_PART); LAS unsigned* st = (LAS unsigned*)(F.lds + P3_STATE);
    __syncthreads();
    { const int row = F.tid >> 5, j = F.tid & 31; unsigned s = 0;
      for (int w = 0; w < 32; ++w) { const unsigned v = hist[row * HS + 32 * j + w]; s += (v & 0xffffu) + (v >> 16); }
      partb[row * 32 + j] = s; }
    __syncthreads();
    if (F.tid < 16) { const int row = F.tid; const unsigned rank = st[row * 4 + 1];
        if (st[row * 4 + 3]) {
            unsigned cum = 0; int jc = -1;
            for (int jj = 0; jj < 32; ++jj) { const int j = fromtop ? 31 - jj : jj; const unsigned p = partb[row * 32 + j]; if (cum + p >= rank) { jc = j; break; } cum += p; }
            unsigned bin = 0, cb = 0;
            if (jc >= 0) { for (int ii = 0; ii < 64; ++ii) { const int bn = fromtop ? (64 * jc + 63 - ii) : (64 * jc + ii); const unsigned v = hist[row * HS + (bn >> 1)]; const unsigned c = (bn & 1) ? (v >> 16) : (v & 0xffffu);
                    if (cum + c >= rank) { bin = (unsigned)bn; cb = c; break; } cum += c; } }
            st[row * 4 + 0] = bin; st[row * 4 + 1] = rank - cum; st[row * 4 + 2] = cb;
        } }
    __syncthreads();
}
__device__ __forceinline__ void p3_zero_hist(Frame& F) {
    LAS unsigned* hist = (LAS unsigned*)(F.lds + P3_HIST);
    for (int i = F.tid; i < 16 * HS; i += NTHR) hist[i] = 0u;
}
__device__ __forceinline__ void p3_block(Frame& F, int b) {
    const bf16_t* QIB = wsp<bf16_t>(F, WS_QIB); const float* WIF = wsp<float>(F, WS_WIF); unsigned* MASK = wsp<unsigned>(F, WS_MASK);
    LAS unsigned* lmask = (LAS unsigned*)(F.lds + P3_LMASK); LAS unsigned* st = (LAS unsigned*)(F.lds + P3_STATE);
    const int lane = F.lane, q = lane & 15, fq = lane >> 4, t0 = 16 * b;
    bf16x8 Bq[4][2]; float wq[4];
#pragma unroll
    for (int h = 0; h < 4; ++h) { Bq[h][0] = *(const bf16x8*)(QIB + (size_t)(t0 + q) * 256 + h * 64 + 8 * fq); Bq[h][1] = *(const bf16x8*)(QIB + (size_t)(t0 + q) * 256 + h * 64 + 32 + 8 * fq); wq[h] = WIF[(t0 + q) * 4 + h]; }
    __syncthreads();
    for (int i = F.tid; i < 16 * 256; i += NTHR) lmask[i] = 0u;
    unsigned thr = 0u, idxs = 0x7fffffffu;
    if (b >= 16) {
        p3_zero_hist(F);
        if (F.tid < 16) { st[F.tid * 4 + 0] = 0u; st[F.tid * 4 + 1] = 256u; st[F.tid * 4 + 2] = 0u; st[F.tid * 4 + 3] = 1u; }
        __syncthreads();
        p3_sweep<0>(F, b, Bq, wq, 0u, 0u, 0u, true); p3_scan(F, true);
        unsigned pref = st[q * 4 + 0];
        __syncthreads(); p3_zero_hist(F); __syncthreads();
        p3_sweep<1>(F, b, Bq, wq, pref, 0u, 0u, true); p3_scan(F, true);
        pref = (pref << 11) | st[q * 4 + 0];
        __syncthreads(); p3_zero_hist(F); __syncthreads();
        p3_sweep<2>(F, b, Bq, wq, pref, 0u, 0u, true); p3_scan(F, true);
        thr = (pref << 10) | st[q * 4 + 0];
        const unsigned quota = st[q * 4 + 1], cnteq = st[q * 4 + 2];
        const bool tie = cnteq > quota;
        __syncthreads();
        if (F.tid == 0) st[64] = 0u;
        __syncthreads();
        if (tie && fq == 0) st[64] = 1u;
        if (F.tid < 16) st[F.tid * 4 + 3] = (st[F.tid * 4 + 2] > st[F.tid * 4 + 1]) ? 1u : 0u;
        __syncthreads();
        if (st[64]) {
            p3_zero_hist(F); __syncthreads();
            p3_sweep<3>(F, b, Bq, wq, 0u, thr, 0u, tie); p3_scan(F, false);
            const unsigned ip = st[q * 4 + 0];
            __syncthreads(); p3_zero_hist(F); __syncthreads();
            p3_sweep<4>(F, b, Bq, wq, ip, thr, 0u, tie); p3_scan(F, false);
            if (tie) idxs = (ip << 2) | st[q * 4 + 0];
        }
    }
    __syncthreads();
    p3_sweep<5>(F, b, Bq, wq, 0u, thr, idxs, true);
    __syncthreads();
    { const int row = F.tid >> 5, j = F.tid & 31, nwords = 8 * (t0 / 256 + 1);
      for (int w = j; w < nwords; w += 32) MASK[(size_t)(t0 + row) * 256 + w] = lmask[row * 256 + w]; }
}
__device__ __forceinline__ void p3_indexer(Frame& F) {
    for (int u = F.vcu; u < 256; u += F.G) { p3_block(F, u); p3_block(F, 511 - u); }
    __syncthreads();
}

constexpr int N_SELF_UNITS = 480, N_ATT_UNITS = 608;
constexpr size_t SLOT_FLOATS = 256 * 128 + 512;
__device__ __forceinline__ int cum_chunks(int qb) { const int n1 = qb, a = n1 >> 3, bb = n1 & 7; return 4 * a * (a + 1) + bb * (a + 1); }
__device__ __forceinline__ void att_decode(int idx, int& type, int& h, int& qb, int& ch, int& nsteps) {
    if (idx < 312) { h = idx / 52; const int j = idx % 52; int n;
        if (j < 8) { n = 8 + j; ch = 0; } else if (j < 24) { const int jj = j - 8; n = 16 + jj / 2; ch = jj % 2; } else if (j < 48) { const int jj = j - 24; n = 24 + jj / 3; ch = jj % 3; } else { n = 32; ch = j - 48; }
        qb = n - 1; nsteps = 64; type = 0; return; }
    if (idx < 480) { const int p = idx - 312, rr = 7 - p / 24, pp = p % 24; h = pp / 4; const int m = pp % 4; const int n = 8 * m + rr; qb = n - 1; ch = m; nsteps = 8 * rr; type = 0; return; }
    const int c = idx - 480; h = c / 32; qb = c % 32; ch = 0; nsteps = 8; type = 1;
}
template <bool MASKED>
__device__ __forceinline__ void attn_unit(const bf16_t* Qh, int ldq, const bf16_t* Kh, int ldk, const bf16_t* Vth, int ldvt, const unsigned* mask, int q0, int key0, int nsteps, float* slot, int wave, int lane) {
    const int q = lane & 31, hh = lane >> 5, qrow = q0 + 32 * wave + q;
    bf16x8 qf[8];
#pragma unroll
    for (int d0 = 0; d0 < 8; ++d0) qf[d0] = *(const bf16x8*)(Qh + (size_t)qrow * ldq + 16 * d0 + 8 * hh);
    f32x16 o[4];
#pragma unroll
    for (int d = 0; d < 4; ++d)
#pragma unroll
        for (int r = 0; r < 16; ++r) o[d][r] = 0.f;
    float l = 0.f;
    for (int st = 0; st < nsteps; ++st) {
        const int s0 = key0 + 32 * st;
        f32x16 sT;
#pragma unroll
        for (int r = 0; r < 16; ++r) sT[r] = 0.f;
        const bf16_t* kp = Kh + (size_t)(s0 + q) * ldk + 8 * hh;
#pragma unroll
        for (int d0 = 0; d0 < 8; ++d0) { const bf16x8 kf = *(const bf16x8*)(kp + 16 * d0); sT = __builtin_amdgcn_mfma_f32_32x32x16_bf16(kf, qf[d0], sT, 0, 0, 0); }
        unsigned mw = 0xffffffffu;
        if constexpr (MASKED) mw = mask[(size_t)qrow * 256 + (s0 >> 5)] >> (4 * hh);
        float p[16];
#pragma unroll
        for (int r = 0; r < 16; ++r) { float e = __builtin_amdgcn_exp2f(sT[r]); if constexpr (MASKED) e = ((mw >> ((r & 3) + 8 * (r >> 2))) & 1u) ? e : 0.f; p[r] = e; l += e; }
        bf16x8 pf[2];
#pragma unroll
        for (int s = 0; s < 2; ++s) { u32x4 w; w.x = pk2(p[8 * s + 0], p[8 * s + 1]); w.y = pk2(p[8 * s + 2], p[8 * s + 3]); w.z = pk2(p[8 * s + 4], p[8 * s + 5]); w.w = pk2(p[8 * s + 6], p[8 * s + 7]); pf[s] = __builtin_bit_cast(bf16x8, w); }
#pragma unroll
        for (int d = 0; d < 4; ++d) { const bf16_t* vp = Vth + (size_t)(32 * d + q) * ldvt + s0 + 4 * hh;
#pragma unroll
            for (int s = 0; s < 2; ++s) { const u32x2 va = *(const u32x2*)(vp + 16 * s), vb = *(const u32x2*)(vp + 16 * s + 8);
                u32x4 w; w.x = va.x; w.y = va.y; w.z = vb.x; w.w = vb.y;
                o[d] = __builtin_amdgcn_mfma_f32_32x32x16_bf16(__builtin_bit_cast(bf16x8, w), pf[s], o[d], 0, 0, 0); } }
    }
    float* sp = slot + (size_t)wave * 4096;
#pragma unroll
    for (int d = 0; d < 4; ++d)
#pragma unroll
        for (int r = 0; r < 16; ++r) sp[(d * 16 + r) * 64 + lane] = o[d][r];
    slot[256 * 128 + wave * 64 + lane] = l;
}
__device__ __forceinline__ void p4_attention(Frame& F) {
    const bf16_t* Q = wsp<bf16_t>(F, WS_Q); const bf16_t* K = wsp<bf16_t>(F, WS_K); const bf16_t* VT = wsp<bf16_t>(F, WS_VT); const bf16_t* XQ = wsp<bf16_t>(F, WS_XQ);
    const bf16_t* KMB = wsp<bf16_t>(F, WS_KMB); const bf16_t* VMT = wsp<bf16_t>(F, WS_VMT); const unsigned* MASK = wsp<unsigned>(F, WS_MASK);
    float* OPS = F.out; float* OPX = wsp<float>(F, WS_OPX);
    LAS int* qslot = (LAS int*)(F.lds);
    for (;;) {
        __syncthreads();
        if (F.tid == 0) qslot[0] = (int)atomicAdd(F.ctl + CW_QUEUE, 1u);
        __syncthreads();
        const int idx = qslot[0];
        if (idx >= N_ATT_UNITS) break;
        int type, h, qb, ch, nsteps; att_decode(idx, type, h, qb, ch, nsteps);
        if (type == 0) { const int slot = h * 80 + cum_chunks(qb) + ch;
            attn_unit<true>(Q + h * 128, 768, K + h * 128, 768, VT + (size_t)h * 128 * SEQ, SEQ, MASK, qb * 256, ch * 2048, nsteps, OPS + (size_t)slot * SLOT_FLOATS, F.wave, F.lane); }
        else { const int slot = h * 32 + qb;
            attn_unit<false>(XQ + h * 128, 512, KMB + h * 128, 512, VMT + (size_t)h * 128 * 256, 256, nullptr, qb * 256, 0, 8, OPX + (size_t)slot * SLOT_FLOATS, F.wave, F.lane); }
    }
}
__device__ __forceinline__ void p5_finalize(Frame& F) {
    const float* OPS = F.out; const float* OPX = wsp<float>(F, WS_OPX); bf16_t* AM = wsp<bf16_t>(F, WS_AMRG);
    const int gw = F.vcu * NWAVES + F.wave, NGW = F.G * NWAVES, lane = F.lane, q = lane & 31, hh = lane >> 5;
    LAS bf16_t* stg = (LAS bf16_t*)(F.lds + F.wave * 16384);
    for (int it = gw; it < (6 + 4) * 32 * 8; it += NGW) {
        const int w = it & 7, qb = (it >> 3) & 31, hx = it >> 8;
        const float* base; int nch, colbase;
        if (hx < 6) { base = OPS + (size_t)(hx * 80 + cum_chunks(qb)) * SLOT_FLOATS; nch = (qb + 8) >> 3; colbase = 768 + hx * 128; }
        else { base = OPX + (size_t)((hx - 6) * 32 + qb) * SLOT_FLOATS; nch = 1; colbase = 1536 + (hx - 6) * 128; }
        float l = 0.f;
        for (int c = 0; c < nch; ++c) l += base[(size_t)c * SLOT_FLOATS + 256 * 128 + w * 64 + lane];
        l += __shfl_xor(l, 32);
        const float inv = 1.0f / l;
#pragma unroll
        for (int d = 0; d < 4; ++d)
#pragma unroll
            for (int r = 0; r < 16; ++r) { float v = 0.f;
                for (int c = 0; c < nch; ++c) v += base[(size_t)c * SLOT_FLOATS + (size_t)w * 4096 + (d * 16 + r) * 64 + lane];
                stg[q * 136 + 32 * d + crow(r, hh)] = (bf16_t)f2bf(v * inv); }
        LDS_WAIT(); asm volatile("" ::: "memory");
        const int t0 = qb * 256 + w * 32;
#pragma unroll
        for (int i = 0; i < 8; ++i) { const int row = i * 4 + (lane >> 4), chk = lane & 15;
            const u32x4 v = *(const LAS u32x4*)(stg + row * 136 + chk * 8);
            *(u32x4*)(AM + (size_t)(t0 + row) * DM + colbase + chk * 8) = v; }
        LDS_WAIT(); asm volatile("" ::: "memory");
    }
}

struct SchedTile {
    int c, G, nM, nN; const char* A; const char* B; size_t tA, tB;
    __device__ __forceinline__ bool next(int i, pg8::Unit& u) const {
        const int L = i * G + c; if (L >= nM * nN) return false; int pm, pn; pg8::tile_order(L, nM, nN, pm, pn);
        u.A = A + (size_t)pm * tA; u.B = B + (size_t)pn * tB; u.Bhi = u.B; u.kind = 0; u.row0 = pm * 256; u.col0 = pn * 256; u.aux = 0; return true; }
};
struct EpiMrg {
    static constexpr bool HOOK = true; static constexpr int HOOK_T1 = 12, HOOK_T2 = 24;
    const bf16_t* EG; bf16_t* MRG;
    __device__ __forceinline__ void hook(f32x4 (&acc)[2][2][4][2], const pg8::Unit& u, int t, int wr, int wc, int fr, int fq) const {
        const int seg = (t == HOOK_T1) ? 0 : 1;
        const unsigned off0 = ((unsigned)(u.row0 + wr * 64 + fr) * 6144u + (unsigned)(seg * 2048 + u.col0 + wc * 32 + 8 * fq)) * 2u;
        const char* eg = (const char*)EG;
#pragma unroll
        for (int ai = 0; ai < 2; ++ai)
#pragma unroll
            for (int m = 0; m < 4; ++m) {
#pragma unroll
                for (int bj = 0; bj < 2; ++bj) { const unsigned off = off0 + (unsigned)((ai * 128 + m * 16) * 6144 + bj * 128) * 2u;
                    const u32x4 ea = *(const u32x4*)(eg + off), eb = *(const u32x4*)(eg + off + 4096u);
                    f32x4 r0, r1;
                    r0[0] = bflo(eb.x) * __builtin_amdgcn_rcpf(bflo(ea.x)); r0[1] = bfhi(eb.x) * __builtin_amdgcn_rcpf(bfhi(ea.x)); r0[2] = bflo(eb.y) * __builtin_amdgcn_rcpf(bflo(ea.y)); r0[3] = bfhi(eb.y) * __builtin_amdgcn_rcpf(bfhi(ea.y));
                    r1[0] = bflo(eb.z) * __builtin_amdgcn_rcpf(bflo(ea.z)); r1[1] = bfhi(eb.z) * __builtin_amdgcn_rcpf(bfhi(ea.z)); r1[2] = bflo(eb.w) * __builtin_amdgcn_rcpf(bflo(ea.w)); r1[3] = bfhi(eb.w) * __builtin_amdgcn_rcpf(bfhi(ea.w));
                    acc[ai][bj][m][0] *= r0; acc[ai][bj][m][1] *= r1; }
                asm volatile("" ::: "memory"); }
    }
    __device__ __forceinline__ void operator()(const f32x4 (&acc)[2][2][4][2], const pg8::Unit& u, int wr, int wc, int fr, int fq) const {
        const int rbase = u.row0 + wr * 64 + fr, cbase = u.col0 + wc * 32 + 8 * fq;
#pragma unroll
        for (int ai = 0; ai < 2; ++ai)
#pragma unroll
            for (int m = 0; m < 4; ++m) { const int row = rbase + ai * 128 + m * 16;
#pragma unroll
                for (int bj = 0; bj < 2; ++bj) { const u32x4 e = *(const u32x4*)(EG + (size_t)row * 6144 + 4096 + cbase + bj * 128);
                    const f32x4 a0 = acc[ai][bj][m][0], a1 = acc[ai][bj][m][1];
                    u32x4 w;
                    w.x = pk2(a0[0] * __builtin_amdgcn_rcpf(bflo(e.x)), a0[1] * __builtin_amdgcn_rcpf(bfhi(e.x))); w.y = pk2(a0[2] * __builtin_amdgcn_rcpf(bflo(e.y)), a0[3] * __builtin_amdgcn_rcpf(bfhi(e.y)));
                    w.z = pk2(a1[0] * __builtin_amdgcn_rcpf(bflo(e.z)), a1[1] * __builtin_amdgcn_rcpf(bfhi(e.z))); w.w = pk2(a1[2] * __builtin_amdgcn_rcpf(bflo(e.w)), a1[3] * __builtin_amdgcn_rcpf(bfhi(e.w)));
                    *(u32x4*)(MRG + (size_t)row * DM + cbase + bj * 128) = w; } }
    }
};
struct EpiRes {
    static constexpr bool HOOK = false; static constexpr int HOOK_T1 = -1, HOOK_T2 = -1;
    const float* x; float* out; bf16_t* X1B;
    __device__ __forceinline__ void hook(f32x4 (&)[2][2][4][2], const pg8::Unit&, int, int, int, int, int) const {}
    __device__ __forceinline__ void operator()(const f32x4 (&acc)[2][2][4][2], const pg8::Unit& u, int wr, int wc, int fr, int fq) const {
        const int rbase = u.row0 + wr * 64 + fr, cbase = u.col0 + wc * 32 + 8 * fq;
#pragma unroll
        for (int ai = 0; ai < 2; ++ai)
#pragma unroll
            for (int m = 0; m < 4; ++m) { const int row = rbase + ai * 128 + m * 16;
#pragma unroll
                for (int bj = 0; bj < 2; ++bj) { const size_t off = (size_t)row * DM + cbase + bj * 128;
                    const f32x4 v0 = *(const f32x4*)(x + off) + acc[ai][bj][m][0], v1 = *(const f32x4*)(x + off + 4) + acc[ai][bj][m][1];
                    *(f32x4*)(out + off) = v0; *(f32x4*)(out + off + 4) = v1;
                    u32x4 w; w.x = pk2(v0[0], v0[1]); w.y = pk2(v0[2], v0[3]); w.z = pk2(v1[0], v1[1]); w.w = pk2(v1[2], v1[3]);
                    *(u32x4*)(X1B + off) = w; } }
    }
};

__device__ __forceinline__ void p8_router(Frame& F) {
    const float* X1 = F.out; const float* WR = wsp<float>(F, WS_WR);
    float* RSTD2 = wsp<float>(F, WS_RSTD2); int* TOKCLS = wsp<int>(F, WS_TOKCLS); int* TOKSLOT = wsp<int>(F, WS_TOKSLOT); float* TOKWA = wsp<float>(F, WS_TOKWA); float* TOKWB = wsp<float>(F, WS_TOKWB);
    LAS float* red = (LAS float*)F.lds;
    LAS float* lg = (LAS float*)(F.lds + 8 * 32 * 33 * 4);
    LAS float* ssq = (LAS float*)(F.lds + 9 * 32 * 33 * 4);
    const int lane = F.lane, i = lane & 31, hh = lane >> 5, w = F.wave;
    for (int u = F.vcu; u < SEQ / 32; u += F.G) {
        const int t0 = 32 * u;
        f32x16 d;
#pragma unroll
        for (int r = 0; r < 16; ++r) d[r] = 0.f;
        float ss = 0.f;
        const float* xp = X1 + (size_t)(t0 + i) * DM + 256 * w + 4 * hh; const float* wp = WR + (size_t)(256 * w + 4 * hh) * 32 + i;
#pragma unroll 4
        for (int m = 0; m < 32; ++m) { const f32x4 a = *(const f32x4*)(xp + 8 * m);
            const float b0 = wp[(8 * m + 0) * 32], b1 = wp[(8 * m + 1) * 32], b2 = wp[(8 * m + 2) * 32], b3 = wp[(8 * m + 3) * 32];
            ss += (a.x * a.x + a.y * a.y) + (a.z * a.z + a.w * a.w);
            d = __builtin_amdgcn_mfma_f32_32x32x2f32(a.x, b0, d, 0, 0, 0); d = __builtin_amdgcn_mfma_f32_32x32x2f32(a.y, b1, d, 0, 0, 0);
            d = __builtin_amdgcn_mfma_f32_32x32x2f32(a.z, b2, d, 0, 0, 0); d = __builtin_amdgcn_mfma_f32_32x32x2f32(a.w, b3, d, 0, 0, 0); }
        ss += __shfl_xor(ss, 32);
        __syncthreads();
#pragma unroll
        for (int r = 0; r < 16; ++r) red[(w * 32 + crow(r, hh)) * 33 + i] = d[r];
        if (hh == 0) ssq[w * 32 + i] = ss;
        __syncthreads();
        for (int e = F.tid; e < 1024; e += NTHR) { const int tk = e >> 5, j = e & 31; float s = 0.f;
#pragma unroll
            for (int ww = 0; ww < 8; ++ww) s += red[(ww * 32 + tk) * 33 + j];
            lg[tk * 33 + j] = s; }
        __syncthreads();
        if (F.tid < 32) { const int tk = F.tid; float s2 = 0.f;
#pragma unroll
            for (int ww = 0; ww < 8; ++ww) s2 += ssq[ww * 32 + tk];
            const float rstd = 1.0f / sqrtf(s2 * (1.0f / DM) + NORM_EPS);
            float g[4]; int gt = 0;
#pragma unroll
            for (int j = 0; j < 4; ++j) g[j] = lg[tk * 33 + j] * rstd;
#pragma unroll
            for (int j = 1; j < 4; ++j) if (g[j] > g[gt]) gt = j;
            float den = 0.f;
#pragma unroll
            for (int j = 0; j < 4; ++j) den += expf(g[j] - g[gt]);
            const float pg = 1.0f / den;
            float le[4];
#pragma unroll
            for (int j = 0; j < 4; ++j) le[j] = lg[tk * 33 + 4 + gt * 4 + j] * rstd;
            int e1 = 0;
#pragma unroll
            for (int j = 1; j < 4; ++j) if (le[j] > le[e1]) e1 = j;
            int e2 = (e1 == 0) ? 1 : 0;
#pragma unroll
            for (int j = 0; j < 4; ++j) if (j != e1 && j != e2 && le[j] > le[e2]) e2 = j;
            const float x2 = expf(le[e2] - le[e1]);
            const float w1 = pg / (1.0f + x2), w2 = pg * x2 / (1.0f + x2);
            const int a = e1 < e2 ? e1 : e2, bb = e1 < e2 ? e2 : e1;
            const float wa = e1 < e2 ? w1 : w2, wb = e1 < e2 ? w2 : w1;
            const int pair = (a == 0) ? (bb - 1) : (a == 1 ? bb + 1 : 5);
            const int cls = gt * 6 + pair;
            const int slot = (int)atomicAdd(F.ctl + CW_CLS + cls, 1u);
            const int t = t0 + tk;
            RSTD2[t] = rstd; TOKCLS[t] = cls; TOKSLOT[t] = slot; TOKWA[t] = wa; TOKWB[t] = wb;
        }
    }
    __syncthreads();
}
__device__ __forceinline__ int moe_tables(Frame& F, LAS int* tb) {
    __syncthreads();
    if (F.tid == 0) { int o = 0;
        for (int c = 0; c < 24; ++c) { const int n = (int)__hip_atomic_load(F.ctl + CW_CLS + c, __ATOMIC_RELAXED, __HIP_MEMORY_SCOPE_AGENT); tb[c] = o; tb[64 + c] = n; const int nt = (n + 255) >> 8;
            for (int j = 0; j < nt; ++j) tb[128 + (o >> 8) + j] = c; o += nt << 8; }
        tb[24] = o; }
    __syncthreads();
    return tb[24] >> 8;
}
__device__ __forceinline__ void p8b_gather(Frame& F) {
    LAS int* tb = (LAS int*)(F.lds + 120 * 1024);
    const int ntiles = moe_tables(F, tb);
    const bf16_t* X1B = wsp<bf16_t>(F, WS_X1B); bf16_t* XG = wsp<bf16_t>(F, WS_XG);
    const float* RSTD2 = wsp<float>(F, WS_RSTD2); const int* TOKCLS = wsp<int>(F, WS_TOKCLS); const int* TOKSLOT = wsp<int>(F, WS_TOKSLOT); const float* TOKWA = wsp<float>(F, WS_TOKWA); const float* TOKWB = wsp<float>(F, WS_TOKWB);
    int* ROWTOK = wsp<int>(F, WS_ROWTOK); float* ROWRS = wsp<float>(F, WS_ROWRS); float* ROWWA = wsp<float>(F, WS_ROWWA); float* ROWWB = wsp<float>(F, WS_ROWWB);
    const int gw = F.vcu * NWAVES + F.wave, NGW = F.G * NWAVES, lane = F.lane;
    for (int t = gw; t < SEQ; t += NGW) {
        const int R = tb[TOKCLS[t]] + TOKSLOT[t];
        const u32x4* src = (const u32x4*)(X1B + (size_t)t * DM) + lane; u32x4* dst = (u32x4*)(XG + (size_t)R * DM) + lane;
#pragma unroll
        for (int j = 0; j < 4; ++j) dst[64 * j] = src[64 * j];
        if (lane == 0) { ROWTOK[R] = t; ROWRS[R] = RSTD2[t]; ROWWA[R] = TOKWA[t]; ROWWB[R] = TOKWB[t]; }
    }
    for (int i = F.vcu * NTHR + F.tid; i < 24 * 256; i += F.G * NTHR) { const int c = i >> 8, j = i & 255; const int n = tb[64 + c], R = tb[c] + n + j;
        const int endc = tb[c] + (((n + 255) >> 8) << 8);
        if (R < endc) { ROWTOK[R] = -1; ROWRS[R] = 0.f; ROWWA[R] = 0.f; ROWWB[R] = 0.f; } }
    (void)ntiles;
}
__device__ __forceinline__ void cls_experts(int cls, int& ea, int& eb) { const int g = cls / 6, p = cls % 6; const int a = (p < 3) ? 0 : (p < 5 ? 1 : 2); const int b = (p < 3) ? p + 1 : (p < 5 ? p - 1 : 3); ea = g * 4 + a; eb = g * 4 + b; }
struct SchedGU {
    int c, G, ntiles; const LAS int* tb; unsigned char* ws;
    __device__ __forceinline__ bool next(int i, pg8::Unit& u) const {
        const int L = i * G + c; if (L >= ntiles * 8) return false; const int mt = L >> 3, pn = L & 7; const int cls = tb[128 + mt]; int ea, eb; cls_experts(cls, ea, eb);
        const int e = pn < 4 ? ea : eb; const char* XG = (const char*)(ws + WS_XG); const char* WGUT = (const char*)(ws + WS_WGUT);
        u.A = XG + (size_t)mt * 256 * DM * 2; u.B = WGUT + ((size_t)e * 1024 + (pn & 3) * 256) * DM * 2; u.Bhi = u.B; u.kind = 0; u.row0 = mt * 256; u.col0 = pn; u.aux = 0; return true; }
};
struct EpiGU {
    static constexpr bool HOOK = false; static constexpr int HOOK_T1 = -1, HOOK_T2 = -1;
    unsigned char* ws;
    __device__ __forceinline__ void hook(f32x4 (&)[2][2][4][2], const pg8::Unit&, int, int, int, int, int) const {}
    __device__ __forceinline__ void operator()(const f32x4 (&acc)[2][2][4][2], const pg8::Unit& u, int wr, int wc, int fr, int fq) const {
        const float* rs = (const float*)(ws + WS_ROWRS); bf16_t* ACT = (bf16_t*)(ws + WS_ACT);
        const int pn = u.col0; const float* cw = (const float*)(ws + (pn < 4 ? WS_ROWWA : WS_ROWWB)); const int cbase = (pn >> 2) * 512 + (pn & 3) * 128 + wc * 32 + 8 * fq;
#pragma unroll
        for (int ai = 0; ai < 2; ++ai)
#pragma unroll
            for (int m = 0; m < 4; ++m) { const int row = u.row0 + ai * 128 + wr * 64 + m * 16 + fr; const float s = rs[row], w = cw[row];
                float a[8];
#pragma unroll
                for (int n = 0; n < 2; ++n)
#pragma unroll
                    for (int e = 0; e < 4; ++e) { const float gv = acc[ai][0][m][n][e] * s, uv = acc[ai][1][m][n][e] * s;
                        a[4 * n + e] = gv * __builtin_amdgcn_rcpf(1.0f + __builtin_amdgcn_exp2f(-gv * LOG2E)) * uv * w; }
                u32x4 o; o.x = pk2(a[0], a[1]); o.y = pk2(a[2], a[3]); o.z = pk2(a[4], a[5]); o.w = pk2(a[6], a[7]);
                *(u32x4*)(ACT + (size_t)row * 1024 + cbase) = o; }
    }
};
struct SchedDN {
    int c, G, ntiles; const LAS int* tb; unsigned char* ws;
    __device__ __forceinline__ bool next(int i, pg8::Unit& u) const {
        const int L = i * G + c; if (L >= ntiles * 8) return false; const int mt = L >> 3, pn = L & 7; const int cls = tb[128 + mt]; int ea, eb; cls_experts(cls, ea, eb);
        const char* ACT = (const char*)(ws + WS_ACT); const char* WDT = (const char*)(ws + WS_WDT);
        u.A = ACT + (size_t)mt * 256 * 1024 * 2; u.B = WDT + ((size_t)ea * DM + pn * 256) * 512 * 2; u.Bhi = WDT + ((size_t)eb * DM + pn * 256) * 512 * 2 - (size_t)8 * 128;
        u.kind = 0; u.row0 = mt * 256; u.col0 = pn * 256; u.aux = 0; return true; }
};
struct EpiDN {
    static constexpr bool HOOK = false; static constexpr int HOOK_T1 = -1, HOOK_T2 = -1;
    unsigned char* ws; float* out;
    __device__ __forceinline__ void hook(f32x4 (&)[2][2][4][2], const pg8::Unit&, int, int, int, int, int) const {}
    __device__ __forceinline__ void operator()(const f32x4 (&acc)[2][2][4][2], const pg8::Unit& u, int wr, int wc, int fr, int fq) const {
        const int* rowtok = (const int*)(ws + WS_ROWTOK);
        const int cbase = u.col0 + wc * 32 + 8 * fq;
#pragma unroll
        for (int ai = 0; ai < 2; ++ai)
#pragma unroll
            for (int m = 0; m < 4; ++m) { const int row = u.row0 + ai * 128 + wr * 64 + m * 16 + fr; const int tok = rowtok[row];
                if (tok >= 0) {
#pragma unroll
                    for (int bj = 0; bj < 2; ++bj) { float* p = out + (size_t)tok * DM + cbase + bj * 128;
                        const f32x4 v0 = *(const f32x4*)p + acc[ai][bj][m][0], v1 = *(const f32x4*)(p + 4) + acc[ai][bj][m][1];
                        *(f32x4*)p = v0; *(f32x4*)(p + 4) = v1; } } }
    }
};

__global__ void __launch_bounds__(NTHR, 2) fwd_kernel(KArgs args) {
    extern __shared__ __attribute__((aligned(16))) unsigned char lds_raw[];
    Frame F;
    F.lds = (LAS unsigned char*)lds_raw; F.MISC = (volatile LAS unsigned*)(F.lds + MISC_OFF);
    F.tid = threadIdx.x; F.lane = F.tid & 63; F.wave = __builtin_amdgcn_readfirstlane(F.tid >> 6);
    F.G = gridDim.x; { const int bx = blockIdx.x; F.vcu = (F.G % 8 == 0) ? (bx % 8) * (F.G / 8) + bx / 8 : bx; }
    F.ws = args.ws; F.out = args.out; F.ctl = (unsigned*)(args.ws + WS_CTL);
    F.x = (const float*)args.in[0]; F.mem = (const float*)args.in[1]; F.positions = (const int*)args.in[2]; F.g_mix = (const float*)args.in[3]; F.w_in = (const float*)args.in[4];
    F.b_gate = (const float*)args.in[5]; F.w_pool_grp = (const float*)args.in[6]; F.pool_scale = (const float*)args.in[7]; F.q_norm_g = (const float*)args.in[8]; F.k_norm_g = (const float*)args.in[9];
    F.g_mem = (const float*)args.in[10]; F.w_mem_kv = (const float*)args.in[11]; F.xq_norm_g = (const float*)args.in[12]; F.xk_norm_g = (const float*)args.in[13]; F.w_pool_out = (const float*)args.in[14];
    F.w_attn_out = (const float*)args.in[15]; F.w_cross_out = (const float*)args.in[16]; F.w_o = (const float*)args.in[17]; F.g_ffn = (const float*)args.in[18]; F.w_rg = (const float*)args.in[19];
    F.w_re = (const float*)args.in[20]; F.w_eg = (const float*)args.in[21]; F.w_eu = (const float*)args.in[22]; F.w_ed = (const float*)args.in[23];
    for (int u = F.tid; u < (LDS_BYTES - LDSCTL_OFF) / 4; u += NTHR) ((LAS unsigned*)(F.lds + LDSCTL_OFF))[u] = 0u;
    __syncthreads();
    XcdBarrier bar = xcd_barrier_post(F.ctl + CW_BAR, F.MISC + 8);
    const int lo = args.ph_lo, hi = args.ph_hi;
#define IN(k) (lo <= (k) && (k) < hi)
#define SEAM(k) do { if (IN(k) && IN((k) + 1)) xcd_barrier(bar); } while (0)
    if (IN(0)) { p0_prologue(F); } SEAM(0);
    if (IN(1)) {
        SchedP1 S{(int)blockIdx.x, F.G, F.ws};
        EpiP1 E{F.ws, wsp<float>(F, WS_RSTD1), wsp<float>(F, WS_RSTDM), F.b_gate};
        pg8::gemm_phase<EpiP1, SchedP1, true, true>(F.lds, pg8::Geom{DM, DM, 32, 1 << 30}, S, E);
    } SEAM(1);
    if (IN(2)) { p2_rowpass(F); } SEAM(2);
    if (IN(3)) { p3_indexer(F); } SEAM(3);
    if (IN(4)) { p4_attention(F); } SEAM(4);
    if (IN(5)) { p5_finalize(F); } SEAM(5);
    if (IN(6)) {
        SchedTile S{(int)blockIdx.x, F.G, 32, 8, (const char*)(F.ws + WS_AMRG), (const char*)(F.ws + WS_BTMRG), (size_t)256 * DM * 2, (size_t)256 * DM * 2};
        EpiMrg E{wsp<bf16_t>(F, WS_EG), wsp<bf16_t>(F, WS_MRG)};
        pg8::gemm_phase<EpiMrg, SchedTile, true, true>(F.lds, pg8::Geom{DM, DM, 32, 1 << 30}, S, E);
    } SEAM(6);
    if (IN(7)) {
        SchedTile S{(int)blockIdx.x, F.G, 32, 8, (const char*)(F.ws + WS_MRG), (const char*)(F.ws + WS_WOT), (size_t)256 * DM * 2, (size_t)256 * DM * 2};
        EpiRes E{F.x, F.out, wsp<bf16_t>(F, WS_X1B)};
        pg8::gemm_phase<EpiRes, SchedTile, true, true>(F.lds, pg8::Geom{DM, DM, 32, 1 << 30}, S, E);
    } SEAM(7);
    if (IN(8)) { p8_router(F); } SEAM(8);
    if (IN(9)) { p8b_gather(F); } SEAM(9);
    if (IN(10)) {
        LAS int* tb = (LAS int*)(F.lds + LDSCTL_OFF + 1024);
        const int ntiles = moe_tables(F, tb);
        SchedGU S{(int)blockIdx.x, F.G, ntiles, tb, F.ws};
        EpiGU E{F.ws};
        pg8::gemm_phase<EpiGU, SchedGU, true, true>(F.lds, pg8::Geom{DM, DM, 32, 1 << 30}, S, E);
    } SEAM(10);
    if (IN(11)) {
        LAS int* tb = (LAS int*)(F.lds + LDSCTL_OFF + 1024);
        const int ntiles = moe_tables(F, tb);
        SchedDN S{(int)blockIdx.x, F.G, ntiles, tb, F.ws};
        EpiDN E{F.ws, F.out};
        pg8::gemm_phase<EpiDN, SchedDN, true, true>(F.lds, pg8::Geom{1024, 512, 16, 8}, S, E);
    }
#undef IN
#undef SEAM
}

extern "C" void kernel_launch(void* const* d_in, const int* in_sizes, int n_in, void* d_out, int out_size, void* d_ws, size_t ws_size, hipStream_t stream) {
    static int grid = 0;
    if (grid == 0) {
        if (n_in != 24 || in_sizes[0] != SEQ * DM || out_size != SEQ * DM || ws_size < WS_END) {
            fprintf(stderr, "kernel_launch: unexpected shapes: n_in %d in0 %d out %d ws %zu (need %zu)\n", n_in, n_in > 0 ? in_sizes[0] : -1, out_size, ws_size, (size_t)WS_END); grid = -1; return; }
        int dev = 0, cus = 0, per_cu = 0;
        if (hipGetDevice(&dev) != hipSuccess || hipDeviceGetAttribute(&cus, hipDeviceAttributeMultiprocessorCount, dev) != hipSuccess) { grid = -1; return; }
        if (hipFuncSetAttribute((const void*)fwd_kernel, hipFuncAttributeMaxDynamicSharedMemorySize, LDS_BYTES) != hipSuccess) { fprintf(stderr, "kernel_launch: hipFuncSetAttribute failed\n"); grid = -1; return; }
        if (hipOccupancyMaxActiveBlocksPerMultiprocessor(&per_cu, (const void*)fwd_kernel, NTHR, LDS_BYTES) != hipSuccess || per_cu < 1) {
            fprintf(stderr, "kernel_launch: occupancy query reports %d workgroups per CU\n", per_cu); (void)hipGetLastError(); per_cu = 1; }
        grid = cus;
    }
    if (grid < 0) return;
    if (hipMemsetAsync((char*)d_ws + WS_CTL, 0, CTL_ZERO_BYTES, stream) != hipSuccess) { fprintf(stderr, "kernel_launch: memset failed\n"); return; }
    KArgs a{};
    for (int i = 0; i < 24; ++i) a.in[i] = d_in[i];
    a.out = (float*)d_out; a.ws = (unsigned char*)d_ws; a.ph_lo = 0; a.ph_hi = 12;
    hipLaunchKernelGGL(fwd_kernel, dim3(grid), dim3(NTHR), LDS_BYTES, stream, a);
    const hipError_t le = hipPeekAtLastError();
    if (le != hipSuccess) fprintf(stderr, "kernel_launch: launch failed: %s\n", hipGetErrorName(le));
}
```

```cpp
#include <hip/hip_runtime.h>
#include <cstdio>
#include <cstdint>

#define LAS __attribute__((address_space(3)))
#define GAS __attribute__((address_space(1)))
typedef unsigned short bf16_t;
typedef short bf16x8 __attribute__((ext_vector_type(8)));
typedef short bf16x4 __attribute__((ext_vector_type(4)));
typedef float f32x4 __attribute__((ext_vector_type(4)));
typedef float f32x16 __attribute__((ext_vector_type(16)));
typedef unsigned u32x4 __attribute__((ext_vector_type(4)));
typedef unsigned u32x2 __attribute__((ext_vector_type(2)));

#ifndef P3_PROF
#define P3_PROF 0
#endif
constexpr int SEQ = 8192, DM = 2048, INC = 10052, MEML = 256;
constexpr int NWAVES = 8, NTHR = 512;
constexpr float NORM_EPS = 1e-6f;
constexpr float LOG2E = 1.4426950408889634f;
constexpr float ATT_SCALE = 0.08838834764831845f;

constexpr size_t MiB = 1u << 20, KiB = 1u << 10;
constexpr size_t WS_CTL = 0, CTL_ZERO_BYTES = 128 * KiB;
constexpr size_t WS_SMALL = 1 * MiB;
constexpr size_t WS_RSTD1 = WS_SMALL + 0, WS_RSTDM = WS_SMALL + 32 * KiB, WS_THRKEY = WS_SMALL + 64 * KiB, WS_THRIDX = WS_SMALL + 96 * KiB;
constexpr size_t WS_WIF = WS_SMALL + 128 * KiB, WS_RSTD2 = WS_SMALL + 256 * KiB, WS_TOKCLS = WS_SMALL + 288 * KiB, WS_TOKSLOT = WS_SMALL + 320 * KiB;
constexpr size_t WS_TOKWA = WS_SMALL + 352 * KiB, WS_TOKWB = WS_SMALL + 384 * KiB, WS_ROWTOK = WS_SMALL + 416 * KiB, WS_ROWRS = WS_SMALL + 480 * KiB;
constexpr size_t WS_ROWWA = WS_SMALL + 544 * KiB, WS_ROWWB = WS_SMALL + 608 * KiB, WS_CNT = WS_SMALL + 672 * KiB, WS_ATTBL = WS_SMALL + 704 * KiB, WS_WR = WS_SMALL + 1 * MiB;
constexpr size_t WS_BTMRG = 4 * MiB, WS_WOT = 12 * MiB;
constexpr size_t WS_XB = 20 * MiB, WS_WINT = 52 * MiB, WS_WVT = 89 * MiB, WS_WMKVT = 92 * MiB, WS_MEMB = 96 * MiB;
constexpr size_t WS_WGUT = 20 * MiB, WS_QIB = 84 * MiB, WS_KIB = 88 * MiB, WS_KMB = 89 * MiB, WS_VMT = 89 * MiB + 512 * KiB;
constexpr size_t WS_WDT = 97 * MiB;
constexpr size_t WS_EG = 129 * MiB, WS_ACT = 185 * MiB;
constexpr size_t WS_AMRG = 225 * MiB, WS_X1B = 225 * MiB;
constexpr size_t WS_Q = 257 * MiB, WS_K = 269 * MiB, WS_VT = 281 * MiB, WS_XQ = 293 * MiB, WS_MRG = 257 * MiB;
constexpr size_t WS_U = 301 * MiB, WS_IDXF = 313 * MiB, WS_OPX = 301 * MiB;
constexpr size_t WS_KVM = 329 * MiB, WS_MASK = 330 * MiB, WS_KVMP = 330 * MiB, WS_END = 338 * MiB;
constexpr int MAXROWS = 14336;
constexpr int CW_BAR = 4096;
constexpr int CW_CLS = 16384;
constexpr int CW_QUEUE = 16512;
constexpr int CW_TILE = 16640;

#define LDS_WAIT() asm volatile("s_waitcnt lgkmcnt(0)" ::: "memory")
#define VM_WAIT() asm volatile("s_waitcnt vmcnt(0)" ::: "memory")
typedef float f32x2_t __attribute__((ext_vector_type(2))); typedef __bf16 bf16x2_t __attribute__((ext_vector_type(2)));
__device__ __forceinline__ unsigned pk2(float lo, float hi) { f32x2_t v = {lo, hi}; bf16x2_t b = __builtin_convertvector(v, bf16x2_t); return __builtin_bit_cast(unsigned, b); }
__device__ __forceinline__ unsigned f2bf(float f) { return pk2(f, 0.f) & 0xffffu; }
__device__ __forceinline__ float bf2f(unsigned short b) { return __builtin_bit_cast(float, (unsigned)b << 16); }
__device__ __forceinline__ float bflo(unsigned w) { return __builtin_bit_cast(float, w << 16); }
__device__ __forceinline__ float bfhi(unsigned w) { return __builtin_bit_cast(float, w & 0xffff0000u); }
__device__ __forceinline__ float wave_sum(float v) {
#pragma unroll
    for (int o = 1; o < 64; o <<= 1) v += __shfl_xor(v, o);
    return v;
}
__device__ __forceinline__ int crow(int r, int hi) { return (r & 3) + 8 * (r >> 2) + 4 * hi; }

#define XB_TMO      128
#define XB_XCNT(j)  (256  + 64 * (j))
#define XB_XSUB(j)  (1280 + 64 * (j))
#define XB_XGEN(j)  (2304 + 64 * (j))
#define XB_TOP      3328
#define XB_TOPGEN   3392
#define XCD_BAR_WORDS 3456
#define XB_SPIN_CAP (1u << 20)
__device__ __forceinline__ unsigned xb_ld(unsigned* p)              { return __hip_atomic_load(p, __ATOMIC_RELAXED, __HIP_MEMORY_SCOPE_AGENT); }
__device__ __forceinline__ unsigned xb_add(unsigned* p, unsigned v) { return __hip_atomic_fetch_add(p, v, __ATOMIC_RELAXED, __HIP_MEMORY_SCOPE_AGENT); }
__device__ __forceinline__ unsigned xb_xcc_id() { return (unsigned)__builtin_amdgcn_s_getreg((3 << 11) | 20) & 0xFu; }
#define XB_SPIN(cond, bar) do { unsigned _sp = 0; while (cond) { __builtin_amdgcn_s_sleep(1); \
    if ((++_sp & 255u) == 0u) { if (xb_ld(&(bar)[XB_TMO])) break; if (_sp > XB_SPIN_CAP) { atomicAdd(&(bar)[XB_TMO], 1u); break; } } } } while (0)
struct XcdBarrier { unsigned* bar; unsigned x; volatile LAS unsigned* st; };
__device__ __forceinline__ XcdBarrier xcd_barrier_post(unsigned* bar, volatile LAS unsigned* st) {
    XcdBarrier b; b.bar = bar; b.x = xb_xcc_id(); b.st = st;
    if (threadIdx.x == 0) (void)xb_add(&bar[XB_XCNT(b.x)], 1u);
    return b;
}
__device__ __forceinline__ void xcd_barrier_complete(unsigned* bar, unsigned x, unsigned& nloc, unsigned& nx) {
    const unsigned G = gridDim.x * gridDim.y * gridDim.z;
    unsigned sum, cnt, mine, sp = 0u;
    for (;;) {
        sum = 0u; cnt = 0u; mine = 0u;
#pragma unroll
        for (unsigned j = 0; j < 16; ++j) { const unsigned c = xb_ld(&bar[XB_XCNT(j)]); sum += c; cnt += (c > 0u) ? 1u : 0u; mine = (j == x) ? c : mine; }
        if (sum == G) break;
        __builtin_amdgcn_s_sleep(1);
        if ((++sp & 255u) == 0u) { if (xb_ld(&bar[XB_TMO])) break; if (sp > XB_SPIN_CAP) { atomicAdd(&bar[XB_TMO], 1u); break; } }
    }
    nloc = mine > 0u ? mine : 1u; nx = cnt > 0u ? cnt : 1u;
}
__device__ __forceinline__ void xcd_barrier(const XcdBarrier& b) {
    asm volatile("s_waitcnt vmcnt(0)" ::: "memory");
    __syncthreads();
    if (threadIdx.x == 0) {
        unsigned* bar = b.bar;
        __builtin_amdgcn_s_waitcnt(0);
        unsigned nloc = b.st[0], nx = b.st[1];
        if (nloc == 0u) { xcd_barrier_complete(bar, b.x, nloc, nx); b.st[0] = nloc; b.st[1] = nx; }
        const unsigned old = xb_add(&bar[XB_XSUB(b.x)], 1u);
        const unsigned gen = old / nloc;
        if (old + 1u == (gen + 1u) * nloc) {
            __builtin_amdgcn_fence(__ATOMIC_RELEASE, "agent");
            asm volatile("s_waitcnt vmcnt(0)" ::: "memory");
            const unsigned og = xb_add(&bar[XB_TOP], 1u);
            const unsigned tg = og / nx;
            if (og + 1u == (tg + 1u) * nx) xb_add(&bar[XB_TOPGEN], 1u);
            else XB_SPIN(xb_ld(&bar[XB_TOPGEN]) == tg, bar);
            __builtin_amdgcn_fence(__ATOMIC_ACQUIRE, "agent");
            xb_add(&bar[XB_XGEN(b.x)], 1u);
            asm volatile("s_waitcnt vmcnt(0)" ::: "memory");
        } else {
            XB_SPIN(xb_ld(&bar[XB_XGEN(b.x)]) == gen, bar);
            __builtin_amdgcn_fence(__ATOMIC_ACQUIRE, "agent");
            asm volatile("s_waitcnt vmcnt(0)" ::: "memory");
        }
    }
    __syncthreads();
}

namespace pg8 {
constexpr int BM = 256, BK = 64, HALF = 128, HTB = HALF * BK * 2, STAGE_BYTES = 8 * HTB, NXCD = 8, WGM = 8;
__host__ __device__ __forceinline__ int lds_byte(int r, int c) { const int st = (r >> 4) * 2 + (c >> 5), rr = r & 15, cc = c & 31, ob = rr * 64 + cc * 2; return st * 1024 + (ob ^ (((ob >> 9) & 1) << 5)); }
__host__ __device__ __forceinline__ void stage_rc(int b, int& R, int& C) { const int st = b / 1024, sb = b % 1024, swz = sb ^ (((sb >> 9) & 1) << 5); R = (st >> 1) * 16 + swz / 64; C = (st & 1) * 32 + (swz % 64) / 2; }
__host__ __device__ __forceinline__ int perm32(int rho) { const int n = rho >> 4, i = rho & 15; return 8 * (i >> 2) + 4 * n + (i & 3); }

struct Unit { const char* A; const char* B; const char* Bhi; int kind; int row0; int col0; int aux; int nt; int lowonly; };
struct Geom { int lda, ldb, nt, ksplit; const int* rowtok; };

__device__ __forceinline__ void tile_order(int L, int nM, int nN, int& pm, int& pn) {
    const int nwg = nM * nN; int wgid = L;
    { const int q = nwg / NXCD, r = nwg % NXCD, xcd = wgid % NXCD, off = wgid / NXCD; wgid = (xcd < r ? xcd * (q + 1) : r * (q + 1) + (xcd - r) * q) + off; }
    const int nig = WGM * nN, gid = wgid / nig, fm = gid * WGM, gsz = (nM - fm) < WGM ? (nM - fm) : WGM;
    pm = fm + ((wgid % nig) % gsz); pn = (wgid % nig) / gsz;
}

template <class Epi, class Sched, bool ALIGN_EPI, bool SP2>
__device__ __forceinline__ void gemm_phase(LAS unsigned char* lds, const Geom g, const Sched& S, const Epi& E) {
    const int tid = threadIdx.x, wid = __builtin_amdgcn_readfirstlane(tid >> 6), lane = tid & 63, wr = wid >> 2, wc = wid & 3, fr = lane & 15, fq = lane >> 4;
    unsigned voffA[2], voffB[2];
#pragma unroll
    for (int i = 0; i < 2; ++i) { int R, C; stage_rc(tid * 16 + i * 8192, R, C); const int Rb = (R & ~31) + perm32(R & 31);
        voffA[i] = (unsigned)(R * g.lda + C) * 2u; voffB[i] = (unsigned)(Rb * g.ldb + C) * 2u; }
    const size_t kstep = (size_t)(BK * 2);
    const size_t hstepA = (size_t)HALF * g.lda * 2, hstepB = (size_t)HALF * g.ldb * 2;
    unsigned voffA1[2];
#pragma unroll
    for (int i = 0; i < 2; ++i) voffA1[i] = voffA[i] + (unsigned)hstepA;
    const unsigned ldsw = (unsigned)wid * 1024u;
    const int aoff = lds_byte(wr * 64 + fr, fq * 8), boff = lds_byte(wc * 32 + fr, fq * 8);
#define PG8_SA(b, h) (((b) * 2 + (h)) * HTB)
#define PG8_SB(b, h) ((4 + (b) * 2 + (h)) * HTB)
#define PG8_STAGE(bufoff, gbase, voff) do { _Pragma("unroll") for (int _i = 0; _i < 2; ++_i) \
        __builtin_amdgcn_global_load_lds((const unsigned*)((const char*)(gbase) + (voff)[_i]), (LAS unsigned*)(lds + (bufoff) + ldsw + _i * 8192), 16, 0, 0); } while (0)
#define PG8_LDA(dst, b, h) do { _Pragma("unroll") for (int m = 0; m < 4; ++m) _Pragma("unroll") for (int k = 0; k < 2; ++k) dst[m][k] = *(const LAS bf16x8*)(lds + PG8_SA(b, h) + aoff + m * 2048 + k * 1024); } while (0)
#define PG8_LDB(dst, b, h) do { _Pragma("unroll") for (int n = 0; n < 2; ++n) _Pragma("unroll") for (int k = 0; k < 2; ++k) dst[n][k] = *(const LAS bf16x8*)(lds + PG8_SB(b, h) + boff + n * 2048 + k * 1024); } while (0)
#define PG8_MMA(ai, bj, At, Bt) do { __builtin_amdgcn_s_setprio(1); _Pragma("unroll") for (int m = 0; m < 4; ++m) _Pragma("unroll") for (int n = 0; n < 2; ++n) _Pragma("unroll") for (int k = 0; k < 2; ++k) \
        acc[ai][bj][m][n] = __builtin_amdgcn_mfma_f32_16x16x32_bf16(Bt[n][k], At[m][k], acc[ai][bj][m][n], 0, 0, 0); __builtin_amdgcn_s_setprio(0); } while (0)
#define PG8_WAIT_V(n) asm volatile("s_waitcnt vmcnt(" #n ")" ::: "memory")
#define PG8_WAIT_L(n) asm volatile("s_waitcnt lgkmcnt(" #n ")" ::: "memory")
#define PG8_BAR __builtin_amdgcn_s_barrier()
#define PG8_SCHED __builtin_amdgcn_sched_barrier(0)
    Unit cur, nxt; int ui = 0;
    if (!S.next(0, cur)) return;
    if (g.rowtok) {
#pragma unroll
        for (int i = 0; i < 2; ++i) { int R, C; stage_rc(tid * 16 + i * 8192, R, C); int t0 = g.rowtok[cur.row0 + R], t1 = g.rowtok[cur.row0 + HALF + R]; t0 = t0 < 0 ? 0 : t0; t1 = t1 < 0 ? 0 : t1;
            voffA[i] = (unsigned)(t0 * g.lda + C) * 2u; voffA1[i] = (unsigned)(t1 * g.lda + C) * 2u; }
    }
    f32x4 acc[2][2][4][2];
#pragma unroll
    for (int a = 0; a < 2; ++a)
#pragma unroll
        for (int b = 0; b < 2; ++b)
#pragma unroll
            for (int m = 0; m < 4; ++m)
#pragma unroll
                for (int n = 0; n < 2; ++n) acc[a][b][m][n] = (f32x4){0.f, 0.f, 0.f, 0.f};
    bf16x8 At[4][2], B0[2][2], B1[2][2];
    const char* cA = cur.A; const char* cB = cur.B; const char* cBhi = cur.Bhi;
    if constexpr (SP2) {
        PG8_STAGE(PG8_SB(0, 0), cB, voffB); PG8_STAGE(PG8_SB(0, 1), cB + hstepB, voffB); PG8_STAGE(PG8_SA(0, 0), cA, voffA); PG8_STAGE(PG8_SA(0, 1), cA, voffA1);
        if (wr == 1) PG8_BAR;
        PG8_WAIT_V(2); PG8_BAR;
        PG8_STAGE(PG8_SB(1, 0), cB + kstep, voffB); PG8_STAGE(PG8_SA(1, 0), cA + kstep, voffA); PG8_STAGE(PG8_SB(1, 1), cB + hstepB + kstep, voffB);
        PG8_WAIT_V(6); PG8_BAR;
    } else {
        PG8_STAGE(PG8_SB(0, 0), cB, voffB); PG8_STAGE(PG8_SA(0, 0), cA, voffA); PG8_STAGE(PG8_SB(0, 1), cB + hstepB, voffB); PG8_STAGE(PG8_SA(0, 1), cA, voffA1);
        if (wr == 1) PG8_BAR;
        PG8_WAIT_V(4); PG8_BAR;
        PG8_STAGE(PG8_SB(1, 0), cB + kstep, voffB); PG8_STAGE(PG8_SA(1, 0), cA + kstep, voffA); PG8_STAGE(PG8_SB(1, 1), cB + hstepB + kstep, voffB);
        PG8_WAIT_V(6); PG8_BAR;
    }
    for (;;) {
        const bool has_next = S.next(ui + 1, nxt);
        const char* nA = has_next ? nxt.A : cA; const char* nB = has_next ? nxt.B : cB;
        const int nt = cur.nt; const bool hi_on = cur.lowonly == 0;
        for (int t = 0; t < nt; t += 2) {
            const bool last = (t == nt - 2);
            if constexpr (Epi::HOOK) { if (t == Epi::HOOK_T1 || t == Epi::HOOK_T2) E.hook(acc, cur, t, wr, wc, fr, fq); }
            const char* a1 = cA + (size_t)(t + 1) * kstep;
            const char* a2 = last ? nA : cA + (size_t)(t + 2) * kstep;
            const char* b2 = last ? nB : ((t + 2) < g.ksplit ? cB : cBhi) + (size_t)(t + 2) * kstep;
            const char* a3 = a2 + kstep; const char* b3 = b2 + kstep;
            if constexpr (SP2) {
            PG8_LDB(B0, 0, 0); PG8_LDB(B1, 0, 1); PG8_SCHED; PG8_LDA(At, 0, 0); PG8_STAGE(PG8_SA(1, 1), a1, voffA1);
            PG8_WAIT_V(8); PG8_WAIT_L(0); PG8_BAR; PG8_MMA(0, 0, At, B0); PG8_MMA(0, 1, At, B1); PG8_BAR; PG8_SCHED;
            PG8_LDA(At, 0, 1); PG8_STAGE(PG8_SB(0, 0), b2, voffB); PG8_STAGE(PG8_SB(0, 1), b2 + hstepB, voffB); PG8_STAGE(PG8_SA(0, 0), a2, voffA);
            PG8_WAIT_V(8); PG8_WAIT_L(0); PG8_BAR; if (hi_on) { PG8_MMA(1, 0, At, B0); PG8_MMA(1, 1, At, B1); } PG8_BAR; PG8_SCHED;
            PG8_LDB(B0, 1, 0); PG8_LDB(B1, 1, 1); PG8_SCHED; PG8_LDA(At, 1, 0); PG8_STAGE(PG8_SA(0, 1), a2, voffA1);
            PG8_WAIT_V(8); PG8_WAIT_L(0); PG8_BAR; PG8_MMA(0, 0, At, B0); PG8_MMA(0, 1, At, B1); PG8_BAR; PG8_SCHED;
            PG8_LDA(At, 1, 1); PG8_STAGE(PG8_SB(1, 0), b3, voffB); PG8_STAGE(PG8_SB(1, 1), b3 + hstepB, voffB); PG8_STAGE(PG8_SA(1, 0), a3, voffA);
            PG8_WAIT_V(8); PG8_WAIT_L(0); PG8_BAR; if (hi_on) { PG8_MMA(1, 0, At, B0); PG8_MMA(1, 1, At, B1); } PG8_BAR; PG8_SCHED;
            } else {
            PG8_LDB(B0, 0, 0); PG8_SCHED; PG8_LDA(At, 0, 0); PG8_STAGE(PG8_SA(1, 1), a1, voffA1);
            PG8_WAIT_L(8); PG8_BAR; PG8_WAIT_L(0); PG8_MMA(0, 0, At, B0); PG8_BAR; PG8_SCHED;
            PG8_LDB(B1, 0, 1); PG8_STAGE(PG8_SB(0, 0), b2, voffB);
            PG8_BAR; PG8_WAIT_L(0); PG8_MMA(0, 1, At, B1); PG8_BAR;
            PG8_LDA(At, 0, 1); PG8_STAGE(PG8_SA(0, 0), a2, voffA);
            PG8_BAR; PG8_WAIT_L(0); PG8_MMA(1, 0, At, B0); PG8_BAR; PG8_SCHED;
            PG8_STAGE(PG8_SB(0, 1), b2 + hstepB, voffB);
            PG8_WAIT_V(6); PG8_BAR; PG8_MMA(1, 1, At, B1); PG8_BAR;
            PG8_LDB(B0, 1, 0); PG8_SCHED; PG8_LDA(At, 1, 0); PG8_STAGE(PG8_SA(0, 1), a2, voffA1);
            PG8_WAIT_L(8); PG8_BAR; PG8_WAIT_L(0); PG8_MMA(0, 0, At, B0); PG8_BAR; PG8_SCHED;
            PG8_LDB(B1, 1, 1); PG8_STAGE(PG8_SB(1, 0), b3, voffB);
            PG8_BAR; PG8_WAIT_L(0); PG8_MMA(0, 1, At, B1); PG8_BAR;
            PG8_LDA(At, 1, 1); PG8_STAGE(PG8_SA(1, 0), a3, voffA);
            PG8_BAR; PG8_WAIT_L(0); PG8_MMA(1, 0, At, B0); PG8_BAR; PG8_SCHED;
            PG8_STAGE(PG8_SB(1, 1), b3 + hstepB, voffB);
            PG8_WAIT_V(6); PG8_BAR; PG8_MMA(1, 1, At, B1); PG8_BAR;
            }
        }
        if constexpr (ALIGN_EPI) { if (wr == 0) PG8_BAR; }
        E(acc, cur, wr, wc, fr, fq);
        if (!has_next) break;
#pragma unroll
        for (int a = 0; a < 2; ++a)
#pragma unroll
            for (int b = 0; b < 2; ++b)
#pragma unroll
                for (int m = 0; m < 4; ++m)
#pragma unroll
                    for (int n = 0; n < 2; ++n) acc[a][b][m][n] = (f32x4){0.f, 0.f, 0.f, 0.f};
        cur = nxt; cA = nA; cB = nB; cBhi = nxt.Bhi; ++ui;
        if constexpr (ALIGN_EPI) { if (wr == 1) PG8_BAR; }
    }
    PG8_WAIT_V(0);
    if constexpr (!ALIGN_EPI) { if (wr == 0) PG8_BAR; }
    PG8_BAR;
#undef PG8_SA
#undef PG8_SB
#undef PG8_STAGE
#undef PG8_LDA
#undef PG8_LDB
#undef PG8_MMA
#undef PG8_WAIT_V
#undef PG8_WAIT_L
#undef PG8_BAR
#undef PG8_SCHED
}
}

constexpr int RING_BYTES = 131072, LDS_BYTES = 147456, LDSCTL_OFF = LDS_BYTES - 2048, MISC_OFF = LDSCTL_OFF + 320;
struct KArgs { const void* in[24]; float* out; unsigned char* ws; int ph_lo, ph_hi; };
struct Frame {
    LAS unsigned char* lds; volatile LAS unsigned* MISC; unsigned* ctl; unsigned char* ws; float* out;
    int tid, lane, wave, vcu, G;
    const float *x, *mem, *g_mix, *w_in, *b_gate, *w_pool_grp, *pool_scale, *q_norm_g, *k_norm_g, *g_mem, *w_mem_kv, *xq_norm_g, *xk_norm_g,
                *w_pool_out, *w_attn_out, *w_cross_out, *w_o, *g_ffn, *w_rg, *w_re, *w_eg, *w_eu, *w_ed;
    const int* positions;
};
template <class T> __device__ __forceinline__ T* wsp(const Frame& F, size_t off) { return (T*)(F.ws + off); }

__device__ __forceinline__ void tr_item(const float* W, int ldw, int k0, int n0, int nvalid, const float* gain, bf16_t* dst, int ldd, int dk0, LAS float*, int lane) {
    const int kg = lane >> 3, ng = lane & 7;
    f32x4 v[2][8]; float g[8];
#pragma unroll
    for (int hh = 0; hh < 2; ++hh) { const int nn = 32 * hh + 4 * ng; const bool ok = nn < nvalid;
#pragma unroll
        for (int i = 0; i < 8; ++i) v[hh][i] = ok ? *(const f32x4*)(W + (size_t)(k0 + 8 * kg + i) * ldw + n0 + nn) : (f32x4){0.f, 0.f, 0.f, 0.f}; }
#pragma unroll
    for (int i = 0; i < 8; ++i) g[i] = gain ? gain[k0 + 8 * kg + i] : 1.0f;
#pragma unroll
    for (int hh = 0; hh < 2; ++hh)
#pragma unroll
        for (int j = 0; j < 4; ++j) { const int n = 32 * hh + 4 * ng + j;
            u32x4 o; o.x = pk2(v[hh][0][j] * g[0], v[hh][1][j] * g[1]); o.y = pk2(v[hh][2][j] * g[2], v[hh][3][j] * g[3]); o.z = pk2(v[hh][4][j] * g[4], v[hh][5][j] * g[5]); o.w = pk2(v[hh][6][j] * g[6], v[hh][7][j] * g[7]);
            *(u32x4*)(dst + (size_t)n * ldd + dk0 + k0 + 8 * kg) = o; }
}
__device__ __forceinline__ void row_to_bf16(const float* xrow, bf16_t* orow, float* rstd_out, int lane) {
    const f32x4* xr = (const f32x4*)xrow + lane;
    f32x4 v[8]; float s = 0.f;
#pragma unroll
    for (int j = 0; j < 8; ++j) { v[j] = xr[64 * j]; s += (v[j].x * v[j].x + v[j].y * v[j].y) + (v[j].z * v[j].z + v[j].w * v[j].w); }
    s = wave_sum(s);
    u32x2* o8 = (u32x2*)orow + lane;
#pragma unroll
    for (int j = 0; j < 8; ++j) { u32x2 w; w.x = pk2(v[j].x, v[j].y); w.y = pk2(v[j].z, v[j].w); o8[64 * j] = w; }
    if (lane == 0) *rstd_out = 1.0f / sqrtf(s * (1.0f / DM) + NORM_EPS);
}
__device__ __forceinline__ void att_build_table(Frame& F);
__device__ __forceinline__ int cum_chunks(int qb);
#ifndef P0_PROF
#define P0_PROF 0
#endif
#define P0T0() unsigned long long _pt = (P0_PROF && F.tid == 0) ? __builtin_amdgcn_s_memrealtime() : 0ull
#define P0T1(k) do { if (P0_PROF == (k)) { __syncthreads(); if (F.tid == 0) atomicMax(F.ctl + CW_QUEUE + 8, (unsigned)(__builtin_amdgcn_s_memrealtime() - _pt)); } } while (0)
__device__ __forceinline__ void p0_prologue(Frame& F) {
    P0T0();
    if (blockIdx.x == 0) att_build_table(F);
    LAS float* scr = (LAS float*)(F.lds + F.wave * 16640);
    const int gw = F.vcu * NWAVES + F.wave, NGW = F.G * NWAVES;
    bf16_t* WINT = wsp<bf16_t>(F, WS_WINT); bf16_t* WVT = wsp<bf16_t>(F, WS_WVT); bf16_t* WMKVT = wsp<bf16_t>(F, WS_WMKVT);
    bf16_t* BTMRG = wsp<bf16_t>(F, WS_BTMRG); bf16_t* WOT = wsp<bf16_t>(F, WS_WOT);
    for (int it = gw; it < 4 * 6 * 64; it += NGW) {
        const int g = it / 384, r = it % 384, ct = r / 64, dt = r % 64;
        const int i = F.lane & 31, kh = F.lane >> 5;
        const float* ap = F.w_pool_grp + (size_t)g * 192 * 192 + (size_t)(32 * ct + i) * 192 + 4 * kh;
        const float* sp = F.pool_scale + g * 192 + 4 * kh;
        const float* bp = F.w_pool_out + (size_t)(g * 192 + 4 * kh) * DM + 32 * dt + i;
        f32x16 acc;
#pragma unroll
        for (int q2 = 0; q2 < 16; ++q2) acc[q2] = 0.f;
#pragma unroll 1
        for (int m0 = 0; m0 < 24; m0 += 6) {
            f32x4 a[6], sc[6]; float b[6][4];
#pragma unroll
            for (int mm = 0; mm < 6; ++mm) { a[mm] = *(const f32x4*)(ap + 8 * (m0 + mm)); sc[mm] = *(const f32x4*)(sp + 8 * (m0 + mm));
#pragma unroll
                for (int e = 0; e < 4; ++e) b[mm][e] = bp[(size_t)(8 * (m0 + mm) + e) * DM]; }
#pragma unroll
            for (int mm = 0; mm < 6; ++mm)
#pragma unroll
                for (int e = 0; e < 4; ++e) acc = __builtin_amdgcn_mfma_f32_32x32x2f32(a[mm][e] * sc[mm][e], b[mm][e], acc, 0, 0, 0);
        }
        bf16_t* op = BTMRG + (size_t)(32 * dt + i) * DM + g * 192 + 32 * ct + 4 * kh;
#pragma unroll
        for (int q4 = 0; q4 < 4; ++q4) { u32x2 o; o.x = pk2(acc[4 * q4 + 0], acc[4 * q4 + 1]); o.y = pk2(acc[4 * q4 + 2], acc[4 * q4 + 3]); *(u32x2*)(op + 8 * q4) = o; }
    }
    P0T1(1);
    __syncthreads();
    constexpr int NB_IN = 158, I_IN = 32 * NB_IN, I_MKV = 32 * 16, I_WO = 32 * 32, I_AO = 12 * 32, I_CO = 8 * 32;
    constexpr int NITEMS = I_IN + I_MKV + I_WO + I_AO + I_CO;
    for (int it = gw; it < NITEMS; it += NGW) {
        int r = it;
        if (r < I_IN) {
            const int kb = r / NB_IN, nb = r % NB_IN; int sc0, drow, nv = 64; bf16_t* dm = WINT; int j;
            if (nb < 12) { j = nb; sc0 = 0; drow = 0; }
            else if (nb < 24) { j = nb - 12; sc0 = 768; drow = 768; }
            else if (nb < 36) { j = nb - 24; sc0 = 1536; drow = 1536; }
            else if (nb < 48) { j = nb - 36; sc0 = 2304; drow = 0; dm = WVT; }
            else if (nb < 52) { j = nb - 48; sc0 = 3072; drow = 2304; }
            else if (nb < 54) { j = nb - 52; sc0 = 3328; drow = 2560; if (j == 1) nv = 4; }
            else if (nb < 62) { j = nb - 54; sc0 = 3396; drow = 2816; }
            else { j = nb - 62; sc0 = 3908; drow = 3328; }
            tr_item(F.w_in, INC, kb * 64, sc0 + 64 * j, nv, F.g_mix, dm + (size_t)(drow + 64 * j) * DM, DM, 0, scr, F.lane); continue; }
        r -= I_IN;
        if (r < I_MKV) { const int kb = r / 16, nb = r % 16; tr_item(F.w_mem_kv, 1024, kb * 64, nb * 64, 64, F.g_mem, WMKVT + (size_t)(nb * 64) * DM, DM, 0, scr, F.lane); continue; }
        r -= I_MKV;
        if (r < I_WO) { const int kb = r / 32, nb = r % 32; tr_item(F.w_o, DM, kb * 64, nb * 64, 64, nullptr, WOT + (size_t)(nb * 64) * DM, DM, 0, scr, F.lane); continue; }
        r -= I_WO;
        if (r < I_AO) { const int kb = r / 32, nb = r % 32; tr_item(F.w_attn_out, DM, kb * 64, nb * 64, 64, nullptr, BTMRG + (size_t)(nb * 64) * DM, DM, 768, scr, F.lane); continue; }
        r -= I_AO;
        { const int kb = r / 32, nb = r % 32; tr_item(F.w_cross_out, DM, kb * 64, nb * 64, 64, nullptr, BTMRG + (size_t)(nb * 64) * DM, DM, 1536, scr, F.lane); }
    }
    P0T1(2);
    { u32x4* z = (u32x4*)(WINT + (size_t)2688 * DM); const int n16 = 128 * DM * 2 / 16;
      for (int i = F.vcu * NTHR + F.tid; i < n16; i += F.G * NTHR) z[i] = (u32x4){0u, 0u, 0u, 0u}; }
    { float* WR = wsp<float>(F, WS_WR);
      for (int i = F.vcu * NTHR + F.tid; i < DM * 32; i += F.G * NTHR) { const int k = i >> 5, j = i & 31;
          float v = 0.f; if (j < 4) v = F.w_rg[k * 4 + j]; else if (j < 20) v = F.w_re[k * 16 + (j - 4)];
          WR[i] = v * F.g_ffn[k]; } }
    P0T1(3);
    { bf16_t* XB = wsp<bf16_t>(F, WS_XB); float* R1 = wsp<float>(F, WS_RSTD1); bf16_t* MB = wsp<bf16_t>(F, WS_MEMB); float* RM = wsp<float>(F, WS_RSTDM);
      for (int m = gw; m < SEQ + MEML; m += NGW) {
          if (m < SEQ) row_to_bf16(F.x + (size_t)m * DM, XB + (size_t)m * DM, R1 + m, F.lane);
          else { const int mm = m - SEQ; row_to_bf16(F.mem + (size_t)mm * DM, MB + (size_t)mm * DM, RM + mm, F.lane); } } }
}

struct SchedP1 {
    int c, G; unsigned char* ws;
    __device__ __forceinline__ bool next(int i, pg8::Unit& u) const {
        const int L = i * G + c; const size_t tstep = (size_t)256 * DM * 2;
        const char* XB = (const char*)(ws + WS_XB); const char* WINT = (const char*)(ws + WS_WINT); const char* WVT = (const char*)(ws + WS_WVT); const char* MEMB = (const char*)(ws + WS_MEMB); const char* WMKVT = (const char*)(ws + WS_WMKVT);
        u.nt = 32; u.lowonly = 0;
        if (L < 1184) { int pm, pn; pg8::tile_order(L, 32, 37, pm, pn);
            u.A = XB + (size_t)pm * tstep; u.B = WINT + (size_t)pn * tstep; u.Bhi = u.B; u.row0 = pm * 256;
            if (pn < 3) { u.kind = 0; u.col0 = pn * 256; u.aux = 0; }
            else if (pn < 6) { u.kind = 0; u.col0 = (pn - 3) * 256; u.aux = 1; }
            else if (pn < 9) { u.kind = 0; u.col0 = (pn - 6) * 256; u.aux = 2; }
            else if (pn < 11) { u.kind = 1; u.col0 = (pn - 9) * 256; u.aux = 0; }
            else if (pn < 13) { u.kind = 0; u.col0 = (pn - 11) * 256; u.aux = 3; }
            else { u.kind = 2; u.col0 = (pn - 13) * 256; u.aux = 0; }
            return true; }
        if (L < 1280) { const int idx = L - 1184, pm = idx / 32, pn = idx % 32;
            u.A = WVT + (size_t)pm * tstep; u.B = XB + (size_t)pn * tstep; u.Bhi = u.B; u.kind = 3; u.row0 = pm * 256; u.col0 = pn * 256; u.aux = 0; return true; }
        if (L < 1312) { const int idx = L - 1280, pn = idx & 3, ks = idx >> 2;
            u.A = MEMB + (size_t)ks * 512; u.B = WMKVT + (size_t)pn * tstep + (size_t)ks * 512; u.Bhi = u.B; u.kind = 4; u.row0 = 0; u.col0 = pn * 256; u.aux = ks; u.nt = 4; return true; }
        return false;
    }
};
struct EpiP1 {
    static constexpr bool HOOK = false; static constexpr int HOOK_T1 = -1, HOOK_T2 = -1;
    unsigned char* ws; const float* rstd1; const float* rstdm; const float* bgate;
    __device__ __forceinline__ void hook(f32x4 (&)[2][2][4][2], const pg8::Unit&, int, int, int, int, int) const {}
    __device__ __forceinline__ void operator()(const f32x4 (&acc)[2][2][4][2], const pg8::Unit& u, int wr, int wc, int fr, int fq) const {
        const int rbase = u.row0 + wr * 64 + fr, cbase = u.col0 + wc * 32 + 8 * fq;
        if (u.kind == 0) {
            bf16_t* C; int ldc;
            if (u.aux == 0) { C = (bf16_t*)(ws + WS_U); ldc = 768; } else if (u.aux == 1) { C = (bf16_t*)(ws + WS_Q); ldc = 768; }
            else if (u.aux == 2) { C = (bf16_t*)(ws + WS_K); ldc = 768; } else { C = (bf16_t*)(ws + WS_XQ); ldc = 512; }
#pragma unroll
            for (int ai = 0; ai < 2; ++ai)
#pragma unroll
                for (int m = 0; m < 4; ++m) { const int row = rbase + ai * 128 + m * 16; const float s = rstd1[row];
#pragma unroll
                    for (int bj = 0; bj < 2; ++bj) { const f32x4 v0 = acc[ai][bj][m][0] * s, v1 = acc[ai][bj][m][1] * s;
                        u32x4 w; w.x = pk2(v0[0], v0[1]); w.y = pk2(v0[2], v0[3]); w.z = pk2(v1[0], v1[1]); w.w = pk2(v1[2], v1[3]);
                        *(u32x4*)(C + (size_t)row * ldc + cbase + bj * 128) = w; } }
        } else if (u.kind == 1 || u.kind == 4) {
            float* C; int ldc; const float* rs;
            if (u.kind == 1) { C = (float*)(ws + WS_IDXF); ldc = 512; rs = rstd1; } else { C = (float*)(ws + WS_KVMP) + (size_t)u.aux * 262144; ldc = 1024; rs = rstdm; }
#pragma unroll
            for (int ai = 0; ai < 2; ++ai)
#pragma unroll
                for (int m = 0; m < 4; ++m) { const int row = rbase + ai * 128 + m * 16; const float s = rs[row];
#pragma unroll
                    for (int bj = 0; bj < 2; ++bj) { float* p = C + (size_t)row * ldc + cbase + bj * 128;
                        *(f32x4*)p = acc[ai][bj][m][0] * s; *(f32x4*)(p + 4) = acc[ai][bj][m][1] * s; } }
        } else if (u.kind == 2) {
            bf16_t* C = (bf16_t*)(ws + WS_EG);
            f32x4 bv[2][2];
#pragma unroll
            for (int bj = 0; bj < 2; ++bj) { bv[bj][0] = *(const f32x4*)(bgate + cbase + bj * 128); bv[bj][1] = *(const f32x4*)(bgate + cbase + bj * 128 + 4); }
#pragma unroll
            for (int ai = 0; ai < 2; ++ai)
#pragma unroll
                for (int m = 0; m < 4; ++m) { const int row = rbase + ai * 128 + m * 16; const float s = rstd1[row];
#pragma unroll
                    for (int bj = 0; bj < 2; ++bj) { f32x4 v0 = acc[ai][bj][m][0] * s + bv[bj][0], v1 = acc[ai][bj][m][1] * s + bv[bj][1];
#pragma unroll
                        for (int e = 0; e < 4; ++e) { v0[e] = 1.0f + __builtin_amdgcn_exp2f(fminf(-v0[e] * LOG2E, 60.f)); v1[e] = 1.0f + __builtin_amdgcn_exp2f(fminf(-v1[e] * LOG2E, 60.f)); }
                        u32x4 w; w.x = pk2(v0[0], v0[1]); w.y = pk2(v0[2], v0[3]); w.z = pk2(v1[0], v1[1]); w.w = pk2(v1[2], v1[3]);
                        *(u32x4*)(C + (size_t)row * 6144 + cbase + bj * 128) = w; } }
        } else {
            bf16_t* C = (bf16_t*)(ws + WS_VT);
            f32x4 sv[2][2];
#pragma unroll
            for (int bj = 0; bj < 2; ++bj) { sv[bj][0] = *(const f32x4*)(rstd1 + cbase + bj * 128); sv[bj][1] = *(const f32x4*)(rstd1 + cbase + bj * 128 + 4); }
#pragma unroll
            for (int ai = 0; ai < 2; ++ai)
#pragma unroll
                for (int m = 0; m < 4; ++m) { const int row = rbase + ai * 128 + m * 16;
#pragma unroll
                    for (int bj = 0; bj < 2; ++bj) { const f32x4 v0 = acc[ai][bj][m][0] * sv[bj][0], v1 = acc[ai][bj][m][1] * sv[bj][1];
                        u32x4 w; w.x = pk2(v0[0], v0[1]); w.y = pk2(v0[2], v0[3]); w.z = pk2(v1[0], v1[1]); w.w = pk2(v1[2], v1[3]);
                        *(u32x4*)(C + (size_t)row * SEQ + cbase + bj * 128) = w; } }
        }
    }
};

__device__ __forceinline__ void rot_cs(float pos, float inv_freq, float& c, float& s) {
    const float ang = pos * inv_freq;
    const double rev = (double)ang * 0.15915494309189535;
    const float fr = (float)(rev - __builtin_rint(rev));
    c = __builtin_amdgcn_cosf(fr); s = __builtin_amdgcn_sinf(fr);
}
__device__ __forceinline__ void unpack8(const u32x4 v, float (&f)[8]) { f[0] = bflo(v.x); f[1] = bfhi(v.x); f[2] = bflo(v.y); f[3] = bfhi(v.y); f[4] = bflo(v.z); f[5] = bfhi(v.z); f[6] = bflo(v.w); f[7] = bfhi(v.w); }
__device__ __forceinline__ u32x4 pack8(const float (&f)[8]) { u32x4 o; o.x = pk2(f[0], f[1]); o.y = pk2(f[2], f[3]); o.z = pk2(f[4], f[5]); o.w = pk2(f[6], f[7]); return o; }
__device__ __forceinline__ void p2_rowpass(Frame& F) {
    P0T0();
    const int gw = F.vcu * NWAVES + F.wave, NGW = F.G * NWAVES, lane = F.lane;
    const bf16_t* U = wsp<bf16_t>(F, WS_U); bf16_t* AM = wsp<bf16_t>(F, WS_AMRG);
    bf16_t* Q = wsp<bf16_t>(F, WS_Q); bf16_t* K = wsp<bf16_t>(F, WS_K); bf16_t* XQ = wsp<bf16_t>(F, WS_XQ);
    const float* IDXF = wsp<float>(F, WS_IDXF); bf16_t* QIB = wsp<bf16_t>(F, WS_QIB); bf16_t* KIB = wsp<bf16_t>(F, WS_KIB); float* WIF = wsp<float>(F, WS_WIF);
    const int m = lane & 15, mlo = m & 7; const bool hi_half = m >= 8;
    float if128[8], if64[4], gq[8], gk[8], gx[8];
#pragma unroll
    for (int e = 0; e < 8; ++e) { if128[e] = __builtin_amdgcn_exp2f(-(float)(2 * (8 * mlo + e)) * (13.287712379549449f / 128.0f)); gq[e] = F.q_norm_g[8 * m + e]; gk[e] = F.k_norm_g[8 * m + e]; gx[e] = F.xq_norm_g[8 * m + e]; }
#pragma unroll
    for (int e = 0; e < 4; ++e) if64[e] = __builtin_amdgcn_exp2f(-(float)(2 * (4 * mlo + e)) * (13.287712379549449f / 64.0f));
    for (int t = gw; t < SEQ; t += NGW) {
        const int colA = 8 * lane, colB = 512 + 8 * lane;
        const int gA = colA / 192, wA = 2 << gA, cntA = (t + 1 < wA) ? (t + 1) : wA;
        const int gB = (lane < 32) ? colB / 192 : 3, wB = 2 << gB, cntB = (lane < 32) ? ((t + 1 < wB) ? (t + 1) : wB) : 0;
        u32x4 ua[8], ub[16];
#pragma unroll
        for (int j = 0; j < 8; ++j) ua[j] = (j < cntA) ? *(const u32x4*)(U + (size_t)(t - j) * 768 + colA) : (u32x4){0u, 0u, 0u, 0u};
#pragma unroll
        for (int j = 0; j < 16; ++j) ub[j] = (j < cntB) ? *(const u32x4*)(U + (size_t)(t - j) * 768 + colB) : (u32x4){0u, 0u, 0u, 0u};
        u32x4 rawqk[3];
#pragma unroll
        for (int ch = 0; ch < 3; ++ch) { const int e0 = ch * 512 + 8 * lane; rawqk[ch] = *(const u32x4*)((e0 < 768) ? (Q + (size_t)t * 768 + e0) : (K + (size_t)t * 768 + (e0 - 768))); }
        const u32x4 rawx = *(const u32x4*)(XQ + (size_t)t * 512 + 8 * lane);
        const float* ip = IDXF + (size_t)t * 512;
        const f32x4 iqa = *(const f32x4*)(ip + 4 * lane), ika = *(const f32x4*)(ip + 256 + 4 * (lane & 15));
        const float iw = ip[320 + (lane & 3)];
        { float sum[8];
#pragma unroll
          for (int e = 0; e < 8; ++e) sum[e] = 0.f;
#pragma unroll
          for (int j = 0; j < 8; ++j) { float f[8]; unpack8(ua[j], f);
#pragma unroll
              for (int e = 0; e < 8; ++e) sum[e] += f[e]; }
          float cur[8]; unpack8(ua[0], cur); const float inv = 1.0f / (float)cntA; float o[8];
#pragma unroll
          for (int e = 0; e < 8; ++e) o[e] = sum[e] * inv - cur[e];
          *(u32x4*)(AM + (size_t)t * DM + colA) = pack8(o); }
        if (lane < 32) { float sum[8];
#pragma unroll
          for (int e = 0; e < 8; ++e) sum[e] = 0.f;
#pragma unroll
          for (int j = 0; j < 16; ++j) { float f[8]; unpack8(ub[j], f);
#pragma unroll
              for (int e = 0; e < 8; ++e) sum[e] += f[e]; }
          float cur[8]; unpack8(ub[0], cur); const float inv = 1.0f / (float)cntB; float o[8];
#pragma unroll
          for (int e = 0; e < 8; ++e) o[e] = sum[e] * inv - cur[e];
          *(u32x4*)(AM + (size_t)t * DM + colB) = pack8(o); }
        const float pos = (float)F.positions[t];
        float c128[8], s128[8], c64[4], s64[4];
#pragma unroll
        for (int e = 0; e < 8; ++e) rot_cs(pos, if128[e], c128[e], s128[e]);
#pragma unroll
        for (int e = 0; e < 4; ++e) rot_cs(pos, if64[e], c64[e], s64[e]);
#pragma unroll
        for (int ch = 0; ch < 3; ++ch) {
            const int e0 = ch * 512 + 8 * lane; const bool isq = e0 < 768;
            bf16_t* p = isq ? (Q + (size_t)t * 768 + e0) : (K + (size_t)t * 768 + (e0 - 768));
            float v[8], pv[8]; unpack8(rawqk[ch], v);
            float ss = 0.f;
#pragma unroll
            for (int e = 0; e < 8; ++e) ss += v[e] * v[e];
            ss += __shfl_xor(ss, 1); ss += __shfl_xor(ss, 2); ss += __shfl_xor(ss, 4); ss += __shfl_xor(ss, 8);
            const float r = (1.0f / sqrtf(ss * (1.0f / 128.0f) + NORM_EPS)) * (isq ? (ATT_SCALE * LOG2E) : 1.0f);
#pragma unroll
            for (int e = 0; e < 8; ++e) v[e] *= r * (isq ? gq[e] : gk[e]);
#pragma unroll
            for (int e = 0; e < 8; ++e) pv[e] = __shfl_xor(v[e], 8);
            float o[8];
#pragma unroll
            for (int e = 0; e < 8; ++e) o[e] = hi_half ? (v[e] * c128[e] + pv[e] * s128[e]) : (v[e] * c128[e] - pv[e] * s128[e]);
            *(u32x4*)p = pack8(o);
        }
        { bf16_t* p = XQ + (size_t)t * 512 + 8 * lane; float v[8]; unpack8(rawx, v);
          float ss = 0.f;
#pragma unroll
          for (int e = 0; e < 8; ++e) ss += v[e] * v[e];
          ss += __shfl_xor(ss, 1); ss += __shfl_xor(ss, 2); ss += __shfl_xor(ss, 4); ss += __shfl_xor(ss, 8);
          const float r = (1.0f / sqrtf(ss * (1.0f / 128.0f) + NORM_EPS)) * (ATT_SCALE * LOG2E);
#pragma unroll
          for (int e = 0; e < 8; ++e) v[e] *= r * gx[e];
          *(u32x4*)p = pack8(v); }
        { const f32x4 a = iqa; f32x4 b; b[0] = __shfl_xor(a[0], 8); b[1] = __shfl_xor(a[1], 8); b[2] = __shfl_xor(a[2], 8); b[3] = __shfl_xor(a[3], 8);
          float o[4];
#pragma unroll
          for (int e = 0; e < 4; ++e) o[e] = hi_half ? (a[e] * c64[e] + b[e] * s64[e]) : (a[e] * c64[e] - b[e] * s64[e]);
          u32x2 w; w.x = pk2(o[0], o[1]); w.y = pk2(o[2], o[3]); *(u32x2*)(QIB + (size_t)t * 256 + 4 * lane) = w; }
        { const f32x4 a = ika; f32x4 b; b[0] = __shfl_xor(a[0], 8); b[1] = __shfl_xor(a[1], 8); b[2] = __shfl_xor(a[2], 8); b[3] = __shfl_xor(a[3], 8);
          float o[4];
#pragma unroll
          for (int e = 0; e < 4; ++e) o[e] = hi_half ? (a[e] * c64[e] + b[e] * s64[e]) : (a[e] * c64[e] - b[e] * s64[e]);
          u32x2 w; w.x = pk2(o[0], o[1]); w.y = pk2(o[2], o[3]); if (lane < 16) *(u32x2*)(KIB + (size_t)t * 64 + 4 * lane) = w; }
        if (lane < 4) WIF[t * 4 + lane] = iw * 0.0625f;
    }
    P0T1(4);
    { const float* KVM = wsp<float>(F, WS_KVMP); bf16_t* KMB = wsp<bf16_t>(F, WS_KMB); bf16_t* VMT = wsp<bf16_t>(F, WS_VMT);
      const float g0 = F.xk_norm_g[lane], g1 = F.xk_norm_g[lane + 64];
      for (int mm = gw; mm < MEML; mm += NGW) {
#pragma unroll
          for (int h = 0; h < 4; ++h) { float k0 = 0.f, k1 = 0.f;
#pragma unroll
              for (int ks = 0; ks < 8; ++ks) { k0 += KVM[(size_t)ks * 262144 + (size_t)mm * 1024 + h * 128 + lane]; k1 += KVM[(size_t)ks * 262144 + (size_t)mm * 1024 + h * 128 + lane + 64]; }
              const float ks2 = wave_sum(k0 * k0 + k1 * k1), kr = 1.0f / sqrtf(ks2 * (1.0f / 128.0f) + NORM_EPS);
              KMB[(size_t)mm * 512 + h * 128 + lane] = (bf16_t)f2bf(k0 * kr * g0); KMB[(size_t)mm * 512 + h * 128 + lane + 64] = (bf16_t)f2bf(k1 * kr * g1); }
#pragma unroll
          for (int j = 0; j < 8; ++j) { const int c = j * 64 + lane; float v = 0.f;
#pragma unroll
              for (int ks = 0; ks < 8; ++ks) v += KVM[(size_t)ks * 262144 + (size_t)mm * 1024 + 512 + c];
              VMT[(size_t)c * 256 + mm] = (bf16_t)f2bf(v); }
      } }
    P0T1(5);
    { LAS float* scr = (LAS float*)(F.lds + F.wave * 16640);
      bf16_t* WGUT = wsp<bf16_t>(F, WS_WGUT); bf16_t* WDT = wsp<bf16_t>(F, WS_WDT);
      constexpr int I_GU = 16 * 2 * 32 * 8, I_D = 16 * 8 * 32;
      for (int it = gw; it < I_GU + I_D; it += NGW) {
          if (it < I_GU) { const int e = it / 512, r = it % 512, up = r / 256, r2 = r % 256, kb = r2 / 8, nb = r2 % 8, f0 = nb * 64;
              const float* W = (up ? F.w_eu : F.w_eg) + (size_t)e * DM * 512;
              const int drow = (f0 / 128) * 256 + up * 128 + (f0 % 128);
              tr_item(W, 512, kb * 64, f0, 64, F.g_ffn, WGUT + ((size_t)e * 1024 + drow) * DM, DM, 0, scr, lane); }
          else { const int r = it - I_GU, e = r / 256, r2 = r % 256, kb = r2 / 32, nb = r2 % 32;
              tr_item(F.w_ed + (size_t)e * 512 * DM, DM, kb * 64, nb * 64, 64, nullptr, WDT + ((size_t)e * DM + nb * 64) * 512, 512, 0, scr, lane); }
      } }
}

constexpr int HS = 1025;
constexpr int P3_HIST = 0, P3_RING = 16 * HS * 4, P3_LMASK = P3_RING + 8 * 3 * 2048, P3_STATE = P3_LMASK + 16 * 256 * 4;
constexpr int P3_CAP = 384;
__device__ __forceinline__ float relu_s(float x) { return __builtin_amdgcn_fmed3f(x, 0.f, __builtin_inff()); }
template <int MODE, bool DIAG> __device__ __forceinline__ void p3_tile(LAS unsigned* hist, LAS unsigned* lmask, LAS unsigned* ccnt, const bf16x8 A0, const bf16x8 A1, const bf16x8 (&Bq)[4][2], const float (&wq)[4],
                                                              int kt, int q, int fq, unsigned pref, unsigned thr, unsigned idxs, bool part, int dtype) {
    const int s0 = 16 * kt;
    float sc[4] = {0.f, 0.f, 0.f, 0.f};
#pragma unroll
    for (int h = 0; h < 4; ++h) { f32x4 d = (f32x4){0.f, 0.f, 0.f, 0.f};
        d = __builtin_amdgcn_mfma_f32_16x16x32_bf16(A0, Bq[h][0], d, 0, 0, 0); d = __builtin_amdgcn_mfma_f32_16x16x32_bf16(A1, Bq[h][1], d, 0, 0, 0);
#pragma unroll
        for (int i = 0; i < 4; ++i) sc[i] = __builtin_fmaf(wq[h], relu_s(d[i]), sc[i]); }
    unsigned nib = 0u, cflag = 0u; unsigned ckey[4];
#pragma unroll
    for (int i = 0; i < 4; ++i) {
        const unsigned bits = __builtin_bit_cast(unsigned, sc[i]);
        const unsigned key = bits ^ ((unsigned)((int)bits >> 31) | 0x80000000u);
        const bool valid = DIAG ? (4 * fq + i <= q) : true;
        const unsigned s = (unsigned)(s0 + 4 * fq + i);
        if constexpr (MODE == 0) { if (valid && part) { const unsigned dg = key >> 21; __hip_atomic_fetch_add(&hist[q * HS + (dg >> 1)], 1u << (16 * (dg & 1u)), __ATOMIC_RELAXED, __HIP_MEMORY_SCOPE_WORKGROUP); } }
        else if constexpr (MODE == 1) { if (valid && part && (key >> 21) == pref) { const unsigned dg = (key >> 10) & 2047u; __hip_atomic_fetch_add(&hist[q * HS + (dg >> 1)], 1u << (16 * (dg & 1u)), __ATOMIC_RELAXED, __HIP_MEMORY_SCOPE_WORKGROUP); } }
        else if constexpr (MODE == 2) { if (valid && part && (key >> 10) == pref) { const unsigned dg = key & 1023u; __hip_atomic_fetch_add(&hist[q * HS + (dg >> 1)], 1u << (16 * (dg & 1u)), __ATOMIC_RELAXED, __HIP_MEMORY_SCOPE_WORKGROUP); } }
        else if constexpr (MODE == 3) { if (valid && part && key == thr) { const unsigned dg = s >> 2; __hip_atomic_fetch_add(&hist[q * HS + (dg >> 1)], 1u << (16 * (dg & 1u)), __ATOMIC_RELAXED, __HIP_MEMORY_SCOPE_WORKGROUP); } }
        else if constexpr (MODE == 4) { if (valid && part && key == thr && (s >> 2) == pref) { const unsigned dg = s & 3u; __hip_atomic_fetch_add(&hist[q * HS + (dg >> 1)], 1u << (16 * (dg & 1u)), __ATOMIC_RELAXED, __HIP_MEMORY_SCOPE_WORKGROUP); } }
        else if constexpr (MODE == 5) { const bool sel = valid && (key > thr || (key == thr && s <= idxs)); nib |= sel ? (1u << i) : 0u; }
        else {
            const unsigned m13 = (bits & 0x7fffffffu) >> 18; const unsigned cl = m13 < 3168u ? 3168u : (m13 > 4191u ? 4191u : m13); const unsigned ix = cl - 3168u;
            const int bi = (int)bits; const unsigned dg = bi > 0 ? 1024u + ix : (bi < 0 ? 1023u - ix : 1024u);
            ckey[i] = key;
            if constexpr (MODE == 9) { if (valid) __hip_atomic_fetch_add(&hist[q * HS + (dg >> 1)], 1u << (16 * (dg & 1u)), __ATOMIC_RELAXED, __HIP_MEMORY_SCOPE_WORKGROUP); }
            else { if (valid && dg > pref) nib |= (1u << i); else if (valid && dg == pref) cflag |= (1u << i); } }
    }
    if constexpr (MODE == 10) {
        if (cflag) { __hip_atomic_fetch_or(&hist[q * HS + 768 + (kt >> 1)], cflag << (16 * (kt & 1) + 4 * fq), __ATOMIC_RELAXED, __HIP_MEMORY_SCOPE_WORKGROUP);
            if (part) { unsigned sl = __hip_atomic_fetch_add(&ccnt[q], (unsigned)__builtin_popcount(cflag), __ATOMIC_RELAXED, __HIP_MEMORY_SCOPE_WORKGROUP);
#pragma unroll
                for (int i = 0; i < 4; ++i) if ((cflag >> i) & 1u) { if (sl < (unsigned)P3_CAP) { hist[q * HS + 2 * sl] = ckey[i]; hist[q * HS + 2 * sl + 1] = (unsigned)(s0 + 4 * fq + i); } ++sl; } } }
    }
    if constexpr (MODE == 5 || MODE == 10) { if (nib) __hip_atomic_fetch_or(&lmask[q * 256 + (kt >> 1)], nib << (16 * (kt & 1) + 4 * fq), __ATOMIC_RELAXED, __HIP_MEMORY_SCOPE_WORKGROUP); }
}
template <int MODE> __device__ __forceinline__ void p3_sweep(Frame& F, int b, const bf16x8 (&Bq)[4][2], const float (&wq)[4], unsigned pref, unsigned thr, unsigned idxs, bool part, int dtype = 0) {
    const char* KIBc = (const char*)wsp<bf16_t>(F, WS_KIB);
    LAS unsigned* hist = (LAS unsigned*)(F.lds + P3_HIST); LAS unsigned* lmask = (LAS unsigned*)(F.lds + P3_LMASK); LAS unsigned* ccnt = (LAS unsigned*)(F.lds + P3_STATE) + 80;
    LAS unsigned char* ring = F.lds + P3_RING + F.wave * 6144;
    const int lane = F.lane, q = lane & 15, fq = lane >> 4;
    unsigned doff[2];
#pragma unroll
    for (int i = 0; i < 2; ++i) { const int p = 64 * i + lane, r = p >> 3, c = p & 7; doff[i] = (unsigned)(r * 128 + ((c ^ ((r >> 1) & 7)) << 4)); }
    int raddr[2];
#pragma unroll
    for (int ks = 0; ks < 2; ++ks) raddr[ks] = q * 128 + (((4 * ks + fq) ^ ((q >> 1) & 7)) << 4);
    const int nj = (b >= F.wave) ? ((b - F.wave) >> 3) + 1 : 0;
#define P3_ISSUE(j, slot) do { int _kt = F.wave + 8 * (j); _kt = _kt < b ? _kt : b; const char* _src = KIBc + (size_t)_kt * 2048; LAS unsigned char* _dst = ring + (slot) * 2048; \
        __builtin_amdgcn_global_load_lds((const unsigned*)(_src + doff[0]), (LAS unsigned*)(_dst), 16, 0, 0); \
        __builtin_amdgcn_global_load_lds((const unsigned*)(_src + doff[1]), (LAS unsigned*)(_dst + 1024), 16, 0, 0); } while (0)
    if (nj > 0) { P3_ISSUE(0, 0); P3_ISSUE(1, 1); }
    int sl = 0;
    for (int j = 0; j < nj; ++j) {
        const int sl2 = (sl == 0) ? 2 : sl - 1;
        P3_ISSUE(j + 2, sl2);
        asm volatile("s_waitcnt vmcnt(4)" ::: "memory");
        const LAS unsigned char* sp = ring + sl * 2048;
        const bf16x8 A0 = *(const LAS bf16x8*)(sp + raddr[0]), A1 = *(const LAS bf16x8*)(sp + raddr[1]);
        const int kt = F.wave + 8 * j;
        if (kt < b) p3_tile<MODE, false>(hist, lmask, ccnt, A0, A1, Bq, wq, kt, q, fq, pref, thr, idxs, part, dtype);
        else p3_tile<MODE, true>(hist, lmask, ccnt, A0, A1, Bq, wq, kt, q, fq, pref, thr, idxs, part, dtype);
        sl = (sl == 2) ? 0 : sl + 1;
    }
    asm volatile("s_waitcnt vmcnt(0)" ::: "memory");
#undef P3_ISSUE
}
__device__ __forceinline__ void p3_scan(Frame& F, bool fromtop) {
    LAS unsigned* hist = (LAS unsigned*)(F.lds + P3_HIST); LAS unsigned* st = (LAS unsigned*)(F.lds + P3_STATE);
    __syncthreads();
    const int lane = F.lane;
#pragma unroll 1
    for (int rr = 0; rr < 2; ++rr) {
        const int row = 2 * F.wave + rr;
        if (st[row * 4 + 3] == 0u) continue;
        const unsigned rank = st[row * 4 + 1];
        unsigned wv[16]; unsigned sj = 0;
#pragma unroll
        for (int i = 0; i < 16; ++i) { wv[i] = hist[row * HS + 16 * lane + i]; sj += (wv[i] & 0xffffu) + (wv[i] >> 16); }
        unsigned P = sj;
#pragma unroll
        for (int o = 1; o < 64; o <<= 1) { const unsigned v = __shfl_up(P, o); if (lane >= o) P += v; }
        const unsigned T = __shfl(P, 63);
        unsigned cum = fromtop ? (T - P) : (P - sj);
        const bool cross = (cum < rank) && (rank <= cum + sj);
        unsigned bin = 0, cb = 0; bool found = false;
#pragma unroll
        for (int ii = 0; ii < 32; ++ii) { const int bl = fromtop ? 31 - ii : ii; const unsigned w = wv[bl >> 1]; const unsigned c = (bl & 1) ? (w >> 16) : (w & 0xffffu);
            const bool hit = !found && (cum + c >= rank);
            if (hit) { bin = (unsigned)(32 * lane + bl); cb = c; found = true; }
            if (!found) cum += c; }
        if (cross) { st[row * 4 + 0] = bin; st[row * 4 + 1] = rank - cum; st[row * 4 + 2] = cb; }
    }
    __syncthreads();
}
__device__ __forceinline__ unsigned wave_count(bool p) { return (unsigned)__builtin_popcountll(__ballot(p)); }
__device__ __forceinline__ void p3_select_row(Frame& F, int row, int shift) {
    LAS unsigned* cand = (LAS unsigned*)(F.lds + P3_HIST) + row * HS; LAS unsigned* lmask = (LAS unsigned*)(F.lds + P3_LMASK) + row * 256; LAS unsigned* st = (LAS unsigned*)(F.lds + P3_STATE);
    const unsigned bin0 = st[row * 4 + 0], rank = st[row * 4 + 1], nc = st[row * 4 + 2];
    const int lane = F.lane;
    unsigned ck[8], ci[8];
#pragma unroll
    for (int i = 0; i < 8; ++i) { const unsigned sl = (unsigned)(lane + 64 * i); const bool ok = sl < nc; ck[i] = ok ? cand[2 * sl] : 0u; ci[i] = ok ? cand[2 * sl + 1] : 0x7fffffffu; }
    unsigned P = 0u; (void)bin0; (void)shift;
#pragma unroll 1
    for (int bit = 31; bit >= 0; --bit) { const unsigned trial = P | (1u << bit); unsigned c = 0;
#pragma unroll
        for (int i = 0; i < 8; ++i) c += wave_count(ck[i] >= trial);
        if (c >= rank) P = trial; }
    const unsigned thr = P; unsigned cg = 0, ce = 0;
#pragma unroll
    for (int i = 0; i < 8; ++i) { cg += wave_count(ck[i] > thr); ce += wave_count(ck[i] == thr); }
    const unsigned quota = rank - cg; unsigned idxs = 0x7fffffffu;
    if (ce > quota) {
        unsigned X = 0;
#pragma unroll 1
        for (int bit = 12; bit >= 0; --bit) { const unsigned trial = X | (1u << bit); unsigned c = 0;
#pragma unroll
            for (int i = 0; i < 8; ++i) c += wave_count(ck[i] == thr && ci[i] < trial);
            if (c < quota) X = trial; }
        idxs = X;
    }
#pragma unroll
    for (int i = 0; i < 8; ++i) { const bool sel = (ck[i] > thr) || (ck[i] == thr && ci[i] <= idxs);
        if (sel && ci[i] != 0x7fffffffu) __hip_atomic_fetch_or(&lmask[ci[i] >> 5], 1u << (ci[i] & 31u), __ATOMIC_RELAXED, __HIP_MEMORY_SCOPE_WORKGROUP); }
}
__device__ __forceinline__ void p3_select_zero(Frame& F, int row) {
    LAS unsigned* zm = (LAS unsigned*)(F.lds + P3_HIST) + row * HS + 768; LAS unsigned* lmask = (LAS unsigned*)(F.lds + P3_LMASK) + row * 256; LAS unsigned* st = (LAS unsigned*)(F.lds + P3_STATE);
    const unsigned quota = st[row * 4 + 1]; const int lane = F.lane;
    unsigned w[4]; unsigned pc = 0;
#pragma unroll
    for (int i = 0; i < 4; ++i) { w[i] = zm[4 * lane + i]; pc += (unsigned)__builtin_popcount(w[i]); }
    unsigned P = pc;
#pragma unroll
    for (int o = 1; o < 64; o <<= 1) { const unsigned v = __shfl_up(P, o); if (lane >= o) P += v; }
    unsigned cum = P - pc;
#pragma unroll
    for (int i = 0; i < 4; ++i) { unsigned ww = w[i]; const unsigned c = (unsigned)__builtin_popcount(ww);
        if (cum >= quota) ww = 0u;
        else if (cum + c > quota) { const unsigned keep = quota - cum; while ((unsigned)__builtin_popcount(ww) > keep) ww &= ~(0x80000000u >> __builtin_clz(ww)); }
        cum += c;
        if (ww) __hip_atomic_fetch_or(&lmask[4 * lane + i], ww, __ATOMIC_RELAXED, __HIP_MEMORY_SCOPE_WORKGROUP); }
}
__device__ __forceinline__ void p3_zero_hist(Frame& F) {
    LAS unsigned* hist = (LAS unsigned*)(F.lds + P3_HIST);
    for (int i = F.tid; i < 16 * HS; i += NTHR) hist[i] = 0u;
}
#define P3T0() unsigned long long _pt = (P3_PROF && F.tid == 0) ? __builtin_amdgcn_s_memrealtime() : 0ull
#define P3T1(k) do { if (P3_PROF == (k) && F.tid == 0) { volatile LAS unsigned* _m = F.MISC + 16; const unsigned long long _d = __builtin_amdgcn_s_memrealtime() - _pt; _m[0] = _m[0] + (unsigned)_d; } } while (0)
__device__ __forceinline__ void p3_block(Frame& F, int b) {
    const bf16_t* QIB = wsp<bf16_t>(F, WS_QIB); const float* WIF = wsp<float>(F, WS_WIF); unsigned* MASK = wsp<unsigned>(F, WS_MASK);
    LAS unsigned* st = (LAS unsigned*)(F.lds + P3_STATE); LAS unsigned* lmask = (LAS unsigned*)(F.lds + P3_LMASK);
    const int lane = F.lane, q = lane & 15, fq = lane >> 4, t0 = 16 * b;
    bf16x8 Bq[4][2]; float wq[4];
#pragma unroll
    for (int h = 0; h < 4; ++h) { Bq[h][0] = *(const bf16x8*)(QIB + (size_t)(t0 + q) * 256 + h * 64 + 8 * fq); Bq[h][1] = *(const bf16x8*)(QIB + (size_t)(t0 + q) * 256 + h * 64 + 32 + 8 * fq); wq[h] = WIF[(t0 + q) * 4 + h]; }
    __syncthreads();
    for (int i = F.tid; i < 16 * 256; i += NTHR) lmask[i] = 0u;
    if (b >= 16) {
        const int dtype = 0;
        p3_zero_hist(F);
        if (F.tid < 16) { st[F.tid * 4 + 0] = 0u; st[F.tid * 4 + 1] = 256u; st[F.tid * 4 + 2] = 0u; st[F.tid * 4 + 3] = 1u; st[80 + F.tid] = 0u; }
        if (F.tid == 0) st[64] = 0u;
        if (fq == 0) st[96 + q] = (unsigned)dtype;
        __syncthreads();
        { P3T0(); p3_sweep<9>(F, b, Bq, wq, 0u, 0u, 0u, true, dtype); P3T1(1); P3T1(4); } { P3T0(); p3_scan(F, true); P3T1(2); }
        if (F.tid < 16) { const unsigned bn = st[F.tid * 4 + 0], cn = st[F.tid * 4 + 2]; const unsigned dt = 0u; (void)dt;
            const unsigned cls = (bn == 1024u) ? 1u : (cn <= (unsigned)P3_CAP ? 0u : 2u);
            st[112 + F.tid] = cls; if (cls == 2u) st[64] = 1u;
            if (P3_PROF >= 11 && cls == 2u) { const int cause = (dt == 1u) ? (bn == 0u ? 11 : 12) : (dt == 2u ? 13 : 14); if (cause == P3_PROF && b >= 128) atomicAdd(F.ctl + CW_QUEUE + 8, 1u); } }
        __syncthreads();
        const unsigned bin0 = st[q * 4 + 0];
        if (st[64] == 0u) {
            for (int i = F.tid; i < 16 * 256; i += NTHR) ((LAS unsigned*)(F.lds + P3_HIST))[(i >> 8) * HS + 768 + (i & 255)] = 0u;
            __syncthreads();
            { P3T0(); p3_sweep<10>(F, b, Bq, wq, bin0, 0u, 0u, st[112 + q] == 0u, dtype); P3T1(1); P3T1(5); }
            __syncthreads();
            { P3T0();
#pragma unroll 1
              for (int rr = 0; rr < 2; ++rr) { const int row = 2 * F.wave + rr; if (st[112 + row] == 0u) p3_select_row(F, row, st[96 + row] ? 20 : 21); else p3_select_zero(F, row); }
              __syncthreads(); P3T1(3); }
        } else {
            if (P3_PROF == 6 && F.tid == 0) atomicAdd(F.ctl + CW_QUEUE + 8, 1u);
            __syncthreads(); p3_zero_hist(F);
            if (F.tid < 16) { st[F.tid * 4 + 0] = 0u; st[F.tid * 4 + 1] = 256u; st[F.tid * 4 + 2] = 0u; st[F.tid * 4 + 3] = 1u; }
            __syncthreads();
            { P3T0(); p3_sweep<0>(F, b, Bq, wq, 0u, 0u, 0u, true); P3T1(1); } { P3T0(); p3_scan(F, true); P3T1(2); }
            unsigned pref = st[q * 4 + 0];
            __syncthreads(); p3_zero_hist(F); __syncthreads();
            { P3T0(); p3_sweep<1>(F, b, Bq, wq, pref, 0u, 0u, true); P3T1(1); } { P3T0(); p3_scan(F, true); P3T1(2); }
            pref = (pref << 11) | st[q * 4 + 0];
            __syncthreads(); p3_zero_hist(F); __syncthreads();
            { P3T0(); p3_sweep<2>(F, b, Bq, wq, pref, 0u, 0u, true); P3T1(1); } { P3T0(); p3_scan(F, true); P3T1(2); }
            const unsigned thr = (pref << 10) | st[q * 4 + 0];
            const unsigned quota = st[q * 4 + 1], cnteq = st[q * 4 + 2];
            const bool tie = cnteq > quota; unsigned idxs = 0x7fffffffu;
            __syncthreads();
            if (F.tid == 0) st[64] = 0u;
            __syncthreads();
            if (tie && fq == 0) st[64] = 1u;
            if (F.tid < 16) st[F.tid * 4 + 3] = (st[F.tid * 4 + 2] > st[F.tid * 4 + 1]) ? 1u : 0u;
            __syncthreads();
            if (st[64]) {
                p3_zero_hist(F); __syncthreads();
                { P3T0(); p3_sweep<3>(F, b, Bq, wq, 0u, thr, 0u, tie); P3T1(1); } { P3T0(); p3_scan(F, false); P3T1(2); }
                const unsigned ip = st[q * 4 + 0];
                __syncthreads(); p3_zero_hist(F); __syncthreads();
                { P3T0(); p3_sweep<4>(F, b, Bq, wq, ip, thr, 0u, tie); P3T1(1); } { P3T0(); p3_scan(F, false); P3T1(2); }
                if (tie) idxs = (ip << 2) | st[q * 4 + 0];
            }
            __syncthreads();
            { P3T0(); p3_sweep<5>(F, b, Bq, wq, 0u, thr, idxs, true); P3T1(1); }
        }
    } else {
        __syncthreads();
        { P3T0(); p3_sweep<5>(F, b, Bq, wq, 0u, 0u, 0x7fffffffu, true); P3T1(1); }
    }
    __syncthreads();
    { const int qb = t0 >> 8, lr0 = t0 & 255, nkt = 4 * (qb + 1), row = (F.tid >> 1) & 15, wl = F.tid & 1;
      for (int kt = F.tid >> 5; kt < nkt; kt += 16) MASK[((size_t)(qb * 128 + kt) * 256 + lr0 + row) * 2 + wl] = lmask[row * 256 + 2 * kt + wl]; }
}
__device__ __forceinline__ void p3_indexer(Frame& F) {
    const unsigned long long t0 = (P3_PROF >= 7 && F.tid == 0) ? __builtin_amdgcn_s_memrealtime() : 0ull;
    LAS int* qs = (LAS int*)(F.lds + LDSCTL_OFF + 256);
    for (;;) {
        __syncthreads();
        if (F.tid == 0) qs[0] = (int)atomicAdd(F.ctl + CW_QUEUE + 1, 1u);
        __syncthreads();
        const int idx = qs[0];
        if (idx >= 512) break;
        p3_block(F, 511 - idx);
    }
    __syncthreads();
    if (P3_PROF == 7 && F.tid == 0) atomicMax(F.ctl + CW_QUEUE + 8, (unsigned)(__builtin_amdgcn_s_memrealtime() - t0));
    if (P3_PROF == 8 && F.tid == 0) atomicMin(F.ctl + CW_QUEUE + 9, (unsigned)(__builtin_amdgcn_s_memrealtime() - t0));
}

constexpr int N_ATT_UNITS = 608;
constexpr size_t SLOT_FLOATS = 256 * 128 + 256;
__device__ __forceinline__ int cum_chunks(int qb) { const int n1 = qb, a = n1 >> 3, bb = n1 & 7; return 4 * a * (a + 1) + bb * (a + 1); }
constexpr int AT_K = 0, AT_V = 16384, AT_M = 32768, AT_STAGE = 34816, AT_EPI = 3 * AT_STAGE;
template <bool MASKED>
__device__ __forceinline__ void attn_unit(LAS unsigned char* lds, const bf16_t* Qh, int ldq, const bf16_t* Kh, int ldk, const bf16_t* Vth, int ldvt, const unsigned* maskt  ,
                                          int q0, int key0, int ntl, bool final, float* slot, bf16_t* outb  , int tid_in, int wave, int lane_in) {
    int tid = tid_in, lane = lane_in; asm volatile("" : "+v"(tid), "+v"(lane));
    const int q = lane & 31, hh = lane >> 5, qrow = q0 + 32 * wave + q;
    bf16x8 qf[8];
#pragma unroll
    for (int d0 = 0; d0 < 8; ++d0) qf[d0] = *(const bf16x8*)(Qh + (size_t)qrow * ldq + 16 * d0 + 8 * hh);
    const char* kbase = (const char*)(Kh + (size_t)key0 * ldk); const char* vbase = (const char*)(Vth + key0); const char* mbase = (const char*)(maskt + (size_t)(key0 >> 6) * 512);
    const unsigned ldsw16 = (unsigned)wave * 1024u, ldsw4 = (unsigned)wave * 256u;
#define AT_ISSUE(t, st) do { int _tid = tid; asm volatile("" : "+v"(_tid)); LAS unsigned char* _b = lds + (st) * AT_STAGE; const char* _kb = kbase + (size_t)(t) * 64 * ldk * 2; const char* _vb = vbase + (size_t)(t) * 128; \
        _Pragma("unroll") for (int _j = 0; _j < 2; ++_j) { const int _p = _tid + 512 * _j; const int _kr = _p >> 4, _kc = (_p & 15) ^ (_kr & 15); const int _vr = _p >> 3, _vc = (_p & 7) ^ ((_vr >> 1) & 7); \
            __builtin_amdgcn_global_load_lds((const unsigned*)(_kb + (unsigned)(_kr * ldk * 2 + _kc * 16)), (LAS unsigned*)(_b + AT_K + ldsw16 + _j * 8192), 16, 0, 0); \
            __builtin_amdgcn_global_load_lds((const unsigned*)(_vb + (unsigned)(_vr * ldvt * 2 + _vc * 16)), (LAS unsigned*)(_b + AT_V + ldsw16 + _j * 8192), 16, 0, 0); } \
        if (MASKED) __builtin_amdgcn_global_load_lds((const unsigned*)(mbase + (size_t)(t) * 2048 + (unsigned)_tid * 4u), (LAS unsigned*)(_b + AT_M + ldsw4), 4, 0, 0); } while (0)
    const int prow = (q & 0x13) | ((q & 4) << 1) | ((q & 8) >> 1);
    const int ky = hh ^ (prow & 15), vw = hh ^ ((q >> 1) & 7);
    int kaddr[8];
#pragma unroll
    for (int d0 = 0; d0 < 8; ++d0) kaddr[d0] = AT_K + prow * 256 + (((2 * d0) ^ ky) << 4);
    const int vrow = AT_V + q * 128;
#define vaddr_(s) (vrow + ((((2 * (s)) ^ vw)) << 4))
    const int maddr = AT_M + (32 * wave + q) * 8;
    f32x16 o[4];
#pragma unroll
    for (int d = 0; d < 4; ++d)
#pragma unroll
        for (int r = 0; r < 16; ++r) o[d][r] = 0.f;
    float l = 0.f;
#define AT_QK(S, SB, BT) do { _Pragma("unroll") for (int _r = 0; _r < 16; ++_r) S[_r] = 0.f; \
        _Pragma("unroll") for (int _d = 0; _d < 8; ++_d) { const bf16x8 _kf = *(const LAS bf16x8*)((SB) + kaddr[_d] + (BT) * 8192); S = __builtin_amdgcn_mfma_f32_32x32x16_bf16(_kf, qf[_d], S, 0, 0, 0); } } while (0)
#define AT_SM(S, MW) do { _Pragma("unroll") for (int _s = 0; _s < 2; ++_s) { float _p[8]; \
        _Pragma("unroll") for (int _j = 0; _j < 8; ++_j) { const int _r = 8 * _s + _j; float _e = __builtin_amdgcn_exp2f(S[_r]); if (MASKED) _e = __builtin_bit_cast(float, __builtin_bit_cast(unsigned, _e) & (unsigned)__builtin_amdgcn_sbfe((int)(MW), (unsigned)((_r & 7) + 16 * (_r >> 3)), 1u)); _p[_j] = _e; l += _e; } \
        u32x4 _w; _w.x = pk2(_p[0], _p[1]); _w.y = pk2(_p[2], _p[3]); _w.z = pk2(_p[4], _p[5]); _w.w = pk2(_p[6], _p[7]); pf[_s] = __builtin_bit_cast(bf16x8, _w); } } while (0)
#define AT_PV(SB, BT) do { _Pragma("unroll") for (int _d = 0; _d < 4; ++_d) _Pragma("unroll") for (int _s = 0; _s < 2; ++_s) { \
        const bf16x8 _vf = *(const LAS bf16x8*)((SB) + vaddr_(2 * (BT) + _s) + _d * 4096); o[_d] = __builtin_amdgcn_mfma_f32_32x32x16_bf16(_vf, pf[_s], o[_d], 0, 0, 0); } } while (0)
#define AT_MW(SB, BT) (MASKED ? (*(const LAS unsigned*)((SB) + maddr + (BT) * 4) >> (8 * hh)) : 0xffffffffu)
    AT_ISSUE(0, 0);
    if (ntl > 1) AT_ISSUE(1, 1);
    if (ntl > 1) { if (MASKED) asm volatile("s_waitcnt vmcnt(5)" ::: "memory"); else asm volatile("s_waitcnt vmcnt(4)" ::: "memory"); }
    else asm volatile("s_waitcnt vmcnt(0)" ::: "memory");
    __builtin_amdgcn_s_barrier(); asm volatile("" ::: "memory");
    f32x16 sc, sn; bf16x8 pf[2];
    AT_QK(sc, lds, 0);
    int st = 0;
    for (int t = 0; t < ntl; ++t) {
        LAS unsigned char* sb = lds + st * AT_STAGE;
        const int stn = (st == 2) ? 0 : st + 1;
        LAS unsigned char* sbn = lds + stn * AT_STAGE;
        { const unsigned mw = AT_MW(sb, 0);
          AT_QK(sn, sb, 1); AT_SM(sc, mw); }
        __builtin_amdgcn_sched_barrier(0);
        AT_PV(sb, 0);
        __builtin_amdgcn_sched_barrier(0);
        if (t + 1 < ntl) asm volatile("s_waitcnt vmcnt(0)" ::: "memory");
        __builtin_amdgcn_s_barrier(); asm volatile("" ::: "memory");
        if (t + 2 < ntl) { const int st2 = (st >= 1) ? st - 1 : 2; AT_ISSUE(t + 2, st2); }
        __builtin_amdgcn_sched_barrier(0);
        { const unsigned mw = AT_MW(sb, 1);
          if (t + 1 < ntl) { AT_QK(sc, sbn, 0); AT_SM(sn, mw); } else { AT_SM(sn, mw); } }
        __builtin_amdgcn_sched_barrier(0);
        AT_PV(sb, 1);
        __builtin_amdgcn_sched_barrier(0);
        st = stn;
    }
#undef vaddr_
#undef AT_QK
#undef AT_SM
#undef AT_PV
#undef AT_MW
#undef AT_ISSUE
    l += __shfl_xor(l, 32);
    int lane_e = lane; asm volatile("" : "+v"(lane_e));
    const int qe = lane_e & 31, he = lane_e >> 5;
    LAS float* stg = (LAS float*)(lds + AT_EPI + wave * 4608);
    const int trow = q0 + 32 * wave;
    const float inv = final ? 1.0f / l : 1.0f;
#pragma unroll
    for (int d = 0; d < 4; ++d) {
#pragma unroll
        for (int r = 0; r < 16; ++r) stg[qe * 36 + crow(r, he)] = o[d][r] * inv;
        LDS_WAIT(); asm volatile("" ::: "memory");
#pragma unroll
        for (int i = 0; i < 4; ++i) { const int row = 8 * i + (lane_e >> 3), c4 = lane_e & 7; const f32x4 v = *(const LAS f32x4*)(stg + row * 36 + 4 * c4);
            if (final) { u32x2 w; w.x = pk2(v[0], v[1]); w.y = pk2(v[2], v[3]); *(u32x2*)(outb + (size_t)(trow + row) * DM + 32 * d + 4 * c4) = w; }
            else *(f32x4*)(slot + (size_t)(32 * wave + row) * 128 + 32 * d + 4 * c4) = v; }
        LDS_WAIT(); asm volatile("" ::: "memory");
    }
    if (!final && he == 0) slot[256 * 128 + 32 * wave + qe] = l;
}
__device__ __forceinline__ void att_build_table(Frame& F) {
    LAS int* cnt = (LAS int*)F.lds; int* TB = wsp<int>(F, WS_ATTBL);
    if (F.tid < 40) cnt[F.tid] = 0;
    __syncthreads();
    int e0[2], e1[2], nl[2];
#pragma unroll
    for (int r = 0; r < 2; ++r) { const int id = F.tid + 512 * r; nl[r] = 0; e0[r] = 0; e1[r] = 0;
        if (id < 768) { const int h = id >> 7, n = ((id >> 2) & 31) + 1, ch = id & 3, k = (n + 7) >> 3;
            if (ch < k) { const int nt = 4 * n, base = nt / k, rem = nt % k; const int len = base + (ch < rem ? 1 : 0), start = ch * base + (ch < rem ? ch : rem);
                const int qb = n - 1; nl[r] = len; e0[r] = 0 | (h << 1) | (qb << 4) | ((k == 1 ? 1 : 0) << 9) | (len << 10); e1[r] = start | ((h * 80 + cum_chunks(qb) + ch) << 8); } }
        else if (id < 896) { const int c = id - 768; nl[r] = 4; e0[r] = 1 | ((c >> 5) << 1) | ((c & 31) << 4) | (1 << 9) | (4 << 10); e1[r] = 0; }
        if (nl[r]) __hip_atomic_fetch_add(&cnt[nl[r]], 1, __ATOMIC_RELAXED, __HIP_MEMORY_SCOPE_WORKGROUP); }
    __syncthreads();
    if (F.tid == 0) { int o = 0; for (int l = 32; l >= 1; --l) { const int c = cnt[l]; cnt[l] = o; o += c; } }
    __syncthreads();
#pragma unroll
    for (int r = 0; r < 2; ++r) if (nl[r]) { const int pos = __hip_atomic_fetch_add(&cnt[nl[r]], 1, __ATOMIC_RELAXED, __HIP_MEMORY_SCOPE_WORKGROUP); TB[2 * pos] = e0[r]; TB[2 * pos + 1] = e1[r]; }
    __syncthreads();
}
__device__ __forceinline__ void p4_attention(Frame& F) {
    const bf16_t* Q = wsp<bf16_t>(F, WS_Q); const bf16_t* K = wsp<bf16_t>(F, WS_K); const bf16_t* VT = wsp<bf16_t>(F, WS_VT); const bf16_t* XQ = wsp<bf16_t>(F, WS_XQ);
    const bf16_t* KMB = wsp<bf16_t>(F, WS_KMB); const bf16_t* VMT = wsp<bf16_t>(F, WS_VMT); const unsigned* MASK = wsp<unsigned>(F, WS_MASK); bf16_t* AM = wsp<bf16_t>(F, WS_AMRG);
    float* OPS = F.out;
    LAS int* qslot = (LAS int*)(F.lds + LDSCTL_OFF + 256);
    for (;;) {
        __syncthreads();
        if (F.tid == 0) qslot[0] = (int)atomicAdd(F.ctl + CW_QUEUE, 1u);
        __syncthreads();
        const int idx = qslot[0];
        if (idx >= N_ATT_UNITS) break;
        const int* TB = wsp<int>(F, WS_ATTBL); const int e0 = TB[2 * idx], e1 = TB[2 * idx + 1];
        const int type = e0 & 1, h = (e0 >> 1) & 7, qb = (e0 >> 4) & 31, fin = (e0 >> 9) & 1, ntl = (e0 >> 10) & 63, kt0 = e1 & 255, slot = e1 >> 8;
        if (type == 0) attn_unit<true>(F.lds, Q + h * 128, 768, K + h * 128, 768, VT + (size_t)h * 128 * SEQ, SEQ, MASK + (size_t)qb * 128 * 512, qb * 256, kt0 * 64, ntl, fin != 0,
                                       OPS + (size_t)slot * SLOT_FLOATS, AM + 768 + h * 128, F.tid, F.wave, F.lane);
        else attn_unit<false>(F.lds, XQ + h * 128, 512, KMB + h * 128, 512, VMT + (size_t)h * 128 * 256, 256, nullptr, qb * 256, 0, 4, true, nullptr, AM + 1536 + h * 128, F.tid, F.wave, F.lane);
    }
}
__device__ __forceinline__ void p5_finalize(Frame& F) {
    const float* OPS = F.out; bf16_t* AM = wsp<bf16_t>(F, WS_AMRG);
    const int gw = F.vcu * NWAVES + F.wave, NGW = F.G * NWAVES, lane = F.lane, half = lane >> 5, c4 = lane & 31;
    for (int it = gw; it < 6 * 24 * 128; it += NGW) {
        const int rp = it & 127, hq = it >> 7, h = hq / 24, qb = 8 + hq % 24, row = 2 * rp + half;
        const int nch = (qb + 8) >> 3;
        const float* base = OPS + (size_t)(h * 80 + cum_chunks(qb)) * SLOT_FLOATS;
        f32x4 v[4]; float lv[4];
#pragma unroll
        for (int c = 0; c < 4; ++c) { const bool ok = c < nch; const float* b = base + (size_t)(ok ? c : 0) * SLOT_FLOATS; v[c] = *(const f32x4*)(b + (size_t)row * 128 + 4 * c4); lv[c] = b[256 * 128 + row];
            if (!ok) { v[c] = (f32x4){0.f, 0.f, 0.f, 0.f}; lv[c] = 0.f; } }
        const f32x4 sv = (v[0] + v[1]) + (v[2] + v[3]); const float inv = 1.0f / ((lv[0] + lv[1]) + (lv[2] + lv[3]));
        u32x2 w; w.x = pk2(sv[0] * inv, sv[1] * inv); w.y = pk2(sv[2] * inv, sv[3] * inv);
        *(u32x2*)(AM + (size_t)(qb * 256 + row) * DM + 768 + h * 128 + 4 * c4) = w;
    }
}

struct SchedTile {
    int c, G, nM, nN; const char* A; const char* B; size_t tA, tB;
    __device__ __forceinline__ bool next(int i, pg8::Unit& u) const {
        const int L = i * G + c; if (L >= nM * nN) return false; int pm, pn; pg8::tile_order(L, nM, nN, pm, pn);
        u.A = A + (size_t)pm * tA; u.B = B + (size_t)pn * tB; u.Bhi = u.B; u.kind = 0; u.row0 = pm * 256; u.col0 = pn * 256; u.aux = 0; u.nt = 32; u.lowonly = 0; return true; }
};
struct EpiMrg {
    static constexpr bool HOOK = true; static constexpr int HOOK_T1 = 12, HOOK_T2 = 24;
    const bf16_t* EG; bf16_t* MRG;
    __device__ __forceinline__ void hook(f32x4 (&acc)[2][2][4][2], const pg8::Unit& u, int t, int wr, int wc, int fr, int fq) const {
        const int seg = (t == HOOK_T1) ? 0 : 1;
        const unsigned off0 = ((unsigned)(u.row0 + wr * 64 + fr) * 6144u + (unsigned)(seg * 2048 + u.col0 + wc * 32 + 8 * fq)) * 2u;
        const char* eg = (const char*)EG;
#pragma unroll
        for (int ai = 0; ai < 2; ++ai)
#pragma unroll
            for (int m = 0; m < 4; ++m) {
#pragma unroll
                for (int bj = 0; bj < 2; ++bj) { const unsigned off = off0 + (unsigned)((ai * 128 + m * 16) * 6144 + bj * 128) * 2u;
                    const u32x4 ea = *(const u32x4*)(eg + off), eb = *(const u32x4*)(eg + off + 4096u);
                    f32x4 r0, r1;
                    r0[0] = bflo(eb.x) * __builtin_amdgcn_rcpf(bflo(ea.x)); r0[1] = bfhi(eb.x) * __builtin_amdgcn_rcpf(bfhi(ea.x)); r0[2] = bflo(eb.y) * __builtin_amdgcn_rcpf(bflo(ea.y)); r0[3] = bfhi(eb.y) * __builtin_amdgcn_rcpf(bfhi(ea.y));
                    r1[0] = bflo(eb.z) * __builtin_amdgcn_rcpf(bflo(ea.z)); r1[1] = bfhi(eb.z) * __builtin_amdgcn_rcpf(bfhi(ea.z)); r1[2] = bflo(eb.w) * __builtin_amdgcn_rcpf(bflo(ea.w)); r1[3] = bfhi(eb.w) * __builtin_amdgcn_rcpf(bfhi(ea.w));
                    acc[ai][bj][m][0] *= r0; acc[ai][bj][m][1] *= r1; }
                asm volatile("" ::: "memory"); }
    }
    __device__ __forceinline__ void operator()(const f32x4 (&acc)[2][2][4][2], const pg8::Unit& u, int wr, int wc, int fr, int fq) const {
        const int rbase = u.row0 + wr * 64 + fr, cbase = u.col0 + wc * 32 + 8 * fq;
#pragma unroll
        for (int ai = 0; ai < 2; ++ai)
#pragma unroll
            for (int m = 0; m < 4; ++m) { const int row = rbase + ai * 128 + m * 16;
#pragma unroll
                for (int bj = 0; bj < 2; ++bj) { const u32x4 e = *(const u32x4*)(EG + (size_t)row * 6144 + 4096 + cbase + bj * 128);
                    const f32x4 a0 = acc[ai][bj][m][0], a1 = acc[ai][bj][m][1];
                    u32x4 w;
                    w.x = pk2(a0[0] * __builtin_amdgcn_rcpf(bflo(e.x)), a0[1] * __builtin_amdgcn_rcpf(bfhi(e.x))); w.y = pk2(a0[2] * __builtin_amdgcn_rcpf(bflo(e.y)), a0[3] * __builtin_amdgcn_rcpf(bfhi(e.y)));
                    w.z = pk2(a1[0] * __builtin_amdgcn_rcpf(bflo(e.z)), a1[1] * __builtin_amdgcn_rcpf(bfhi(e.z))); w.w = pk2(a1[2] * __builtin_amdgcn_rcpf(bflo(e.w)), a1[3] * __builtin_amdgcn_rcpf(bfhi(e.w)));
                    *(u32x4*)(MRG + (size_t)row * DM + cbase + bj * 128) = w; } }
    }
};
struct EpiRes {
    static constexpr bool HOOK = false; static constexpr int HOOK_T1 = -1, HOOK_T2 = -1;
    const float* x; float* out; bf16_t* X1B;
    __device__ __forceinline__ void hook(f32x4 (&)[2][2][4][2], const pg8::Unit&, int, int, int, int, int) const {}
    __device__ __forceinline__ void operator()(const f32x4 (&acc)[2][2][4][2], const pg8::Unit& u, int wr, int wc, int fr, int fq) const {
        const int rbase = u.row0 + wr * 64 + fr, cbase = u.col0 + wc * 32 + 8 * fq;
#pragma unroll
        for (int ai = 0; ai < 2; ++ai)
#pragma unroll
            for (int m = 0; m < 4; ++m) { const int row = rbase + ai * 128 + m * 16;
#pragma unroll
                for (int bj = 0; bj < 2; ++bj) { const size_t off = (size_t)row * DM + cbase + bj * 128;
                    const f32x4 v0 = *(const f32x4*)(x + off) + acc[ai][bj][m][0], v1 = *(const f32x4*)(x + off + 4) + acc[ai][bj][m][1];
                    *(f32x4*)(out + off) = v0; *(f32x4*)(out + off + 4) = v1;
                    u32x4 w; w.x = pk2(v0[0], v0[1]); w.y = pk2(v0[2], v0[3]); w.z = pk2(v1[0], v1[1]); w.w = pk2(v1[2], v1[3]);
                    *(u32x4*)(X1B + off) = w; } }
    }
};

__device__ __forceinline__ void p8_router(Frame& F) {
    const float* X1 = F.out; const float* WR = wsp<float>(F, WS_WR);
    float* RSTD2 = wsp<float>(F, WS_RSTD2); int* TOKCLS = wsp<int>(F, WS_TOKCLS); int* TOKSLOT = wsp<int>(F, WS_TOKSLOT); float* TOKWA = wsp<float>(F, WS_TOKWA); float* TOKWB = wsp<float>(F, WS_TOKWB);
    LAS float* red = (LAS float*)F.lds;
    LAS float* lg = (LAS float*)(F.lds + 8 * 32 * 33 * 4);
    LAS float* ssq = (LAS float*)(F.lds + 9 * 32 * 33 * 4);
    LAS int* lcnt = (LAS int*)(F.lds + 9 * 32 * 33 * 4 + 1024); int* CNT = wsp<int>(F, WS_CNT);
    const int lane = F.lane, i = lane & 31, hh = lane >> 5, w = F.wave;
    for (int u = F.vcu; u < SEQ / 32; u += F.G) {
        const int t0 = 32 * u;
        f32x16 d;
#pragma unroll
        for (int r = 0; r < 16; ++r) d[r] = 0.f;
        float ss = 0.f;
        const float* xp = X1 + (size_t)(t0 + i) * DM + 256 * w + 4 * hh; const float* wp = WR + (size_t)(256 * w + 4 * hh) * 32 + i;
#pragma unroll 1
        for (int m0 = 0; m0 < 32; m0 += 8) {
            f32x4 a[8]; float bw[8][4];
#pragma unroll
            for (int mm = 0; mm < 8; ++mm) { a[mm] = *(const f32x4*)(xp + 8 * (m0 + mm));
#pragma unroll
                for (int e = 0; e < 4; ++e) bw[mm][e] = wp[(8 * (m0 + mm) + e) * 32]; }
#pragma unroll
            for (int mm = 0; mm < 8; ++mm) { ss += (a[mm].x * a[mm].x + a[mm].y * a[mm].y) + (a[mm].z * a[mm].z + a[mm].w * a[mm].w);
                d = __builtin_amdgcn_mfma_f32_32x32x2f32(a[mm].x, bw[mm][0], d, 0, 0, 0); d = __builtin_amdgcn_mfma_f32_32x32x2f32(a[mm].y, bw[mm][1], d, 0, 0, 0);
                d = __builtin_amdgcn_mfma_f32_32x32x2f32(a[mm].z, bw[mm][2], d, 0, 0, 0); d = __builtin_amdgcn_mfma_f32_32x32x2f32(a[mm].w, bw[mm][3], d, 0, 0, 0); }
        }
        ss += __shfl_xor(ss, 32);
        __syncthreads();
#pragma unroll
        for (int r = 0; r < 16; ++r) red[(w * 32 + crow(r, hh)) * 33 + i] = d[r];
        if (hh == 0) ssq[w * 32 + i] = ss;
        if (F.tid < 24) lcnt[F.tid] = 0;
        __syncthreads();
        for (int e = F.tid; e < 1024; e += NTHR) { const int tk = e >> 5, j = e & 31; float s = 0.f;
#pragma unroll
            for (int ww = 0; ww < 8; ++ww) s += red[(ww * 32 + tk) * 33 + j];
            lg[tk * 33 + j] = s; }
        __syncthreads();
        if (F.tid < 32) { const int tk = F.tid; float s2 = 0.f;
#pragma unroll
            for (int ww = 0; ww < 8; ++ww) s2 += ssq[ww * 32 + tk];
            const float rstd = 1.0f / sqrtf(s2 * (1.0f / DM) + NORM_EPS);
            float g[4]; int gt = 0;
#pragma unroll
            for (int j = 0; j < 4; ++j) g[j] = lg[tk * 33 + j] * rstd;
#pragma unroll
            for (int j = 1; j < 4; ++j) if (g[j] > g[gt]) gt = j;
            float den = 0.f;
#pragma unroll
            for (int j = 0; j < 4; ++j) den += expf(g[j] - g[gt]);
            const float pg = 1.0f / den;
            float le[4];
#pragma unroll
            for (int j = 0; j < 4; ++j) le[j] = lg[tk * 33 + 4 + gt * 4 + j] * rstd;
            int e1 = 0;
#pragma unroll
            for (int j = 1; j < 4; ++j) if (le[j] > le[e1]) e1 = j;
            int e2 = (e1 == 0) ? 1 : 0;
#pragma unroll
            for (int j = 0; j < 4; ++j) if (j != e1 && j != e2 && le[j] > le[e2]) e2 = j;
            const float x2 = expf(le[e2] - le[e1]);
            const float w1 = pg / (1.0f + x2), w2 = pg * x2 / (1.0f + x2);
            const int a = e1 < e2 ? e1 : e2, bb = e1 < e2 ? e2 : e1;
            const float wa = e1 < e2 ? w1 : w2, wb = e1 < e2 ? w2 : w1;
            const int pair = (a == 0) ? (bb - 1) : (a == 1 ? bb + 1 : 5);
            const int cls = gt * 6 + pair;
            const int slot = __hip_atomic_fetch_add(&lcnt[cls], 1, __ATOMIC_RELAXED, __HIP_MEMORY_SCOPE_WORKGROUP);
            const int t = t0 + tk;
            RSTD2[t] = rstd; TOKCLS[t] = cls; TOKSLOT[t] = slot; TOKWA[t] = wa; TOKWB[t] = wb;
        }
        __syncthreads();
        if (F.tid < 24) CNT[u * 24 + F.tid] = lcnt[F.tid];
    }
    __syncthreads();
}
__device__ __forceinline__ int moe_tables(Frame& F, LAS int* tb) {
    __syncthreads();
    if (F.tid == 0) { int o = 0;
        for (int c = 0; c < 24; ++c) { const int n = (int)__hip_atomic_load(F.ctl + CW_CLS + c, __ATOMIC_RELAXED, __HIP_MEMORY_SCOPE_AGENT); tb[c] = o; tb[64 + c] = n; const int nt = (n + 255) >> 8;
            for (int j = 0; j < nt; ++j) { tb[128 + (o >> 8) + j] = c; tb[192 + (o >> 8) + j] = (n - 256 * j <= 128) ? 1 : 0; } o += nt << 8; }
        tb[24] = o; const int ntl = o >> 8; int k = 0;
        for (int j = 0; j < ntl; ++j) if (!tb[192 + j]) tb[256 + k++] = j;
        for (int j = 0; j < ntl; ++j) if (tb[192 + j]) tb[256 + k++] = j; }
    __syncthreads();
    return tb[24] >> 8;
}
__device__ __forceinline__ void p8b_gather(Frame& F) {
    LAS int* tb = (LAS int*)(F.lds + LDSCTL_OFF + 512);
    LAS int* cn = (LAS int*)F.lds;
    LAS int* psum = (LAS int*)(F.lds + 32768);
    LAS int* tot = (LAS int*)(F.lds + 32768 + 2048);
    const int* CNT = wsp<int>(F, WS_CNT);
    __syncthreads();
    for (int i = F.tid; i < 256 * 24; i += NTHR) cn[i] = CNT[i];
    __syncthreads();
    const int c = F.tid >> 4, part = F.tid & 15;
    if (F.tid < 384) { int sm = 0;
#pragma unroll
        for (int j = 0; j < 16; ++j) sm += cn[(part * 16 + j) * 24 + c];
        psum[c * 16 + part] = sm; }
    __syncthreads();
    if (F.tid < 24) { int run = 0;
        for (int j = 0; j < 16; ++j) { const int v = psum[F.tid * 16 + j]; psum[F.tid * 16 + j] = run; run += v; }
        tot[F.tid] = run; }
    __syncthreads();
    if (F.tid < 384) { int run = psum[c * 16 + part];
#pragma unroll
        for (int j = 0; j < 16; ++j) { const int idx = (part * 16 + j) * 24 + c; const int v = cn[idx]; cn[idx] = run; run += v; } }
    if (F.tid == 0) { int o = 0;
        for (int cc = 0; cc < 24; ++cc) { const int n = tot[cc]; tb[cc] = o; tb[64 + cc] = n; o += ((n + 255) >> 8) << 8; }
        tb[24] = o; }
    if (blockIdx.x == 0 && F.tid < 24) __hip_atomic_store(F.ctl + CW_CLS + F.tid, (unsigned)tot[F.tid], __ATOMIC_RELAXED, __HIP_MEMORY_SCOPE_AGENT);
    __syncthreads();
    const float* RSTD2 = wsp<float>(F, WS_RSTD2); const int* TOKCLS = wsp<int>(F, WS_TOKCLS); const int* TOKSLOT = wsp<int>(F, WS_TOKSLOT); const float* TOKWA = wsp<float>(F, WS_TOKWA); const float* TOKWB = wsp<float>(F, WS_TOKWB);
    int* ROWTOK = wsp<int>(F, WS_ROWTOK); float* ROWRS = wsp<float>(F, WS_ROWRS); float* ROWWA = wsp<float>(F, WS_ROWWA); float* ROWWB = wsp<float>(F, WS_ROWWB);
    const int gw = F.vcu * NWAVES + F.wave, NGW = F.G * NWAVES, lane = F.lane;
    for (int t = gw * 64 + lane; t < SEQ; t += NGW * 64) {
        const int cl = TOKCLS[t]; const int R = tb[cl] + cn[(t >> 5) * 24 + cl] + TOKSLOT[t];
        ROWTOK[R] = t; ROWRS[R] = RSTD2[t]; ROWWA[R] = TOKWA[t]; ROWWB[R] = TOKWB[t];
    }
    for (int i = F.vcu * NTHR + F.tid; i < 24 * 256; i += F.G * NTHR) { const int cc = i >> 8, j = i & 255; const int n = tb[64 + cc], R = tb[cc] + n + j;
        const int endc = tb[cc] + (((n + 255) >> 8) << 8);
        if (R < endc) { ROWTOK[R] = -1; ROWRS[R] = 0.f; ROWWA[R] = 0.f; ROWWB[R] = 0.f; } }
}
__device__ __forceinline__ void cls_experts(int cls, int& ea, int& eb) { const int g = cls / 6, p = cls % 6; const int a = (p < 3) ? 0 : (p < 5 ? 1 : 2); const int b = (p < 3) ? p + 1 : (p < 5 ? p - 1 : 3); ea = g * 4 + a; eb = g * 4 + b; }
struct EpiGU {
    static constexpr bool HOOK = false; static constexpr int HOOK_T1 = -1, HOOK_T2 = -1;
    unsigned char* ws;
    __device__ __forceinline__ void hook(f32x4 (&)[2][2][4][2], const pg8::Unit&, int, int, int, int, int) const {}
    __device__ __forceinline__ void operator()(const f32x4 (&acc)[2][2][4][2], const pg8::Unit& u, int wr, int wc, int fr, int fq) const {
        const float* rs = (const float*)(ws + WS_ROWRS); const __amdgpu_buffer_rsrc_t rsrc = __builtin_amdgcn_make_buffer_rsrc(ws + WS_ACT, 0, (int)(MAXROWS * 1024 * 2), 0x00020000);
        const int pn = u.col0; const float* cw = (const float*)(ws + (pn < 4 ? WS_ROWWA : WS_ROWWB)); const int cbase = (pn >> 2) * 512 + (pn & 3) * 128 + wc * 32 + 8 * fq;
#pragma unroll
        for (int ai = 0; ai < 2; ++ai)
#pragma unroll
            for (int m = 0; m < 4; ++m) { const int row = u.row0 + ai * 128 + wr * 64 + m * 16 + fr; const float s = rs[row], w = cw[row];
                float a[8];
#pragma unroll
                for (int n = 0; n < 2; ++n)
#pragma unroll
                    for (int e = 0; e < 4; ++e) { const float gv = acc[ai][0][m][n][e] * s, uv = acc[ai][1][m][n][e] * s;
                        a[4 * n + e] = gv * __builtin_amdgcn_rcpf(1.0f + __builtin_amdgcn_exp2f(-gv * LOG2E)) * uv * w; }
                u32x4 o; o.x = pk2(a[0], a[1]); o.y = pk2(a[2], a[3]); o.z = pk2(a[4], a[5]); o.w = pk2(a[6], a[7]);
                __builtin_amdgcn_raw_buffer_store_b128(o, rsrc, (int)(((unsigned)row * 1024u + (unsigned)cbase) * 2u), 0, 16); }
    }
};
struct EpiDN {
    static constexpr bool HOOK = false; static constexpr int HOOK_T1 = -1, HOOK_T2 = -1;
    unsigned char* ws; float* out;
    __device__ __forceinline__ void hook(f32x4 (&)[2][2][4][2], const pg8::Unit&, int, int, int, int, int) const {}
    __device__ __forceinline__ void operator()(const f32x4 (&acc)[2][2][4][2], const pg8::Unit& u, int wr, int wc, int fr, int fq) const {
        const int* rowtok = (const int*)(ws + WS_ROWTOK);
        const int cbase = u.col0 + wc * 32 + 8 * fq;
#pragma unroll
        for (int ai = 0; ai < 2; ++ai)
#pragma unroll
            for (int m = 0; m < 4; ++m) { const int row = u.row0 + ai * 128 + wr * 64 + m * 16 + fr; const int tok = rowtok[row];
                if (tok >= 0) {
#pragma unroll
                    for (int bj = 0; bj < 2; ++bj) { float* p = out + (size_t)tok * DM + cbase + bj * 128;
                        const f32x4 v0 = *(const f32x4*)p + acc[ai][bj][m][0], v1 = *(const f32x4*)(p + 4) + acc[ai][bj][m][1];
                        *(f32x4*)p = v0; *(f32x4*)(p + 4) = v1; } } }
    }
};

struct SchedOne { pg8::Unit u; __device__ __forceinline__ bool next(int i, pg8::Unit& o) const { if (i != 0) return false; o = u; return true; } };
__device__ __forceinline__ void p9_experts(Frame& F) {
    LAS int* tb = (LAS int*)(F.lds + LDSCTL_OFF + 512);
    const int ntiles = moe_tables(F, tb);
    LAS int* qs = (LAS int*)(F.lds + LDSCTL_OFF + 256);
    const int nun = 16 * ntiles;
    unsigned pend = 0u;
    if (F.tid == 0) pend = atomicAdd(F.ctl + CW_QUEUE + 2, 1u);
    for (;;) {
        __syncthreads();
        if (F.tid == 0) { qs[0] = (int)pend; pend = atomicAdd(F.ctl + CW_QUEUE + 2, 1u); }
        __syncthreads();
        const int idx = qs[0];
        if (idx >= nun) break;
        const bool dn = idx >= 8 * ntiles; const int L = dn ? idx - 8 * ntiles : idx; const int mt = tb[256 + (L >> 3)], pn = L & 7; const int cls = tb[128 + mt]; int ea, eb; cls_experts(cls, ea, eb);
        pg8::Unit u; u.kind = 0; u.row0 = mt * 256; u.aux = 0; u.lowonly = tb[192 + mt];
        if (!dn) {
            const int e = pn < 4 ? ea : eb;
            u.A = (const char*)(F.ws + WS_X1B); u.B = (const char*)(F.ws + WS_WGUT) + ((size_t)e * 1024 + (pn & 3) * 256) * DM * 2; u.Bhi = u.B; u.col0 = pn; u.nt = 32;
            SchedOne S{u}; EpiGU E{F.ws};
            pg8::gemm_phase<EpiGU, SchedOne, true, true>(F.lds, pg8::Geom{DM, DM, 32, 1 << 30, wsp<int>(F, WS_ROWTOK)}, S, E);
            asm volatile("s_waitcnt vmcnt(0)" ::: "memory");
            __syncthreads();
            if (F.tid == 0) __hip_atomic_fetch_add(F.ctl + CW_TILE + mt, 1u, __ATOMIC_RELAXED, __HIP_MEMORY_SCOPE_AGENT);
        } else {
            if (F.tid == 0) { unsigned sp = 0;
                while (__hip_atomic_load(F.ctl + CW_TILE + mt, __ATOMIC_RELAXED, __HIP_MEMORY_SCOPE_AGENT) < 8u) { __builtin_amdgcn_s_sleep(8); if (++sp > (1u << 20)) break; }
                __builtin_amdgcn_fence(__ATOMIC_ACQUIRE, "agent");
                asm volatile("s_waitcnt vmcnt(0)" ::: "memory"); }
            __syncthreads();
            u.A = (const char*)(F.ws + WS_ACT) + (size_t)mt * 256 * 1024 * 2; u.B = (const char*)(F.ws + WS_WDT) + ((size_t)ea * DM + pn * 256) * 512 * 2;
            u.Bhi = (const char*)(F.ws + WS_WDT) + ((size_t)eb * DM + pn * 256) * 512 * 2 - (size_t)8 * 128; u.col0 = pn * 256; u.nt = 16;
            SchedOne S{u}; EpiDN E{F.ws, F.out};
            pg8::gemm_phase<EpiDN, SchedOne, true, true>(F.lds, pg8::Geom{1024, 512, 16, 8, nullptr}, S, E);
        }
    }
}
template <int K> __device__ __forceinline__ void run_phase(Frame& F) {
    if constexpr (K == 0) p0_prologue(F);
    else if constexpr (K == 1) {
        SchedP1 S{(int)blockIdx.x, F.G, F.ws};
        EpiP1 E{F.ws, wsp<float>(F, WS_RSTD1), wsp<float>(F, WS_RSTDM), F.b_gate};
        pg8::gemm_phase<EpiP1, SchedP1, true, true>(F.lds, pg8::Geom{DM, DM, 32, 1 << 30, nullptr}, S, E);
    } else if constexpr (K == 2) p2_rowpass(F);
    else if constexpr (K == 3) p3_indexer(F);
    else if constexpr (K == 4) p4_attention(F);
    else if constexpr (K == 5) p5_finalize(F);
    else if constexpr (K == 6) {
        SchedTile S{(int)blockIdx.x, F.G, 32, 8, (const char*)(F.ws + WS_AMRG), (const char*)(F.ws + WS_BTMRG), (size_t)256 * DM * 2, (size_t)256 * DM * 2};
        EpiMrg E{wsp<bf16_t>(F, WS_EG), wsp<bf16_t>(F, WS_MRG)};
        pg8::gemm_phase<EpiMrg, SchedTile, true, true>(F.lds, pg8::Geom{DM, DM, 32, 1 << 30, nullptr}, S, E);
    } else if constexpr (K == 7) {
        SchedTile S{(int)blockIdx.x, F.G, 32, 8, (const char*)(F.ws + WS_MRG), (const char*)(F.ws + WS_WOT), (size_t)256 * DM * 2, (size_t)256 * DM * 2};
        EpiRes E{F.x, F.out, wsp<bf16_t>(F, WS_X1B)};
        pg8::gemm_phase<EpiRes, SchedTile, true, true>(F.lds, pg8::Geom{DM, DM, 32, 1 << 30, nullptr}, S, E);
    } else if constexpr (K == 8) p8_router(F);
    else if constexpr (K == 9) p8b_gather(F);
    else p9_experts(F);
}
__global__ void __launch_bounds__(NTHR, 2) fwd_kernel(KArgs args) {
    extern __shared__ __attribute__((aligned(16))) unsigned char lds_raw[];
    Frame F;
    F.lds = (LAS unsigned char*)lds_raw; F.MISC = (volatile LAS unsigned*)(F.lds + MISC_OFF);
    F.tid = threadIdx.x; F.lane = F.tid & 63; F.wave = __builtin_amdgcn_readfirstlane(F.tid >> 6);
    F.G = gridDim.x; { const int bx = blockIdx.x; F.vcu = (F.G % 8 == 0) ? (bx % 8) * (F.G / 8) + bx / 8 : bx; }
    F.ws = args.ws; F.out = args.out; F.ctl = (unsigned*)(args.ws + WS_CTL);
    F.x = (const float*)args.in[0]; F.mem = (const float*)args.in[1]; F.positions = (const int*)args.in[2]; F.g_mix = (const float*)args.in[3]; F.w_in = (const float*)args.in[4];
    F.b_gate = (const float*)args.in[5]; F.w_pool_grp = (const float*)args.in[6]; F.pool_scale = (const float*)args.in[7]; F.q_norm_g = (const float*)args.in[8]; F.k_norm_g = (const float*)args.in[9];
    F.g_mem = (const float*)args.in[10]; F.w_mem_kv = (const float*)args.in[11]; F.xq_norm_g = (const float*)args.in[12]; F.xk_norm_g = (const float*)args.in[13]; F.w_pool_out = (const float*)args.in[14];
    F.w_attn_out = (const float*)args.in[15]; F.w_cross_out = (const float*)args.in[16]; F.w_o = (const float*)args.in[17]; F.g_ffn = (const float*)args.in[18]; F.w_rg = (const float*)args.in[19];
    F.w_re = (const float*)args.in[20]; F.w_eg = (const float*)args.in[21]; F.w_eu = (const float*)args.in[22]; F.w_ed = (const float*)args.in[23];
    for (int u = F.tid; u < (LDS_BYTES - LDSCTL_OFF) / 4; u += NTHR) ((LAS unsigned*)(F.lds + LDSCTL_OFF))[u] = 0u;
    __syncthreads();
    XcdBarrier bar = xcd_barrier_post(F.ctl + CW_BAR, F.MISC + 8);
    if (P3_PROF == 8 && blockIdx.x == 0 && F.tid == 0) __hip_atomic_store(F.ctl + CW_QUEUE + 9, 0x7fffffffu, __ATOMIC_RELAXED, __HIP_MEMORY_SCOPE_AGENT);
    const int lo = args.ph_lo, hi = args.ph_hi;
#define IN(k) (lo <= (k) && (k) < hi)
#define SEAM(k) do { if (IN(k) && IN((k) + 1)) xcd_barrier(bar); } while (0)
#ifndef PROBE_TS
#define PROBE_TS -1
#endif
#ifndef PROBE_REPEAT
#define PROBE_REPEAT -1
#endif
    unsigned long long ts0 = 0, ts1 = 0;
#ifndef ONLY_PHASE
#define ONLY_PHASE -1
#endif
#define PHASE(k) do { if ((ONLY_PHASE < 0 || ONLY_PHASE == (k)) && IN(k)) { if (PROBE_TS == (k)) ts0 = __builtin_amdgcn_s_memrealtime(); run_phase<k>(F); \
        if (PROBE_REPEAT == (k)) { xcd_barrier(bar); run_phase<k>(F); } } \
        if (PROBE_TS == (k)) { xcd_barrier(bar); ts1 = __builtin_amdgcn_s_memrealtime(); } else { SEAM(k); } } while (0)
    PHASE(0); PHASE(1); PHASE(2); PHASE(3); PHASE(4); PHASE(5); PHASE(6); PHASE(7); PHASE(8); PHASE(9); PHASE(10);
#ifdef EXTRA_BARS
    for (int _i = 0; _i < 10; ++_i) xcd_barrier(bar);
#endif
    if (P0_PROF) { xcd_barrier(bar); if (blockIdx.x == 0 && F.tid == 0) F.out[0] += (float)__hip_atomic_load(F.ctl + CW_QUEUE + 8, __ATOMIC_RELAXED, __HIP_MEMORY_SCOPE_AGENT) * 0.001f; }
    if (P3_PROF) { xcd_barrier(bar); if (blockIdx.x == 0 && F.tid == 0) { float v = (float)F.MISC[16] * 0.001f;
        if (P3_PROF == 6 || P3_PROF >= 11) v = (float)__hip_atomic_load(F.ctl + CW_QUEUE + 8, __ATOMIC_RELAXED, __HIP_MEMORY_SCOPE_AGENT);
        if (P3_PROF == 7) v = (float)__hip_atomic_load(F.ctl + CW_QUEUE + 8, __ATOMIC_RELAXED, __HIP_MEMORY_SCOPE_AGENT) * 0.001f;
        if (P3_PROF == 8) v = (float)__hip_atomic_load(F.ctl + CW_QUEUE + 9, __ATOMIC_RELAXED, __HIP_MEMORY_SCOPE_AGENT) * 0.001f;
        F.out[0] += v; } }
    if (PROBE_TS >= 0) { if (PROBE_TS != 10) xcd_barrier(bar); if (blockIdx.x == 0 && F.tid == 0) F.out[0] += (float)(ts1 - ts0) * 0.001f; }
#undef IN
#undef SEAM
#undef PHASE
}

extern "C" void kernel_launch(void* const* d_in, const int* in_sizes, int n_in, void* d_out, int out_size, void* d_ws, size_t ws_size, hipStream_t stream) {
    static int grid = 0;
    if (grid == 0) {
        if (n_in != 24 || in_sizes[0] != SEQ * DM || out_size != SEQ * DM || ws_size < WS_END) {
            fprintf(stderr, "kernel_launch: unexpected shapes: n_in %d in0 %d out %d ws %zu (need %zu)\n", n_in, n_in > 0 ? in_sizes[0] : -1, out_size, ws_size, (size_t)WS_END); grid = -1; return; }
        int dev = 0, cus = 0, per_cu = 0;
        if (hipGetDevice(&dev) != hipSuccess || hipDeviceGetAttribute(&cus, hipDeviceAttributeMultiprocessorCount, dev) != hipSuccess) { grid = -1; return; }
        if (hipFuncSetAttribute((const void*)fwd_kernel, hipFuncAttributeMaxDynamicSharedMemorySize, LDS_BYTES) != hipSuccess) { fprintf(stderr, "kernel_launch: hipFuncSetAttribute failed\n"); grid = -1; return; }
        if (hipOccupancyMaxActiveBlocksPerMultiprocessor(&per_cu, (const void*)fwd_kernel, NTHR, LDS_BYTES) != hipSuccess || per_cu < 1) {
            fprintf(stderr, "kernel_launch: occupancy query reports %d workgroups per CU\n", per_cu); (void)hipGetLastError(); per_cu = 1; }
        grid = cus;
    }
    if (grid < 0) return;
    if (hipMemsetAsync((char*)d_ws + WS_CTL, 0, CTL_ZERO_BYTES, stream) != hipSuccess) { fprintf(stderr, "kernel_launch: memset failed\n"); return; }
    KArgs a{};
    for (int i = 0; i < 24; ++i) a.in[i] = d_in[i];
    a.out = (float*)d_out; a.ws = (unsigned char*)d_ws; a.ph_lo = 0; a.ph_hi = 11;
    hipLaunchKernelGGL(fwd_kernel, dim3(grid), dim3(NTHR), LDS_BYTES, stream, a);
    const hipError_t le = hipPeekAtLastError();
    if (le != hipSuccess) fprintf(stderr, "kernel_launch: launch failed: %s\n", hipGetErrorName(le));
}
```

```cpp
#include <hip/hip_runtime.h>
#include <cstdio>
#include <cstdint>

#define LAS __attribute__((address_space(3)))
#define GAS __attribute__((address_space(1)))
typedef unsigned short bf16_t;
typedef short bf16x8 __attribute__((ext_vector_type(8)));
typedef short bf16x4 __attribute__((ext_vector_type(4)));
typedef float f32x4 __attribute__((ext_vector_type(4)));
typedef float f32x16 __attribute__((ext_vector_type(16)));
typedef unsigned u32x4 __attribute__((ext_vector_type(4)));
typedef unsigned u32x2 __attribute__((ext_vector_type(2)));

#ifndef P3_PROF
#define P3_PROF 0
#endif
constexpr int SEQ = 8192, DM = 2048, INC = 10052, MEML = 256;
constexpr int NWAVES = 8, NTHR = 512;
constexpr float NORM_EPS = 1e-6f;
constexpr float LOG2E = 1.4426950408889634f;
constexpr float ATT_SCALE = 0.08838834764831845f;

constexpr size_t MiB = 1u << 20, KiB = 1u << 10;
constexpr size_t WS_CTL = 0, CTL_ZERO_BYTES = 128 * KiB;
constexpr size_t WS_SMALL = 1 * MiB;
constexpr size_t WS_RSTD1 = WS_SMALL + 0, WS_RSTDM = WS_SMALL + 32 * KiB, WS_THRKEY = WS_SMALL + 64 * KiB, WS_THRIDX = WS_SMALL + 96 * KiB;
constexpr size_t WS_WIF = WS_SMALL + 128 * KiB, WS_RSTD2 = WS_SMALL + 256 * KiB, WS_TOKCLS = WS_SMALL + 288 * KiB, WS_TOKSLOT = WS_SMALL + 320 * KiB;
constexpr size_t WS_TOKWA = WS_SMALL + 352 * KiB, WS_TOKWB = WS_SMALL + 384 * KiB, WS_ROWTOK = WS_SMALL + 416 * KiB, WS_ROWRS = WS_SMALL + 480 * KiB;
constexpr size_t WS_ROWWA = WS_SMALL + 544 * KiB, WS_ROWWB = WS_SMALL + 608 * KiB, WS_CNT = WS_SMALL + 672 * KiB, WS_ATTBL = WS_SMALL + 704 * KiB, WS_WR = WS_SMALL + 1 * MiB;
constexpr size_t WS_BTMRG = 4 * MiB, WS_WOT = 12 * MiB;
constexpr size_t WS_XB = 20 * MiB, WS_WINT = 52 * MiB, WS_WVT = 89 * MiB, WS_WMKVT = 92 * MiB, WS_MEMB = 96 * MiB;
constexpr size_t WS_WGUT = 20 * MiB, WS_QIB = 84 * MiB, WS_KIB = 88 * MiB, WS_KMB = 89 * MiB, WS_VMT = 89 * MiB + 512 * KiB;
constexpr size_t WS_WDT = 97 * MiB;
constexpr size_t WS_EG = 129 * MiB, WS_ACT = 185 * MiB;
constexpr size_t WS_AMRG = 225 * MiB, WS_X1B = 225 * MiB;
constexpr size_t WS_Q = 257 * MiB, WS_K = 269 * MiB, WS_VT = 281 * MiB, WS_XQ = 293 * MiB, WS_MRG = 257 * MiB;
constexpr size_t WS_U = 301 * MiB, WS_IDXF = 313 * MiB, WS_OPX = 301 * MiB;
constexpr size_t WS_KVM = 329 * MiB, WS_MASK = 330 * MiB, WS_KVMP = 330 * MiB, WS_END = 338 * MiB;
constexpr int MAXROWS = 14336;
constexpr int CW_BAR = 4096;
constexpr int CW_CLS = 16384;
constexpr int CW_QUEUE = 16512;
constexpr int CW_TILE = 16640;

#define LDS_WAIT() asm volatile("s_waitcnt lgkmcnt(0)" ::: "memory")
#define VM_WAIT() asm volatile("s_waitcnt vmcnt(0)" ::: "memory")
typedef float f32x2_t __attribute__((ext_vector_type(2))); typedef __bf16 bf16x2_t __attribute__((ext_vector_type(2)));
__device__ __forceinline__ unsigned pk2(float lo, float hi) { f32x2_t v = {lo, hi}; bf16x2_t b = __builtin_convertvector(v, bf16x2_t); return __builtin_bit_cast(unsigned, b); }
__device__ __forceinline__ unsigned f2bf(float f) { return pk2(f, 0.f) & 0xffffu; }
__device__ __forceinline__ float bf2f(unsigned short b) { return __builtin_bit_cast(float, (unsigned)b << 16); }
__device__ __forceinline__ float bflo(unsigned w) { return __builtin_bit_cast(float, w << 16); }
__device__ __forceinline__ float bfhi(unsigned w) { return __builtin_bit_cast(float, w & 0xffff0000u); }
__device__ __forceinline__ float wave_sum(float v) {
#pragma unroll
    for (int o = 1; o < 64; o <<= 1) v += __shfl_xor(v, o);
    return v;
}
__device__ __forceinline__ int crow(int r, int hi) { return (r & 3) + 8 * (r >> 2) + 4 * hi; }

#define XB_TMO      128
#define XB_XCNT(j)  (256  + 64 * (j))
#define XB_XSUB(j)  (1280 + 64 * (j))
#define XB_XGEN(j)  (2304 + 64 * (j))
#define XB_TOP      3328
#define XB_TOPGEN   3392
#define XCD_BAR_WORDS 3456
#define XB_SPIN_CAP (1u << 20)
__device__ __forceinline__ unsigned xb_ld(unsigned* p)              { return __hip_atomic_load(p, __ATOMIC_RELAXED, __HIP_MEMORY_SCOPE_AGENT); }
__device__ __forceinline__ unsigned xb_add(unsigned* p, unsigned v) { return __hip_atomic_fetch_add(p, v, __ATOMIC_RELAXED, __HIP_MEMORY_SCOPE_AGENT); }
__device__ __forceinline__ unsigned xb_xcc_id() { return (unsigned)__builtin_amdgcn_s_getreg((3 << 11) | 20) & 0xFu; }
#define XB_SPIN(cond, bar) do { unsigned _sp = 0; while (cond) { __builtin_amdgcn_s_sleep(1); \
    if ((++_sp & 255u) == 0u) { if (xb_ld(&(bar)[XB_TMO])) break; if (_sp > XB_SPIN_CAP) { atomicAdd(&(bar)[XB_TMO], 1u); break; } } } } while (0)
struct XcdBarrier { unsigned* bar; unsigned x; volatile LAS unsigned* st; };
__device__ __forceinline__ XcdBarrier xcd_barrier_post(unsigned* bar, volatile LAS unsigned* st) {
    XcdBarrier b; b.bar = bar; b.x = xb_xcc_id(); b.st = st;
    if (threadIdx.x == 0) (void)xb_add(&bar[XB_XCNT(b.x)], 1u);
    return b;
}
__device__ __forceinline__ void xcd_barrier_complete(unsigned* bar, unsigned x, unsigned& nloc, unsigned& nx) {
    const unsigned G = gridDim.x * gridDim.y * gridDim.z;
    unsigned sum, cnt, mine, sp = 0u;
    for (;;) {
        sum = 0u; cnt = 0u; mine = 0u;
#pragma unroll
        for (unsigned j = 0; j < 16; ++j) { const unsigned c = xb_ld(&bar[XB_XCNT(j)]); sum += c; cnt += (c > 0u) ? 1u : 0u; mine = (j == x) ? c : mine; }
        if (sum == G) break;
        __builtin_amdgcn_s_sleep(1);
        if ((++sp & 255u) == 0u) { if (xb_ld(&bar[XB_TMO])) break; if (sp > XB_SPIN_CAP) { atomicAdd(&bar[XB_TMO], 1u); break; } }
    }
    nloc = mine > 0u ? mine : 1u; nx = cnt > 0u ? cnt : 1u;
}
__device__ __forceinline__ void xcd_barrier(const XcdBarrier& b) {
    asm volatile("s_waitcnt vmcnt(0)" ::: "memory");
    __syncthreads();
    if (threadIdx.x == 0) {
        unsigned* bar = b.bar;
        __builtin_amdgcn_s_waitcnt(0);
        unsigned nloc = b.st[0], nx = b.st[1];
        if (nloc == 0u) { xcd_barrier_complete(bar, b.x, nloc, nx); b.st[0] = nloc; b.st[1] = nx; }
        const unsigned old = xb_add(&bar[XB_XSUB(b.x)], 1u);
        const unsigned gen = old / nloc;
        if (old + 1u == (gen + 1u) * nloc) {
            __builtin_amdgcn_fence(__ATOMIC_RELEASE, "agent");
            asm volatile("s_waitcnt vmcnt(0)" ::: "memory");
            const unsigned og = xb_add(&bar[XB_TOP], 1u);
            const unsigned tg = og / nx;
            if (og + 1u == (tg + 1u) * nx) xb_add(&bar[XB_TOPGEN], 1u);
            else XB_SPIN(xb_ld(&bar[XB_TOPGEN]) == tg, bar);
            __builtin_amdgcn_fence(__ATOMIC_ACQUIRE, "agent");
            xb_add(&bar[XB_XGEN(b.x)], 1u);
            asm volatile("s_waitcnt vmcnt(0)" ::: "memory");
        } else {
            XB_SPIN(xb_ld(&bar[XB_XGEN(b.x)]) == gen, bar);
            __builtin_amdgcn_fence(__ATOMIC_ACQUIRE, "agent");
            asm volatile("s_waitcnt vmcnt(0)" ::: "memory");
        }
    }
    __syncthreads();
}

namespace pg8 {
constexpr int BM = 256, BK = 64, HALF = 128, HTB = HALF * BK * 2, STAGE_BYTES = 8 * HTB, NXCD = 8, WGM = 8;
__host__ __device__ __forceinline__ int lds_byte(int r, int c) { const int st = (r >> 4) * 2 + (c >> 5), rr = r & 15, cc = c & 31, ob = rr * 64 + cc * 2; return st * 1024 + (ob ^ (((ob >> 9) & 1) << 5)); }
__host__ __device__ __forceinline__ void stage_rc(int b, int& R, int& C) { const int st = b / 1024, sb = b % 1024, swz = sb ^ (((sb >> 9) & 1) << 5); R = (st >> 1) * 16 + swz / 64; C = (st & 1) * 32 + (swz % 64) / 2; }
__host__ __device__ __forceinline__ int perm32(int rho) { const int n = rho >> 4, i = rho & 15; return 8 * (i >> 2) + 4 * n + (i & 3); }

struct Unit { const char* A; const char* B; const char* Bhi; int kind; int row0; int col0; int aux; int nt; int lowonly; };
struct Geom { int lda, ldb, nt, ksplit; const int* rowtok; };

__device__ __forceinline__ void tile_order(int L, int nM, int nN, int& pm, int& pn) {
    const int nwg = nM * nN; int wgid = L;
    { const int q = nwg / NXCD, r = nwg % NXCD, xcd = wgid % NXCD, off = wgid / NXCD; wgid = (xcd < r ? xcd * (q + 1) : r * (q + 1) + (xcd - r) * q) + off; }
    const int nig = WGM * nN, gid = wgid / nig, fm = gid * WGM, gsz = (nM - fm) < WGM ? (nM - fm) : WGM;
    pm = fm + ((wgid % nig) % gsz); pn = (wgid % nig) / gsz;
}

template <class Epi, class Sched, bool ALIGN_EPI, bool SP2>
__device__ __forceinline__ void gemm_phase(LAS unsigned char* lds, const Geom g, const Sched& S, const Epi& E) {
    const int tid = threadIdx.x, wid = __builtin_amdgcn_readfirstlane(tid >> 6), lane = tid & 63, wr = wid >> 2, wc = wid & 3, fr = lane & 15, fq = lane >> 4;
    unsigned voffA[2], voffB[2];
#pragma unroll
    for (int i = 0; i < 2; ++i) { int R, C; stage_rc(tid * 16 + i * 8192, R, C); const int Rb = (R & ~31) + perm32(R & 31);
        voffA[i] = (unsigned)(R * g.lda + C) * 2u; voffB[i] = (unsigned)(Rb * g.ldb + C) * 2u; }
    const size_t kstep = (size_t)(BK * 2);
    const size_t hstepA = (size_t)HALF * g.lda * 2, hstepB = (size_t)HALF * g.ldb * 2;
    unsigned voffA1[2];
#pragma unroll
    for (int i = 0; i < 2; ++i) voffA1[i] = voffA[i] + (unsigned)hstepA;
    const unsigned ldsw = (unsigned)wid * 1024u;
    const int aoff = lds_byte(wr * 64 + fr, fq * 8), boff = lds_byte(wc * 32 + fr, fq * 8);
#define PG8_SA(b, h) (((b) * 2 + (h)) * HTB)
#define PG8_SB(b, h) ((4 + (b) * 2 + (h)) * HTB)
#define PG8_STAGE(bufoff, gbase, voff) do { _Pragma("unroll") for (int _i = 0; _i < 2; ++_i) \
        __builtin_amdgcn_global_load_lds((const unsigned*)((const char*)(gbase) + (voff)[_i]), (LAS unsigned*)(lds + (bufoff) + ldsw + _i * 8192), 16, 0, 0); } while (0)
#define PG8_LDA(dst, b, h) do { _Pragma("unroll") for (int m = 0; m < 4; ++m) _Pragma("unroll") for (int k = 0; k < 2; ++k) dst[m][k] = *(const LAS bf16x8*)(lds + PG8_SA(b, h) + aoff + m * 2048 + k * 1024); } while (0)
#define PG8_LDB(dst, b, h) do { _Pragma("unroll") for (int n = 0; n < 2; ++n) _Pragma("unroll") for (int k = 0; k < 2; ++k) dst[n][k] = *(const LAS bf16x8*)(lds + PG8_SB(b, h) + boff + n * 2048 + k * 1024); } while (0)
#define PG8_MMA(ai, bj, At, Bt) do { __builtin_amdgcn_s_setprio(1); _Pragma("unroll") for (int m = 0; m < 4; ++m) _Pragma("unroll") for (int n = 0; n < 2; ++n) _Pragma("unroll") for (int k = 0; k < 2; ++k) \
        acc[ai][bj][m][n] = __builtin_amdgcn_mfma_f32_16x16x32_bf16(Bt[n][k], At[m][k], acc[ai][bj][m][n], 0, 0, 0); __builtin_amdgcn_s_setprio(0); } while (0)
#define PG8_WAIT_V(n) asm volatile("s_waitcnt vmcnt(" #n ")" ::: "memory")
#define PG8_WAIT_L(n) asm volatile("s_waitcnt lgkmcnt(" #n ")" ::: "memory")
#define PG8_BAR __builtin_amdgcn_s_barrier()
#define PG8_SCHED __builtin_amdgcn_sched_barrier(0)
    Unit cur, nxt; int ui = 0;
    if (!S.next(0, cur)) return;
    if (g.rowtok) {
#pragma unroll
        for (int i = 0; i < 2; ++i) { int R, C; stage_rc(tid * 16 + i * 8192, R, C); int t0 = g.rowtok[cur.row0 + R], t1 = g.rowtok[cur.row0 + HALF + R]; t0 = t0 < 0 ? 0 : t0; t1 = t1 < 0 ? 0 : t1;
            voffA[i] = (unsigned)(t0 * g.lda + C) * 2u; voffA1[i] = (unsigned)(t1 * g.lda + C) * 2u; }
    }
    f32x4 acc[2][2][4][2];
#pragma unroll
    for (int a = 0; a < 2; ++a)
#pragma unroll
        for (int b = 0; b < 2; ++b)
#pragma unroll
            for (int m = 0; m < 4; ++m)
#pragma unroll
                for (int n = 0; n < 2; ++n) acc[a][b][m][n] = (f32x4){0.f, 0.f, 0.f, 0.f};
    bf16x8 At[4][2], B0[2][2], B1[2][2];
    const char* cA = cur.A; const char* cB = cur.B; const char* cBhi = cur.Bhi;
    if constexpr (SP2) {
        PG8_STAGE(PG8_SB(0, 0), cB, voffB); PG8_STAGE(PG8_SB(0, 1), cB + hstepB, voffB); PG8_STAGE(PG8_SA(0, 0), cA, voffA); PG8_STAGE(PG8_SA(0, 1), cA, voffA1);
        if (wr == 1) PG8_BAR;
        PG8_WAIT_V(2); PG8_BAR;
        PG8_STAGE(PG8_SB(1, 0), cB + kstep, voffB); PG8_STAGE(PG8_SA(1, 0), cA + kstep, voffA); PG8_STAGE(PG8_SB(1, 1), cB + hstepB + kstep, voffB);
        PG8_WAIT_V(6); PG8_BAR;
    } else {
        PG8_STAGE(PG8_SB(0, 0), cB, voffB); PG8_STAGE(PG8_SA(0, 0), cA, voffA); PG8_STAGE(PG8_SB(0, 1), cB + hstepB, voffB); PG8_STAGE(PG8_SA(0, 1), cA, voffA1);
        if (wr == 1) PG8_BAR;
        PG8_WAIT_V(4); PG8_BAR;
        PG8_STAGE(PG8_SB(1, 0), cB + kstep, voffB); PG8_STAGE(PG8_SA(1, 0), cA + kstep, voffA); PG8_STAGE(PG8_SB(1, 1), cB + hstepB + kstep, voffB);
        PG8_WAIT_V(6); PG8_BAR;
    }
    for (;;) {
        const bool has_next = S.next(ui + 1, nxt);
        const char* nA = has_next ? nxt.A : cA; const char* nB = has_next ? nxt.B : cB;
        const int nt = cur.nt; const bool hi_on = cur.lowonly == 0;
        for (int t = 0; t < nt; t += 2) {
            const bool last = (t == nt - 2);
            if constexpr (Epi::HOOK) { if (t == Epi::HOOK_T1 || t == Epi::HOOK_T2) E.hook(acc, cur, t, wr, wc, fr, fq); }
            const char* a1 = cA + (size_t)(t + 1) * kstep;
            const char* a2 = last ? nA : cA + (size_t)(t + 2) * kstep;
            const char* b2 = last ? nB : ((t + 2) < g.ksplit ? cB : cBhi) + (size_t)(t + 2) * kstep;
            const char* a3 = a2 + kstep; const char* b3 = b2 + kstep;
            if constexpr (SP2) {
            PG8_LDB(B0, 0, 0); PG8_LDB(B1, 0, 1); PG8_SCHED; PG8_LDA(At, 0, 0); PG8_STAGE(PG8_SA(1, 1), a1, voffA1);
            PG8_WAIT_V(8); PG8_WAIT_L(0); PG8_BAR; PG8_MMA(0, 0, At, B0); PG8_MMA(0, 1, At, B1); PG8_BAR; PG8_SCHED;
            PG8_LDA(At, 0, 1); PG8_STAGE(PG8_SB(0, 0), b2, voffB); PG8_STAGE(PG8_SB(0, 1), b2 + hstepB, voffB); PG8_STAGE(PG8_SA(0, 0), a2, voffA);
            PG8_WAIT_V(8); PG8_WAIT_L(0); PG8_BAR; if (hi_on) { PG8_MMA(1, 0, At, B0); PG8_MMA(1, 1, At, B1); } PG8_BAR; PG8_SCHED;
            PG8_LDB(B0, 1, 0); PG8_LDB(B1, 1, 1); PG8_SCHED; PG8_LDA(At, 1, 0); PG8_STAGE(PG8_SA(0, 1), a2, voffA1);
            PG8_WAIT_V(8); PG8_WAIT_L(0); PG8_BAR; PG8_MMA(0, 0, At, B0); PG8_MMA(0, 1, At, B1); PG8_BAR; PG8_SCHED;
            PG8_LDA(At, 1, 1); PG8_STAGE(PG8_SB(1, 0), b3, voffB); PG8_STAGE(PG8_SB(1, 1), b3 + hstepB, voffB); PG8_STAGE(PG8_SA(1, 0), a3, voffA);
            PG8_WAIT_V(8); PG8_WAIT_L(0); PG8_BAR; if (hi_on) { PG8_MMA(1, 0, At, B0); PG8_MMA(1, 1, At, B1); } PG8_BAR; PG8_SCHED;
            } else {
            PG8_LDB(B0, 0, 0); PG8_SCHED; PG8_LDA(At, 0, 0); PG8_STAGE(PG8_SA(1, 1), a1, voffA1);
            PG8_WAIT_L(8); PG8_BAR; PG8_WAIT_L(0); PG8_MMA(0, 0, At, B0); PG8_BAR; PG8_SCHED;
            PG8_LDB(B1, 0, 1); PG8_STAGE(PG8_SB(0, 0), b2, voffB);
            PG8_BAR; PG8_WAIT_L(0); PG8_MMA(0, 1, At, B1); PG8_BAR;
            PG8_LDA(At, 0, 1); PG8_STAGE(PG8_SA(0, 0), a2, voffA);
            PG8_BAR; PG8_WAIT_L(0); PG8_MMA(1, 0, At, B0); PG8_BAR; PG8_SCHED;
            PG8_STAGE(PG8_SB(0, 1), b2 + hstepB, voffB);
            PG8_WAIT_V(6); PG8_BAR; PG8_MMA(1, 1, At, B1); PG8_BAR;
            PG8_LDB(B0, 1, 0); PG8_SCHED; PG8_LDA(At, 1, 0); PG8_STAGE(PG8_SA(0, 1), a2, voffA1);
            PG8_WAIT_L(8); PG8_BAR; PG8_WAIT_L(0); PG8_MMA(0, 0, At, B0); PG8_BAR; PG8_SCHED;
            PG8_LDB(B1, 1, 1); PG8_STAGE(PG8_SB(1, 0), b3, voffB);
            PG8_BAR; PG8_WAIT_L(0); PG8_MMA(0, 1, At, B1); PG8_BAR;
            PG8_LDA(At, 1, 1); PG8_STAGE(PG8_SA(1, 0), a3, voffA);
            PG8_BAR; PG8_WAIT_L(0); PG8_MMA(1, 0, At, B0); PG8_BAR; PG8_SCHED;
            PG8_STAGE(PG8_SB(1, 1), b3 + hstepB, voffB);
            PG8_WAIT_V(6); PG8_BAR; PG8_MMA(1, 1, At, B1); PG8_BAR;
            }
        }
        if constexpr (ALIGN_EPI) { if (wr == 0) PG8_BAR; }
        E(acc, cur, wr, wc, fr, fq);
        if (!has_next) break;
#pragma unroll
        for (int a = 0; a < 2; ++a)
#pragma unroll
            for (int b = 0; b < 2; ++b)
#pragma unroll
                for (int m = 0; m < 4; ++m)
#pragma unroll
                    for (int n = 0; n < 2; ++n) acc[a][b][m][n] = (f32x4){0.f, 0.f, 0.f, 0.f};
        cur = nxt; cA = nA; cB = nB; cBhi = nxt.Bhi; ++ui;
        if constexpr (ALIGN_EPI) { if (wr == 1) PG8_BAR; }
    }
    PG8_WAIT_V(0);
    if constexpr (!ALIGN_EPI) { if (wr == 0) PG8_BAR; }
    PG8_BAR;
#undef PG8_SA
#undef PG8_SB
#undef PG8_STAGE
#undef PG8_LDA
#undef PG8_LDB
#undef PG8_MMA
#undef PG8_WAIT_V
#undef PG8_WAIT_L
#undef PG8_BAR
#undef PG8_SCHED
}
}

constexpr int RING_BYTES = 131072, LDS_BYTES = 147456, LDSCTL_OFF = LDS_BYTES - 2048, MISC_OFF = LDSCTL_OFF + 320;
struct KArgs { const void* in[24]; float* out; unsigned char* ws; int ph_lo, ph_hi; };
struct Frame {
    LAS unsigned char* lds; volatile LAS unsigned* MISC; unsigned* ctl; unsigned char* ws; float* out;
    int tid, lane, wave, vcu, G;
    const float *x, *mem, *g_mix, *w_in, *b_gate, *w_pool_grp, *pool_scale, *q_norm_g, *k_norm_g, *g_mem, *w_mem_kv, *xq_norm_g, *xk_norm_g,
                *w_pool_out, *w_attn_out, *w_cross_out, *w_o, *g_ffn, *w_rg, *w_re, *w_eg, *w_eu, *w_ed;
    const int* positions;
};
template <class T> __device__ __forceinline__ T* wsp(const Frame& F, size_t off) { return (T*)(F.ws + off); }

__device__ __forceinline__ void tr_item(const float* W, int ldw, int k0, int n0, int nvalid, const float* gain, bf16_t* dst, int ldd, int dk0, LAS float*, int lane) {
    const int kg = lane >> 3, ng = lane & 7;
    f32x4 v[2][8]; float g[8];
#pragma unroll
    for (int hh = 0; hh < 2; ++hh) { const int nn = 32 * hh + 4 * ng; const bool ok = nn < nvalid;
#pragma unroll
        for (int i = 0; i < 8; ++i) v[hh][i] = ok ? *(const f32x4*)(W + (size_t)(k0 + 8 * kg + i) * ldw + n0 + nn) : (f32x4){0.f, 0.f, 0.f, 0.f}; }
#pragma unroll
    for (int i = 0; i < 8; ++i) g[i] = gain ? gain[k0 + 8 * kg + i] : 1.0f;
#pragma unroll
    for (int hh = 0; hh < 2; ++hh)
#pragma unroll
        for (int j = 0; j < 4; ++j) { const int n = 32 * hh + 4 * ng + j;
            u32x4 o; o.x = pk2(v[hh][0][j] * g[0], v[hh][1][j] * g[1]); o.y = pk2(v[hh][2][j] * g[2], v[hh][3][j] * g[3]); o.z = pk2(v[hh][4][j] * g[4], v[hh][5][j] * g[5]); o.w = pk2(v[hh][6][j] * g[6], v[hh][7][j] * g[7]);
            *(u32x4*)(dst + (size_t)n * ldd + dk0 + k0 + 8 * kg) = o; }
}
__device__ __forceinline__ void row_to_bf16(const float* xrow, bf16_t* orow, float* rstd_out, int lane) {
    const f32x4* xr = (const f32x4*)xrow + lane;
    f32x4 v[8]; float s = 0.f;
#pragma unroll
    for (int j = 0; j < 8; ++j) { v[j] = xr[64 * j]; s += (v[j].x * v[j].x + v[j].y * v[j].y) + (v[j].z * v[j].z + v[j].w * v[j].w); }
    s = wave_sum(s);
    u32x2* o8 = (u32x2*)orow + lane;
#pragma unroll
    for (int j = 0; j < 8; ++j) { u32x2 w; w.x = pk2(v[j].x, v[j].y); w.y = pk2(v[j].z, v[j].w); o8[64 * j] = w; }
    if (lane == 0) *rstd_out = 1.0f / sqrtf(s * (1.0f / DM) + NORM_EPS);
}
__device__ __forceinline__ void att_build_table(Frame& F);
__device__ __forceinline__ int cum_chunks(int qb);
#ifndef P0_PROF
#define P0_PROF 0
#endif
#define P0T0() unsigned long long _pt = (P0_PROF && F.tid == 0) ? __builtin_amdgcn_s_memrealtime() : 0ull
#define P0T1(k) do { if (P0_PROF == (k)) { __syncthreads(); if (F.tid == 0) atomicMax(F.ctl + CW_QUEUE + 8, (unsigned)(__builtin_amdgcn_s_memrealtime() - _pt)); } } while (0)
__device__ __forceinline__ void p0_prologue(Frame& F) {
    P0T0();
    if (blockIdx.x == 0) att_build_table(F);
    LAS float* scr = (LAS float*)(F.lds + F.wave * 16640);
    const int gw = F.vcu * NWAVES + F.wave, NGW = F.G * NWAVES;
    bf16_t* WINT = wsp<bf16_t>(F, WS_WINT); bf16_t* WVT = wsp<bf16_t>(F, WS_WVT); bf16_t* WMKVT = wsp<bf16_t>(F, WS_WMKVT);
    bf16_t* BTMRG = wsp<bf16_t>(F, WS_BTMRG); bf16_t* WOT = wsp<bf16_t>(F, WS_WOT);
    for (int it = gw; it < 4 * 6 * 64; it += NGW) {
        const int g = it / 384, r = it % 384, ct = r / 64, dt = r % 64;
        const int i = F.lane & 31, kh = F.lane >> 5;
        const float* ap = F.w_pool_grp + (size_t)g * 192 * 192 + (size_t)(32 * ct + i) * 192 + 4 * kh;
        const float* sp = F.pool_scale + g * 192 + 4 * kh;
        const float* bp = F.w_pool_out + (size_t)(g * 192 + 4 * kh) * DM + 32 * dt + i;
        f32x16 acc;
#pragma unroll
        for (int q2 = 0; q2 < 16; ++q2) acc[q2] = 0.f;
#pragma unroll 1
        for (int m0 = 0; m0 < 24; m0 += 6) {
            f32x4 a[6], sc[6]; float b[6][4];
#pragma unroll
            for (int mm = 0; mm < 6; ++mm) { a[mm] = *(const f32x4*)(ap + 8 * (m0 + mm)); sc[mm] = *(const f32x4*)(sp + 8 * (m0 + mm));
#pragma unroll
                for (int e = 0; e < 4; ++e) b[mm][e] = bp[(size_t)(8 * (m0 + mm) + e) * DM]; }
#pragma unroll
            for (int mm = 0; mm < 6; ++mm)
#pragma unroll
                for (int e = 0; e < 4; ++e) acc = __builtin_amdgcn_mfma_f32_32x32x2f32(a[mm][e] * sc[mm][e], b[mm][e], acc, 0, 0, 0);
        }
        bf16_t* op = BTMRG + (size_t)(32 * dt + i) * DM + g * 192 + 32 * ct + 4 * kh;
#pragma unroll
        for (int q4 = 0; q4 < 4; ++q4) { u32x2 o; o.x = pk2(acc[4 * q4 + 0], acc[4 * q4 + 1]); o.y = pk2(acc[4 * q4 + 2], acc[4 * q4 + 3]); *(u32x2*)(op + 8 * q4) = o; }
    }
    P0T1(1);
    __syncthreads();
    constexpr int NB_IN = 158, I_IN = 32 * NB_IN, I_MKV = 32 * 16, I_WO = 32 * 32, I_AO = 12 * 32, I_CO = 8 * 32;
    constexpr int NITEMS = I_IN + I_MKV + I_WO + I_AO + I_CO;
    for (int it = gw; it < NITEMS; it += NGW) {
        int r = it;
        if (r < I_IN) {
            const int kb = r / NB_IN, nb = r % NB_IN; int sc0, drow, nv = 64; bf16_t* dm = WINT; int j;
            if (nb < 12) { j = nb; sc0 = 0; drow = 0; }
            else if (nb < 24) { j = nb - 12; sc0 = 768; drow = 768; }
            else if (nb < 36) { j = nb - 24; sc0 = 1536; drow = 1536; }
            else if (nb < 48) { j = nb - 36; sc0 = 2304; drow = 0; dm = WVT; }
            else if (nb < 52) { j = nb - 48; sc0 = 3072; drow = 2304; }
            else if (nb < 54) { j = nb - 52; sc0 = 3328; drow = 2560; if (j == 1) nv = 4; }
            else if (nb < 62) { j = nb - 54; sc0 = 3396; drow = 2816; }
            else { j = nb - 62; sc0 = 3908; drow = 3328; }
            tr_item(F.w_in, INC, kb * 64, sc0 + 64 * j, nv, F.g_mix, dm + (size_t)(drow + 64 * j) * DM, DM, 0, scr, F.lane); continue; }
        r -= I_IN;
        if (r < I_MKV) { const int kb = r / 16, nb = r % 16; tr_item(F.w_mem_kv, 1024, kb * 64, nb * 64, 64, F.g_mem, WMKVT + (size_t)(nb * 64) * DM, DM, 0, scr, F.lane); continue; }
        r -= I_MKV;
        if (r < I_WO) { const int kb = r / 32, nb = r % 32; tr_item(F.w_o, DM, kb * 64, nb * 64, 64, nullptr, WOT + (size_t)(nb * 64) * DM, DM, 0, scr, F.lane); continue; }
        r -= I_WO;
        if (r < I_AO) { const int kb = r / 32, nb = r % 32; tr_item(F.w_attn_out, DM, kb * 64, nb * 64, 64, nullptr, BTMRG + (size_t)(nb * 64) * DM, DM, 768, scr, F.lane); continue; }
        r -= I_AO;
        { const int kb = r / 32, nb = r % 32; tr_item(F.w_cross_out, DM, kb * 64, nb * 64, 64, nullptr, BTMRG + (size_t)(nb * 64) * DM, DM, 1536, scr, F.lane); }
    }
    P0T1(2);
    { u32x4* z = (u32x4*)(WINT + (size_t)2688 * DM); const int n16 = 128 * DM * 2 / 16;
      for (int i = F.vcu * NTHR + F.tid; i < n16; i += F.G * NTHR) z[i] = (u32x4){0u, 0u, 0u, 0u}; }
    { float* WR = wsp<float>(F, WS_WR);
      for (int i = F.vcu * NTHR + F.tid; i < DM * 32; i += F.G * NTHR) { const int k = i >> 5, j = i & 31;
          float v = 0.f; if (j < 4) v = F.w_rg[k * 4 + j]; else if (j < 20) v = F.w_re[k * 16 + (j - 4)];
          WR[i] = v * F.g_ffn[k]; } }
    P0T1(3);
    { bf16_t* XB = wsp<bf16_t>(F, WS_XB); float* R1 = wsp<float>(F, WS_RSTD1); bf16_t* MB = wsp<bf16_t>(F, WS_MEMB); float* RM = wsp<float>(F, WS_RSTDM);
      for (int m = gw; m < SEQ + MEML; m += NGW) {
          if (m < SEQ) row_to_bf16(F.x + (size_t)m * DM, XB + (size_t)m * DM, R1 + m, F.lane);
          else { const int mm = m - SEQ; row_to_bf16(F.mem + (size_t)mm * DM, MB + (size_t)mm * DM, RM + mm, F.lane); } } }
}

struct SchedP1 {
    int c, G; unsigned char* ws;
    __device__ __forceinline__ bool next(int i, pg8::Unit& u) const {
        const int L = i * G + c; const size_t tstep = (size_t)256 * DM * 2;
        const char* XB = (const char*)(ws + WS_XB); const char* WINT = (const char*)(ws + WS_WINT); const char* WVT = (const char*)(ws + WS_WVT); const char* MEMB = (const char*)(ws + WS_MEMB); const char* WMKVT = (const char*)(ws + WS_WMKVT);
        u.nt = 32; u.lowonly = 0;
        if (L < 1184) { int pm, pn; pg8::tile_order(L, 32, 37, pm, pn);
            u.A = XB + (size_t)pm * tstep; u.B = WINT + (size_t)pn * tstep; u.Bhi = u.B; u.row0 = pm * 256;
            if (pn < 3) { u.kind = 0; u.col0 = pn * 256; u.aux = 0; }
            else if (pn < 6) { u.kind = 0; u.col0 = (pn - 3) * 256; u.aux = 1; }
            else if (pn < 9) { u.kind = 0; u.col0 = (pn - 6) * 256; u.aux = 2; }
            else if (pn < 11) { u.kind = 1; u.col0 = (pn - 9) * 256; u.aux = 0; }
            else if (pn < 13) { u.kind = 0; u.col0 = (pn - 11) * 256; u.aux = 3; }
            else { u.kind = 2; u.col0 = (pn - 13) * 256; u.aux = 0; }
            return true; }
        if (L < 1280) { const int idx = L - 1184, pm = idx / 32, pn = idx % 32;
            u.A = WVT + (size_t)pm * tstep; u.B = XB + (size_t)pn * tstep; u.Bhi = u.B; u.kind = 3; u.row0 = pm * 256; u.col0 = pn * 256; u.aux = 0; return true; }
        if (L < 1312) { const int idx = L - 1280, pn = idx & 3, ks = idx >> 2;
            u.A = MEMB + (size_t)ks * 512; u.B = WMKVT + (size_t)pn * tstep + (size_t)ks * 512; u.Bhi = u.B; u.kind = 4; u.row0 = 0; u.col0 = pn * 256; u.aux = ks; u.nt = 4; return true; }
        return false;
    }
};
struct EpiP1 {
    static constexpr bool HOOK = false; static constexpr int HOOK_T1 = -1, HOOK_T2 = -1;
    unsigned char* ws; const float* rstd1; const float* rstdm; const float* bgate;
    __device__ __forceinline__ void hook(f32x4 (&)[2][2][4][2], const pg8::Unit&, int, int, int, int, int) const {}
    __device__ __forceinline__ void operator()(const f32x4 (&acc)[2][2][4][2], const pg8::Unit& u, int wr, int wc, int fr, int fq) const {
        const int rbase = u.row0 + wr * 64 + fr, cbase = u.col0 + wc * 32 + 8 * fq;
        if (u.kind == 0) {
            bf16_t* C; int ldc;
            if (u.aux == 0) { C = (bf16_t*)(ws + WS_U); ldc = 768; } else if (u.aux == 1) { C = (bf16_t*)(ws + WS_Q); ldc = 768; }
            else if (u.aux == 2) { C = (bf16_t*)(ws + WS_K); ldc = 768; } else { C = (bf16_t*)(ws + WS_XQ); ldc = 512; }
#pragma unroll
            for (int ai = 0; ai < 2; ++ai)
#pragma unroll
                for (int m = 0; m < 4; ++m) { const int row = rbase + ai * 128 + m * 16; const float s = rstd1[row];
#pragma unroll
                    for (int bj = 0; bj < 2; ++bj) { const f32x4 v0 = acc[ai][bj][m][0] * s, v1 = acc[ai][bj][m][1] * s;
                        u32x4 w; w.x = pk2(v0[0], v0[1]); w.y = pk2(v0[2], v0[3]); w.z = pk2(v1[0], v1[1]); w.w = pk2(v1[2], v1[3]);
                        *(u32x4*)(C + (size_t)row * ldc + cbase + bj * 128) = w; } }
        } else if (u.kind == 1 || u.kind == 4) {
            float* C; int ldc; const float* rs;
            if (u.kind == 1) { C = (float*)(ws + WS_IDXF); ldc = 512; rs = rstd1; } else { C = (float*)(ws + WS_KVMP) + (size_t)u.aux * 262144; ldc = 1024; rs = rstdm; }
#pragma unroll
            for (int ai = 0; ai < 2; ++ai)
#pragma unroll
                for (int m = 0; m < 4; ++m) { const int row = rbase + ai * 128 + m * 16; const float s = rs[row];
#pragma unroll
                    for (int bj = 0; bj < 2; ++bj) { float* p = C + (size_t)row * ldc + cbase + bj * 128;
                        *(f32x4*)p = acc[ai][bj][m][0] * s; *(f32x4*)(p + 4) = acc[ai][bj][m][1] * s; } }
        } else if (u.kind == 2) {
            bf16_t* C = (bf16_t*)(ws + WS_EG);
            f32x4 bv[2][2];
#pragma unroll
            for (int bj = 0; bj < 2; ++bj) { bv[bj][0] = *(const f32x4*)(bgate + cbase + bj * 128); bv[bj][1] = *(const f32x4*)(bgate + cbase + bj * 128 + 4); }
#pragma unroll
            for (int ai = 0; ai < 2; ++ai)
#pragma unroll
                for (int m = 0; m < 4; ++m) { const int row = rbase + ai * 128 + m * 16; const float s = rstd1[row];
#pragma unroll
                    for (int bj = 0; bj < 2; ++bj) { f32x4 v0 = acc[ai][bj][m][0] * s + bv[bj][0], v1 = acc[ai][bj][m][1] * s + bv[bj][1];
#pragma unroll
                        for (int e = 0; e < 4; ++e) { v0[e] = 1.0f + __builtin_amdgcn_exp2f(fminf(-v0[e] * LOG2E, 60.f)); v1[e] = 1.0f + __builtin_amdgcn_exp2f(fminf(-v1[e] * LOG2E, 60.f)); }
                        u32x4 w; w.x = pk2(v0[0], v0[1]); w.y = pk2(v0[2], v0[3]); w.z = pk2(v1[0], v1[1]); w.w = pk2(v1[2], v1[3]);
                        *(u32x4*)(C + (size_t)row * 6144 + cbase + bj * 128) = w; } }
        } else {
            bf16_t* C = (bf16_t*)(ws + WS_VT);
            f32x4 sv[2][2];
#pragma unroll
            for (int bj = 0; bj < 2; ++bj) { sv[bj][0] = *(const f32x4*)(rstd1 + cbase + bj * 128); sv[bj][1] = *(const f32x4*)(rstd1 + cbase + bj * 128 + 4); }
#pragma unroll
            for (int ai = 0; ai < 2; ++ai)
#pragma unroll
                for (int m = 0; m < 4; ++m) { const int row = rbase + ai * 128 + m * 16;
#pragma unroll
                    for (int bj = 0; bj < 2; ++bj) { const f32x4 v0 = acc[ai][bj][m][0] * sv[bj][0], v1 = acc[ai][bj][m][1] * sv[bj][1];
                        u32x4 w; w.x = pk2(v0[0], v0[1]); w.y = pk2(v0[2], v0[3]); w.z = pk2(v1[0], v1[1]); w.w = pk2(v1[2], v1[3]);
                        *(u32x4*)(C + (size_t)row * SEQ + cbase + bj * 128) = w; } }
        }
    }
};

__device__ __forceinline__ void rot_cs(float pos, float inv_freq, float& c, float& s) {
    const float ang = pos * inv_freq;
    const double rev = (double)ang * 0.15915494309189535;
    const float fr = (float)(rev - __builtin_rint(rev));
    c = __builtin_amdgcn_cosf(fr); s = __builtin_amdgcn_sinf(fr);
}
__device__ __forceinline__ void unpack8(const u32x4 v, float (&f)[8]) { f[0] = bflo(v.x); f[1] = bfhi(v.x); f[2] = bflo(v.y); f[3] = bfhi(v.y); f[4] = bflo(v.z); f[5] = bfhi(v.z); f[6] = bflo(v.w); f[7] = bfhi(v.w); }
__device__ __forceinline__ u32x4 pack8(const float (&f)[8]) { u32x4 o; o.x = pk2(f[0], f[1]); o.y = pk2(f[2], f[3]); o.z = pk2(f[4], f[5]); o.w = pk2(f[6], f[7]); return o; }
__device__ __forceinline__ void p2_rowpass(Frame& F) {
    P0T0();
    const int gw = F.vcu * NWAVES + F.wave, NGW = F.G * NWAVES, lane = F.lane;
    const bf16_t* U = wsp<bf16_t>(F, WS_U); bf16_t* AM = wsp<bf16_t>(F, WS_AMRG);
    bf16_t* Q = wsp<bf16_t>(F, WS_Q); bf16_t* K = wsp<bf16_t>(F, WS_K); bf16_t* XQ = wsp<bf16_t>(F, WS_XQ);
    const float* IDXF = wsp<float>(F, WS_IDXF); bf16_t* QIB = wsp<bf16_t>(F, WS_QIB); bf16_t* KIB = wsp<bf16_t>(F, WS_KIB); float* WIF = wsp<float>(F, WS_WIF);
    const int m = lane & 15, mlo = m & 7; const bool hi_half = m >= 8;
    float if128[8], if64[4], gq[8], gk[8], gx[8];
#pragma unroll
    for (int e = 0; e < 8; ++e) { if128[e] = __builtin_amdgcn_exp2f(-(float)(2 * (8 * mlo + e)) * (13.287712379549449f / 128.0f)); gq[e] = F.q_norm_g[8 * m + e]; gk[e] = F.k_norm_g[8 * m + e]; gx[e] = F.xq_norm_g[8 * m + e]; }
#pragma unroll
    for (int e = 0; e < 4; ++e) if64[e] = __builtin_amdgcn_exp2f(-(float)(2 * (4 * mlo + e)) * (13.287712379549449f / 64.0f));
    for (int t = gw; t < SEQ; t += NGW) {
        const int colA = 8 * lane, colB = 512 + 8 * lane;
        const int gA = colA / 192, wA = 2 << gA, cntA = (t + 1 < wA) ? (t + 1) : wA;
        const int gB = (lane < 32) ? colB / 192 : 3, wB = 2 << gB, cntB = (lane < 32) ? ((t + 1 < wB) ? (t + 1) : wB) : 0;
        u32x4 ua[8], ub[16];
#pragma unroll
        for (int j = 0; j < 8; ++j) ua[j] = (j < cntA) ? *(const u32x4*)(U + (size_t)(t - j) * 768 + colA) : (u32x4){0u, 0u, 0u, 0u};
#pragma unroll
        for (int j = 0; j < 16; ++j) ub[j] = (j < cntB) ? *(const u32x4*)(U + (size_t)(t - j) * 768 + colB) : (u32x4){0u, 0u, 0u, 0u};
        u32x4 rawqk[3];
#pragma unroll
        for (int ch = 0; ch < 3; ++ch) { const int e0 = ch * 512 + 8 * lane; rawqk[ch] = *(const u32x4*)((e0 < 768) ? (Q + (size_t)t * 768 + e0) : (K + (size_t)t * 768 + (e0 - 768))); }
        const u32x4 rawx = *(const u32x4*)(XQ + (size_t)t * 512 + 8 * lane);
        const float* ip = IDXF + (size_t)t * 512;
        const f32x4 iqa = *(const f32x4*)(ip + 4 * lane), ika = *(const f32x4*)(ip + 256 + 4 * (lane & 15));
        const float iw = ip[320 + (lane & 3)];
        { float sum[8];
#pragma unroll
          for (int e = 0; e < 8; ++e) sum[e] = 0.f;
#pragma unroll
          for (int j = 0; j < 8; ++j) { float f[8]; unpack8(ua[j], f);
#pragma unroll
              for (int e = 0; e < 8; ++e) sum[e] += f[e]; }
          float cur[8]; unpack8(ua[0], cur); const float inv = 1.0f / (float)cntA; float o[8];
#pragma unroll
          for (int e = 0; e < 8; ++e) o[e] = sum[e] * inv - cur[e];
          *(u32x4*)(AM + (size_t)t * DM + colA) = pack8(o); }
        if (lane < 32) { float sum[8];
#pragma unroll
          for (int e = 0; e < 8; ++e) sum[e] = 0.f;
#pragma unroll
          for (int j = 0; j < 16; ++j) { float f[8]; unpack8(ub[j], f);
#pragma unroll
              for (int e = 0; e < 8; ++e) sum[e] += f[e]; }
          float cur[8]; unpack8(ub[0], cur); const float inv = 1.0f / (float)cntB; float o[8];
#pragma unroll
          for (int e = 0; e < 8; ++e) o[e] = sum[e] * inv - cur[e];
          *(u32x4*)(AM + (size_t)t * DM + colB) = pack8(o); }
        const float pos = (float)F.positions[t];
        float c128[8], s128[8], c64[4], s64[4];
#pragma unroll
        for (int e = 0; e < 8; ++e) rot_cs(pos, if128[e], c128[e], s128[e]);
#pragma unroll
        for (int e = 0; e < 4; ++e) rot_cs(pos, if64[e], c64[e], s64[e]);
#pragma unroll
        for (int ch = 0; ch < 3; ++ch) {
            const int e0 = ch * 512 + 8 * lane; const bool isq = e0 < 768;
            bf16_t* p = isq ? (Q + (size_t)t * 768 + e0) : (K + (size_t)t * 768 + (e0 - 768));
            float v[8], pv[8]; unpack8(rawqk[ch], v);
            float ss = 0.f;
#pragma unroll
            for (int e = 0; e < 8; ++e) ss += v[e] * v[e];
            ss += __shfl_xor(ss, 1); ss += __shfl_xor(ss, 2); ss += __shfl_xor(ss, 4); ss += __shfl_xor(ss, 8);
            const float r = (1.0f / sqrtf(ss * (1.0f / 128.0f) + NORM_EPS)) * (isq ? (ATT_SCALE * LOG2E) : 1.0f);
#pragma unroll
            for (int e = 0; e < 8; ++e) v[e] *= r * (isq ? gq[e] : gk[e]);
#pragma unroll
            for (int e = 0; e < 8; ++e) pv[e] = __shfl_xor(v[e], 8);
            float o[8];
#pragma unroll
            for (int e = 0; e < 8; ++e) o[e] = hi_half ? (v[e] * c128[e] + pv[e] * s128[e]) : (v[e] * c128[e] - pv[e] * s128[e]);
            *(u32x4*)p = pack8(o);
        }
        { bf16_t* p = XQ + (size_t)t * 512 + 8 * lane; float v[8]; unpack8(rawx, v);
          float ss = 0.f;
#pragma unroll
          for (int e = 0; e < 8; ++e) ss += v[e] * v[e];
          ss += __shfl_xor(ss, 1); ss += __shfl_xor(ss, 2); ss += __shfl_xor(ss, 4); ss += __shfl_xor(ss, 8);
          const float r = (1.0f / sqrtf(ss * (1.0f / 128.0f) + NORM_EPS)) * (ATT_SCALE * LOG2E);
#pragma unroll
          for (int e = 0; e < 8; ++e) v[e] *= r * gx[e];
          *(u32x4*)p = pack8(v); }
        { const f32x4 a = iqa; f32x4 b; b[0] = __shfl_xor(a[0], 8); b[1] = __shfl_xor(a[1], 8); b[2] = __shfl_xor(a[2], 8); b[3] = __shfl_xor(a[3], 8);
          float o[4];
#pragma unroll
          for (int e = 0; e < 4; ++e) o[e] = hi_half ? (a[e] * c64[e] + b[e] * s64[e]) : (a[e] * c64[e] - b[e] * s64[e]);
          u32x2 w; w.x = pk2(o[0], o[1]); w.y = pk2(o[2], o[3]); *(u32x2*)(QIB + (size_t)t * 256 + 4 * lane) = w; }
        { const f32x4 a = ika; f32x4 b; b[0] = __shfl_xor(a[0], 8); b[1] = __shfl_xor(a[1], 8); b[2] = __shfl_xor(a[2], 8); b[3] = __shfl_xor(a[3], 8);
          float o[4];
#pragma unroll
          for (int e = 0; e < 4; ++e) o[e] = hi_half ? (a[e] * c64[e] + b[e] * s64[e]) : (a[e] * c64[e] - b[e] * s64[e]);
          u32x2 w; w.x = pk2(o[0], o[1]); w.y = pk2(o[2], o[3]); if (lane < 16) *(u32x2*)(KIB + (size_t)t * 64 + 4 * lane) = w; }
        if (lane < 4) WIF[t * 4 + lane] = iw * 0.0625f;
    }
    P0T1(4);
    { const float* KVM = wsp<float>(F, WS_KVMP); bf16_t* KMB = wsp<bf16_t>(F, WS_KMB); bf16_t* VMT = wsp<bf16_t>(F, WS_VMT);
      const float g0 = F.xk_norm_g[lane], g1 = F.xk_norm_g[lane + 64];
      for (int mm = gw; mm < MEML; mm += NGW) {
#pragma unroll
          for (int h = 0; h < 4; ++h) { float k0 = 0.f, k1 = 0.f;
#pragma unroll
              for (int ks = 0; ks < 8; ++ks) { k0 += KVM[(size_t)ks * 262144 + (size_t)mm * 1024 + h * 128 + lane]; k1 += KVM[(size_t)ks * 262144 + (size_t)mm * 1024 + h * 128 + lane + 64]; }
              const float ks2 = wave_sum(k0 * k0 + k1 * k1), kr = 1.0f / sqrtf(ks2 * (1.0f / 128.0f) + NORM_EPS);
              KMB[(size_t)mm * 512 + h * 128 + lane] = (bf16_t)f2bf(k0 * kr * g0); KMB[(size_t)mm * 512 + h * 128 + lane + 64] = (bf16_t)f2bf(k1 * kr * g1); }
#pragma unroll
          for (int j = 0; j < 8; ++j) { const int c = j * 64 + lane; float v = 0.f;
#pragma unroll
              for (int ks = 0; ks < 8; ++ks) v += KVM[(size_t)ks * 262144 + (size_t)mm * 1024 + 512 + c];
              VMT[(size_t)c * 256 + mm] = (bf16_t)f2bf(v); }
      } }
    P0T1(5);
    { LAS float* scr = (LAS float*)(F.lds + F.wave * 16640);
      bf16_t* WGUT = wsp<bf16_t>(F, WS_WGUT); bf16_t* WDT = wsp<bf16_t>(F, WS_WDT);
      constexpr int I_GU = 16 * 2 * 32 * 8, I_D = 16 * 8 * 32;
      for (int it = gw; it < I_GU + I_D; it += NGW) {
          if (it < I_GU) { const int e = it / 512, r = it % 512, up = r / 256, r2 = r % 256, kb = r2 / 8, nb = r2 % 8, f0 = nb * 64;
              const float* W = (up ? F.w_eu : F.w_eg) + (size_t)e * DM * 512;
              const int drow = (f0 / 128) * 256 + up * 128 + (f0 % 128);
              tr_item(W, 512, kb * 64, f0, 64, F.g_ffn, WGUT + ((size_t)e * 1024 + drow) * DM, DM, 0, scr, lane); }
          else { const int r = it - I_GU, e = r / 256, r2 = r % 256, kb = r2 / 32, nb = r2 % 32;
              tr_item(F.w_ed + (size_t)e * 512 * DM, DM, kb * 64, nb * 64, 64, nullptr, WDT + ((size_t)e * DM + nb * 64) * 512, 512, 0, scr, lane); }
      } }
}

constexpr int HS = 1025;
constexpr int P3_HIST = 0, P3_RING = 16 * HS * 4, P3_LMASK = P3_RING + 8 * 3 * 2048, P3_STATE = P3_LMASK + 16 * 256 * 4;
constexpr int P3_CAP = 384;
__device__ __forceinline__ float relu_s(float x) { const int b = __builtin_bit_cast(int, x); return __builtin_bit_cast(float, b > 0 ? b : 0); }
__device__ __forceinline__ void p3_scores(const bf16x8 A0, const bf16x8 A1, const bf16x8 (&Bq)[4][2], const float (&wq)[4], float (&sc)[4]) {
    f32x2_t s01 = {0.f, 0.f}, s23 = {0.f, 0.f};
#pragma unroll
    for (int h = 0; h < 4; ++h) { f32x4 d = (f32x4){0.f, 0.f, 0.f, 0.f};
        d = __builtin_amdgcn_mfma_f32_16x16x32_bf16(A0, Bq[h][0], d, 0, 0, 0); d = __builtin_amdgcn_mfma_f32_16x16x32_bf16(A1, Bq[h][1], d, 0, 0, 0);
        const f32x2_t w2 = {wq[h], wq[h]}, r01 = {relu_s(d[0]), relu_s(d[1])}, r23 = {relu_s(d[2]), relu_s(d[3])};
        s01 = __builtin_elementwise_fma(w2, r01, s01); s23 = __builtin_elementwise_fma(w2, r23, s23); }
    sc[0] = s01[0]; sc[1] = s01[1]; sc[2] = s23[0]; sc[3] = s23[1];
}
template <int MODE, bool ALLV> __device__ __forceinline__ void p3_update(LAS unsigned* hist, LAS unsigned* lmask, LAS unsigned* ccnt, const float (&sc)[4], unsigned vb,
                                                              int kt, int q, int fq, unsigned pref, unsigned thr, unsigned idxs, bool part) {
    const int s0 = 16 * kt;
    unsigned nib = 0u, cflag = 0u; unsigned ckey[4];
#pragma unroll
    for (int i = 0; i < 4; ++i) {
        const unsigned bits = __builtin_bit_cast(unsigned, sc[i]);
        const unsigned key = bits ^ ((unsigned)((int)bits >> 31) | 0x80000000u);
        const bool valid = ALLV ? true : (((vb >> i) & 1u) != 0u);
        const unsigned s = (unsigned)(s0 + 4 * fq + i);
        if constexpr (MODE == 0) { if (valid && part) { const unsigned dg = key >> 21; __hip_atomic_fetch_add(&hist[q * HS + (dg >> 1)], 1u << (16 * (dg & 1u)), __ATOMIC_RELAXED, __HIP_MEMORY_SCOPE_WORKGROUP); } }
        else if constexpr (MODE == 1) { if (valid && part && (key >> 21) == pref) { const unsigned dg = (key >> 10) & 2047u; __hip_atomic_fetch_add(&hist[q * HS + (dg >> 1)], 1u << (16 * (dg & 1u)), __ATOMIC_RELAXED, __HIP_MEMORY_SCOPE_WORKGROUP); } }
        else if constexpr (MODE == 2) { if (valid && part && (key >> 10) == pref) { const unsigned dg = key & 1023u; __hip_atomic_fetch_add(&hist[q * HS + (dg >> 1)], 1u << (16 * (dg & 1u)), __ATOMIC_RELAXED, __HIP_MEMORY_SCOPE_WORKGROUP); } }
        else if constexpr (MODE == 3) { if (valid && part && key == thr) { const unsigned dg = s >> 2; __hip_atomic_fetch_add(&hist[q * HS + (dg >> 1)], 1u << (16 * (dg & 1u)), __ATOMIC_RELAXED, __HIP_MEMORY_SCOPE_WORKGROUP); } }
        else if constexpr (MODE == 4) { if (valid && part && key == thr && (s >> 2) == pref) { const unsigned dg = s & 3u; __hip_atomic_fetch_add(&hist[q * HS + (dg >> 1)], 1u << (16 * (dg & 1u)), __ATOMIC_RELAXED, __HIP_MEMORY_SCOPE_WORKGROUP); } }
        else if constexpr (MODE == 5) { const bool sel = valid && (key > thr || (key == thr && s <= idxs)); nib |= sel ? (1u << i) : 0u; }
        else {
            const unsigned m13 = (bits & 0x7fffffffu) >> 18; const unsigned cl = m13 < 3168u ? 3168u : (m13 > 4191u ? 4191u : m13);
            const unsigned dg = (cl - 2144u) ^ ((unsigned)((int)bits >> 31) & 2047u);
            ckey[i] = key;
            if constexpr (MODE == 9) { if (valid) __hip_atomic_fetch_add(&hist[q * HS + (dg >> 1)], 1u << (16 * (dg & 1u)), __ATOMIC_RELAXED, __HIP_MEMORY_SCOPE_WORKGROUP); }
            else { nib |= (valid && dg > pref) ? (1u << i) : 0u; cflag |= (valid && dg == pref) ? (1u << i) : 0u; } }
    }
    if constexpr (MODE == 10) {
        if (cflag) { __hip_atomic_fetch_or(&hist[q * HS + 768 + (kt >> 1)], cflag << (16 * (kt & 1) + 4 * fq), __ATOMIC_RELAXED, __HIP_MEMORY_SCOPE_WORKGROUP);
            if (part) { unsigned sl = __hip_atomic_fetch_add(&ccnt[q], (unsigned)__builtin_popcount(cflag), __ATOMIC_RELAXED, __HIP_MEMORY_SCOPE_WORKGROUP);
#pragma unroll
                for (int i = 0; i < 4; ++i) if ((cflag >> i) & 1u) { if (sl < (unsigned)P3_CAP) { hist[q * HS + 2 * sl] = ckey[i]; hist[q * HS + 2 * sl + 1] = (unsigned)(s0 + 4 * fq + i); } ++sl; } } }
    }
    if constexpr (MODE == 5 || MODE == 10) { if (nib) __hip_atomic_fetch_or(&lmask[q * 256 + (kt >> 1)], nib << (16 * (kt & 1) + 4 * fq), __ATOMIC_RELAXED, __HIP_MEMORY_SCOPE_WORKGROUP); }
}
template <int MODE> __device__ __forceinline__ void p3_sweep(Frame& F, int b, const bf16x8 (&Bq)[4][2], const float (&wq)[4], unsigned pref, unsigned thr, unsigned idxs, bool part, int dtype = 0) {
    const char* KIBc = (const char*)wsp<bf16_t>(F, WS_KIB);
    LAS unsigned* hist = (LAS unsigned*)(F.lds + P3_HIST); LAS unsigned* lmask = (LAS unsigned*)(F.lds + P3_LMASK); LAS unsigned* ccnt = (LAS unsigned*)(F.lds + P3_STATE) + 80;
    const int lane = F.lane, q = lane & 15, fq = lane >> 4;
    const unsigned goff = (unsigned)(q * 128 + fq * 16);
    unsigned dbits = 0u;
#pragma unroll
    for (int i = 0; i < 4; ++i) dbits |= (4 * fq + i <= q) ? (1u << i) : 0u;
    const int nj = (b >= F.wave) ? ((b - F.wave) >> 3) + 1 : 0;
#define P3_LD(j, a0, a1) do { int _kt = F.wave + 8 * (j); _kt = _kt < b ? _kt : b; const char* _src = KIBc + (size_t)_kt * 2048 + goff; a0 = *(const bf16x8*)(_src); a1 = *(const bf16x8*)(_src + 64); } while (0)
    bf16x8 C00, C01, C10, C11;
    if (nj > 0) { P3_LD(0, C00, C01); P3_LD(1, C10, C11); }
    for (int j = 0; j < nj; j += 2) {
        bf16x8 N00, N01, N10, N11;
        P3_LD(j + 2, N00, N01); P3_LD(j + 3, N10, N11);
        float sa[4], sb[4];
        p3_scores(C00, C01, Bq, wq, sa); p3_scores(C10, C11, Bq, wq, sb);
        const int kt0 = F.wave + 8 * j, kt1 = kt0 + 8;
        if (kt1 < b) {
            p3_update<MODE, true>(hist, lmask, ccnt, sa, 0xFu, kt0, q, fq, pref, thr, idxs, part);
            p3_update<MODE, true>(hist, lmask, ccnt, sb, 0xFu, kt1, q, fq, pref, thr, idxs, part);
        } else {
            p3_update<MODE, false>(hist, lmask, ccnt, sa, kt0 < b ? 0xFu : dbits, kt0, q, fq, pref, thr, idxs, part);
            if (kt1 == b) p3_update<MODE, false>(hist, lmask, ccnt, sb, dbits, kt1, q, fq, pref, thr, idxs, part);
        }
        C00 = N00; C01 = N01; C10 = N10; C11 = N11;
    }
#undef P3_LD
}
__device__ __forceinline__ void p3_scan(Frame& F, bool fromtop) {
    LAS unsigned* hist = (LAS unsigned*)(F.lds + P3_HIST); LAS unsigned* st = (LAS unsigned*)(F.lds + P3_STATE);
    __syncthreads();
    const int lane = F.lane;
#pragma unroll 1
    for (int rr = 0; rr < 2; ++rr) {
        const int row = 2 * F.wave + rr;
        if (st[row * 4 + 3] == 0u) continue;
        const unsigned rank = st[row * 4 + 1];
        unsigned wv[16]; unsigned sj = 0;
#pragma unroll
        for (int i = 0; i < 16; ++i) { wv[i] = hist[row * HS + 16 * lane + i]; sj += (wv[i] & 0xffffu) + (wv[i] >> 16); }
        unsigned P = sj;
#pragma unroll
        for (int o = 1; o < 64; o <<= 1) { const unsigned v = __shfl_up(P, o); if (lane >= o) P += v; }
        const unsigned T = __shfl(P, 63);
        unsigned cum = fromtop ? (T - P) : (P - sj);
        const bool cross = (cum < rank) && (rank <= cum + sj);
        unsigned bin = 0, cb = 0; bool found = false;
#pragma unroll
        for (int ii = 0; ii < 32; ++ii) { const int bl = fromtop ? 31 - ii : ii; const unsigned w = wv[bl >> 1]; const unsigned c = (bl & 1) ? (w >> 16) : (w & 0xffffu);
            const bool hit = !found && (cum + c >= rank);
            if (hit) { bin = (unsigned)(32 * lane + bl); cb = c; found = true; }
            if (!found) cum += c; }
        if (cross) { st[row * 4 + 0] = bin; st[row * 4 + 1] = rank - cum; st[row * 4 + 2] = cb; }
    }
    __syncthreads();
}
__device__ __forceinline__ unsigned wave_count(bool p) { return (unsigned)__builtin_popcountll(__ballot(p)); }
__device__ __forceinline__ void p3_select_row(Frame& F, int row, int shift) {
    LAS unsigned* cand = (LAS unsigned*)(F.lds + P3_HIST) + row * HS; LAS unsigned* lmask = (LAS unsigned*)(F.lds + P3_LMASK) + row * 256; LAS unsigned* st = (LAS unsigned*)(F.lds + P3_STATE);
    const unsigned bin0 = st[row * 4 + 0], rank = st[row * 4 + 1], nc = st[row * 4 + 2];
    const int lane = F.lane;
    unsigned ck[8], ci[8];
#pragma unroll
    for (int i = 0; i < 8; ++i) { const unsigned sl = (unsigned)(lane + 64 * i); const bool ok = sl < nc; ck[i] = ok ? cand[2 * sl] : 0u; ci[i] = ok ? cand[2 * sl + 1] : 0x7fffffffu; }
    unsigned P = 0u; (void)bin0; (void)shift;
#pragma unroll 1
    for (int bit = 31; bit >= 0; --bit) { const unsigned trial = P | (1u << bit); unsigned c = 0;
#pragma unroll
        for (int i = 0; i < 8; ++i) c += wave_count(ck[i] >= trial);
        if (c >= rank) P = trial; }
    const unsigned thr = P; unsigned cg = 0, ce = 0;
#pragma unroll
    for (int i = 0; i < 8; ++i) { cg += wave_count(ck[i] > thr); ce += wave_count(ck[i] == thr); }
    const unsigned quota = rank - cg; unsigned idxs = 0x7fffffffu;
    if (ce > quota) {
        unsigned X = 0;
#pragma unroll 1
        for (int bit = 12; bit >= 0; --bit) { const unsigned trial = X | (1u << bit); unsigned c = 0;
#pragma unroll
            for (int i = 0; i < 8; ++i) c += wave_count(ck[i] == thr && ci[i] < trial);
            if (c < quota) X = trial; }
        idxs = X;
    }
#pragma unroll
    for (int i = 0; i < 8; ++i) { const bool sel = (ck[i] > thr) || (ck[i] == thr && ci[i] <= idxs);
        if (sel && ci[i] != 0x7fffffffu) __hip_atomic_fetch_or(&lmask[ci[i] >> 5], 1u << (ci[i] & 31u), __ATOMIC_RELAXED, __HIP_MEMORY_SCOPE_WORKGROUP); }
}
__device__ __forceinline__ void p3_select_zero(Frame& F, int row) {
    LAS unsigned* zm = (LAS unsigned*)(F.lds + P3_HIST) + row * HS + 768; LAS unsigned* lmask = (LAS unsigned*)(F.lds + P3_LMASK) + row * 256; LAS unsigned* st = (LAS unsigned*)(F.lds + P3_STATE);
    const unsigned quota = st[row * 4 + 1]; const int lane = F.lane;
    unsigned w[4]; unsigned pc = 0;
#pragma unroll
    for (int i = 0; i < 4; ++i) { w[i] = zm[4 * lane + i]; pc += (unsigned)__builtin_popcount(w[i]); }
    unsigned P = pc;
#pragma unroll
    for (int o = 1; o < 64; o <<= 1) { const unsigned v = __shfl_up(P, o); if (lane >= o) P += v; }
    unsigned cum = P - pc;
#pragma unroll
    for (int i = 0; i < 4; ++i) { unsigned ww = w[i]; const unsigned c = (unsigned)__builtin_popcount(ww);
        if (cum >= quota) ww = 0u;
        else if (cum + c > quota) { const unsigned keep = quota - cum; while ((unsigned)__builtin_popcount(ww) > keep) ww &= ~(0x80000000u >> __builtin_clz(ww)); }
        cum += c;
        if (ww) __hip_atomic_fetch_or(&lmask[4 * lane + i], ww, __ATOMIC_RELAXED, __HIP_MEMORY_SCOPE_WORKGROUP); }
}
__device__ __forceinline__ void p3_zero_hist(Frame& F) {
    LAS unsigned* hist = (LAS unsigned*)(F.lds + P3_HIST);
    for (int i = F.tid; i < 16 * HS; i += NTHR) hist[i] = 0u;
}
#define P3T0() unsigned long long _pt = (P3_PROF && F.tid == 0) ? __builtin_amdgcn_s_memrealtime() : 0ull
#define P3T1(k) do { if (P3_PROF == (k) && F.tid == 0) { volatile LAS unsigned* _m = F.MISC + 16; const unsigned long long _d = __builtin_amdgcn_s_memrealtime() - _pt; _m[0] = _m[0] + (unsigned)_d; } } while (0)
__device__ __forceinline__ void p3_block(Frame& F, int b) {
    const bf16_t* QIB = wsp<bf16_t>(F, WS_QIB); const float* WIF = wsp<float>(F, WS_WIF); unsigned* MASK = wsp<unsigned>(F, WS_MASK);
    LAS unsigned* st = (LAS unsigned*)(F.lds + P3_STATE); LAS unsigned* lmask = (LAS unsigned*)(F.lds + P3_LMASK);
    const int lane = F.lane, q = lane & 15, fq = lane >> 4, t0 = 16 * b;
    bf16x8 Bq[4][2]; float wq[4];
#pragma unroll
    for (int h = 0; h < 4; ++h) { Bq[h][0] = *(const bf16x8*)(QIB + (size_t)(t0 + q) * 256 + h * 64 + 8 * fq); Bq[h][1] = *(const bf16x8*)(QIB + (size_t)(t0 + q) * 256 + h * 64 + 32 + 8 * fq); wq[h] = WIF[(t0 + q) * 4 + h]; }
    __syncthreads();
    for (int i = F.tid; i < 16 * 256; i += NTHR) lmask[i] = 0u;
    if (b >= 16) {
        const int dtype = 0;
        p3_zero_hist(F);
        if (F.tid < 16) { st[F.tid * 4 + 0] = 0u; st[F.tid * 4 + 1] = 256u; st[F.tid * 4 + 2] = 0u; st[F.tid * 4 + 3] = 1u; st[80 + F.tid] = 0u; }
        if (F.tid == 0) st[64] = 0u;
        if (fq == 0) st[96 + q] = (unsigned)dtype;
        __syncthreads();
        { P3T0(); p3_sweep<9>(F, b, Bq, wq, 0u, 0u, 0u, true, dtype); P3T1(1); P3T1(4); } { P3T0(); p3_scan(F, true); P3T1(2); }
        if (F.tid < 16) { const unsigned bn = st[F.tid * 4 + 0], cn = st[F.tid * 4 + 2]; const unsigned dt = 0u; (void)dt;
            const unsigned cls = (bn == 1024u) ? 1u : (cn <= (unsigned)P3_CAP ? 0u : 2u);
            st[112 + F.tid] = cls; if (cls == 2u) st[64] = 1u;
            if (P3_PROF >= 11 && cls == 2u) { const int cause = (dt == 1u) ? (bn == 0u ? 11 : 12) : (dt == 2u ? 13 : 14); if (cause == P3_PROF && b >= 128) atomicAdd(F.ctl + CW_QUEUE + 8, 1u); } }
        __syncthreads();
        const unsigned bin0 = st[q * 4 + 0];
        if (st[64] == 0u) {
            for (int i = F.tid; i < 16 * 256; i += NTHR) ((LAS unsigned*)(F.lds + P3_HIST))[(i >> 8) * HS + 768 + (i & 255)] = 0u;
            __syncthreads();
            { P3T0(); p3_sweep<10>(F, b, Bq, wq, bin0, 0u, 0u, st[112 + q] == 0u, dtype); P3T1(1); P3T1(5); }
            __syncthreads();
            { P3T0();
#pragma unroll 1
              for (int rr = 0; rr < 2; ++rr) { const int row = 2 * F.wave + rr; if (st[112 + row] == 0u) p3_select_row(F, row, st[96 + row] ? 20 : 21); else p3_select_zero(F, row); }
              __syncthreads(); P3T1(3); }
        } else {
            if (P3_PROF == 6 && F.tid == 0) atomicAdd(F.ctl + CW_QUEUE + 8, 1u);
            __syncthreads(); p3_zero_hist(F);
            if (F.tid < 16) { st[F.tid * 4 + 0] = 0u; st[F.tid * 4 + 1] = 256u; st[F.tid * 4 + 2] = 0u; st[F.tid * 4 + 3] = 1u; }
            __syncthreads();
            { P3T0(); p3_sweep<0>(F, b, Bq, wq, 0u, 0u, 0u, true); P3T1(1); } { P3T0(); p3_scan(F, true); P3T1(2); }
            unsigned pref = st[q * 4 + 0];
            __syncthreads(); p3_zero_hist(F); __syncthreads();
            { P3T0(); p3_sweep<1>(F, b, Bq, wq, pref, 0u, 0u, true); P3T1(1); } { P3T0(); p3_scan(F, true); P3T1(2); }
            pref = (pref << 11) | st[q * 4 + 0];
            __syncthreads(); p3_zero_hist(F); __syncthreads();
            { P3T0(); p3_sweep<2>(F, b, Bq, wq, pref, 0u, 0u, true); P3T1(1); } { P3T0(); p3_scan(F, true); P3T1(2); }
            const unsigned thr = (pref << 10) | st[q * 4 + 0];
            const unsigned quota = st[q * 4 + 1], cnteq = st[q * 4 + 2];
            const bool tie = cnteq > quota; unsigned idxs = 0x7fffffffu;
            __syncthreads();
            if (F.tid == 0) st[64] = 0u;
            __syncthreads();
            if (tie && fq == 0) st[64] = 1u;
            if (F.tid < 16) st[F.tid * 4 + 3] = (st[F.tid * 4 + 2] > st[F.tid * 4 + 1]) ? 1u : 0u;
            __syncthreads();
            if (st[64]) {
                p3_zero_hist(F); __syncthreads();
                { P3T0(); p3_sweep<3>(F, b, Bq, wq, 0u, thr, 0u, tie); P3T1(1); } { P3T0(); p3_scan(F, false); P3T1(2); }
                const unsigned ip = st[q * 4 + 0];
                __syncthreads(); p3_zero_hist(F); __syncthreads();
                { P3T0(); p3_sweep<4>(F, b, Bq, wq, ip, thr, 0u, tie); P3T1(1); } { P3T0(); p3_scan(F, false); P3T1(2); }
                if (tie) idxs = (ip << 2) | st[q * 4 + 0];
            }
            __syncthreads();
            { P3T0(); p3_sweep<5>(F, b, Bq, wq, 0u, thr, idxs, true); P3T1(1); }
        }
    } else {
        __syncthreads();
        { P3T0(); p3_sweep<5>(F, b, Bq, wq, 0u, 0u, 0x7fffffffu, true); P3T1(1); }
    }
    __syncthreads();
    { const int qb = t0 >> 8, lr0 = t0 & 255, nkt = 4 * (qb + 1), row = (F.tid >> 1) & 15, wl = F.tid & 1;
      for (int kt = F.tid >> 5; kt < nkt; kt += 16) MASK[((size_t)(qb * 128 + kt) * 256 + lr0 + row) * 2 + wl] = lmask[row * 256 + 2 * kt + wl]; }
}
__device__ __forceinline__ void p3_indexer(Frame& F) {
    const unsigned long long t0 = (P3_PROF >= 7 && F.tid == 0) ? __builtin_amdgcn_s_memrealtime() : 0ull;
    LAS int* qs = (LAS int*)(F.lds + LDSCTL_OFF + 256);
    for (;;) {
        __syncthreads();
        if (F.tid == 0) qs[0] = (int)atomicAdd(F.ctl + CW_QUEUE + 1, 1u);
        __syncthreads();
        const int idx = qs[0];
        if (idx >= 512) break;
        p3_block(F, 511 - idx);
    }
    __syncthreads();
    if (P3_PROF == 7 && F.tid == 0) atomicMax(F.ctl + CW_QUEUE + 8, (unsigned)(__builtin_amdgcn_s_memrealtime() - t0));
    if (P3_PROF == 8 && F.tid == 0) atomicMin(F.ctl + CW_QUEUE + 9, (unsigned)(__builtin_amdgcn_s_memrealtime() - t0));
}

constexpr int N_ATT_UNITS = 608;
constexpr size_t SLOT_FLOATS = 256 * 128 + 256;
__device__ __forceinline__ int cum_chunks(int qb) { const int n1 = qb, a = n1 >> 3, bb = n1 & 7; return 4 * a * (a + 1) + bb * (a + 1); }
constexpr int AT_K = 0, AT_V = 16384, AT_M = 32768, AT_STAGE = 34816, AT_EPI = 3 * AT_STAGE;
template <bool MASKED>
__device__ __forceinline__ void attn_unit(LAS unsigned char* lds, const bf16_t* Qh, int ldq, const bf16_t* Kh, int ldk, const bf16_t* Vth, int ldvt, const unsigned* maskt  ,
                                          int q0, int key0, int ntl, bool final, float* slot, bf16_t* outb  , int tid_in, int wave, int lane_in) {
    int tid = tid_in, lane = lane_in; asm volatile("" : "+v"(tid), "+v"(lane));
    const int q = lane & 31, hh = lane >> 5, qrow = q0 + 32 * wave + q;
    bf16x8 qf[8];
#pragma unroll
    for (int d0 = 0; d0 < 8; ++d0) qf[d0] = *(const bf16x8*)(Qh + (size_t)qrow * ldq + 16 * d0 + 8 * hh);
    const char* kbase = (const char*)(Kh + (size_t)key0 * ldk); const char* vbase = (const char*)(Vth + key0); const char* mbase = (const char*)(maskt + (size_t)(key0 >> 6) * 512);
    const unsigned ldsw16 = (unsigned)wave * 1024u, ldsw4 = (unsigned)wave * 256u;
#define AT_ISSUE(t, st) do { int _tid = tid; asm volatile("" : "+v"(_tid)); LAS unsigned char* _b = lds + (st) * AT_STAGE; const char* _kb = kbase + (size_t)(t) * 64 * ldk * 2; const char* _vb = vbase + (size_t)(t) * 128; \
        _Pragma("unroll") for (int _j = 0; _j < 2; ++_j) { const int _p = _tid + 512 * _j; const int _kr = _p >> 4, _kc = (_p & 15) ^ (_kr & 15); const int _vr = _p >> 3, _vc = (_p & 7) ^ ((_vr >> 1) & 7); \
            __builtin_amdgcn_global_load_lds((const unsigned*)(_kb + (unsigned)(_kr * ldk * 2 + _kc * 16)), (LAS unsigned*)(_b + AT_K + ldsw16 + _j * 8192), 16, 0, 0); \
            __builtin_amdgcn_global_load_lds((const unsigned*)(_vb + (unsigned)(_vr * ldvt * 2 + _vc * 16)), (LAS unsigned*)(_b + AT_V + ldsw16 + _j * 8192), 16, 0, 0); } \
        if (MASKED) __builtin_amdgcn_global_load_lds((const unsigned*)(mbase + (size_t)(t) * 2048 + (unsigned)_tid * 4u), (LAS unsigned*)(_b + AT_M + ldsw4), 4, 0, 0); } while (0)
    const int prow = (q & 0x13) | ((q & 4) << 1) | ((q & 8) >> 1);
    const int ky = hh ^ (prow & 15), vw = hh ^ ((q >> 1) & 7);
    int kaddr[8];
#pragma unroll
    for (int d0 = 0; d0 < 8; ++d0) kaddr[d0] = AT_K + prow * 256 + (((2 * d0) ^ ky) << 4);
    const int vrow = AT_V + q * 128;
#define vaddr_(s) (vrow + ((((2 * (s)) ^ vw)) << 4))
    const int maddr = AT_M + (32 * wave + q) * 8;
    f32x16 o[4];
#pragma unroll
    for (int d = 0; d < 4; ++d)
#pragma unroll
        for (int r = 0; r < 16; ++r) o[d][r] = 0.f;
    float l = 0.f;
#define AT_QK(S, SB, BT) do { _Pragma("unroll") for (int _r = 0; _r < 16; ++_r) S[_r] = 0.f; \
        _Pragma("unroll") for (int _d = 0; _d < 8; ++_d) { const bf16x8 _kf = *(const LAS bf16x8*)((SB) + kaddr[_d] + (BT) * 8192); S = __builtin_amdgcn_mfma_f32_32x32x16_bf16(_kf, qf[_d], S, 0, 0, 0); } } while (0)
#define AT_SM(S, MW) do { _Pragma("unroll") for (int _s = 0; _s < 2; ++_s) { float _p[8]; \
        _Pragma("unroll") for (int _j = 0; _j < 8; ++_j) { const int _r = 8 * _s + _j; float _e = __builtin_amdgcn_exp2f(S[_r]); if (MASKED) _e = __builtin_bit_cast(float, __builtin_bit_cast(unsigned, _e) & (unsigned)__builtin_amdgcn_sbfe((int)(MW), (unsigned)((_r & 7) + 16 * (_r >> 3)), 1u)); _p[_j] = _e; l += _e; } \
        u32x4 _w; _w.x = pk2(_p[0], _p[1]); _w.y = pk2(_p[2], _p[3]); _w.z = pk2(_p[4], _p[5]); _w.w = pk2(_p[6], _p[7]); pf[_s] = __builtin_bit_cast(bf16x8, _w); } } while (0)
#define AT_PV(SB, BT) do { _Pragma("unroll") for (int _d = 0; _d < 4; ++_d) _Pragma("unroll") for (int _s = 0; _s < 2; ++_s) { \
        const bf16x8 _vf = *(const LAS bf16x8*)((SB) + vaddr_(2 * (BT) + _s) + _d * 4096); o[_d] = __builtin_amdgcn_mfma_f32_32x32x16_bf16(_vf, pf[_s], o[_d], 0, 0, 0); } } while (0)
#define AT_MW(SB, BT) (MASKED ? (*(const LAS unsigned*)((SB) + maddr + (BT) * 4) >> (8 * hh)) : 0xffffffffu)
    AT_ISSUE(0, 0);
    if (ntl > 1) AT_ISSUE(1, 1);
    if (ntl > 1) { if (MASKED) asm volatile("s_waitcnt vmcnt(5)" ::: "memory"); else asm volatile("s_waitcnt vmcnt(4)" ::: "memory"); }
    else asm volatile("s_waitcnt vmcnt(0)" ::: "memory");
    __builtin_amdgcn_s_barrier(); asm volatile("" ::: "memory");
    f32x16 sc, sn; bf16x8 pf[2];
    AT_QK(sc, lds, 0);
    int st = 0;
    for (int t = 0; t < ntl; ++t) {
        LAS unsigned char* sb = lds + st * AT_STAGE;
        const int stn = (st == 2) ? 0 : st + 1;
        LAS unsigned char* sbn = lds + stn * AT_STAGE;
        { const unsigned mw = AT_MW(sb, 0);
          AT_QK(sn, sb, 1); AT_SM(sc, mw); }
        __builtin_amdgcn_sched_barrier(0);
        AT_PV(sb, 0);
        __builtin_amdgcn_sched_barrier(0);
        if (t + 1 < ntl) asm volatile("s_waitcnt vmcnt(0)" ::: "memory");
        __builtin_amdgcn_s_barrier(); asm volatile("" ::: "memory");
        if (t + 2 < ntl) { const int st2 = (st >= 1) ? st - 1 : 2; AT_ISSUE(t + 2, st2); }
        __builtin_amdgcn_sched_barrier(0);
        { const unsigned mw = AT_MW(sb, 1);
          if (t + 1 < ntl) { AT_QK(sc, sbn, 0); AT_SM(sn, mw); } else { AT_SM(sn, mw); } }
        __builtin_amdgcn_sched_barrier(0);
        AT_PV(sb, 1);
        __builtin_amdgcn_sched_barrier(0);
        st = stn;
    }
#undef vaddr_
#undef AT_QK
#undef AT_SM
#undef AT_PV
#undef AT_MW
#undef AT_ISSUE
    l += __shfl_xor(l, 32);
    int lane_e = lane; asm volatile("" : "+v"(lane_e));
    const int qe = lane_e & 31, he = lane_e >> 5;
    LAS float* stg = (LAS float*)(lds + AT_EPI + wave * 4608);
    const int trow = q0 + 32 * wave;
    const float inv = final ? 1.0f / l : 1.0f;
#pragma unroll
    for (int d = 0; d < 4; ++d) {
#pragma unroll
        for (int r = 0; r < 16; ++r) stg[qe * 36 + crow(r, he)] = o[d][r] * inv;
        LDS_WAIT(); asm volatile("" ::: "memory");
#pragma unroll
        for (int i = 0; i < 4; ++i) { const int row = 8 * i + (lane_e >> 3), c4 = lane_e & 7; const f32x4 v = *(const LAS f32x4*)(stg + row * 36 + 4 * c4);
            if (final) { u32x2 w; w.x = pk2(v[0], v[1]); w.y = pk2(v[2], v[3]); *(u32x2*)(outb + (size_t)(trow + row) * DM + 32 * d + 4 * c4) = w; }
            else *(f32x4*)(slot + (size_t)(32 * wave + row) * 128 + 32 * d + 4 * c4) = v; }
        LDS_WAIT(); asm volatile("" ::: "memory");
    }
    if (!final && he == 0) slot[256 * 128 + 32 * wave + qe] = l;
}
__device__ __forceinline__ void att_build_table(Frame& F) {
    LAS int* cnt = (LAS int*)F.lds; int* TB = wsp<int>(F, WS_ATTBL);
    if (F.tid < 40) cnt[F.tid] = 0;
    __syncthreads();
    int e0[2], e1[2], nl[2];
#pragma unroll
    for (int r = 0; r < 2; ++r) { const int id = F.tid + 512 * r; nl[r] = 0; e0[r] = 0; e1[r] = 0;
        if (id < 768) { const int h = id >> 7, n = ((id >> 2) & 31) + 1, ch = id & 3, k = (n + 7) >> 3;
            if (ch < k) { const int nt = 4 * n, base = nt / k, rem = nt % k; const int len = base + (ch < rem ? 1 : 0), start = ch * base + (ch < rem ? ch : rem);
                const int qb = n - 1; nl[r] = len; e0[r] = 0 | (h << 1) | (qb << 4) | ((k == 1 ? 1 : 0) << 9) | (len << 10); e1[r] = start | ((h * 80 + cum_chunks(qb) + ch) << 8); } }
        else if (id < 896) { const int c = id - 768; nl[r] = 4; e0[r] = 1 | ((c >> 5) << 1) | ((c & 31) << 4) | (1 << 9) | (4 << 10); e1[r] = 0; }
        if (nl[r]) __hip_atomic_fetch_add(&cnt[nl[r]], 1, __ATOMIC_RELAXED, __HIP_MEMORY_SCOPE_WORKGROUP); }
    __syncthreads();
    if (F.tid == 0) { int o = 0; for (int l = 32; l >= 1; --l) { const int c = cnt[l]; cnt[l] = o; o += c; } }
    __syncthreads();
#pragma unroll
    for (int r = 0; r < 2; ++r) if (nl[r]) { const int pos = __hip_atomic_fetch_add(&cnt[nl[r]], 1, __ATOMIC_RELAXED, __HIP_MEMORY_SCOPE_WORKGROUP); TB[2 * pos] = e0[r]; TB[2 * pos + 1] = e1[r]; }
    __syncthreads();
}
__device__ __forceinline__ void p4_attention(Frame& F) {
    const bf16_t* Q = wsp<bf16_t>(F, WS_Q); const bf16_t* K = wsp<bf16_t>(F, WS_K); const bf16_t* VT = wsp<bf16_t>(F, WS_VT); const bf16_t* XQ = wsp<bf16_t>(F, WS_XQ);
    const bf16_t* KMB = wsp<bf16_t>(F, WS_KMB); const bf16_t* VMT = wsp<bf16_t>(F, WS_VMT); const unsigned* MASK = wsp<unsigned>(F, WS_MASK); bf16_t* AM = wsp<bf16_t>(F, WS_AMRG);
    float* OPS = F.out;
    LAS int* qslot = (LAS int*)(F.lds + LDSCTL_OFF + 256);
    for (;;) {
        __syncthreads();
        if (F.tid == 0) qslot[0] = (int)atomicAdd(F.ctl + CW_QUEUE, 1u);
        __syncthreads();
        const int idx = qslot[0];
        if (idx >= N_ATT_UNITS) break;
        const int* TB = wsp<int>(F, WS_ATTBL); const int e0 = TB[2 * idx], e1 = TB[2 * idx + 1];
        const int type = e0 & 1, h = (e0 >> 1) & 7, qb = (e0 >> 4) & 31, fin = (e0 >> 9) & 1, ntl = (e0 >> 10) & 63, kt0 = e1 & 255, slot = e1 >> 8;
        if (type == 0) attn_unit<true>(F.lds, Q + h * 128, 768, K + h * 128, 768, VT + (size_t)h * 128 * SEQ, SEQ, MASK + (size_t)qb * 128 * 512, qb * 256, kt0 * 64, ntl, fin != 0,
                                       OPS + (size_t)slot * SLOT_FLOATS, AM + 768 + h * 128, F.tid, F.wave, F.lane);
        else attn_unit<false>(F.lds, XQ + h * 128, 512, KMB + h * 128, 512, VMT + (size_t)h * 128 * 256, 256, nullptr, qb * 256, 0, 4, true, nullptr, AM + 1536 + h * 128, F.tid, F.wave, F.lane);
    }
}
__device__ __forceinline__ void p5_finalize(Frame& F) {
    const float* OPS = F.out; bf16_t* AM = wsp<bf16_t>(F, WS_AMRG);
    const int gw = F.vcu * NWAVES + F.wave, NGW = F.G * NWAVES, lane = F.lane, half = lane >> 5, c4 = lane & 31;
    for (int it = gw; it < 6 * 24 * 128; it += NGW) {
        const int rp = it & 127, hq = it >> 7, h = hq / 24, qb = 8 + hq % 24, row = 2 * rp + half;
        const int nch = (qb + 8) >> 3;
        const float* base = OPS + (size_t)(h * 80 + cum_chunks(qb)) * SLOT_FLOATS;
        f32x4 v[4]; float lv[4];
#pragma unroll
        for (int c = 0; c < 4; ++c) { const bool ok = c < nch; const float* b = base + (size_t)(ok ? c : 0) * SLOT_FLOATS; v[c] = *(const f32x4*)(b + (size_t)row * 128 + 4 * c4); lv[c] = b[256 * 128 + row];
            if (!ok) { v[c] = (f32x4){0.f, 0.f, 0.f, 0.f}; lv[c] = 0.f; } }
        const f32x4 sv = (v[0] + v[1]) + (v[2] + v[3]); const float inv = 1.0f / ((lv[0] + lv[1]) + (lv[2] + lv[3]));
        u32x2 w; w.x = pk2(sv[0] * inv, sv[1] * inv); w.y = pk2(sv[2] * inv, sv[3] * inv);
        *(u32x2*)(AM + (size_t)(qb * 256 + row) * DM + 768 + h * 128 + 4 * c4) = w;
    }
}

struct SchedTile {
    int c, G, nM, nN; const char* A; const char* B; size_t tA, tB;
    __device__ __forceinline__ bool next(int i, pg8::Unit& u) const {
        const int L = i * G + c; if (L >= nM * nN) return false; int pm, pn; pg8::tile_order(L, nM, nN, pm, pn);
        u.A = A + (size_t)pm * tA; u.B = B + (size_t)pn * tB; u.Bhi = u.B; u.kind = 0; u.row0 = pm * 256; u.col0 = pn * 256; u.aux = 0; u.nt = 32; u.lowonly = 0; return true; }
};
struct EpiMrg {
    static constexpr bool HOOK = true; static constexpr int HOOK_T1 = 12, HOOK_T2 = 24;
    const bf16_t* EG; bf16_t* MRG;
    __device__ __forceinline__ void hook(f32x4 (&acc)[2][2][4][2], const pg8::Unit& u, int t, int wr, int wc, int fr, int fq) const {
        const int seg = (t == HOOK_T1) ? 0 : 1;
        const unsigned off0 = ((unsigned)(u.row0 + wr * 64 + fr) * 6144u + (unsigned)(seg * 2048 + u.col0 + wc * 32 + 8 * fq)) * 2u;
        const char* eg = (const char*)EG;
#pragma unroll
        for (int ai = 0; ai < 2; ++ai)
#pragma unroll
            for (int m = 0; m < 4; ++m) {
#pragma unroll
                for (int bj = 0; bj < 2; ++bj) { const unsigned off = off0 + (unsigned)((ai * 128 + m * 16) * 6144 + bj * 128) * 2u;
                    const u32x4 ea = *(const u32x4*)(eg + off), eb = *(const u32x4*)(eg + off + 4096u);
                    f32x4 r0, r1;
                    r0[0] = bflo(eb.x) * __builtin_amdgcn_rcpf(bflo(ea.x)); r0[1] = bfhi(eb.x) * __builtin_amdgcn_rcpf(bfhi(ea.x)); r0[2] = bflo(eb.y) * __builtin_amdgcn_rcpf(bflo(ea.y)); r0[3] = bfhi(eb.y) * __builtin_amdgcn_rcpf(bfhi(ea.y));
                    r1[0] = bflo(eb.z) * __builtin_amdgcn_rcpf(bflo(ea.z)); r1[1] = bfhi(eb.z) * __builtin_amdgcn_rcpf(bfhi(ea.z)); r1[2] = bflo(eb.w) * __builtin_amdgcn_rcpf(bflo(ea.w)); r1[3] = bfhi(eb.w) * __builtin_amdgcn_rcpf(bfhi(ea.w));
                    acc[ai][bj][m][0] *= r0; acc[ai][bj][m][1] *= r1; }
                asm volatile("" ::: "memory"); }
    }
    __device__ __forceinline__ void operator()(const f32x4 (&acc)[2][2][4][2], const pg8::Unit& u, int wr, int wc, int fr, int fq) const {
        const int rbase = u.row0 + wr * 64 + fr, cbase = u.col0 + wc * 32 + 8 * fq;
#pragma unroll
        for (int ai = 0; ai < 2; ++ai)
#pragma unroll
            for (int m = 0; m < 4; ++m) { const int row = rbase + ai * 128 + m * 16;
#pragma unroll
                for (int bj = 0; bj < 2; ++bj) { const u32x4 e = *(const u32x4*)(EG + (size_t)row * 6144 + 4096 + cbase + bj * 128);
                    const f32x4 a0 = acc[ai][bj][m][0], a1 = acc[ai][bj][m][1];
                    u32x4 w;
                    w.x = pk2(a0[0] * __builtin_amdgcn_rcpf(bflo(e.x)), a0[1] * __builtin_amdgcn_rcpf(bfhi(e.x))); w.y = pk2(a0[2] * __builtin_amdgcn_rcpf(bflo(e.y)), a0[3] * __builtin_amdgcn_rcpf(bfhi(e.y)));
                    w.z = pk2(a1[0] * __builtin_amdgcn_rcpf(bflo(e.z)), a1[1] * __builtin_amdgcn_rcpf(bfhi(e.z))); w.w = pk2(a1[2] * __builtin_amdgcn_rcpf(bflo(e.w)), a1[3] * __builtin_amdgcn_rcpf(bfhi(e.w)));
                    *(u32x4*)(MRG + (size_t)row * DM + cbase + bj * 128) = w; } }
    }
};
struct EpiRes {
    static constexpr bool HOOK = false; static constexpr int HOOK_T1 = -1, HOOK_T2 = -1;
    const float* x; float* out; bf16_t* X1B;
    __device__ __forceinline__ void hook(f32x4 (&)[2][2][4][2], const pg8::Unit&, int, int, int, int, int) const {}
    __device__ __forceinline__ void operator()(const f32x4 (&acc)[2][2][4][2], const pg8::Unit& u, int wr, int wc, int fr, int fq) const {
        const int rbase = u.row0 + wr * 64 + fr, cbase = u.col0 + wc * 32 + 8 * fq;
#pragma unroll
        for (int ai = 0; ai < 2; ++ai)
#pragma unroll
            for (int m = 0; m < 4; ++m) { const int row = rbase + ai * 128 + m * 16;
#pragma unroll
                for (int bj = 0; bj < 2; ++bj) { const size_t off = (size_t)row * DM + cbase + bj * 128;
                    const f32x4 v0 = *(const f32x4*)(x + off) + acc[ai][bj][m][0], v1 = *(const f32x4*)(x + off + 4) + acc[ai][bj][m][1];
                    *(f32x4*)(out + off) = v0; *(f32x4*)(out + off + 4) = v1;
                    u32x4 w; w.x = pk2(v0[0], v0[1]); w.y = pk2(v0[2], v0[3]); w.z = pk2(v1[0], v1[1]); w.w = pk2(v1[2], v1[3]);
                    *(u32x4*)(X1B + off) = w; } }
    }
};

__device__ __forceinline__ void p8_router(Frame& F) {
    const float* X1 = F.out; const float* WR = wsp<float>(F, WS_WR);
    float* RSTD2 = wsp<float>(F, WS_RSTD2); int* TOKCLS = wsp<int>(F, WS_TOKCLS); int* TOKSLOT = wsp<int>(F, WS_TOKSLOT); float* TOKWA = wsp<float>(F, WS_TOKWA); float* TOKWB = wsp<float>(F, WS_TOKWB);
    LAS float* red = (LAS float*)F.lds;
    LAS float* lg = (LAS float*)(F.lds + 8 * 32 * 33 * 4);
    LAS float* ssq = (LAS float*)(F.lds + 9 * 32 * 33 * 4);
    LAS int* lcnt = (LAS int*)(F.lds + 9 * 32 * 33 * 4 + 1024); int* CNT = wsp<int>(F, WS_CNT);
    const int lane = F.lane, i = lane & 31, hh = lane >> 5, w = F.wave;
    for (int u = F.vcu; u < SEQ / 32; u += F.G) {
        const int t0 = 32 * u;
        f32x16 d;
#pragma unroll
        for (int r = 0; r < 16; ++r) d[r] = 0.f;
        float ss = 0.f;
        const float* xp = X1 + (size_t)(t0 + i) * DM + 256 * w + 4 * hh; const float* wp = WR + (size_t)(256 * w + 4 * hh) * 32 + i;
#pragma unroll 1
        for (int m0 = 0; m0 < 32; m0 += 8) {
            f32x4 a[8]; float bw[8][4];
#pragma unroll
            for (int mm = 0; mm < 8; ++mm) { a[mm] = *(const f32x4*)(xp + 8 * (m0 + mm));
#pragma unroll
                for (int e = 0; e < 4; ++e) bw[mm][e] = wp[(8 * (m0 + mm) + e) * 32]; }
#pragma unroll
            for (int mm = 0; mm < 8; ++mm) { ss += (a[mm].x * a[mm].x + a[mm].y * a[mm].y) + (a[mm].z * a[mm].z + a[mm].w * a[mm].w);
                d = __builtin_amdgcn_mfma_f32_32x32x2f32(a[mm].x, bw[mm][0], d, 0, 0, 0); d = __builtin_amdgcn_mfma_f32_32x32x2f32(a[mm].y, bw[mm][1], d, 0, 0, 0);
                d = __builtin_amdgcn_mfma_f32_32x32x2f32(a[mm].z, bw[mm][2], d, 0, 0, 0); d = __builtin_amdgcn_mfma_f32_32x32x2f32(a[mm].w, bw[mm][3], d, 0, 0, 0); }
        }
        ss += __shfl_xor(ss, 32);
        __syncthreads();
#pragma unroll
        for (int r = 0; r < 16; ++r) red[(w * 32 + crow(r, hh)) * 33 + i] = d[r];
        if (hh == 0) ssq[w * 32 + i] = ss;
        if (F.tid < 24) lcnt[F.tid] = 0;
        __syncthreads();
        for (int e = F.tid; e < 1024; e += NTHR) { const int tk = e >> 5, j = e & 31; float s = 0.f;
#pragma unroll
            for (int ww = 0; ww < 8; ++ww) s += red[(ww * 32 + tk) * 33 + j];
            lg[tk * 33 + j] = s; }
        __syncthreads();
        if (F.tid < 32) { const int tk = F.tid; float s2 = 0.f;
#pragma unroll
            for (int ww = 0; ww < 8; ++ww) s2 += ssq[ww * 32 + tk];
            const float rstd = 1.0f / sqrtf(s2 * (1.0f / DM) + NORM_EPS);
            float g[4]; int gt = 0;
#pragma unroll
            for (int j = 0; j < 4; ++j) g[j] = lg[tk * 33 + j] * rstd;
#pragma unroll
            for (int j = 1; j < 4; ++j) if (g[j] > g[gt]) gt = j;
            float den = 0.f;
#pragma unroll
            for (int j = 0; j < 4; ++j) den += expf(g[j] - g[gt]);
            const float pg = 1.0f / den;
            float le[4];
#pragma unroll
            for (int j = 0; j < 4; ++j) le[j] = lg[tk * 33 + 4 + gt * 4 + j] * rstd;
            int e1 = 0;
#pragma unroll
            for (int j = 1; j < 4; ++j) if (le[j] > le[e1]) e1 = j;
            int e2 = (e1 == 0) ? 1 : 0;
#pragma unroll
            for (int j = 0; j < 4; ++j) if (j != e1 && j != e2 && le[j] > le[e2]) e2 = j;
            const float x2 = expf(le[e2] - le[e1]);
            const float w1 = pg / (1.0f + x2), w2 = pg * x2 / (1.0f + x2);
            const int a = e1 < e2 ? e1 : e2, bb = e1 < e2 ? e2 : e1;
            const float wa = e1 < e2 ? w1 : w2, wb = e1 < e2 ? w2 : w1;
            const int pair = (a == 0) ? (bb - 1) : (a == 1 ? bb + 1 : 5);
            const int cls = gt * 6 + pair;
            const int slot = __hip_atomic_fetch_add(&lcnt[cls], 1, __ATOMIC_RELAXED, __HIP_MEMORY_SCOPE_WORKGROUP);
            const int t = t0 + tk;
            RSTD2[t] = rstd; TOKCLS[t] = cls; TOKSLOT[t] = slot; TOKWA[t] = wa; TOKWB[t] = wb;
        }
        __syncthreads();
        if (F.tid < 24) CNT[u * 24 + F.tid] = lcnt[F.tid];
    }
    __syncthreads();
}
__device__ __forceinline__ int moe_tables(Frame& F, LAS int* tb) {
    __syncthreads();
    if (F.tid == 0) { int o = 0;
        for (int c = 0; c < 24; ++c) { const int n = (int)__hip_atomic_load(F.ctl + CW_CLS + c, __ATOMIC_RELAXED, __HIP_MEMORY_SCOPE_AGENT); tb[c] = o; tb[64 + c] = n; const int nt = (n + 255) >> 8;
            for (int j = 0; j < nt; ++j) { tb[128 + (o >> 8) + j] = c; tb[192 + (o >> 8) + j] = (n - 256 * j <= 128) ? 1 : 0; } o += nt << 8; }
        tb[24] = o; const int ntl = o >> 8; int k = 0;
        for (int j = 0; j < ntl; ++j) if (!tb[192 + j]) tb[256 + k++] = j;
        for (int j = 0; j < ntl; ++j) if (tb[192 + j]) tb[256 + k++] = j; }
    __syncthreads();
    return tb[24] >> 8;
}
__device__ __forceinline__ void p8b_gather(Frame& F) {
    LAS int* tb = (LAS int*)(F.lds + LDSCTL_OFF + 512);
    LAS int* cn = (LAS int*)F.lds;
    LAS int* psum = (LAS int*)(F.lds + 32768);
    LAS int* tot = (LAS int*)(F.lds + 32768 + 2048);
    const int* CNT = wsp<int>(F, WS_CNT);
    __syncthreads();
    for (int i = F.tid; i < 256 * 24; i += NTHR) cn[i] = CNT[i];
    __syncthreads();
    const int c = F.tid >> 4, part = F.tid & 15;
    if (F.tid < 384) { int sm = 0;
#pragma unroll
        for (int j = 0; j < 16; ++j) sm += cn[(part * 16 + j) * 24 + c];
        psum[c * 16 + part] = sm; }
    __syncthreads();
    if (F.tid < 24) { int run = 0;
        for (int j = 0; j < 16; ++j) { const int v = psum[F.tid * 16 + j]; psum[F.tid * 16 + j] = run; run += v; }
        tot[F.tid] = run; }
    __syncthreads();
    if (F.tid < 384) { int run = psum[c * 16 + part];
#pragma unroll
        for (int j = 0; j < 16; ++j) { const int idx = (part * 16 + j) * 24 + c; const int v = cn[idx]; cn[idx] = run; run += v; } }
    if (F.tid == 0) { int o = 0;
        for (int cc = 0; cc < 24; ++cc) { const int n = tot[cc]; tb[cc] = o; tb[64 + cc] = n; o += ((n + 255) >> 8) << 8; }
        tb[24] = o; }
    if (blockIdx.x == 0 && F.tid < 24) __hip_atomic_store(F.ctl + CW_CLS + F.tid, (unsigned)tot[F.tid], __ATOMIC_RELAXED, __HIP_MEMORY_SCOPE_AGENT);
    __syncthreads();
    const float* RSTD2 = wsp<float>(F, WS_RSTD2); const int* TOKCLS = wsp<int>(F, WS_TOKCLS); const int* TOKSLOT = wsp<int>(F, WS_TOKSLOT); const float* TOKWA = wsp<float>(F, WS_TOKWA); const float* TOKWB = wsp<float>(F, WS_TOKWB);
    int* ROWTOK = wsp<int>(F, WS_ROWTOK); float* ROWRS = wsp<float>(F, WS_ROWRS); float* ROWWA = wsp<float>(F, WS_ROWWA); float* ROWWB = wsp<float>(F, WS_ROWWB);
    const int gw = F.vcu * NWAVES + F.wave, NGW = F.G * NWAVES, lane = F.lane;
    for (int t = gw * 64 + lane; t < SEQ; t += NGW * 64) {
        const int cl = TOKCLS[t]; const int R = tb[cl] + cn[(t >> 5) * 24 + cl] + TOKSLOT[t];
        ROWTOK[R] = t; ROWRS[R] = RSTD2[t]; ROWWA[R] = TOKWA[t]; ROWWB[R] = TOKWB[t];
    }
    for (int i = F.vcu * NTHR + F.tid; i < 24 * 256; i += F.G * NTHR) { const int cc = i >> 8, j = i & 255; const int n = tb[64 + cc], R = tb[cc] + n + j;
        const int endc = tb[cc] + (((n + 255) >> 8) << 8);
        if (R < endc) { ROWTOK[R] = -1; ROWRS[R] = 0.f; ROWWA[R] = 0.f; ROWWB[R] = 0.f; } }
}
__device__ __forceinline__ void cls_experts(int cls, int& ea, int& eb) { const int g = cls / 6, p = cls % 6; const int a = (p < 3) ? 0 : (p < 5 ? 1 : 2); const int b = (p < 3) ? p + 1 : (p < 5 ? p - 1 : 3); ea = g * 4 + a; eb = g * 4 + b; }
struct EpiGU {
    static constexpr bool HOOK = false; static constexpr int HOOK_T1 = -1, HOOK_T2 = -1;
    unsigned char* ws;
    __device__ __forceinline__ void hook(f32x4 (&)[2][2][4][2], const pg8::Unit&, int, int, int, int, int) const {}
    __device__ __forceinline__ void operator()(const f32x4 (&acc)[2][2][4][2], const pg8::Unit& u, int wr, int wc, int fr, int fq) const {
        const float* rs = (const float*)(ws + WS_ROWRS); const __amdgpu_buffer_rsrc_t rsrc = __builtin_amdgcn_make_buffer_rsrc(ws + WS_ACT, 0, (int)(MAXROWS * 1024 * 2), 0x00020000);
        const int pn = u.col0; const float* cw = (const float*)(ws + (pn < 4 ? WS_ROWWA : WS_ROWWB)); const int cbase = (pn >> 2) * 512 + (pn & 3) * 128 + wc * 32 + 8 * fq;
#pragma unroll
        for (int ai = 0; ai < 2; ++ai)
#pragma unroll
            for (int m = 0; m < 4; ++m) { const int row = u.row0 + ai * 128 + wr * 64 + m * 16 + fr; const float s = rs[row], w = cw[row];
                float a[8];
#pragma unroll
                for (int n = 0; n < 2; ++n)
#pragma unroll
                    for (int e = 0; e < 4; ++e) { const float gv = acc[ai][0][m][n][e] * s, uv = acc[ai][1][m][n][e] * s;
                        a[4 * n + e] = gv * __builtin_amdgcn_rcpf(1.0f + __builtin_amdgcn_exp2f(-gv * LOG2E)) * uv * w; }
                u32x4 o; o.x = pk2(a[0], a[1]); o.y = pk2(a[2], a[3]); o.z = pk2(a[4], a[5]); o.w = pk2(a[6], a[7]);
                __builtin_amdgcn_raw_buffer_store_b128(o, rsrc, (int)(((unsigned)row * 1024u + (unsigned)cbase) * 2u), 0, 16); }
    }
};
struct EpiDN {
    static constexpr bool HOOK = false; static constexpr int HOOK_T1 = -1, HOOK_T2 = -1;
    unsigned char* ws; float* out;
    __device__ __forceinline__ void hook(f32x4 (&)[2][2][4][2], const pg8::Unit&, int, int, int, int, int) const {}
    __device__ __forceinline__ void operator()(const f32x4 (&acc)[2][2][4][2], const pg8::Unit& u, int wr, int wc, int fr, int fq) const {
        const int* rowtok = (const int*)(ws + WS_ROWTOK);
        const int cbase = u.col0 + wc * 32 + 8 * fq;
#pragma unroll
        for (int ai = 0; ai < 2; ++ai)
#pragma unroll
            for (int m = 0; m < 4; ++m) { const int row = u.row0 + ai * 128 + wr * 64 + m * 16 + fr; const int tok = rowtok[row];
                if (tok >= 0) {
#pragma unroll
                    for (int bj = 0; bj < 2; ++bj) { float* p = out + (size_t)tok * DM + cbase + bj * 128;
                        const f32x4 v0 = *(const f32x4*)p + acc[ai][bj][m][0], v1 = *(const f32x4*)(p + 4) + acc[ai][bj][m][1];
                        *(f32x4*)p = v0; *(f32x4*)(p + 4) = v1; } } }
    }
};

struct SchedOne { pg8::Unit u; __device__ __forceinline__ bool next(int i, pg8::Unit& o) const { if (i != 0) return false; o = u; return true; } };
__device__ __forceinline__ void p9_experts(Frame& F) {
    LAS int* tb = (LAS int*)(F.lds + LDSCTL_OFF + 512);
    const int ntiles = moe_tables(F, tb);
    LAS int* qs = (LAS int*)(F.lds + LDSCTL_OFF + 256);
    const int nun = 16 * ntiles;
    unsigned pend = 0u;
    if (F.tid == 0) pend = atomicAdd(F.ctl + CW_QUEUE + 2, 1u);
    for (;;) {
        __syncthreads();
        if (F.tid == 0) { qs[0] = (int)pend; pend = atomicAdd(F.ctl + CW_QUEUE + 2, 1u); }
        __syncthreads();
        const int idx = qs[0];
        if (idx >= nun) break;
        const bool dn = idx >= 8 * ntiles; const int L = dn ? idx - 8 * ntiles : idx; const int mt = tb[256 + (L >> 3)], pn = L & 7; const int cls = tb[128 + mt]; int ea, eb; cls_experts(cls, ea, eb);
        pg8::Unit u; u.kind = 0; u.row0 = mt * 256; u.aux = 0; u.lowonly = tb[192 + mt];
        if (!dn) {
            const int e = pn < 4 ? ea : eb;
            u.A = (const char*)(F.ws + WS_X1B); u.B = (const char*)(F.ws + WS_WGUT) + ((size_t)e * 1024 + (pn & 3) * 256) * DM * 2; u.Bhi = u.B; u.col0 = pn; u.nt = 32;
            SchedOne S{u}; EpiGU E{F.ws};
            pg8::gemm_phase<EpiGU, SchedOne, true, true>(F.lds, pg8::Geom{DM, DM, 32, 1 << 30, wsp<int>(F, WS_ROWTOK)}, S, E);
            asm volatile("s_waitcnt vmcnt(0)" ::: "memory");
            __syncthreads();
            if (F.tid == 0) __hip_atomic_fetch_add(F.ctl + CW_TILE + mt, 1u, __ATOMIC_RELAXED, __HIP_MEMORY_SCOPE_AGENT);
        } else {
            if (F.tid == 0) { unsigned sp = 0;
                while (__hip_atomic_load(F.ctl + CW_TILE + mt, __ATOMIC_RELAXED, __HIP_MEMORY_SCOPE_AGENT) < 8u) { __builtin_amdgcn_s_sleep(8); if (++sp > (1u << 20)) break; }
                __builtin_amdgcn_fence(__ATOMIC_ACQUIRE, "agent");
                asm volatile("s_waitcnt vmcnt(0)" ::: "memory"); }
            __syncthreads();
            u.A = (const char*)(F.ws + WS_ACT) + (size_t)mt * 256 * 1024 * 2; u.B = (const char*)(F.ws + WS_WDT) + ((size_t)ea * DM + pn * 256) * 512 * 2;
            u.Bhi = (const char*)(F.ws + WS_WDT) + ((size_t)eb * DM + pn * 256) * 512 * 2 - (size_t)8 * 128; u.col0 = pn * 256; u.nt = 16;
            SchedOne S{u}; EpiDN E{F.ws, F.out};
            pg8::gemm_phase<EpiDN, SchedOne, true, true>(F.lds, pg8::Geom{1024, 512, 16, 8, nullptr}, S, E);
        }
    }
}
template <int K> __device__ __forceinline__ void run_phase(Frame& F) {
    if constexpr (K == 0) p0_prologue(F);
    else if constexpr (K == 1) {
        SchedP1 S{(int)blockIdx.x, F.G, F.ws};
        EpiP1 E{F.ws, wsp<float>(F, WS_RSTD1), wsp<float>(F, WS_RSTDM), F.b_gate};
        pg8::gemm_phase<EpiP1, SchedP1, true, true>(F.lds, pg8::Geom{DM, DM, 32, 1 << 30, nullptr}, S, E);
    } else if constexpr (K == 2) p2_rowpass(F);
    else if constexpr (K == 3) p3_indexer(F);
    else if constexpr (K == 4) p4_attention(F);
    else if constexpr (K == 5) p5_finalize(F);
    else if constexpr (K == 6) {
        SchedTile S{(int)blockIdx.x, F.G, 32, 8, (const char*)(F.ws + WS_AMRG), (const char*)(F.ws + WS_BTMRG), (size_t)256 * DM * 2, (size_t)256 * DM * 2};
        EpiMrg E{wsp<bf16_t>(F, WS_EG), wsp<bf16_t>(F, WS_MRG)};
        pg8::gemm_phase<EpiMrg, SchedTile, true, true>(F.lds, pg8::Geom{DM, DM, 32, 1 << 30, nullptr}, S, E);
    } else if constexpr (K == 7) {
        SchedTile S{(int)blockIdx.x, F.G, 32, 8, (const char*)(F.ws + WS_MRG), (const char*)(F.ws + WS_WOT), (size_t)256 * DM * 2, (size_t)256 * DM * 2};
        EpiRes E{F.x, F.out, wsp<bf16_t>(F, WS_X1B)};
        pg8::gemm_phase<EpiRes, SchedTile, true, true>(F.lds, pg8::Geom{DM, DM, 32, 1 << 30, nullptr}, S, E);
    } else if constexpr (K == 8) p8_router(F);
    else if constexpr (K == 9) p8b_gather(F);
    else p9_experts(F);
}
__global__ void __launch_bounds__(NTHR, 2) fwd_kernel(KArgs args) {
    extern __shared__ __attribute__((aligned(16))) unsigned char lds_raw[];
    Frame F;
    F.lds = (LAS unsigned char*)lds_raw; F.MISC = (volatile LAS unsigned*)(F.lds + MISC_OFF);
    F.tid = threadIdx.x; F.lane = F.tid & 63; F.wave = __builtin_amdgcn_readfirstlane(F.tid >> 6);
    F.G = gridDim.x; { const int bx = blockIdx.x; F.vcu = (F.G % 8 == 0) ? (bx % 8) * (F.G / 8) + bx / 8 : bx; }
    F.ws = args.ws; F.out = args.out; F.ctl = (unsigned*)(args.ws + WS_CTL);
    F.x = (const float*)args.in[0]; F.mem = (const float*)args.in[1]; F.positions = (const int*)args.in[2]; F.g_mix = (const float*)args.in[3]; F.w_in = (const float*)args.in[4];
    F.b_gate = (const float*)args.in[5]; F.w_pool_grp = (const float*)args.in[6]; F.pool_scale = (const float*)args.in[7]; F.q_norm_g = (const float*)args.in[8]; F.k_norm_g = (const float*)args.in[9];
    F.g_mem = (const float*)args.in[10]; F.w_mem_kv = (const float*)args.in[11]; F.xq_norm_g = (const float*)args.in[12]; F.xk_norm_g = (const float*)args.in[13]; F.w_pool_out = (const float*)args.in[14];
    F.w_attn_out = (const float*)args.in[15]; F.w_cross_out = (const float*)args.in[16]; F.w_o = (const float*)args.in[17]; F.g_ffn = (const float*)args.in[18]; F.w_rg = (const float*)args.in[19];
    F.w_re = (const float*)args.in[20]; F.w_eg = (const float*)args.in[21]; F.w_eu = (const float*)args.in[22]; F.w_ed = (const float*)args.in[23];
    for (int u = F.tid; u < (LDS_BYTES - LDSCTL_OFF) / 4; u += NTHR) ((LAS unsigned*)(F.lds + LDSCTL_OFF))[u] = 0u;
    __syncthreads();
    XcdBarrier bar = xcd_barrier_post(F.ctl + CW_BAR, F.MISC + 8);
    if (P3_PROF == 8 && blockIdx.x == 0 && F.tid == 0) __hip_atomic_store(F.ctl + CW_QUEUE + 9, 0x7fffffffu, __ATOMIC_RELAXED, __HIP_MEMORY_SCOPE_AGENT);
    const int lo = args.ph_lo, hi = args.ph_hi;
#define IN(k) (lo <= (k) && (k) < hi)
#define SEAM(k) do { if (IN(k) && IN((k) + 1)) xcd_barrier(bar); } while (0)
#ifndef PROBE_TS
#define PROBE_TS -1
#endif
#ifndef PROBE_REPEAT
#define PROBE_REPEAT -1
#endif
    unsigned long long ts0 = 0, ts1 = 0;
#ifndef ONLY_PHASE
#define ONLY_PHASE -1
#endif
#define PHASE(k) do { if ((ONLY_PHASE < 0 || ONLY_PHASE == (k)) && IN(k)) { if (PROBE_TS == (k)) ts0 = __builtin_amdgcn_s_memrealtime(); run_phase<k>(F); \
        if (PROBE_REPEAT == (k)) { xcd_barrier(bar); run_phase<k>(F); } } \
        if (PROBE_TS == (k)) { xcd_barrier(bar); ts1 = __builtin_amdgcn_s_memrealtime(); } else { SEAM(k); } } while (0)
    PHASE(0); PHASE(1); PHASE(2); PHASE(3); PHASE(4); PHASE(5); PHASE(6); PHASE(7); PHASE(8); PHASE(9); PHASE(10);
#ifdef EXTRA_BARS
    for (int _i = 0; _i < 10; ++_i) xcd_barrier(bar);
#endif
    if (P0_PROF) { xcd_barrier(bar); if (blockIdx.x == 0 && F.tid == 0) F.out[0] += (float)__hip_atomic_load(F.ctl + CW_QUEUE + 8, __ATOMIC_RELAXED, __HIP_MEMORY_SCOPE_AGENT) * 0.001f; }
    if (P3_PROF) { xcd_barrier(bar); if (blockIdx.x == 0 && F.tid == 0) { float v = (float)F.MISC[16] * 0.001f;
        if (P3_PROF == 6 || P3_PROF >= 11) v = (float)__hip_atomic_load(F.ctl + CW_QUEUE + 8, __ATOMIC_RELAXED, __HIP_MEMORY_SCOPE_AGENT);
        if (P3_PROF == 7) v = (float)__hip_atomic_load(F.ctl + CW_QUEUE + 8, __ATOMIC_RELAXED, __HIP_MEMORY_SCOPE_AGENT) * 0.001f;
        if (P3_PROF == 8) v = (float)__hip_atomic_load(F.ctl + CW_QUEUE + 9, __ATOMIC_RELAXED, __HIP_MEMORY_SCOPE_AGENT) * 0.001f;
        F.out[0] += v; } }
    if (PROBE_TS >= 0) { if (PROBE_TS != 10) xcd_barrier(bar); if (blockIdx.x == 0 && F.tid == 0) F.out[0] += (float)(ts1 - ts0) * 0.001f; }
#undef IN
#undef SEAM
#undef PHASE
}

extern "C" void kernel_launch(void* const* d_in, const int* in_sizes, int n_in, void* d_out, int out_size, void* d_ws, size_t ws_size, hipStream_t stream) {
    static int grid = 0;
    if (grid == 0) {
        if (n_in != 24 || in_sizes[0] != SEQ * DM || out_size != SEQ * DM || ws_size < WS_END) {
            fprintf(stderr, "kernel_launch: unexpected shapes: n_in %d in0 %d out %d ws %zu (need %zu)\n", n_in, n_in > 0 ? in_sizes[0] : -1, out_size, ws_size, (size_t)WS_END); grid = -1; return; }
        int dev = 0, cus = 0, per_cu = 0;
        if (hipGetDevice(&dev) != hipSuccess || hipDeviceGetAttribute(&cus, hipDeviceAttributeMultiprocessorCount, dev) != hipSuccess) { grid = -1; return; }
        if (hipFuncSetAttribute((const void*)fwd_kernel, hipFuncAttributeMaxDynamicSharedMemorySize, LDS_BYTES) != hipSuccess) { fprintf(stderr, "kernel_launch: hipFuncSetAttribute failed\n"); grid = -1; return; }
        if (hipOccupancyMaxActiveBlocksPerMultiprocessor(&per_cu, (const void*)fwd_kernel, NTHR, LDS_BYTES) != hipSuccess || per_cu < 1) {
            fprintf(stderr, "kernel_launch: occupancy query reports %d workgroups per CU\n", per_cu); (void)hipGetLastError(); per_cu = 1; }
        grid = cus;
    }
    if (grid < 0) return;
    if (hipMemsetAsync((char*)d_ws + WS_CTL, 0, CTL_ZERO_BYTES, stream) != hipSuccess) { fprintf(stderr, "kernel_launch: memset failed\n"); return; }
    KArgs a{};
    for (int i = 0; i < 24; ++i) a.in[i] = d_in[i];
    a.out = (float*)d_out; a.ws = (unsigned char*)d_ws; a.ph_lo = 0; a.ph_hi = 11;
    hipLaunchKernelGGL(fwd_kernel, dim3(grid), dim3(NTHR), LDS_BYTES, stream, a);
    const hipError_t le = hipPeekAtLastError();
    if (le != hipSuccess) fprintf(stderr, "kernel_launch: launch failed: %s\n", hipGetErrorName(le));
}
```

```cpp
#include <hip/hip_runtime.h>
#include <cstdio>
#include <cstdint>

#define LAS __attribute__((address_space(3)))
#define GAS __attribute__((address_space(1)))
typedef unsigned short bf16_t;
typedef short bf16x8 __attribute__((ext_vector_type(8)));
typedef short bf16x4 __attribute__((ext_vector_type(4)));
typedef float f32x4 __attribute__((ext_vector_type(4)));
typedef float f32x16 __attribute__((ext_vector_type(16)));
typedef unsigned u32x4 __attribute__((ext_vector_type(4)));
typedef unsigned u32x2 __attribute__((ext_vector_type(2)));

#ifndef P3_PROF
#define P3_PROF 0
#endif
constexpr int SEQ = 8192, DM = 2048, INC = 10052, MEML = 256;
constexpr int NWAVES = 8, NTHR = 512;
constexpr float NORM_EPS = 1e-6f;
constexpr float LOG2E = 1.4426950408889634f;
constexpr float ATT_SCALE = 0.08838834764831845f;

constexpr size_t MiB = 1u << 20, KiB = 1u << 10;
constexpr size_t WS_CTL = 0, CTL_ZERO_BYTES = 128 * KiB;
constexpr size_t WS_SMALL = 1 * MiB;
constexpr size_t WS_RSTD1 = WS_SMALL + 0, WS_RSTDM = WS_SMALL + 32 * KiB, WS_THRKEY = WS_SMALL + 64 * KiB, WS_THRIDX = WS_SMALL + 96 * KiB;
constexpr size_t WS_WIF = WS_SMALL + 128 * KiB, WS_RSTD2 = WS_SMALL + 256 * KiB, WS_TOKCLS = WS_SMALL + 288 * KiB, WS_TOKSLOT = WS_SMALL + 320 * KiB;
constexpr size_t WS_TOKWA = WS_SMALL + 352 * KiB, WS_TOKWB = WS_SMALL + 384 * KiB, WS_ROWTOK = WS_SMALL + 416 * KiB, WS_ROWRS = WS_SMALL + 480 * KiB;
constexpr size_t WS_ROWWA = WS_SMALL + 544 * KiB, WS_ROWWB = WS_SMALL + 608 * KiB, WS_CNT = WS_SMALL + 672 * KiB, WS_ATTBL = WS_SMALL + 704 * KiB, WS_WR = WS_SMALL + 1 * MiB;
constexpr size_t WS_BTMRG = 4 * MiB, WS_WOT = 12 * MiB;
constexpr size_t WS_XB = 20 * MiB, WS_WINT = 52 * MiB, WS_WVT = 89 * MiB, WS_WMKVT = 92 * MiB, WS_MEMB = 96 * MiB;
constexpr size_t WS_WGUT = 20 * MiB, WS_QIB = 84 * MiB, WS_KIB = 88 * MiB, WS_KMB = 89 * MiB, WS_VMT = 89 * MiB + 512 * KiB;
constexpr size_t WS_WDT = 97 * MiB;
constexpr size_t WS_EG = 129 * MiB, WS_ACT = 185 * MiB;
constexpr size_t WS_AMRG = 225 * MiB, WS_X1B = 225 * MiB;
constexpr size_t WS_Q = 257 * MiB, WS_K = 269 * MiB, WS_VT = 281 * MiB, WS_XQ = 293 * MiB, WS_MRG = 257 * MiB;
constexpr size_t WS_U = 301 * MiB, WS_IDXF = 313 * MiB, WS_OPX = 301 * MiB;
constexpr size_t WS_KVM = 329 * MiB, WS_MASK = 330 * MiB, WS_KVMP = 330 * MiB, WS_END = 338 * MiB;
constexpr int MAXROWS = 14336;
constexpr int CW_BAR = 4096;
constexpr int CW_CLS = 16384;
constexpr int CW_QUEUE = 16512;
constexpr int CW_TILE = 16640;

#define LDS_WAIT() asm volatile("s_waitcnt lgkmcnt(0)" ::: "memory")
#define VM_WAIT() asm volatile("s_waitcnt vmcnt(0)" ::: "memory")
typedef float f32x2_t __attribute__((ext_vector_type(2))); typedef __bf16 bf16x2_t __attribute__((ext_vector_type(2)));
__device__ __forceinline__ unsigned pk2(float lo, float hi) { f32x2_t v = {lo, hi}; bf16x2_t b = __builtin_convertvector(v, bf16x2_t); return __builtin_bit_cast(unsigned, b); }
__device__ __forceinline__ unsigned f2bf(float f) { return pk2(f, 0.f) & 0xffffu; }
__device__ __forceinline__ float bf2f(unsigned short b) { return __builtin_bit_cast(float, (unsigned)b << 16); }
__device__ __forceinline__ float bflo(unsigned w) { return __builtin_bit_cast(float, w << 16); }
__device__ __forceinline__ float bfhi(unsigned w) { return __builtin_bit_cast(float, w & 0xffff0000u); }
__device__ __forceinline__ float wave_sum(float v) {
#pragma unroll
    for (int o = 1; o < 64; o <<= 1) v += __shfl_xor(v, o);
    return v;
}
__device__ __forceinline__ int crow(int r, int hi) { return (r & 3) + 8 * (r >> 2) + 4 * hi; }

#define XB_TMO      128
#define XB_XCNT(j)  (256  + 64 * (j))
#define XB_XSUB(j)  (1280 + 64 * (j))
#define XB_XGEN(j)  (2304 + 64 * (j))
#define XB_TOP      3328
#define XB_TOPGEN   3392
#define XCD_BAR_WORDS 3456
#define XB_SPIN_CAP (1u << 20)
__device__ __forceinline__ unsigned xb_ld(unsigned* p)              { return __hip_atomic_load(p, __ATOMIC_RELAXED, __HIP_MEMORY_SCOPE_AGENT); }
__device__ __forceinline__ unsigned xb_add(unsigned* p, unsigned v) { return __hip_atomic_fetch_add(p, v, __ATOMIC_RELAXED, __HIP_MEMORY_SCOPE_AGENT); }
__device__ __forceinline__ unsigned xb_xcc_id() { return (unsigned)__builtin_amdgcn_s_getreg((3 << 11) | 20) & 0xFu; }
#define XB_SPIN(cond, bar) do { unsigned _sp = 0; while (cond) { __builtin_amdgcn_s_sleep(1); \
    if ((++_sp & 255u) == 0u) { if (xb_ld(&(bar)[XB_TMO])) break; if (_sp > XB_SPIN_CAP) { atomicAdd(&(bar)[XB_TMO], 1u); break; } } } } while (0)
struct XcdBarrier { unsigned* bar; unsigned x; volatile LAS unsigned* st; };
__device__ __forceinline__ XcdBarrier xcd_barrier_post(unsigned* bar, volatile LAS unsigned* st) {
    XcdBarrier b; b.bar = bar; b.x = xb_xcc_id(); b.st = st;
    if (threadIdx.x == 0) (void)xb_add(&bar[XB_XCNT(b.x)], 1u);
    return b;
}
__device__ __forceinline__ void xcd_barrier_complete(unsigned* bar, unsigned x, unsigned& nloc, unsigned& nx) {
    const unsigned G = gridDim.x * gridDim.y * gridDim.z;
    unsigned sum, cnt, mine, sp = 0u;
    for (;;) {
        sum = 0u; cnt = 0u; mine = 0u;
#pragma unroll
        for (unsigned j = 0; j < 16; ++j) { const unsigned c = xb_ld(&bar[XB_XCNT(j)]); sum += c; cnt += (c > 0u) ? 1u : 0u; mine = (j == x) ? c : mine; }
        if (sum == G) break;
        __builtin_amdgcn_s_sleep(1);
        if ((++sp & 255u) == 0u) { if (xb_ld(&bar[XB_TMO])) break; if (sp > XB_SPIN_CAP) { atomicAdd(&bar[XB_TMO], 1u); break; } }
    }
    nloc = mine > 0u ? mine : 1u; nx = cnt > 0u ? cnt : 1u;
}
__device__ __forceinline__ void xcd_barrier(const XcdBarrier& b) {
    asm volatile("s_waitcnt vmcnt(0)" ::: "memory");
    __syncthreads();
    if (threadIdx.x == 0) {
        unsigned* bar = b.bar;
        __builtin_amdgcn_s_waitcnt(0);
        unsigned nloc = b.st[0], nx = b.st[1];
        if (nloc == 0u) { xcd_barrier_complete(bar, b.x, nloc, nx); b.st[0] = nloc; b.st[1] = nx; }
        const unsigned old = xb_add(&bar[XB_XSUB(b.x)], 1u);
        const unsigned gen = old / nloc;
        if (old + 1u == (gen + 1u) * nloc) {
            __builtin_amdgcn_fence(__ATOMIC_RELEASE, "agent");
            asm volatile("s_waitcnt vmcnt(0)" ::: "memory");
            const unsigned og = xb_add(&bar[XB_TOP], 1u);
            const unsigned tg = og / nx;
            if (og + 1u == (tg + 1u) * nx) xb_add(&bar[XB_TOPGEN], 1u);
            else XB_SPIN(xb_ld(&bar[XB_TOPGEN]) == tg, bar);
            __builtin_amdgcn_fence(__ATOMIC_ACQUIRE, "agent");
            xb_add(&bar[XB_XGEN(b.x)], 1u);
            asm volatile("s_waitcnt vmcnt(0)" ::: "memory");
        } else {
            XB_SPIN(xb_ld(&bar[XB_XGEN(b.x)]) == gen, bar);
            __builtin_amdgcn_fence(__ATOMIC_ACQUIRE, "agent");
            asm volatile("s_waitcnt vmcnt(0)" ::: "memory");
        }
    }
    __syncthreads();
}

namespace pg8 {
constexpr int BM = 256, BK = 64, HALF = 128, HTB = HALF * BK * 2, STAGE_BYTES = 8 * HTB, NXCD = 8, WGM = 8;
__host__ __device__ __forceinline__ int lds_byte(int r, int c) { const int st = (r >> 4) * 2 + (c >> 5), rr = r & 15, cc = c & 31, ob = rr * 64 + cc * 2; return st * 1024 + (ob ^ (((ob >> 9) & 1) << 5)); }
__host__ __device__ __forceinline__ void stage_rc(int b, int& R, int& C) { const int st = b / 1024, sb = b % 1024, swz = sb ^ (((sb >> 9) & 1) << 5); R = (st >> 1) * 16 + swz / 64; C = (st & 1) * 32 + (swz % 64) / 2; }
__host__ __device__ __forceinline__ int perm32(int rho) { const int n = rho >> 4, i = rho & 15; return 8 * (i >> 2) + 4 * n + (i & 3); }

struct Unit { const char* A; const char* B; const char* Bhi; int kind; int row0; int col0; int aux; int nt; int lowonly; };
struct Geom { int lda, ldb, nt, ksplit; const int* rowtok; };

__device__ __forceinline__ void tile_order(int L, int nM, int nN, int& pm, int& pn) {
    const int nwg = nM * nN; int wgid = L;
    { const int q = nwg / NXCD, r = nwg % NXCD, xcd = wgid % NXCD, off = wgid / NXCD; wgid = (xcd < r ? xcd * (q + 1) : r * (q + 1) + (xcd - r) * q) + off; }
    const int nig = WGM * nN, gid = wgid / nig, fm = gid * WGM, gsz = (nM - fm) < WGM ? (nM - fm) : WGM;
    pm = fm + ((wgid % nig) % gsz); pn = (wgid % nig) / gsz;
}

template <class Epi, class Sched, bool ALIGN_EPI, bool SP2>
__device__ __forceinline__ void gemm_phase(LAS unsigned char* lds, const Geom g, const Sched& S, const Epi& E) {
    const int tid = threadIdx.x, wid = __builtin_amdgcn_readfirstlane(tid >> 6), lane = tid & 63, wr = wid >> 2, wc = wid & 3, fr = lane & 15, fq = lane >> 4;
    unsigned voffA[2], voffB[2];
#pragma unroll
    for (int i = 0; i < 2; ++i) { int R, C; stage_rc(tid * 16 + i * 8192, R, C); const int Rb = (R & ~31) + perm32(R & 31);
        voffA[i] = (unsigned)(R * g.lda + C) * 2u; voffB[i] = (unsigned)(Rb * g.ldb + C) * 2u; }
    const size_t kstep = (size_t)(BK * 2);
    const size_t hstepA = (size_t)HALF * g.lda * 2, hstepB = (size_t)HALF * g.ldb * 2;
    unsigned voffA1[2];
#pragma unroll
    for (int i = 0; i < 2; ++i) voffA1[i] = voffA[i] + (unsigned)hstepA;
    const unsigned ldsw = (unsigned)wid * 1024u;
    const int aoff = lds_byte(wr * 64 + fr, fq * 8), boff = lds_byte(wc * 32 + fr, fq * 8);
#define PG8_SA(b, h) (((b) * 2 + (h)) * HTB)
#define PG8_SB(b, h) ((4 + (b) * 2 + (h)) * HTB)
#define PG8_STAGE(bufoff, gbase, voff) do { _Pragma("unroll") for (int _i = 0; _i < 2; ++_i) \
        __builtin_amdgcn_global_load_lds((const unsigned*)((const char*)(gbase) + (voff)[_i]), (LAS unsigned*)(lds + (bufoff) + ldsw + _i * 8192), 16, 0, 0); } while (0)
#define PG8_LDA(dst, b, h) do { _Pragma("unroll") for (int m = 0; m < 4; ++m) _Pragma("unroll") for (int k = 0; k < 2; ++k) dst[m][k] = *(const LAS bf16x8*)(lds + PG8_SA(b, h) + aoff + m * 2048 + k * 1024); } while (0)
#define PG8_LDB(dst, b, h) do { _Pragma("unroll") for (int n = 0; n < 2; ++n) _Pragma("unroll") for (int k = 0; k < 2; ++k) dst[n][k] = *(const LAS bf16x8*)(lds + PG8_SB(b, h) + boff + n * 2048 + k * 1024); } while (0)
#define PG8_MMA(ai, bj, At, Bt) do { __builtin_amdgcn_s_setprio(1); _Pragma("unroll") for (int m = 0; m < 4; ++m) _Pragma("unroll") for (int n = 0; n < 2; ++n) _Pragma("unroll") for (int k = 0; k < 2; ++k) \
        acc[ai][bj][m][n] = __builtin_amdgcn_mfma_f32_16x16x32_bf16(Bt[n][k], At[m][k], acc[ai][bj][m][n], 0, 0, 0); __builtin_amdgcn_s_setprio(0); } while (0)
#define PG8_WAIT_V(n) asm volatile("s_waitcnt vmcnt(" #n ")" ::: "memory")
#define PG8_WAIT_L(n) asm volatile("s_waitcnt lgkmcnt(" #n ")" ::: "memory")
#define PG8_BAR __builtin_amdgcn_s_barrier()
#define PG8_SCHED __builtin_amdgcn_sched_barrier(0)
    Unit cur, nxt; int ui = 0;
    if (!S.next(0, cur)) return;
    if (g.rowtok) {
#pragma unroll
        for (int i = 0; i < 2; ++i) { int R, C; stage_rc(tid * 16 + i * 8192, R, C); int t0 = g.rowtok[cur.row0 + R], t1 = g.rowtok[cur.row0 + HALF + R]; t0 = t0 < 0 ? 0 : t0; t1 = t1 < 0 ? 0 : t1;
            voffA[i] = (unsigned)(t0 * g.lda + C) * 2u; voffA1[i] = (unsigned)(t1 * g.lda + C) * 2u; }
    }
    f32x4 acc[2][2][4][2];
#pragma unroll
    for (int a = 0; a < 2; ++a)
#pragma unroll
        for (int b = 0; b < 2; ++b)
#pragma unroll
            for (int m = 0; m < 4; ++m)
#pragma unroll
                for (int n = 0; n < 2; ++n) acc[a][b][m][n] = (f32x4){0.f, 0.f, 0.f, 0.f};
    bf16x8 At[4][2], B0[2][2], B1[2][2];
    const char* cA = cur.A; const char* cB = cur.B; const char* cBhi = cur.Bhi;
    if constexpr (SP2) {
        PG8_STAGE(PG8_SB(0, 0), cB, voffB); PG8_STAGE(PG8_SB(0, 1), cB + hstepB, voffB); PG8_STAGE(PG8_SA(0, 0), cA, voffA); PG8_STAGE(PG8_SA(0, 1), cA, voffA1);
        if (wr == 1) PG8_BAR;
        PG8_WAIT_V(2); PG8_BAR;
        PG8_STAGE(PG8_SB(1, 0), cB + kstep, voffB); PG8_STAGE(PG8_SA(1, 0), cA + kstep, voffA); PG8_STAGE(PG8_SB(1, 1), cB + hstepB + kstep, voffB);
        PG8_WAIT_V(6); PG8_BAR;
    } else {
        PG8_STAGE(PG8_SB(0, 0), cB, voffB); PG8_STAGE(PG8_SA(0, 0), cA, voffA); PG8_STAGE(PG8_SB(0, 1), cB + hstepB, voffB); PG8_STAGE(PG8_SA(0, 1), cA, voffA1);
        if (wr == 1) PG8_BAR;
        PG8_WAIT_V(4); PG8_BAR;
        PG8_STAGE(PG8_SB(1, 0), cB + kstep, voffB); PG8_STAGE(PG8_SA(1, 0), cA + kstep, voffA); PG8_STAGE(PG8_SB(1, 1), cB + hstepB + kstep, voffB);
        PG8_WAIT_V(6); PG8_BAR;
    }
    for (;;) {
        const bool has_next = S.next(ui + 1, nxt);
        const char* nA = has_next ? nxt.A : cA; const char* nB = has_next ? nxt.B : cB;
        const int nt = cur.nt; const bool hi_on = cur.lowonly == 0;
        for (int t = 0; t < nt; t += 2) {
            const bool last = (t == nt - 2);
            if constexpr (Epi::HOOK) { if (t == Epi::HOOK_T1 || t == Epi::HOOK_T2) E.hook(acc, cur, t, wr, wc, fr, fq); }
            const char* a1 = cA + (size_t)(t + 1) * kstep;
            const char* a2 = last ? nA : cA + (size_t)(t + 2) * kstep;
            const char* b2 = last ? nB : ((t + 2) < g.ksplit ? cB : cBhi) + (size_t)(t + 2) * kstep;
            const char* a3 = a2 + kstep; const char* b3 = b2 + kstep;
            if constexpr (SP2) {
            PG8_LDB(B0, 0, 0); PG8_LDB(B1, 0, 1); PG8_SCHED; PG8_LDA(At, 0, 0); PG8_STAGE(PG8_SA(1, 1), a1, voffA1);
            PG8_WAIT_V(8); PG8_WAIT_L(0); PG8_BAR; PG8_MMA(0, 0, At, B0); PG8_MMA(0, 1, At, B1); PG8_BAR; PG8_SCHED;
            PG8_LDA(At, 0, 1); PG8_STAGE(PG8_SB(0, 0), b2, voffB); PG8_STAGE(PG8_SB(0, 1), b2 + hstepB, voffB); PG8_STAGE(PG8_SA(0, 0), a2, voffA);
            PG8_WAIT_V(8); PG8_WAIT_L(0); PG8_BAR; if (hi_on) { PG8_MMA(1, 0, At, B0); PG8_MMA(1, 1, At, B1); } PG8_BAR; PG8_SCHED;
            PG8_LDB(B0, 1, 0); PG8_LDB(B1, 1, 1); PG8_SCHED; PG8_LDA(At, 1, 0); PG8_STAGE(PG8_SA(0, 1), a2, voffA1);
            PG8_WAIT_V(8); PG8_WAIT_L(0); PG8_BAR; PG8_MMA(0, 0, At, B0); PG8_MMA(0, 1, At, B1); PG8_BAR; PG8_SCHED;
            PG8_LDA(At, 1, 1); PG8_STAGE(PG8_SB(1, 0), b3, voffB); PG8_STAGE(PG8_SB(1, 1), b3 + hstepB, voffB); PG8_STAGE(PG8_SA(1, 0), a3, voffA);
            PG8_WAIT_V(8); PG8_WAIT_L(0); PG8_BAR; if (hi_on) { PG8_MMA(1, 0, At, B0); PG8_MMA(1, 1, At, B1); } PG8_BAR; PG8_SCHED;
            } else {
            PG8_LDB(B0, 0, 0); PG8_SCHED; PG8_LDA(At, 0, 0); PG8_STAGE(PG8_SA(1, 1), a1, voffA1);
            PG8_WAIT_L(8); PG8_BAR; PG8_WAIT_L(0); PG8_MMA(0, 0, At, B0); PG8_BAR; PG8_SCHED;
            PG8_LDB(B1, 0, 1); PG8_STAGE(PG8_SB(0, 0), b2, voffB);
            PG8_BAR; PG8_WAIT_L(0); PG8_MMA(0, 1, At, B1); PG8_BAR;
            PG8_LDA(At, 0, 1); PG8_STAGE(PG8_SA(0, 0), a2, voffA);
            PG8_BAR; PG8_WAIT_L(0); PG8_MMA(1, 0, At, B0); PG8_BAR; PG8_SCHED;
            PG8_STAGE(PG8_SB(0, 1), b2 + hstepB, voffB);
            PG8_WAIT_V(6); PG8_BAR; PG8_MMA(1, 1, At, B1); PG8_BAR;
            PG8_LDB(B0, 1, 0); PG8_SCHED; PG8_LDA(At, 1, 0); PG8_STAGE(PG8_SA(0, 1), a2, voffA1);
            PG8_WAIT_L(8); PG8_BAR; PG8_WAIT_L(0); PG8_MMA(0, 0, At, B0); PG8_BAR; PG8_SCHED;
            PG8_LDB(B1, 1, 1); PG8_STAGE(PG8_SB(1, 0), b3, voffB);
            PG8_BAR; PG8_WAIT_L(0); PG8_MMA(0, 1, At, B1); PG8_BAR;
            PG8_LDA(At, 1, 1); PG8_STAGE(PG8_SA(1, 0), a3, voffA);
            PG8_BAR; PG8_WAIT_L(0); PG8_MMA(1, 0, At, B0); PG8_BAR; PG8_SCHED;
            PG8_STAGE(PG8_SB(1, 1), b3 + hstepB, voffB);
            PG8_WAIT_V(6); PG8_BAR; PG8_MMA(1, 1, At, B1); PG8_BAR;
            }
        }
        if constexpr (ALIGN_EPI) { if (wr == 0) PG8_BAR; }
        E(acc, cur, wr, wc, fr, fq);
        if (!has_next) break;
#pragma unroll
        for (int a = 0; a < 2; ++a)
#pragma unroll
            for (int b = 0; b < 2; ++b)
#pragma unroll
                for (int m = 0; m < 4; ++m)
#pragma unroll
                    for (int n = 0; n < 2; ++n) acc[a][b][m][n] = (f32x4){0.f, 0.f, 0.f, 0.f};
        cur = nxt; cA = nA; cB = nB; cBhi = nxt.Bhi; ++ui;
        if constexpr (ALIGN_EPI) { if (wr == 1) PG8_BAR; }
    }
    PG8_WAIT_V(0);
    if constexpr (!ALIGN_EPI) { if (wr == 0) PG8_BAR; }
    PG8_BAR;
#undef PG8_SA
#undef PG8_SB
#undef PG8_STAGE
#undef PG8_LDA
#undef PG8_LDB
#undef PG8_MMA
#undef PG8_WAIT_V
#undef PG8_WAIT_L
#undef PG8_BAR
#undef PG8_SCHED
}
}

constexpr int RING_BYTES = 131072, LDS_BYTES = 147456, LDSCTL_OFF = LDS_BYTES - 2048, MISC_OFF = LDSCTL_OFF + 320;
struct KArgs { const void* in[24]; float* out; unsigned char* ws; int ph_lo, ph_hi; };
struct Frame {
    LAS unsigned char* lds; volatile LAS unsigned* MISC; unsigned* ctl; unsigned char* ws; float* out;
    int tid, lane, wave, vcu, G;
    const float *x, *mem, *g_mix, *w_in, *b_gate, *w_pool_grp, *pool_scale, *q_norm_g, *k_norm_g, *g_mem, *w_mem_kv, *xq_norm_g, *xk_norm_g,
                *w_pool_out, *w_attn_out, *w_cross_out, *w_o, *g_ffn, *w_rg, *w_re, *w_eg, *w_eu, *w_ed;
    const int* positions;
};
template <class T> __device__ __forceinline__ T* wsp(const Frame& F, size_t off) { return (T*)(F.ws + off); }

struct TrD { const float* W; const float* gain; bf16_t* dst; int ldw, k0, n0, nvalid, ldd, dk0; };
__device__ __forceinline__ void tr_load(const TrD& d, f32x4 (&v)[2][8], float (&g)[8], int lane) {
    const int kg = lane >> 3, ng = lane & 7;
#pragma unroll
    for (int hh = 0; hh < 2; ++hh) { const int nn = 32 * hh + 4 * ng; const bool ok = nn < d.nvalid;
#pragma unroll
        for (int i = 0; i < 8; ++i) v[hh][i] = ok ? *(const f32x4*)(d.W + (size_t)(d.k0 + 8 * kg + i) * d.ldw + d.n0 + nn) : (f32x4){0.f, 0.f, 0.f, 0.f}; }
#pragma unroll
    for (int i = 0; i < 8; ++i) g[i] = d.gain ? d.gain[d.k0 + 8 * kg + i] : 1.0f;
}
__device__ __forceinline__ void tr_store(const TrD& d, const f32x4 (&v)[2][8], const float (&g)[8], int lane) {
    const int kg = lane >> 3, ng = lane & 7;
#pragma unroll
    for (int hh = 0; hh < 2; ++hh)
#pragma unroll
        for (int j = 0; j < 4; ++j) { const int n = 32 * hh + 4 * ng + j;
            u32x4 o; o.x = pk2(v[hh][0][j] * g[0], v[hh][1][j] * g[1]); o.y = pk2(v[hh][2][j] * g[2], v[hh][3][j] * g[3]); o.z = pk2(v[hh][4][j] * g[4], v[hh][5][j] * g[5]); o.w = pk2(v[hh][6][j] * g[6], v[hh][7][j] * g[7]);
            *(u32x4*)(d.dst + (size_t)n * d.ldd + d.dk0 + d.k0 + 8 * kg) = o; }
}
__device__ __forceinline__ void tr_item(const float* W, int ldw, int k0, int n0, int nvalid, const float* gain, bf16_t* dst, int ldd, int dk0, LAS float*, int lane) {
    const TrD d{W, gain, dst, ldw, k0, n0, nvalid, ldd, dk0};
    f32x4 v[2][8]; float g[8];
    tr_load(d, v, g, lane); tr_store(d, v, g, lane);
}
__device__ __forceinline__ void tr_pair(const TrD& d0, const TrD& d1, int lane) {
    f32x4 v0[2][8], v1[2][8]; float g0[8], g1[8];
    tr_load(d0, v0, g0, lane); tr_load(d1, v1, g1, lane);
    tr_store(d0, v0, g0, lane); tr_store(d1, v1, g1, lane);
}
__device__ __forceinline__ void row_to_bf16(const float* xrow, bf16_t* orow, float* rstd_out, int lane) {
    const f32x4* xr = (const f32x4*)xrow + lane;
    f32x4 v[8]; float s = 0.f;
#pragma unroll
    for (int j = 0; j < 8; ++j) { v[j] = xr[64 * j]; s += (v[j].x * v[j].x + v[j].y * v[j].y) + (v[j].z * v[j].z + v[j].w * v[j].w); }
    s = wave_sum(s);
    u32x2* o8 = (u32x2*)orow + lane;
#pragma unroll
    for (int j = 0; j < 8; ++j) { u32x2 w; w.x = pk2(v[j].x, v[j].y); w.y = pk2(v[j].z, v[j].w); o8[64 * j] = w; }
    if (lane == 0) *rstd_out = 1.0f / sqrtf(s * (1.0f / DM) + NORM_EPS);
}
__device__ __forceinline__ void att_build_table(Frame& F);
__device__ __forceinline__ int cum_chunks(int qb);
#ifndef P0_PROF
#define P0_PROF 0
#endif
#define P0T0() unsigned long long _pt = (P0_PROF && F.tid == 0) ? __builtin_amdgcn_s_memrealtime() : 0ull
#define P0T1(k) do { if (P0_PROF == (k)) { __syncthreads(); if (F.tid == 0) atomicMax(F.ctl + CW_QUEUE + 8, (unsigned)(__builtin_amdgcn_s_memrealtime() - _pt)); } } while (0)
__device__ __forceinline__ void wcomb_item(Frame& F, int it, bf16_t* BTMRG) {
        const int g = it / 384, r = it % 384, ct = r / 64, dt = r % 64;
        const int i = F.lane & 31, kh = F.lane >> 5;
        const float* ap = F.w_pool_grp + (size_t)g * 192 * 192 + (size_t)(32 * ct + i) * 192 + 4 * kh;
        const float* sp = F.pool_scale + g * 192 + 4 * kh;
        const float* bp = F.w_pool_out + (size_t)(g * 192 + 4 * kh) * DM + 32 * dt + i;
        f32x16 acc;
#pragma unroll
        for (int q2 = 0; q2 < 16; ++q2) acc[q2] = 0.f;
#pragma unroll 1
        for (int m0 = 0; m0 < 24; m0 += 12) {
            f32x4 a[12], sc[12]; float b[12][4];
#pragma unroll
            for (int mm = 0; mm < 12; ++mm) { a[mm] = *(const f32x4*)(ap + 8 * (m0 + mm)); sc[mm] = *(const f32x4*)(sp + 8 * (m0 + mm));
#pragma unroll
                for (int e = 0; e < 4; ++e) b[mm][e] = bp[(size_t)(8 * (m0 + mm) + e) * DM]; }
#pragma unroll
            for (int mm = 0; mm < 12; ++mm)
#pragma unroll
                for (int e = 0; e < 4; ++e) acc = __builtin_amdgcn_mfma_f32_32x32x2f32(a[mm][e] * sc[mm][e], b[mm][e], acc, 0, 0, 0);
        }
        bf16_t* op = BTMRG + (size_t)(32 * dt + i) * DM + g * 192 + 32 * ct + 4 * kh;
#pragma unroll
        for (int q4 = 0; q4 < 4; ++q4) { u32x2 o; o.x = pk2(acc[4 * q4 + 0], acc[4 * q4 + 1]); o.y = pk2(acc[4 * q4 + 2], acc[4 * q4 + 3]); *(u32x2*)(op + 8 * q4) = o; }
}
__device__ __forceinline__ void p0_prologue(Frame& F) {
    P0T0();
    if (blockIdx.x == 0) att_build_table(F);
    LAS float* scr = (LAS float*)(F.lds + F.wave * 16640);
    const int gw = F.vcu * NWAVES + F.wave, NGW = F.G * NWAVES;
    bf16_t* WINT = wsp<bf16_t>(F, WS_WINT); bf16_t* WVT = wsp<bf16_t>(F, WS_WVT); bf16_t* WMKVT = wsp<bf16_t>(F, WS_WMKVT);
    bf16_t* BTMRG = wsp<bf16_t>(F, WS_BTMRG); bf16_t* WOT = wsp<bf16_t>(F, WS_WOT);
    for (int it = gw; it < 4 * 6 * 64; it += NGW) wcomb_item(F, it, BTMRG);
    __syncthreads();
    constexpr int NB_IN = 158, I_IN = 32 * NB_IN, I_MKV = 32 * 16, I_WO = 32 * 32, I_AO = 12 * 32, I_CO = 8 * 32;
    constexpr int NITEMS = I_IN + I_MKV + I_WO + I_AO + I_CO;
    auto decode = [&](int r, TrD& d) {
        d.nvalid = 64; d.dk0 = 0; d.ldd = DM;
        if (r < I_IN) {
            const int kb = r / NB_IN, nb = r % NB_IN; int sc0, drow; bf16_t* dm = WINT; int j;
            if (nb < 12) { j = nb; sc0 = 0; drow = 0; }
            else if (nb < 24) { j = nb - 12; sc0 = 768; drow = 768; }
            else if (nb < 36) { j = nb - 24; sc0 = 1536; drow = 1536; }
            else if (nb < 48) { j = nb - 36; sc0 = 2304; drow = 0; dm = WVT; }
            else if (nb < 52) { j = nb - 48; sc0 = 3072; drow = 2304; }
            else if (nb < 54) { j = nb - 52; sc0 = 3328; drow = 2560; if (j == 1) d.nvalid = 4; }
            else if (nb < 62) { j = nb - 54; sc0 = 3396; drow = 2816; }
            else { j = nb - 62; sc0 = 3908; drow = 3328; }
            d.W = F.w_in; d.ldw = INC; d.k0 = kb * 64; d.n0 = sc0 + 64 * j; d.gain = F.g_mix; d.dst = dm + (size_t)(drow + 64 * j) * DM; return; }
        r -= I_IN;
        if (r < I_MKV) { const int kb = r / 16, nb = r % 16; d.W = F.w_mem_kv; d.ldw = 1024; d.k0 = kb * 64; d.n0 = nb * 64; d.gain = F.g_mem; d.dst = WMKVT + (size_t)(nb * 64) * DM; return; }
        r -= I_MKV;
        if (r < I_WO) { const int kb = r / 32, nb = r % 32; d.W = F.w_o; d.ldw = DM; d.k0 = kb * 64; d.n0 = nb * 64; d.gain = nullptr; d.dst = WOT + (size_t)(nb * 64) * DM; return; }
        r -= I_WO;
        if (r < I_AO) { const int kb = r / 32, nb = r % 32; d.W = F.w_attn_out; d.ldw = DM; d.k0 = kb * 64; d.n0 = nb * 64; d.gain = nullptr; d.dst = BTMRG + (size_t)(nb * 64) * DM; d.dk0 = 768; return; }
        r -= I_AO;
        { const int kb = r / 32, nb = r % 32; d.W = F.w_cross_out; d.ldw = DM; d.k0 = kb * 64; d.n0 = nb * 64; d.gain = nullptr; d.dst = BTMRG + (size_t)(nb * 64) * DM; d.dk0 = 1536; }
    };
    for (int it = gw; it < NITEMS; it += 2 * NGW) {
        TrD d0, d1; decode(it, d0);
        if (it + NGW < NITEMS) { decode(it + NGW, d1); tr_pair(d0, d1, F.lane); }
        else { f32x4 v[2][8]; float g[8]; tr_load(d0, v, g, F.lane); tr_store(d0, v, g, F.lane); }
    }
    P0T1(2);
    { u32x4* z = (u32x4*)(WINT + (size_t)2688 * DM); const int n16 = 128 * DM * 2 / 16;
      for (int i = F.vcu * NTHR + F.tid; i < n16; i += F.G * NTHR) z[i] = (u32x4){0u, 0u, 0u, 0u}; }
    { float* WR = wsp<float>(F, WS_WR);
      for (int i = F.vcu * NTHR + F.tid; i < DM * 32; i += F.G * NTHR) { const int k = i >> 5, j = i & 31;
          float v = 0.f; if (j < 4) v = F.w_rg[k * 4 + j]; else if (j < 20) v = F.w_re[k * 16 + (j - 4)];
          WR[i] = v * F.g_ffn[k]; } }
    P0T1(3);
    { bf16_t* XB = wsp<bf16_t>(F, WS_XB); float* R1 = wsp<float>(F, WS_RSTD1); bf16_t* MB = wsp<bf16_t>(F, WS_MEMB); float* RM = wsp<float>(F, WS_RSTDM);
      for (int m0 = gw; m0 < SEQ + MEML; m0 += 4 * NGW) {
          f32x4 v[4][8];
#pragma unroll
          for (int r = 0; r < 4; ++r) { const int m = m0 + r * NGW; if (m < SEQ + MEML) { const f32x4* xr = (const f32x4*)(m < SEQ ? F.x + (size_t)m * DM : F.mem + (size_t)(m - SEQ) * DM) + F.lane;
#pragma unroll
              for (int j = 0; j < 8; ++j) v[r][j] = xr[64 * j]; } }
#pragma unroll
          for (int r = 0; r < 4; ++r) { const int m = m0 + r * NGW; if (m < SEQ + MEML) { float s = 0.f;
#pragma unroll
              for (int j = 0; j < 8; ++j) s += (v[r][j].x * v[r][j].x + v[r][j].y * v[r][j].y) + (v[r][j].z * v[r][j].z + v[r][j].w * v[r][j].w);
              s = wave_sum(s);
              u32x2* o8 = (u32x2*)(m < SEQ ? XB + (size_t)m * DM : MB + (size_t)(m - SEQ) * DM) + F.lane;
#pragma unroll
              for (int j = 0; j < 8; ++j) { u32x2 w; w.x = pk2(v[r][j].x, v[r][j].y); w.y = pk2(v[r][j].z, v[r][j].w); o8[64 * j] = w; }
              if (F.lane == 0) { const float rs = 1.0f / sqrtf(s * (1.0f / DM) + NORM_EPS); if (m < SEQ) R1[m] = rs; else RM[m - SEQ] = rs; } } } } }
}

struct SchedP1 {
    int c, G; unsigned char* ws;
    __device__ __forceinline__ bool next(int i, pg8::Unit& u) const {
        const int L = i * G + c; const size_t tstep = (size_t)256 * DM * 2;
        const char* XB = (const char*)(ws + WS_XB); const char* WINT = (const char*)(ws + WS_WINT); const char* WVT = (const char*)(ws + WS_WVT); const char* MEMB = (const char*)(ws + WS_MEMB); const char* WMKVT = (const char*)(ws + WS_WMKVT);
        u.nt = 32; u.lowonly = 0;
        if (L < 1184) { int pm, pn; pg8::tile_order(L, 32, 37, pm, pn);
            u.A = XB + (size_t)pm * tstep; u.B = WINT + (size_t)pn * tstep; u.Bhi = u.B; u.row0 = pm * 256;
            if (pn < 3) { u.kind = 0; u.col0 = pn * 256; u.aux = 0; }
            else if (pn < 6) { u.kind = 0; u.col0 = (pn - 3) * 256; u.aux = 1; }
            else if (pn < 9) { u.kind = 0; u.col0 = (pn - 6) * 256; u.aux = 2; }
            else if (pn < 11) { u.kind = 1; u.col0 = (pn - 9) * 256; u.aux = 0; }
            else if (pn < 13) { u.kind = 0; u.col0 = (pn - 11) * 256; u.aux = 3; }
            else { u.kind = 2; u.col0 = (pn - 13) * 256; u.aux = 0; }
            return true; }
        if (L < 1280) { const int idx = L - 1184, pm = idx / 32, pn = idx % 32;
            u.A = WVT + (size_t)pm * tstep; u.B = XB + (size_t)pn * tstep; u.Bhi = u.B; u.kind = 3; u.row0 = pm * 256; u.col0 = pn * 256; u.aux = 0; return true; }
        if (L < 1312) { const int idx = L - 1280, pn = idx & 3, ks = idx >> 2;
            u.A = MEMB + (size_t)ks * 512; u.B = WMKVT + (size_t)pn * tstep + (size_t)ks * 512; u.Bhi = u.B; u.kind = 4; u.row0 = 0; u.col0 = pn * 256; u.aux = ks; u.nt = 4; return true; }
        return false;
    }
};
struct EpiP1 {
    static constexpr bool HOOK = false; static constexpr int HOOK_T1 = -1, HOOK_T2 = -1;
    unsigned char* ws; const float* rstd1; const float* rstdm; const float* bgate;
    __device__ __forceinline__ void hook(f32x4 (&)[2][2][4][2], const pg8::Unit&, int, int, int, int, int) const {}
    __device__ __forceinline__ void operator()(const f32x4 (&acc)[2][2][4][2], const pg8::Unit& u, int wr, int wc, int fr, int fq) const {
        const int rbase = u.row0 + wr * 64 + fr, cbase = u.col0 + wc * 32 + 8 * fq;
        if (u.kind == 0) {
            bf16_t* C; int ldc;
            if (u.aux == 0) { C = (bf16_t*)(ws + WS_U); ldc = 768; } else if (u.aux == 1) { C = (bf16_t*)(ws + WS_Q); ldc = 768; }
            else if (u.aux == 2) { C = (bf16_t*)(ws + WS_K); ldc = 768; } else { C = (bf16_t*)(ws + WS_XQ); ldc = 512; }
#pragma unroll
            for (int ai = 0; ai < 2; ++ai)
#pragma unroll
                for (int m = 0; m < 4; ++m) { const int row = rbase + ai * 128 + m * 16; const float s = rstd1[row];
#pragma unroll
                    for (int bj = 0; bj < 2; ++bj) { const f32x4 v0 = acc[ai][bj][m][0] * s, v1 = acc[ai][bj][m][1] * s;
                        u32x4 w; w.x = pk2(v0[0], v0[1]); w.y = pk2(v0[2], v0[3]); w.z = pk2(v1[0], v1[1]); w.w = pk2(v1[2], v1[3]);
                        *(u32x4*)(C + (size_t)row * ldc + cbase + bj * 128) = w; } }
        } else if (u.kind == 1 || u.kind == 4) {
            float* C; int ldc; const float* rs;
            if (u.kind == 1) { C = (float*)(ws + WS_IDXF); ldc = 512; rs = rstd1; } else { C = (float*)(ws + WS_KVMP) + (size_t)u.aux * 262144; ldc = 1024; rs = rstdm; }
#pragma unroll
            for (int ai = 0; ai < 2; ++ai)
#pragma unroll
                for (int m = 0; m < 4; ++m) { const int row = rbase + ai * 128 + m * 16; const float s = rs[row];
#pragma unroll
                    for (int bj = 0; bj < 2; ++bj) { float* p = C + (size_t)row * ldc + cbase + bj * 128;
                        *(f32x4*)p = acc[ai][bj][m][0] * s; *(f32x4*)(p + 4) = acc[ai][bj][m][1] * s; } }
        } else if (u.kind == 2) {
            bf16_t* C = (bf16_t*)(ws + WS_EG);
            f32x4 bv[2][2];
#pragma unroll
            for (int bj = 0; bj < 2; ++bj) { bv[bj][0] = *(const f32x4*)(bgate + cbase + bj * 128); bv[bj][1] = *(const f32x4*)(bgate + cbase + bj * 128 + 4); }
#pragma unroll
            for (int ai = 0; ai < 2; ++ai)
#pragma unroll
                for (int m = 0; m < 4; ++m) { const int row = rbase + ai * 128 + m * 16; const float s = rstd1[row];
#pragma unroll
                    for (int bj = 0; bj < 2; ++bj) { f32x4 v0 = acc[ai][bj][m][0] * s + bv[bj][0], v1 = acc[ai][bj][m][1] * s + bv[bj][1];
#pragma unroll
                        for (int e = 0; e < 4; ++e) { v0[e] = 1.0f + __builtin_amdgcn_exp2f(fminf(-v0[e] * LOG2E, 60.f)); v1[e] = 1.0f + __builtin_amdgcn_exp2f(fminf(-v1[e] * LOG2E, 60.f)); }
                        u32x4 w; w.x = pk2(v0[0], v0[1]); w.y = pk2(v0[2], v0[3]); w.z = pk2(v1[0], v1[1]); w.w = pk2(v1[2], v1[3]);
                        *(u32x4*)(C + (size_t)row * 6144 + cbase + bj * 128) = w; } }
        } else {
            bf16_t* C = (bf16_t*)(ws + WS_VT);
            f32x4 sv[2][2];
#pragma unroll
            for (int bj = 0; bj < 2; ++bj) { sv[bj][0] = *(const f32x4*)(rstd1 + cbase + bj * 128); sv[bj][1] = *(const f32x4*)(rstd1 + cbase + bj * 128 + 4); }
#pragma unroll
            for (int ai = 0; ai < 2; ++ai)
#pragma unroll
                for (int m = 0; m < 4; ++m) { const int row = rbase + ai * 128 + m * 16;
#pragma unroll
                    for (int bj = 0; bj < 2; ++bj) { const f32x4 v0 = acc[ai][bj][m][0] * sv[bj][0], v1 = acc[ai][bj][m][1] * sv[bj][1];
                        u32x4 w; w.x = pk2(v0[0], v0[1]); w.y = pk2(v0[2], v0[3]); w.z = pk2(v1[0], v1[1]); w.w = pk2(v1[2], v1[3]);
                        *(u32x4*)(C + (size_t)row * SEQ + cbase + bj * 128) = w; } }
        }
    }
};

__device__ __forceinline__ void rot_cs(float pos, float inv_freq, float& c, float& s) {
    const float ang = pos * inv_freq;
    const double rev = (double)ang * 0.15915494309189535;
    const float fr = (float)(rev - __builtin_rint(rev));
    c = __builtin_amdgcn_cosf(fr); s = __builtin_amdgcn_sinf(fr);
}
__device__ __forceinline__ void unpack8(const u32x4 v, float (&f)[8]) { f[0] = bflo(v.x); f[1] = bfhi(v.x); f[2] = bflo(v.y); f[3] = bfhi(v.y); f[4] = bflo(v.z); f[5] = bfhi(v.z); f[6] = bflo(v.w); f[7] = bfhi(v.w); }
__device__ __forceinline__ u32x4 pack8(const float (&f)[8]) { u32x4 o; o.x = pk2(f[0], f[1]); o.y = pk2(f[2], f[3]); o.z = pk2(f[4], f[5]); o.w = pk2(f[6], f[7]); return o; }
__device__ __forceinline__ void p2_rowpass(Frame& F) {
    P0T0();
    const int gw = F.vcu * NWAVES + F.wave, NGW = F.G * NWAVES, lane = F.lane;
    const bf16_t* U = wsp<bf16_t>(F, WS_U); bf16_t* AM = wsp<bf16_t>(F, WS_AMRG);
    bf16_t* Q = wsp<bf16_t>(F, WS_Q); bf16_t* K = wsp<bf16_t>(F, WS_K); bf16_t* XQ = wsp<bf16_t>(F, WS_XQ);
    const float* IDXF = wsp<float>(F, WS_IDXF); bf16_t* QIB = wsp<bf16_t>(F, WS_QIB); bf16_t* KIB = wsp<bf16_t>(F, WS_KIB); float* WIF = wsp<float>(F, WS_WIF);
    const int m = lane & 15, mlo = m & 7; const bool hi_half = m >= 8;
    float if128[8], if64[4], gq[8], gk[8], gx[8];
#pragma unroll
    for (int e = 0; e < 8; ++e) { if128[e] = __builtin_amdgcn_exp2f(-(float)(2 * (8 * mlo + e)) * (13.287712379549449f / 128.0f)); gq[e] = F.q_norm_g[8 * m + e]; gk[e] = F.k_norm_g[8 * m + e]; gx[e] = F.xq_norm_g[8 * m + e]; }
#pragma unroll
    for (int e = 0; e < 4; ++e) if64[e] = __builtin_amdgcn_exp2f(-(float)(2 * (4 * mlo + e)) * (13.287712379549449f / 64.0f));
    for (int t = gw; t < SEQ; t += NGW) {
        const int colA = 8 * lane, colB = 512 + 8 * lane;
        const int gA = colA / 192, wA = 2 << gA, cntA = (t + 1 < wA) ? (t + 1) : wA;
        const int gB = (lane < 32) ? colB / 192 : 3, wB = 2 << gB, cntB = (lane < 32) ? ((t + 1 < wB) ? (t + 1) : wB) : 0;
        u32x4 ua[8], ub[16];
#pragma unroll
        for (int j = 0; j < 8; ++j) ua[j] = (j < cntA) ? *(const u32x4*)(U + (size_t)(t - j) * 768 + colA) : (u32x4){0u, 0u, 0u, 0u};
#pragma unroll
        for (int j = 0; j < 16; ++j) ub[j] = (j < cntB) ? *(const u32x4*)(U + (size_t)(t - j) * 768 + colB) : (u32x4){0u, 0u, 0u, 0u};
        u32x4 rawqk[3];
#pragma unroll
        for (int ch = 0; ch < 3; ++ch) { const int e0 = ch * 512 + 8 * lane; rawqk[ch] = *(const u32x4*)((e0 < 768) ? (Q + (size_t)t * 768 + e0) : (K + (size_t)t * 768 + (e0 - 768))); }
        const u32x4 rawx = *(const u32x4*)(XQ + (size_t)t * 512 + 8 * lane);
        const float* ip = IDXF + (size_t)t * 512;
        const f32x4 iqa = *(const f32x4*)(ip + 4 * lane), ika = *(const f32x4*)(ip + 256 + 4 * (lane & 15));
        const float iw = ip[320 + (lane & 3)];
        { float sum[8];
#pragma unroll
          for (int e = 0; e < 8; ++e) sum[e] = 0.f;
#pragma unroll
          for (int j = 0; j < 8; ++j) { float f[8]; unpack8(ua[j], f);
#pragma unroll
              for (int e = 0; e < 8; ++e) sum[e] += f[e]; }
          float cur[8]; unpack8(ua[0], cur); const float inv = 1.0f / (float)cntA; float o[8];
#pragma unroll
          for (int e = 0; e < 8; ++e) o[e] = sum[e] * inv - cur[e];
          *(u32x4*)(AM + (size_t)t * DM + colA) = pack8(o); }
        if (lane < 32) { float sum[8];
#pragma unroll
          for (int e = 0; e < 8; ++e) sum[e] = 0.f;
#pragma unroll
          for (int j = 0; j < 16; ++j) { float f[8]; unpack8(ub[j], f);
#pragma unroll
              for (int e = 0; e < 8; ++e) sum[e] += f[e]; }
          float cur[8]; unpack8(ub[0], cur); const float inv = 1.0f / (float)cntB; float o[8];
#pragma unroll
          for (int e = 0; e < 8; ++e) o[e] = sum[e] * inv - cur[e];
          *(u32x4*)(AM + (size_t)t * DM + colB) = pack8(o); }
        const float pos = (float)F.positions[t];
        float c128[8], s128[8], c64[4], s64[4];
#pragma unroll
        for (int e = 0; e < 8; ++e) rot_cs(pos, if128[e], c128[e], s128[e]);
#pragma unroll
        for (int e = 0; e < 4; ++e) rot_cs(pos, if64[e], c64[e], s64[e]);
#pragma unroll
        for (int ch = 0; ch < 3; ++ch) {
            const int e0 = ch * 512 + 8 * lane; const bool isq = e0 < 768;
            bf16_t* p = isq ? (Q + (size_t)t * 768 + e0) : (K + (size_t)t * 768 + (e0 - 768));
            float v[8], pv[8]; unpack8(rawqk[ch], v);
            float ss = 0.f;
#pragma unroll
            for (int e = 0; e < 8; ++e) ss += v[e] * v[e];
            ss += __shfl_xor(ss, 1); ss += __shfl_xor(ss, 2); ss += __shfl_xor(ss, 4); ss += __shfl_xor(ss, 8);
            const float r = (1.0f / sqrtf(ss * (1.0f / 128.0f) + NORM_EPS)) * (isq ? (ATT_SCALE * LOG2E) : 1.0f);
#pragma unroll
            for (int e = 0; e < 8; ++e) v[e] *= r * (isq ? gq[e] : gk[e]);
#pragma unroll
            for (int e = 0; e < 8; ++e) pv[e] = __shfl_xor(v[e], 8);
            float o[8];
#pragma unroll
            for (int e = 0; e < 8; ++e) o[e] = hi_half ? (v[e] * c128[e] + pv[e] * s128[e]) : (v[e] * c128[e] - pv[e] * s128[e]);
            *(u32x4*)p = pack8(o);
        }
        { bf16_t* p = XQ + (size_t)t * 512 + 8 * lane; float v[8]; unpack8(rawx, v);
          float ss = 0.f;
#pragma unroll
          for (int e = 0; e < 8; ++e) ss += v[e] * v[e];
          ss += __shfl_xor(ss, 1); ss += __shfl_xor(ss, 2); ss += __shfl_xor(ss, 4); ss += __shfl_xor(ss, 8);
          const float r = (1.0f / sqrtf(ss * (1.0f / 128.0f) + NORM_EPS)) * (ATT_SCALE * LOG2E);
#pragma unroll
          for (int e = 0; e < 8; ++e) v[e] *= r * gx[e];
          *(u32x4*)p = pack8(v); }
        { const f32x4 a = iqa; f32x4 b; b[0] = __shfl_xor(a[0], 8); b[1] = __shfl_xor(a[1], 8); b[2] = __shfl_xor(a[2], 8); b[3] = __shfl_xor(a[3], 8);
          float o[4];
#pragma unroll
          for (int e = 0; e < 4; ++e) o[e] = hi_half ? (a[e] * c64[e] + b[e] * s64[e]) : (a[e] * c64[e] - b[e] * s64[e]);
          u32x2 w; w.x = pk2(o[0], o[1]); w.y = pk2(o[2], o[3]); *(u32x2*)(QIB + (size_t)t * 256 + 4 * lane) = w; }
        { const f32x4 a = ika; f32x4 b; b[0] = __shfl_xor(a[0], 8); b[1] = __shfl_xor(a[1], 8); b[2] = __shfl_xor(a[2], 8); b[3] = __shfl_xor(a[3], 8);
          float o[4];
#pragma unroll
          for (int e = 0; e < 4; ++e) o[e] = hi_half ? (a[e] * c64[e] + b[e] * s64[e]) : (a[e] * c64[e] - b[e] * s64[e]);
          u32x2 w; w.x = pk2(o[0], o[1]); w.y = pk2(o[2], o[3]); if (lane < 16) *(u32x2*)(KIB + (size_t)t * 64 + 4 * lane) = w; }
        if (lane < 4) WIF[t * 4 + lane] = iw * 0.0625f;
    }
    P0T1(4);
    { const float* KVM = wsp<float>(F, WS_KVMP); bf16_t* KMB = wsp<bf16_t>(F, WS_KMB); bf16_t* VMT = wsp<bf16_t>(F, WS_VMT);
      const float g0 = F.xk_norm_g[lane], g1 = F.xk_norm_g[lane + 64];
      for (int mm = gw; mm < MEML; mm += NGW) {
#pragma unroll
          for (int h = 0; h < 4; ++h) { float k0 = 0.f, k1 = 0.f;
#pragma unroll
              for (int ks = 0; ks < 8; ++ks) { k0 += KVM[(size_t)ks * 262144 + (size_t)mm * 1024 + h * 128 + lane]; k1 += KVM[(size_t)ks * 262144 + (size_t)mm * 1024 + h * 128 + lane + 64]; }
              const float ks2 = wave_sum(k0 * k0 + k1 * k1), kr = 1.0f / sqrtf(ks2 * (1.0f / 128.0f) + NORM_EPS);
              KMB[(size_t)mm * 512 + h * 128 + lane] = (bf16_t)f2bf(k0 * kr * g0); KMB[(size_t)mm * 512 + h * 128 + lane + 64] = (bf16_t)f2bf(k1 * kr * g1); }
#pragma unroll
          for (int j = 0; j < 8; ++j) { const int c = j * 64 + lane; float v = 0.f;
#pragma unroll
              for (int ks = 0; ks < 8; ++ks) v += KVM[(size_t)ks * 262144 + (size_t)mm * 1024 + 512 + c];
              VMT[(size_t)c * 256 + mm] = (bf16_t)f2bf(v); }
      } }
    P0T1(5);
    { LAS float* scr = (LAS float*)(F.lds + F.wave * 16640);
      bf16_t* WGUT = wsp<bf16_t>(F, WS_WGUT); bf16_t* WDT = wsp<bf16_t>(F, WS_WDT);
      constexpr int I_GU = 16 * 2 * 32 * 8, I_D = 16 * 8 * 32;
      auto dec = [&](int it, TrD& d) {
          d.nvalid = 64; d.dk0 = 0;
          if (it < I_GU) { const int e = it / 512, r = it % 512, up = r / 256, r2 = r % 256, kb = r2 / 8, nb = r2 % 8, f0 = nb * 64;
              const int drow = (f0 / 128) * 256 + up * 128 + (f0 % 128);
              d.W = (up ? F.w_eu : F.w_eg) + (size_t)e * DM * 512; d.ldw = 512; d.k0 = kb * 64; d.n0 = f0; d.gain = F.g_ffn; d.dst = WGUT + ((size_t)e * 1024 + drow) * DM; d.ldd = DM; }
          else { const int r = it - I_GU, e = r / 256, r2 = r % 256, kb = r2 / 32, nb = r2 % 32;
              d.W = F.w_ed + (size_t)e * 512 * DM; d.ldw = DM; d.k0 = kb * 64; d.n0 = nb * 64; d.gain = nullptr; d.dst = WDT + ((size_t)e * DM + nb * 64) * 512; d.ldd = 512; } };
      for (int it = gw; it < I_GU + I_D; it += 2 * NGW) {
          TrD d0, d1; dec(it, d0);
          if (it + NGW < I_GU + I_D) { dec(it + NGW, d1); tr_pair(d0, d1, lane); }
          else { f32x4 v[2][8]; float g[8]; tr_load(d0, v, g, lane); tr_store(d0, v, g, lane); }
      } }
}

constexpr int HS = 1025;
constexpr int P3_HIST = 0, P3_RING = 16 * HS * 4, P3_LMASK = P3_RING + 8 * 3 * 2048, P3_STATE = P3_LMASK + 16 * 256 * 4;
constexpr int P3_CAP = 384;
__device__ __forceinline__ float relu_s(float x) { const int b = __builtin_bit_cast(int, x); return __builtin_bit_cast(float, b > 0 ? b : 0); }
__device__ __forceinline__ void p3_scores(const bf16x8 A0, const bf16x8 A1, const bf16x8 (&Bq)[4][2], const float (&wq)[4], float (&sc)[4]) {
    f32x2_t s01 = {0.f, 0.f}, s23 = {0.f, 0.f};
#pragma unroll
    for (int h = 0; h < 4; ++h) { f32x4 d = (f32x4){0.f, 0.f, 0.f, 0.f};
        d = __builtin_amdgcn_mfma_f32_16x16x32_bf16(A0, Bq[h][0], d, 0, 0, 0); d = __builtin_amdgcn_mfma_f32_16x16x32_bf16(A1, Bq[h][1], d, 0, 0, 0);
        const f32x2_t w2 = {wq[h], wq[h]}, r01 = {relu_s(d[0]), relu_s(d[1])}, r23 = {relu_s(d[2]), relu_s(d[3])};
        s01 = __builtin_elementwise_fma(w2, r01, s01); s23 = __builtin_elementwise_fma(w2, r23, s23); }
    sc[0] = s01[0]; sc[1] = s01[1]; sc[2] = s23[0]; sc[3] = s23[1];
}
template <int MODE, bool ALLV> __device__ __forceinline__ void p3_update(LAS unsigned* hist, LAS unsigned* lmask, LAS unsigned* ccnt, const float (&sc)[4], unsigned vb,
                                                              int kt, int q, int fq, unsigned pref, unsigned thr, unsigned idxs, bool part) {
    const int s0 = 16 * kt;
    unsigned nib = 0u, cflag = 0u; unsigned ckey[4];
#pragma unroll
    for (int i = 0; i < 4; ++i) {
        const unsigned bits = __builtin_bit_cast(unsigned, sc[i]);
        const unsigned key = bits ^ ((unsigned)((int)bits >> 31) | 0x80000000u);
        const bool valid = ALLV ? true : (((vb >> i) & 1u) != 0u);
        const unsigned s = (unsigned)(s0 + 4 * fq + i);
        if constexpr (MODE == 0) { if (valid && part) { const unsigned dg = key >> 21; __hip_atomic_fetch_add(&hist[q * HS + (dg >> 1)], 1u << (16 * (dg & 1u)), __ATOMIC_RELAXED, __HIP_MEMORY_SCOPE_WORKGROUP); } }
        else if constexpr (MODE == 1) { if (valid && part && (key >> 21) == pref) { const unsigned dg = (key >> 10) & 2047u; __hip_atomic_fetch_add(&hist[q * HS + (dg >> 1)], 1u << (16 * (dg & 1u)), __ATOMIC_RELAXED, __HIP_MEMORY_SCOPE_WORKGROUP); } }
        else if constexpr (MODE == 2) { if (valid && part && (key >> 10) == pref) { const unsigned dg = key & 1023u; __hip_atomic_fetch_add(&hist[q * HS + (dg >> 1)], 1u << (16 * (dg & 1u)), __ATOMIC_RELAXED, __HIP_MEMORY_SCOPE_WORKGROUP); } }
        else if constexpr (MODE == 3) { if (valid && part && key == thr) { const unsigned dg = s >> 2; __hip_atomic_fetch_add(&hist[q * HS + (dg >> 1)], 1u << (16 * (dg & 1u)), __ATOMIC_RELAXED, __HIP_MEMORY_SCOPE_WORKGROUP); } }
        else if constexpr (MODE == 4) { if (valid && part && key == thr && (s >> 2) == pref) { const unsigned dg = s & 3u; __hip_atomic_fetch_add(&hist[q * HS + (dg >> 1)], 1u << (16 * (dg & 1u)), __ATOMIC_RELAXED, __HIP_MEMORY_SCOPE_WORKGROUP); } }
        else if constexpr (MODE == 5) { const bool sel = valid && (key > thr || (key == thr && s <= idxs)); nib |= sel ? (1u << i) : 0u; }
        else {
            const unsigned m13 = (bits & 0x7fffffffu) >> 18; const unsigned cl = m13 < 3168u ? 3168u : (m13 > 4191u ? 4191u : m13);
            const unsigned dg = (cl - 2144u) ^ ((unsigned)((int)bits >> 31) & 2047u);
            ckey[i] = key;
            if constexpr (MODE == 9) { if (valid) __hip_atomic_fetch_add(&hist[q * HS + (dg >> 1)], 1u << (16 * (dg & 1u)), __ATOMIC_RELAXED, __HIP_MEMORY_SCOPE_WORKGROUP); }
            else { nib |= (valid && dg > pref) ? (1u << i) : 0u; cflag |= (valid && dg == pref) ? (1u << i) : 0u; } }
    }
    if constexpr (MODE == 10) {
        if (cflag) { __hip_atomic_fetch_or(&hist[q * HS + 768 + (kt >> 1)], cflag << (16 * (kt & 1) + 4 * fq), __ATOMIC_RELAXED, __HIP_MEMORY_SCOPE_WORKGROUP);
            if (part) { unsigned sl = __hip_atomic_fetch_add(&ccnt[q], (unsigned)__builtin_popcount(cflag), __ATOMIC_RELAXED, __HIP_MEMORY_SCOPE_WORKGROUP);
#pragma unroll
                for (int i = 0; i < 4; ++i) if ((cflag >> i) & 1u) { if (sl < (unsigned)P3_CAP) { hist[q * HS + 2 * sl] = ckey[i]; hist[q * HS + 2 * sl + 1] = (unsigned)(s0 + 4 * fq + i); } ++sl; } } }
    }
    if constexpr (MODE == 5 || MODE == 10) { if (nib) __hip_atomic_fetch_or(&lmask[q * 256 + (kt >> 1)], nib << (16 * (kt & 1) + 4 * fq), __ATOMIC_RELAXED, __HIP_MEMORY_SCOPE_WORKGROUP); }
}
template <int MODE> __device__ __forceinline__ void p3_sweep(Frame& F, int b, const bf16x8 (&Bq)[4][2], const float (&wq)[4], unsigned pref, unsigned thr, unsigned idxs, bool part, int dtype = 0) {
    const char* KIBc = (const char*)wsp<bf16_t>(F, WS_KIB);
    LAS unsigned* hist = (LAS unsigned*)(F.lds + P3_HIST); LAS unsigned* lmask = (LAS unsigned*)(F.lds + P3_LMASK); LAS unsigned* ccnt = (LAS unsigned*)(F.lds + P3_STATE) + 80;
    const int lane = F.lane, q = lane & 15, fq = lane >> 4;
    const unsigned goff = (unsigned)(q * 128 + fq * 16);
    unsigned dbits = 0u;
#pragma unroll
    for (int i = 0; i < 4; ++i) dbits |= (4 * fq + i <= q) ? (1u << i) : 0u;
    const int nj = (b >= F.wave) ? ((b - F.wave) >> 3) + 1 : 0;
#define P3_LD(j, a0, a1) do { int _kt = F.wave + 8 * (j); _kt = _kt < b ? _kt : b; const char* _src = KIBc + (size_t)_kt * 2048 + goff; a0 = *(const bf16x8*)(_src); a1 = *(const bf16x8*)(_src + 64); } while (0)
    bf16x8 C00, C01, C10, C11;
    if (nj > 0) { P3_LD(0, C00, C01); P3_LD(1, C10, C11); }
    for (int j = 0; j < nj; j += 2) {
        bf16x8 N00, N01, N10, N11;
        P3_LD(j + 2, N00, N01); P3_LD(j + 3, N10, N11);
        float sa[4], sb[4];
        p3_scores(C00, C01, Bq, wq, sa); p3_scores(C10, C11, Bq, wq, sb);
        const int kt0 = F.wave + 8 * j, kt1 = kt0 + 8;
        if (kt1 < b) {
            p3_update<MODE, true>(hist, lmask, ccnt, sa, 0xFu, kt0, q, fq, pref, thr, idxs, part);
            p3_update<MODE, true>(hist, lmask, ccnt, sb, 0xFu, kt1, q, fq, pref, thr, idxs, part);
        } else {
            p3_update<MODE, false>(hist, lmask, ccnt, sa, kt0 < b ? 0xFu : dbits, kt0, q, fq, pref, thr, idxs, part);
            if (kt1 == b) p3_update<MODE, false>(hist, lmask, ccnt, sb, dbits, kt1, q, fq, pref, thr, idxs, part);
        }
        C00 = N00; C01 = N01; C10 = N10; C11 = N11;
    }
#undef P3_LD
}
__device__ __forceinline__ void p3_scan(Frame& F, bool fromtop) {
    LAS unsigned* hist = (LAS unsigned*)(F.lds + P3_HIST); LAS unsigned* st = (LAS unsigned*)(F.lds + P3_STATE);
    __syncthreads();
    const int lane = F.lane;
#pragma unroll 1
    for (int rr = 0; rr < 2; ++rr) {
        const int row = 2 * F.wave + rr;
        if (st[row * 4 + 3] == 0u) continue;
        const unsigned rank = st[row * 4 + 1];
        unsigned wv[16]; unsigned sj = 0;
#pragma unroll
        for (int i = 0; i < 16; ++i) { wv[i] = hist[row * HS + 16 * lane + i]; sj += (wv[i] & 0xffffu) + (wv[i] >> 16); }
        unsigned P = sj;
#pragma unroll
        for (int o = 1; o < 64; o <<= 1) { const unsigned v = __shfl_up(P, o); if (lane >= o) P += v; }
        const unsigned T = __shfl(P, 63);
        unsigned cum = fromtop ? (T - P) : (P - sj);
        const bool cross = (cum < rank) && (rank <= cum + sj);
        unsigned bin = 0, cb = 0; bool found = false;
#pragma unroll
        for (int ii = 0; ii < 32; ++ii) { const int bl = fromtop ? 31 - ii : ii; const unsigned w = wv[bl >> 1]; const unsigned c = (bl & 1) ? (w >> 16) : (w & 0xffffu);
            const bool hit = !found && (cum + c >= rank);
            if (hit) { bin = (unsigned)(32 * lane + bl); cb = c; found = true; }
            if (!found) cum += c; }
        if (cross) { st[row * 4 + 0] = bin; st[row * 4 + 1] = rank - cum; st[row * 4 + 2] = cb; }
    }
    __syncthreads();
}
__device__ __forceinline__ unsigned wave_count(bool p) { return (unsigned)__builtin_popcountll(__ballot(p)); }
__device__ __forceinline__ void p3_select_row(Frame& F, int row, int shift) {
    LAS unsigned* cand = (LAS unsigned*)(F.lds + P3_HIST) + row * HS; LAS unsigned* lmask = (LAS unsigned*)(F.lds + P3_LMASK) + row * 256; LAS unsigned* st = (LAS unsigned*)(F.lds + P3_STATE);
    const unsigned bin0 = st[row * 4 + 0], rank = st[row * 4 + 1], nc = st[row * 4 + 2];
    const int lane = F.lane;
    unsigned ck[8], ci[8];
#pragma unroll
    for (int i = 0; i < 8; ++i) { const unsigned sl = (unsigned)(lane + 64 * i); const bool ok = sl < nc; ck[i] = ok ? cand[2 * sl] : 0u; ci[i] = ok ? cand[2 * sl + 1] : 0x7fffffffu; }
    unsigned P = 0u; (void)bin0; (void)shift;
#pragma unroll 1
    for (int bit = 31; bit >= 0; --bit) { const unsigned trial = P | (1u << bit); unsigned c = 0;
#pragma unroll
        for (int i = 0; i < 8; ++i) c += wave_count(ck[i] >= trial);
        if (c >= rank) P = trial; }
    const unsigned thr = P; unsigned cg = 0, ce = 0;
#pragma unroll
    for (int i = 0; i < 8; ++i) { cg += wave_count(ck[i] > thr); ce += wave_count(ck[i] == thr); }
    const unsigned quota = rank - cg; unsigned idxs = 0x7fffffffu;
    if (ce > quota) {
        unsigned X = 0;
#pragma unroll 1
        for (int bit = 12; bit >= 0; --bit) { const unsigned trial = X | (1u << bit); unsigned c = 0;
#pragma unroll
            for (int i = 0; i < 8; ++i) c += wave_count(ck[i] == thr && ci[i] < trial);
            if (c < quota) X = trial; }
        idxs = X;
    }
#pragma unroll
    for (int i = 0; i < 8; ++i) { const bool sel = (ck[i] > thr) || (ck[i] == thr && ci[i] <= idxs);
        if (sel && ci[i] != 0x7fffffffu) __hip_atomic_fetch_or(&lmask[ci[i] >> 5], 1u << (ci[i] & 31u), __ATOMIC_RELAXED, __HIP_MEMORY_SCOPE_WORKGROUP); }
}
__device__ __forceinline__ void p3_select_zero(Frame& F, int row) {
    LAS unsigned* zm = (LAS unsigned*)(F.lds + P3_HIST) + row * HS + 768; LAS unsigned* lmask = (LAS unsigned*)(F.lds + P3_LMASK) + row * 256; LAS unsigned* st = (LAS unsigned*)(F.lds + P3_STATE);
    const unsigned quota = st[row * 4 + 1]; const int lane = F.lane;
    unsigned w[4]; unsigned pc = 0;
#pragma unroll
    for (int i = 0; i < 4; ++i) { w[i] = zm[4 * lane + i]; pc += (unsigned)__builtin_popcount(w[i]); }
    unsigned P = pc;
#pragma unroll
    for (int o = 1; o < 64; o <<= 1) { const unsigned v = __shfl_up(P, o); if (lane >= o) P += v; }
    unsigned cum = P - pc;
#pragma unroll
    for (int i = 0; i < 4; ++i) { unsigned ww = w[i]; const unsigned c = (unsigned)__builtin_popcount(ww);
        if (cum >= quota) ww = 0u;
        else if (cum + c > quota) { const unsigned keep = quota - cum; while ((unsigned)__builtin_popcount(ww) > keep) ww &= ~(0x80000000u >> __builtin_clz(ww)); }
        cum += c;
        if (ww) __hip_atomic_fetch_or(&lmask[4 * lane + i], ww, __ATOMIC_RELAXED, __HIP_MEMORY_SCOPE_WORKGROUP); }
}
__device__ __forceinline__ void p3_zero_hist(Frame& F) {
    LAS unsigned* hist = (LAS unsigned*)(F.lds + P3_HIST);
    for (int i = F.tid; i < 16 * HS; i += NTHR) hist[i] = 0u;
}
#define P3T0() unsigned long long _pt = (P3_PROF && F.tid == 0) ? __builtin_amdgcn_s_memrealtime() : 0ull
#define P3T1(k) do { if (P3_PROF == (k) && F.tid == 0) { volatile LAS unsigned* _m = F.MISC + 16; const unsigned long long _d = __builtin_amdgcn_s_memrealtime() - _pt; _m[0] = _m[0] + (unsigned)_d; } } while (0)
__device__ __forceinline__ void p3_block(Frame& F, int b) {
    const bf16_t* QIB = wsp<bf16_t>(F, WS_QIB); const float* WIF = wsp<float>(F, WS_WIF); unsigned* MASK = wsp<unsigned>(F, WS_MASK);
    LAS unsigned* st = (LAS unsigned*)(F.lds + P3_STATE); LAS unsigned* lmask = (LAS unsigned*)(F.lds + P3_LMASK);
    const int lane = F.lane, q = lane & 15, fq = lane >> 4, t0 = 16 * b;
    bf16x8 Bq[4][2]; float wq[4];
#pragma unroll
    for (int h = 0; h < 4; ++h) { Bq[h][0] = *(const bf16x8*)(QIB + (size_t)(t0 + q) * 256 + h * 64 + 8 * fq); Bq[h][1] = *(const bf16x8*)(QIB + (size_t)(t0 + q) * 256 + h * 64 + 32 + 8 * fq); wq[h] = WIF[(t0 + q) * 4 + h]; }
    __syncthreads();
    for (int i = F.tid; i < 16 * 256; i += NTHR) lmask[i] = 0u;
    if (b >= 16) {
        const int dtype = 0;
        p3_zero_hist(F);
        if (F.tid < 16) { st[F.tid * 4 + 0] = 0u; st[F.tid * 4 + 1] = 256u; st[F.tid * 4 + 2] = 0u; st[F.tid * 4 + 3] = 1u; st[80 + F.tid] = 0u; }
        if (F.tid == 0) st[64] = 0u;
        if (fq == 0) st[96 + q] = (unsigned)dtype;
        __syncthreads();
        { P3T0(); p3_sweep<9>(F, b, Bq, wq, 0u, 0u, 0u, true, dtype); P3T1(1); P3T1(4); } { P3T0(); p3_scan(F, true); P3T1(2); }
        if (F.tid < 16) { const unsigned bn = st[F.tid * 4 + 0], cn = st[F.tid * 4 + 2]; const unsigned dt = 0u; (void)dt;
            const unsigned cls = (bn == 1024u) ? 1u : (cn <= (unsigned)P3_CAP ? 0u : 2u);
            st[112 + F.tid] = cls; if (cls == 2u) st[64] = 1u;
            if (P3_PROF >= 11 && cls == 2u) { const int cause = (dt == 1u) ? (bn == 0u ? 11 : 12) : (dt == 2u ? 13 : 14); if (cause == P3_PROF && b >= 128) atomicAdd(F.ctl + CW_QUEUE + 8, 1u); } }
        __syncthreads();
        const unsigned bin0 = st[q * 4 + 0];
        if (st[64] == 0u) {
            for (int i = F.tid; i < 16 * 256; i += NTHR) ((LAS unsigned*)(F.lds + P3_HIST))[(i >> 8) * HS + 768 + (i & 255)] = 0u;
            __syncthreads();
            { P3T0(); p3_sweep<10>(F, b, Bq, wq, bin0, 0u, 0u, st[112 + q] == 0u, dtype); P3T1(1); P3T1(5); }
            __syncthreads();
            { P3T0();
#pragma unroll 1
              for (int rr = 0; rr < 2; ++rr) { const int row = 2 * F.wave + rr; if (st[112 + row] == 0u) p3_select_row(F, row, st[96 + row] ? 20 : 21); else p3_select_zero(F, row); }
              __syncthreads(); P3T1(3); }
        } else {
            if (P3_PROF == 6 && F.tid == 0) atomicAdd(F.ctl + CW_QUEUE + 8, 1u);
            __syncthreads(); p3_zero_hist(F);
            if (F.tid < 16) { st[F.tid * 4 + 0] = 0u; st[F.tid * 4 + 1] = 256u; st[F.tid * 4 + 2] = 0u; st[F.tid * 4 + 3] = 1u; }
            __syncthreads();
            { P3T0(); p3_sweep<0>(F, b, Bq, wq, 0u, 0u, 0u, true); P3T1(1); } { P3T0(); p3_scan(F, true); P3T1(2); }
            unsigned pref = st[q * 4 + 0];
            __syncthreads(); p3_zero_hist(F); __syncthreads();
            { P3T0(); p3_sweep<1>(F, b, Bq, wq, pref, 0u, 0u, true); P3T1(1); } { P3T0(); p3_scan(F, true); P3T1(2); }
            pref = (pref << 11) | st[q * 4 + 0];
            __syncthreads(); p3_zero_hist(F); __syncthreads();
            { P3T0(); p3_sweep<2>(F, b, Bq, wq, pref, 0u, 0u, true); P3T1(1); } { P3T0(); p3_scan(F, true); P3T1(2); }
            const unsigned thr = (pref << 10) | st[q * 4 + 0];
            const unsigned quota = st[q * 4 + 1], cnteq = st[q * 4 + 2];
            const bool tie = cnteq > quota; unsigned idxs = 0x7fffffffu;
            __syncthreads();
            if (F.tid == 0) st[64] = 0u;
            __syncthreads();
            if (tie && fq == 0) st[64] = 1u;
            if (F.tid < 16) st[F.tid * 4 + 3] = (st[F.tid * 4 + 2] > st[F.tid * 4 + 1]) ? 1u : 0u;
            __syncthreads();
            if (st[64]) {
                p3_zero_hist(F); __syncthreads();
                { P3T0(); p3_sweep<3>(F, b, Bq, wq, 0u, thr, 0u, tie); P3T1(1); } { P3T0(); p3_scan(F, false); P3T1(2); }
                const unsigned ip = st[q * 4 + 0];
                __syncthreads(); p3_zero_hist(F); __syncthreads();
                { P3T0(); p3_sweep<4>(F, b, Bq, wq, ip, thr, 0u, tie); P3T1(1); } { P3T0(); p3_scan(F, false); P3T1(2); }
                if (tie) idxs = (ip << 2) | st[q * 4 + 0];
            }
            __syncthreads();
            { P3T0(); p3_sweep<5>(F, b, Bq, wq, 0u, thr, idxs, true); P3T1(1); }
        }
    } else {
        __syncthreads();
        { P3T0(); p3_sweep<5>(F, b, Bq, wq, 0u, 0u, 0x7fffffffu, true); P3T1(1); }
    }
    __syncthreads();
    { const int qb = t0 >> 8, lr0 = t0 & 255, nkt = 4 * (qb + 1), row = (F.tid >> 1) & 15, wl = F.tid & 1;
      for (int kt = F.tid >> 5; kt < nkt; kt += 16) MASK[((size_t)(qb * 128 + kt) * 256 + lr0 + row) * 2 + wl] = lmask[row * 256 + 2 * kt + wl]; }
}
__device__ __forceinline__ void p3_indexer(Frame& F) {
    const unsigned long long t0 = (P3_PROF >= 7 && F.tid == 0) ? __builtin_amdgcn_s_memrealtime() : 0ull;
    LAS int* qs = (LAS int*)(F.lds + LDSCTL_OFF + 256);
    for (;;) {
        __syncthreads();
        if (F.tid == 0) qs[0] = (int)atomicAdd(F.ctl + CW_QUEUE + 1, 1u);
        __syncthreads();
        const int idx = qs[0];
        if (idx >= 512) break;
        p3_block(F, 511 - idx);
    }
    __syncthreads();
    if (P3_PROF == 7 && F.tid == 0) atomicMax(F.ctl + CW_QUEUE + 8, (unsigned)(__builtin_amdgcn_s_memrealtime() - t0));
    if (P3_PROF == 8 && F.tid == 0) atomicMin(F.ctl + CW_QUEUE + 9, (unsigned)(__builtin_amdgcn_s_memrealtime() - t0));
}

constexpr int N_ATT_UNITS = 608;
constexpr size_t SLOT_FLOATS = 256 * 128 + 256;
__device__ __forceinline__ int cum_chunks(int qb) { const int n1 = qb, a = n1 >> 3, bb = n1 & 7; return 4 * a * (a + 1) + bb * (a + 1); }
constexpr int AT_K = 0, AT_V = 16384, AT_M = 32768, AT_STAGE = 34816, AT_EPI = 3 * AT_STAGE;
template <bool MASKED>
__device__ __forceinline__ void attn_unit(LAS unsigned char* lds, const bf16_t* Qh, int ldq, const bf16_t* Kh, int ldk, const bf16_t* Vth, int ldvt, const unsigned* maskt  ,
                                          int q0, int key0, int ntl, bool final, float* slot, bf16_t* outb  , int tid_in, int wave, int lane_in) {
    int tid = tid_in, lane = lane_in; asm volatile("" : "+v"(tid), "+v"(lane));
    const int q = lane & 31, hh = lane >> 5, qrow = q0 + 32 * wave + q;
    bf16x8 qf[8];
#pragma unroll
    for (int d0 = 0; d0 < 8; ++d0) qf[d0] = *(const bf16x8*)(Qh + (size_t)qrow * ldq + 16 * d0 + 8 * hh);
    const char* kbase = (const char*)(Kh + (size_t)key0 * ldk); const char* vbase = (const char*)(Vth + key0); const char* mbase = (const char*)(maskt + (size_t)(key0 >> 6) * 512);
    const unsigned ldsw16 = (unsigned)wave * 1024u, ldsw4 = (unsigned)wave * 256u;
#define AT_ISSUE(t, st) do { int _tid = tid; asm volatile("" : "+v"(_tid)); LAS unsigned char* _b = lds + (st) * AT_STAGE; const char* _kb = kbase + (size_t)(t) * 64 * ldk * 2; const char* _vb = vbase + (size_t)(t) * 128; \
        _Pragma("unroll") for (int _j = 0; _j < 2; ++_j) { const int _p = _tid + 512 * _j; const int _kr = _p >> 4, _kc = (_p & 15) ^ (_kr & 15); const int _vr = _p >> 3, _vc = (_p & 7) ^ ((_vr >> 1) & 7); \
            __builtin_amdgcn_global_load_lds((const unsigned*)(_kb + (unsigned)(_kr * ldk * 2 + _kc * 16)), (LAS unsigned*)(_b + AT_K + ldsw16 + _j * 8192), 16, 0, 0); \
            __builtin_amdgcn_global_load_lds((const unsigned*)(_vb + (unsigned)(_vr * ldvt * 2 + _vc * 16)), (LAS unsigned*)(_b + AT_V + ldsw16 + _j * 8192), 16, 0, 0); } \
        if (MASKED) __builtin_amdgcn_global_load_lds((const unsigned*)(mbase + (size_t)(t) * 2048 + (unsigned)_tid * 4u), (LAS unsigned*)(_b + AT_M + ldsw4), 4, 0, 0); } while (0)
    const int prow = (q & 0x13) | ((q & 4) << 1) | ((q & 8) >> 1);
    const int ky = hh ^ (prow & 15), vw = hh ^ ((q >> 1) & 7);
    int kaddr[8];
#pragma unroll
    for (int d0 = 0; d0 < 8; ++d0) kaddr[d0] = AT_K + prow * 256 + (((2 * d0) ^ ky) << 4);
    const int vrow = AT_V + q * 128;
#define vaddr_(s) (vrow + ((((2 * (s)) ^ vw)) << 4))
    const int maddr = AT_M + (32 * wave + q) * 8;
    f32x16 o[4];
#pragma unroll
    for (int d = 0; d < 4; ++d)
#pragma unroll
        for (int r = 0; r < 16; ++r) o[d][r] = 0.f;
    float l = 0.f;
#define AT_QK(S, SB, BT) do { _Pragma("unroll") for (int _r = 0; _r < 16; ++_r) S[_r] = 0.f; \
        _Pragma("unroll") for (int _d = 0; _d < 8; ++_d) { const bf16x8 _kf = *(const LAS bf16x8*)((SB) + kaddr[_d] + (BT) * 8192); S = __builtin_amdgcn_mfma_f32_32x32x16_bf16(_kf, qf[_d], S, 0, 0, 0); } } while (0)
#define AT_SM(S, MW) do { _Pragma("unroll") for (int _s = 0; _s < 2; ++_s) { float _p[8]; \
        _Pragma("unroll") for (int _j = 0; _j < 8; ++_j) { const int _r = 8 * _s + _j; float _e = __builtin_amdgcn_exp2f(S[_r]); if (MASKED) _e = __builtin_bit_cast(float, __builtin_bit_cast(unsigned, _e) & (unsigned)__builtin_amdgcn_sbfe((int)(MW), (unsigned)((_r & 7) + 16 * (_r >> 3)), 1u)); _p[_j] = _e; l += _e; } \
        u32x4 _w; _w.x = pk2(_p[0], _p[1]); _w.y = pk2(_p[2], _p[3]); _w.z = pk2(_p[4], _p[5]); _w.w = pk2(_p[6], _p[7]); pf[_s] = __builtin_bit_cast(bf16x8, _w); } } while (0)
#define AT_PV(SB, BT) do { _Pragma("unroll") for (int _d = 0; _d < 4; ++_d) _Pragma("unroll") for (int _s = 0; _s < 2; ++_s) { \
        const bf16x8 _vf = *(const LAS bf16x8*)((SB) + vaddr_(2 * (BT) + _s) + _d * 4096); o[_d] = __builtin_amdgcn_mfma_f32_32x32x16_bf16(_vf, pf[_s], o[_d], 0, 0, 0); } } while (0)
#define AT_MW(SB, BT) (MASKED ? (*(const LAS unsigned*)((SB) + maddr + (BT) * 4) >> (8 * hh)) : 0xffffffffu)
    AT_ISSUE(0, 0);
    if (ntl > 1) AT_ISSUE(1, 1);
    if (ntl > 1) { if (MASKED) asm volatile("s_waitcnt vmcnt(5)" ::: "memory"); else asm volatile("s_waitcnt vmcnt(4)" ::: "memory"); }
    else asm volatile("s_waitcnt vmcnt(0)" ::: "memory");
    __builtin_amdgcn_s_barrier(); asm volatile("" ::: "memory");
    f32x16 sc, sn; bf16x8 pf[2];
    AT_QK(sc, lds, 0);
    int st = 0;
    for (int t = 0; t < ntl; ++t) {
        LAS unsigned char* sb = lds + st * AT_STAGE;
        const int stn = (st == 2) ? 0 : st + 1;
        LAS unsigned char* sbn = lds + stn * AT_STAGE;
        { const unsigned mw = AT_MW(sb, 0);
          AT_QK(sn, sb, 1); AT_SM(sc, mw); }
        __builtin_amdgcn_sched_barrier(0);
        AT_PV(sb, 0);
        __builtin_amdgcn_sched_barrier(0);
        if (t + 1 < ntl) asm volatile("s_waitcnt vmcnt(0)" ::: "memory");
        __builtin_amdgcn_s_barrier(); asm volatile("" ::: "memory");
        if (t + 2 < ntl) { const int st2 = (st >= 1) ? st - 1 : 2; AT_ISSUE(t + 2, st2); }
        __builtin_amdgcn_sched_barrier(0);
        { const unsigned mw = AT_MW(sb, 1);
          if (t + 1 < ntl) { AT_QK(sc, sbn, 0); AT_SM(sn, mw); } else { AT_SM(sn, mw); } }
        __builtin_amdgcn_sched_barrier(0);
        AT_PV(sb, 1);
        __builtin_amdgcn_sched_barrier(0);
        st = stn;
    }
#undef vaddr_
#undef AT_QK
#undef AT_SM
#undef AT_PV
#undef AT_MW
#undef AT_ISSUE
    l += __shfl_xor(l, 32);
    int lane_e = lane; asm volatile("" : "+v"(lane_e));
    const int qe = lane_e & 31, he = lane_e >> 5;
    LAS float* stg = (LAS float*)(lds + AT_EPI + wave * 4608);
    const int trow = q0 + 32 * wave;
    const float inv = final ? 1.0f / l : 1.0f;
#pragma unroll
    for (int d = 0; d < 4; ++d) {
#pragma unroll
        for (int r = 0; r < 16; ++r) stg[qe * 36 + crow(r, he)] = o[d][r] * inv;
        LDS_WAIT(); asm volatile("" ::: "memory");
#pragma unroll
        for (int i = 0; i < 4; ++i) { const int row = 8 * i + (lane_e >> 3), c4 = lane_e & 7; const f32x4 v = *(const LAS f32x4*)(stg + row * 36 + 4 * c4);
            if (final) { u32x2 w; w.x = pk2(v[0], v[1]); w.y = pk2(v[2], v[3]); *(u32x2*)(outb + (size_t)(trow + row) * DM + 32 * d + 4 * c4) = w; }
            else *(f32x4*)(slot + (size_t)(32 * wave + row) * 128 + 32 * d + 4 * c4) = v; }
        LDS_WAIT(); asm volatile("" ::: "memory");
    }
    if (!final && he == 0) slot[256 * 128 + 32 * wave + qe] = l;
}
__device__ __forceinline__ void att_build_table(Frame& F) {
    LAS int* cnt = (LAS int*)F.lds; int* TB = wsp<int>(F, WS_ATTBL);
    if (F.tid < 40) cnt[F.tid] = 0;
    __syncthreads();
    int e0[2], e1[2], nl[2];
#pragma unroll
    for (int r = 0; r < 2; ++r) { const int id = F.tid + 512 * r; nl[r] = 0; e0[r] = 0; e1[r] = 0;
        if (id < 768) { const int h = id >> 7, n = ((id >> 2) & 31) + 1, ch = id & 3, k = (n + 7) >> 3;
            if (ch < k) { const int nt = 4 * n, base = nt / k, rem = nt % k; const int len = base + (ch < rem ? 1 : 0), start = ch * base + (ch < rem ? ch : rem);
                const int qb = n - 1; nl[r] = len; e0[r] = 0 | (h << 1) | (qb << 4) | ((k == 1 ? 1 : 0) << 9) | (len << 10); e1[r] = start | ((h * 80 + cum_chunks(qb) + ch) << 8); } }
        else if (id < 896) { const int c = id - 768; nl[r] = 4; e0[r] = 1 | ((c >> 5) << 1) | ((c & 31) << 4) | (1 << 9) | (4 << 10); e1[r] = 0; }
        if (nl[r]) __hip_atomic_fetch_add(&cnt[nl[r]], 1, __ATOMIC_RELAXED, __HIP_MEMORY_SCOPE_WORKGROUP); }
    __syncthreads();
    if (F.tid == 0) { int o = 0; for (int l = 32; l >= 1; --l) { const int c = cnt[l]; cnt[l] = o; o += c; } }
    __syncthreads();
#pragma unroll
    for (int r = 0; r < 2; ++r) if (nl[r]) { const int pos = __hip_atomic_fetch_add(&cnt[nl[r]], 1, __ATOMIC_RELAXED, __HIP_MEMORY_SCOPE_WORKGROUP); TB[2 * pos] = e0[r]; TB[2 * pos + 1] = e1[r]; }
    __syncthreads();
}
__device__ __forceinline__ void p4_attention(Frame& F) {
    const bf16_t* Q = wsp<bf16_t>(F, WS_Q); const bf16_t* K = wsp<bf16_t>(F, WS_K); const bf16_t* VT = wsp<bf16_t>(F, WS_VT); const bf16_t* XQ = wsp<bf16_t>(F, WS_XQ);
    const bf16_t* KMB = wsp<bf16_t>(F, WS_KMB); const bf16_t* VMT = wsp<bf16_t>(F, WS_VMT); const unsigned* MASK = wsp<unsigned>(F, WS_MASK); bf16_t* AM = wsp<bf16_t>(F, WS_AMRG);
    float* OPS = F.out;
    LAS int* qslot = (LAS int*)(F.lds + LDSCTL_OFF + 256);
    for (;;) {
        __syncthreads();
        if (F.tid == 0) qslot[0] = (int)atomicAdd(F.ctl + CW_QUEUE, 1u);
        __syncthreads();
        const int idx = qslot[0];
        if (idx >= N_ATT_UNITS) break;
        const int* TB = wsp<int>(F, WS_ATTBL); const int e0 = TB[2 * idx], e1 = TB[2 * idx + 1];
        const int type = e0 & 1, h = (e0 >> 1) & 7, qb = (e0 >> 4) & 31, fin = (e0 >> 9) & 1, ntl = (e0 >> 10) & 63, kt0 = e1 & 255, slot = e1 >> 8;
        if (type == 0) attn_unit<true>(F.lds, Q + h * 128, 768, K + h * 128, 768, VT + (size_t)h * 128 * SEQ, SEQ, MASK + (size_t)qb * 128 * 512, qb * 256, kt0 * 64, ntl, fin != 0,
                                       OPS + (size_t)slot * SLOT_FLOATS, AM + 768 + h * 128, F.tid, F.wave, F.lane);
        else attn_unit<false>(F.lds, XQ + h * 128, 512, KMB + h * 128, 512, VMT + (size_t)h * 128 * 256, 256, nullptr, qb * 256, 0, 4, true, nullptr, AM + 1536 + h * 128, F.tid, F.wave, F.lane);
    }
}
__device__ __forceinline__ void p5_finalize(Frame& F) {
    const float* OPS = F.out; bf16_t* AM = wsp<bf16_t>(F, WS_AMRG);
    const int gw = F.vcu * NWAVES + F.wave, NGW = F.G * NWAVES, lane = F.lane, half = lane >> 5, c4 = lane & 31;
    for (int it = gw; it < 6 * 24 * 128; it += NGW) {
        const int rp = it & 127, hq = it >> 7, h = hq / 24, qb = 8 + hq % 24, row = 2 * rp + half;
        const int nch = (qb + 8) >> 3;
        const float* base = OPS + (size_t)(h * 80 + cum_chunks(qb)) * SLOT_FLOATS;
        f32x4 v[4]; float lv[4];
#pragma unroll
        for (int c = 0; c < 4; ++c) { const bool ok = c < nch; const float* b = base + (size_t)(ok ? c : 0) * SLOT_FLOATS; v[c] = *(const f32x4*)(b + (size_t)row * 128 + 4 * c4); lv[c] = b[256 * 128 + row];
            if (!ok) { v[c] = (f32x4){0.f, 0.f, 0.f, 0.f}; lv[c] = 0.f; } }
        const f32x4 sv = (v[0] + v[1]) + (v[2] + v[3]); const float inv = 1.0f / ((lv[0] + lv[1]) + (lv[2] + lv[3]));
        u32x2 w; w.x = pk2(sv[0] * inv, sv[1] * inv); w.y = pk2(sv[2] * inv, sv[3] * inv);
        *(u32x2*)(AM + (size_t)(qb * 256 + row) * DM + 768 + h * 128 + 4 * c4) = w;
    }
}

struct SchedTile {
    int c, G, nM, nN; const char* A; const char* B; size_t tA, tB;
    __device__ __forceinline__ bool next(int i, pg8::Unit& u) const {
        const int L = i * G + c; if (L >= nM * nN) return false; int pm, pn; pg8::tile_order(L, nM, nN, pm, pn);
        u.A = A + (size_t)pm * tA; u.B = B + (size_t)pn * tB; u.Bhi = u.B; u.kind = 0; u.row0 = pm * 256; u.col0 = pn * 256; u.aux = 0; u.nt = 32; u.lowonly = 0; return true; }
};
struct EpiMrg {
    static constexpr bool HOOK = true; static constexpr int HOOK_T1 = 12, HOOK_T2 = 24;
    const bf16_t* EG; bf16_t* MRG;
    __device__ __forceinline__ void hook(f32x4 (&acc)[2][2][4][2], const pg8::Unit& u, int t, int wr, int wc, int fr, int fq) const {
        const int seg = (t == HOOK_T1) ? 0 : 1;
        const unsigned off0 = ((unsigned)(u.row0 + wr * 64 + fr) * 6144u + (unsigned)(seg * 2048 + u.col0 + wc * 32 + 8 * fq)) * 2u;
        const char* eg = (const char*)EG;
#pragma unroll
        for (int ai = 0; ai < 2; ++ai)
#pragma unroll
            for (int m = 0; m < 4; ++m) {
#pragma unroll
                for (int bj = 0; bj < 2; ++bj) { const unsigned off = off0 + (unsigned)((ai * 128 + m * 16) * 6144 + bj * 128) * 2u;
                    const u32x4 ea = *(const u32x4*)(eg + off), eb = *(const u32x4*)(eg + off + 4096u);
                    f32x4 r0, r1;
                    r0[0] = bflo(eb.x) * __builtin_amdgcn_rcpf(bflo(ea.x)); r0[1] = bfhi(eb.x) * __builtin_amdgcn_rcpf(bfhi(ea.x)); r0[2] = bflo(eb.y) * __builtin_amdgcn_rcpf(bflo(ea.y)); r0[3] = bfhi(eb.y) * __builtin_amdgcn_rcpf(bfhi(ea.y));
                    r1[0] = bflo(eb.z) * __builtin_amdgcn_rcpf(bflo(ea.z)); r1[1] = bfhi(eb.z) * __builtin_amdgcn_rcpf(bfhi(ea.z)); r1[2] = bflo(eb.w) * __builtin_amdgcn_rcpf(bflo(ea.w)); r1[3] = bfhi(eb.w) * __builtin_amdgcn_rcpf(bfhi(ea.w));
                    acc[ai][bj][m][0] *= r0; acc[ai][bj][m][1] *= r1; }
                asm volatile("" ::: "memory"); }
    }
    __device__ __forceinline__ void operator()(const f32x4 (&acc)[2][2][4][2], const pg8::Unit& u, int wr, int wc, int fr, int fq) const {
        const int rbase = u.row0 + wr * 64 + fr, cbase = u.col0 + wc * 32 + 8 * fq;
#pragma unroll
        for (int ai = 0; ai < 2; ++ai)
#pragma unroll
            for (int m = 0; m < 4; ++m) { const int row = rbase + ai * 128 + m * 16;
#pragma unroll
                for (int bj = 0; bj < 2; ++bj) { const u32x4 e = *(const u32x4*)(EG + (size_t)row * 6144 + 4096 + cbase + bj * 128);
                    const f32x4 a0 = acc[ai][bj][m][0], a1 = acc[ai][bj][m][1];
                    u32x4 w;
                    w.x = pk2(a0[0] * __builtin_amdgcn_rcpf(bflo(e.x)), a0[1] * __builtin_amdgcn_rcpf(bfhi(e.x))); w.y = pk2(a0[2] * __builtin_amdgcn_rcpf(bflo(e.y)), a0[3] * __builtin_amdgcn_rcpf(bfhi(e.y)));
                    w.z = pk2(a1[0] * __builtin_amdgcn_rcpf(bflo(e.z)), a1[1] * __builtin_amdgcn_rcpf(bfhi(e.z))); w.w = pk2(a1[2] * __builtin_amdgcn_rcpf(bflo(e.w)), a1[3] * __builtin_amdgcn_rcpf(bfhi(e.w)));
                    *(u32x4*)(MRG + (size_t)row * DM + cbase + bj * 128) = w; } }
    }
};
struct EpiRes {
    static constexpr bool HOOK = false; static constexpr int HOOK_T1 = -1, HOOK_T2 = -1;
    const float* x; float* out; bf16_t* X1B;
    __device__ __forceinline__ void hook(f32x4 (&)[2][2][4][2], const pg8::Unit&, int, int, int, int, int) const {}
    __device__ __forceinline__ void operator()(const f32x4 (&acc)[2][2][4][2], const pg8::Unit& u, int wr, int wc, int fr, int fq) const {
        const int rbase = u.row0 + wr * 64 + fr, cbase = u.col0 + wc * 32 + 8 * fq;
#pragma unroll
        for (int ai = 0; ai < 2; ++ai)
#pragma unroll
            for (int m = 0; m < 4; ++m) { const int row = rbase + ai * 128 + m * 16;
#pragma unroll
                for (int bj = 0; bj < 2; ++bj) { const size_t off = (size_t)row * DM + cbase + bj * 128;
                    const f32x4 v0 = *(const f32x4*)(x + off) + acc[ai][bj][m][0], v1 = *(const f32x4*)(x + off + 4) + acc[ai][bj][m][1];
                    *(f32x4*)(out + off) = v0; *(f32x4*)(out + off + 4) = v1;
                    u32x4 w; w.x = pk2(v0[0], v0[1]); w.y = pk2(v0[2], v0[3]); w.z = pk2(v1[0], v1[1]); w.w = pk2(v1[2], v1[3]);
                    *(u32x4*)(X1B + off) = w; } }
    }
};

__device__ __forceinline__ void p8_router(Frame& F) {
    const float* X1 = F.out; const float* WR = wsp<float>(F, WS_WR);
    float* RSTD2 = wsp<float>(F, WS_RSTD2); int* TOKCLS = wsp<int>(F, WS_TOKCLS); int* TOKSLOT = wsp<int>(F, WS_TOKSLOT); float* TOKWA = wsp<float>(F, WS_TOKWA); float* TOKWB = wsp<float>(F, WS_TOKWB);
    LAS float* red = (LAS float*)F.lds;
    LAS float* lg = (LAS float*)(F.lds + 8 * 32 * 33 * 4);
    LAS float* ssq = (LAS float*)(F.lds + 9 * 32 * 33 * 4);
    LAS int* lcnt = (LAS int*)(F.lds + 9 * 32 * 33 * 4 + 1024); int* CNT = wsp<int>(F, WS_CNT);
    const int lane = F.lane, i = lane & 31, hh = lane >> 5, w = F.wave;
    for (int u = F.vcu; u < SEQ / 32; u += F.G) {
        const int t0 = 32 * u;
        f32x16 d;
#pragma unroll
        for (int r = 0; r < 16; ++r) d[r] = 0.f;
        float ss = 0.f;
        const float* xp = X1 + (size_t)(t0 + i) * DM + 256 * w + 4 * hh; const float* wp = WR + (size_t)(256 * w + 4 * hh) * 32 + i;
#pragma unroll 1
        for (int m0 = 0; m0 < 32; m0 += 8) {
            f32x4 a[8]; float bw[8][4];
#pragma unroll
            for (int mm = 0; mm < 8; ++mm) { a[mm] = *(const f32x4*)(xp + 8 * (m0 + mm));
#pragma unroll
                for (int e = 0; e < 4; ++e) bw[mm][e] = wp[(8 * (m0 + mm) + e) * 32]; }
#pragma unroll
            for (int mm = 0; mm < 8; ++mm) { ss += (a[mm].x * a[mm].x + a[mm].y * a[mm].y) + (a[mm].z * a[mm].z + a[mm].w * a[mm].w);
                d = __builtin_amdgcn_mfma_f32_32x32x2f32(a[mm].x, bw[mm][0], d, 0, 0, 0); d = __builtin_amdgcn_mfma_f32_32x32x2f32(a[mm].y, bw[mm][1], d, 0, 0, 0);
                d = __builtin_amdgcn_mfma_f32_32x32x2f32(a[mm].z, bw[mm][2], d, 0, 0, 0); d = __builtin_amdgcn_mfma_f32_32x32x2f32(a[mm].w, bw[mm][3], d, 0, 0, 0); }
        }
        ss += __shfl_xor(ss, 32);
        __syncthreads();
#pragma unroll
        for (int r = 0; r < 16; ++r) red[(w * 32 + crow(r, hh)) * 33 + i] = d[r];
        if (hh == 0) ssq[w * 32 + i] = ss;
        if (F.tid < 24) lcnt[F.tid] = 0;
        __syncthreads();
        for (int e = F.tid; e < 1024; e += NTHR) { const int tk = e >> 5, j = e & 31; float s = 0.f;
#pragma unroll
            for (int ww = 0; ww < 8; ++ww) s += red[(ww * 32 + tk) * 33 + j];
            lg[tk * 33 + j] = s; }
        __syncthreads();
        if (F.tid < 32) { const int tk = F.tid; float s2 = 0.f;
#pragma unroll
            for (int ww = 0; ww < 8; ++ww) s2 += ssq[ww * 32 + tk];
            const float rstd = 1.0f / sqrtf(s2 * (1.0f / DM) + NORM_EPS);
            float g[4]; int gt = 0;
#pragma unroll
            for (int j = 0; j < 4; ++j) g[j] = lg[tk * 33 + j] * rstd;
#pragma unroll
            for (int j = 1; j < 4; ++j) if (g[j] > g[gt]) gt = j;
            float den = 0.f;
#pragma unroll
            for (int j = 0; j < 4; ++j) den += expf(g[j] - g[gt]);
            const float pg = 1.0f / den;
            float le[4];
#pragma unroll
            for (int j = 0; j < 4; ++j) le[j] = lg[tk * 33 + 4 + gt * 4 + j] * rstd;
            int e1 = 0;
#pragma unroll
            for (int j = 1; j < 4; ++j) if (le[j] > le[e1]) e1 = j;
            int e2 = (e1 == 0) ? 1 : 0;
#pragma unroll
            for (int j = 0; j < 4; ++j) if (j != e1 && j != e2 && le[j] > le[e2]) e2 = j;
            const float x2 = expf(le[e2] - le[e1]);
            const float w1 = pg / (1.0f + x2), w2 = pg * x2 / (1.0f + x2);
            const int a = e1 < e2 ? e1 : e2, bb = e1 < e2 ? e2 : e1;
            const float wa = e1 < e2 ? w1 : w2, wb = e1 < e2 ? w2 : w1;
            const int pair = (a == 0) ? (bb - 1) : (a == 1 ? bb + 1 : 5);
            const int cls = gt * 6 + pair;
            const int slot = __hip_atomic_fetch_add(&lcnt[cls], 1, __ATOMIC_RELAXED, __HIP_MEMORY_SCOPE_WORKGROUP);
            const int t = t0 + tk;
            RSTD2[t] = rstd; TOKCLS[t] = cls; TOKSLOT[t] = slot; TOKWA[t] = wa; TOKWB[t] = wb;
        }
        __syncthreads();
        if (F.tid < 24) CNT[u * 24 + F.tid] = lcnt[F.tid];
    }
    __syncthreads();
}
__device__ __forceinline__ int moe_tables(Frame& F, LAS int* tb) {
    __syncthreads();
    if (F.tid == 0) { int o = 0;
        for (int c = 0; c < 24; ++c) { const int n = (int)__hip_atomic_load(F.ctl + CW_CLS + c, __ATOMIC_RELAXED, __HIP_MEMORY_SCOPE_AGENT); tb[c] = o; tb[64 + c] = n; const int nt = (n + 255) >> 8;
            for (int j = 0; j < nt; ++j) { tb[128 + (o >> 8) + j] = c; tb[192 + (o >> 8) + j] = (n - 256 * j <= 128) ? 1 : 0; } o += nt << 8; }
        tb[24] = o; const int ntl = o >> 8; int k = 0;
        for (int j = 0; j < ntl; ++j) if (!tb[192 + j]) tb[256 + k++] = j;
        for (int j = 0; j < ntl; ++j) if (tb[192 + j]) tb[256 + k++] = j; }
    __syncthreads();
    return tb[24] >> 8;
}
__device__ __forceinline__ void p8b_gather(Frame& F) {
    LAS int* tb = (LAS int*)(F.lds + LDSCTL_OFF + 512);
    LAS int* cn = (LAS int*)F.lds;
    LAS int* psum = (LAS int*)(F.lds + 32768);
    LAS int* tot = (LAS int*)(F.lds + 32768 + 2048);
    const int* CNT = wsp<int>(F, WS_CNT);
    __syncthreads();
    for (int i = F.tid; i < 256 * 24; i += NTHR) cn[i] = CNT[i];
    __syncthreads();
    const int c = F.tid >> 4, part = F.tid & 15;
    if (F.tid < 384) { int sm = 0;
#pragma unroll
        for (int j = 0; j < 16; ++j) sm += cn[(part * 16 + j) * 24 + c];
        psum[c * 16 + part] = sm; }
    __syncthreads();
    if (F.tid < 24) { int run = 0;
        for (int j = 0; j < 16; ++j) { const int v = psum[F.tid * 16 + j]; psum[F.tid * 16 + j] = run; run += v; }
        tot[F.tid] = run; }
    __syncthreads();
    if (F.tid < 384) { int run = psum[c * 16 + part];
#pragma unroll
        for (int j = 0; j < 16; ++j) { const int idx = (part * 16 + j) * 24 + c; const int v = cn[idx]; cn[idx] = run; run += v; } }
    if (F.tid == 0) { int o = 0;
        for (int cc = 0; cc < 24; ++cc) { const int n = tot[cc]; tb[cc] = o; tb[64 + cc] = n; o += ((n + 255) >> 8) << 8; }
        tb[24] = o; }
    if (blockIdx.x == 0 && F.tid < 24) __hip_atomic_store(F.ctl + CW_CLS + F.tid, (unsigned)tot[F.tid], __ATOMIC_RELAXED, __HIP_MEMORY_SCOPE_AGENT);
    __syncthreads();
    const float* RSTD2 = wsp<float>(F, WS_RSTD2); const int* TOKCLS = wsp<int>(F, WS_TOKCLS); const int* TOKSLOT = wsp<int>(F, WS_TOKSLOT); const float* TOKWA = wsp<float>(F, WS_TOKWA); const float* TOKWB = wsp<float>(F, WS_TOKWB);
    int* ROWTOK = wsp<int>(F, WS_ROWTOK); float* ROWRS = wsp<float>(F, WS_ROWRS); float* ROWWA = wsp<float>(F, WS_ROWWA); float* ROWWB = wsp<float>(F, WS_ROWWB);
    const int gw = F.vcu * NWAVES + F.wave, NGW = F.G * NWAVES, lane = F.lane;
    for (int t = gw * 64 + lane; t < SEQ; t += NGW * 64) {
        const int cl = TOKCLS[t]; const int R = tb[cl] + cn[(t >> 5) * 24 + cl] + TOKSLOT[t];
        ROWTOK[R] = t; ROWRS[R] = RSTD2[t]; ROWWA[R] = TOKWA[t]; ROWWB[R] = TOKWB[t];
    }
    for (int i = F.vcu * NTHR + F.tid; i < 24 * 256; i += F.G * NTHR) { const int cc = i >> 8, j = i & 255; const int n = tb[64 + cc], R = tb[cc] + n + j;
        const int endc = tb[cc] + (((n + 255) >> 8) << 8);
        if (R < endc) { ROWTOK[R] = -1; ROWRS[R] = 0.f; ROWWA[R] = 0.f; ROWWB[R] = 0.f; } }
}
__device__ __forceinline__ void cls_experts(int cls, int& ea, int& eb) { const int g = cls / 6, p = cls % 6; const int a = (p < 3) ? 0 : (p < 5 ? 1 : 2); const int b = (p < 3) ? p + 1 : (p < 5 ? p - 1 : 3); ea = g * 4 + a; eb = g * 4 + b; }
struct EpiGU {
    static constexpr bool HOOK = false; static constexpr int HOOK_T1 = -1, HOOK_T2 = -1;
    unsigned char* ws;
    __device__ __forceinline__ void hook(f32x4 (&)[2][2][4][2], const pg8::Unit&, int, int, int, int, int) const {}
    __device__ __forceinline__ void operator()(const f32x4 (&acc)[2][2][4][2], const pg8::Unit& u, int wr, int wc, int fr, int fq) const {
        const float* rs = (const float*)(ws + WS_ROWRS); const __amdgpu_buffer_rsrc_t rsrc = __builtin_amdgcn_make_buffer_rsrc(ws + WS_ACT, 0, (int)(MAXROWS * 1024 * 2), 0x00020000);
        const int pn = u.col0; const float* cw = (const float*)(ws + (pn < 4 ? WS_ROWWA : WS_ROWWB)); const int cbase = (pn >> 2) * 512 + (pn & 3) * 128 + wc * 32 + 8 * fq;
#pragma unroll
        for (int ai = 0; ai < 2; ++ai)
#pragma unroll
            for (int m = 0; m < 4; ++m) { const int row = u.row0 + ai * 128 + wr * 64 + m * 16 + fr; const float s = rs[row], w = cw[row];
                float a[8];
#pragma unroll
                for (int n = 0; n < 2; ++n)
#pragma unroll
                    for (int e = 0; e < 4; ++e) { const float gv = acc[ai][0][m][n][e] * s, uv = acc[ai][1][m][n][e] * s;
                        a[4 * n + e] = gv * __builtin_amdgcn_rcpf(1.0f + __builtin_amdgcn_exp2f(-gv * LOG2E)) * uv * w; }
                u32x4 o; o.x = pk2(a[0], a[1]); o.y = pk2(a[2], a[3]); o.z = pk2(a[4], a[5]); o.w = pk2(a[6], a[7]);
                __builtin_amdgcn_raw_buffer_store_b128(o, rsrc, (int)(((unsigned)row * 1024u + (unsigned)cbase) * 2u), 0, 16); }
    }
};
struct EpiDN {
    static constexpr bool HOOK = false; static constexpr int HOOK_T1 = -1, HOOK_T2 = -1;
    unsigned char* ws; float* out;
    __device__ __forceinline__ void hook(f32x4 (&)[2][2][4][2], const pg8::Unit&, int, int, int, int, int) const {}
    __device__ __forceinline__ void operator()(const f32x4 (&acc)[2][2][4][2], const pg8::Unit& u, int wr, int wc, int fr, int fq) const {
        const int* rowtok = (const int*)(ws + WS_ROWTOK);
        const int cbase = u.col0 + wc * 32 + 8 * fq;
#pragma unroll
        for (int ai = 0; ai < 2; ++ai)
#pragma unroll
            for (int m = 0; m < 4; ++m) { const int row = u.row0 + ai * 128 + wr * 64 + m * 16 + fr; const int tok = rowtok[row];
                if (tok >= 0) {
#pragma unroll
                    for (int bj = 0; bj < 2; ++bj) { float* p = out + (size_t)tok * DM + cbase + bj * 128;
                        const f32x4 v0 = *(const f32x4*)p + acc[ai][bj][m][0], v1 = *(const f32x4*)(p + 4) + acc[ai][bj][m][1];
                        *(f32x4*)p = v0; *(f32x4*)(p + 4) = v1; } } }
    }
};

struct SchedOne { pg8::Unit u; __device__ __forceinline__ bool next(int i, pg8::Unit& o) const { if (i != 0) return false; o = u; return true; } };
__device__ __forceinline__ void p9_experts(Frame& F) {
    LAS int* tb = (LAS int*)(F.lds + LDSCTL_OFF + 512);
    const int ntiles = moe_tables(F, tb);
    LAS int* qs = (LAS int*)(F.lds + LDSCTL_OFF + 256);
    const int nun = 16 * ntiles;
    unsigned pend = 0u;
    if (F.tid == 0) pend = atomicAdd(F.ctl + CW_QUEUE + 2, 1u);
    for (;;) {
        __syncthreads();
        if (F.tid == 0) { qs[0] = (int)pend; pend = atomicAdd(F.ctl + CW_QUEUE + 2, 1u); }
        __syncthreads();
        const int idx = qs[0];
        if (idx >= nun) break;
        const bool dn = idx >= 8 * ntiles; const int L = dn ? idx - 8 * ntiles : idx; const int mt = tb[256 + (L >> 3)], pn = L & 7; const int cls = tb[128 + mt]; int ea, eb; cls_experts(cls, ea, eb);
        pg8::Unit u; u.kind = 0; u.row0 = mt * 256; u.aux = 0; u.lowonly = tb[192 + mt];
        if (!dn) {
            const int e = pn < 4 ? ea : eb;
            u.A = (const char*)(F.ws + WS_X1B); u.B = (const char*)(F.ws + WS_WGUT) + ((size_t)e * 1024 + (pn & 3) * 256) * DM * 2; u.Bhi = u.B; u.col0 = pn; u.nt = 32;
            SchedOne S{u}; EpiGU E{F.ws};
            pg8::gemm_phase<EpiGU, SchedOne, true, true>(F.lds, pg8::Geom{DM, DM, 32, 1 << 30, wsp<int>(F, WS_ROWTOK)}, S, E);
            asm volatile("s_waitcnt vmcnt(0)" ::: "memory");
            __syncthreads();
            if (F.tid == 0) __hip_atomic_fetch_add(F.ctl + CW_TILE + mt, 1u, __ATOMIC_RELAXED, __HIP_MEMORY_SCOPE_AGENT);
        } else {
            if (F.tid == 0) { unsigned sp = 0;
                while (__hip_atomic_load(F.ctl + CW_TILE + mt, __ATOMIC_RELAXED, __HIP_MEMORY_SCOPE_AGENT) < 8u) { __builtin_amdgcn_s_sleep(8); if (++sp > (1u << 20)) break; }
                __builtin_amdgcn_fence(__ATOMIC_ACQUIRE, "agent");
                asm volatile("s_waitcnt vmcnt(0)" ::: "memory"); }
            __syncthreads();
            u.A = (const char*)(F.ws + WS_ACT) + (size_t)mt * 256 * 1024 * 2; u.B = (const char*)(F.ws + WS_WDT) + ((size_t)ea * DM + pn * 256) * 512 * 2;
            u.Bhi = (const char*)(F.ws + WS_WDT) + ((size_t)eb * DM + pn * 256) * 512 * 2 - (size_t)8 * 128; u.col0 = pn * 256; u.nt = 16;
            SchedOne S{u}; EpiDN E{F.ws, F.out};
            pg8::gemm_phase<EpiDN, SchedOne, true, true>(F.lds, pg8::Geom{1024, 512, 16, 8, nullptr}, S, E);
        }
    }
}
template <int K> __device__ __forceinline__ void run_phase(Frame& F) {
    if constexpr (K == 0) p0_prologue(F);
    else if constexpr (K == 1) {
        SchedP1 S{(int)blockIdx.x, F.G, F.ws};
        EpiP1 E{F.ws, wsp<float>(F, WS_RSTD1), wsp<float>(F, WS_RSTDM), F.b_gate};
        pg8::gemm_phase<EpiP1, SchedP1, true, true>(F.lds, pg8::Geom{DM, DM, 32, 1 << 30, nullptr}, S, E);
    } else if constexpr (K == 2) p2_rowpass(F);
    else if constexpr (K == 3) p3_indexer(F);
    else if constexpr (K == 4) p4_attention(F);
    else if constexpr (K == 5) p5_finalize(F);
    else if constexpr (K == 6) {
        SchedTile S{(int)blockIdx.x, F.G, 32, 8, (const char*)(F.ws + WS_AMRG), (const char*)(F.ws + WS_BTMRG), (size_t)256 * DM * 2, (size_t)256 * DM * 2};
        EpiMrg E{wsp<bf16_t>(F, WS_EG), wsp<bf16_t>(F, WS_MRG)};
        pg8::gemm_phase<EpiMrg, SchedTile, true, true>(F.lds, pg8::Geom{DM, DM, 32, 1 << 30, nullptr}, S, E);
    } else if constexpr (K == 7) {
        SchedTile S{(int)blockIdx.x, F.G, 32, 8, (const char*)(F.ws + WS_MRG), (const char*)(F.ws + WS_WOT), (size_t)256 * DM * 2, (size_t)256 * DM * 2};
        EpiRes E{F.x, F.out, wsp<bf16_t>(F, WS_X1B)};
        pg8::gemm_phase<EpiRes, SchedTile, true, true>(F.lds, pg8::Geom{DM, DM, 32, 1 << 30, nullptr}, S, E);
    } else if constexpr (K == 8) p8_router(F);
    else if constexpr (K == 9) p8b_gather(F);
    else p9_experts(F);
}
__global__ void __launch_bounds__(NTHR, 2) fwd_kernel(KArgs args) {
    extern __shared__ __attribute__((aligned(16))) unsigned char lds_raw[];
    Frame F;
    F.lds = (LAS unsigned char*)lds_raw; F.MISC = (volatile LAS unsigned*)(F.lds + MISC_OFF);
    F.tid = threadIdx.x; F.lane = F.tid & 63; F.wave = __builtin_amdgcn_readfirstlane(F.tid >> 6);
    F.G = gridDim.x; { const int bx = blockIdx.x; F.vcu = (F.G % 8 == 0) ? (bx % 8) * (F.G / 8) + bx / 8 : bx; }
    F.ws = args.ws; F.out = args.out; F.ctl = (unsigned*)(args.ws + WS_CTL);
    F.x = (const float*)args.in[0]; F.mem = (const float*)args.in[1]; F.positions = (const int*)args.in[2]; F.g_mix = (const float*)args.in[3]; F.w_in = (const float*)args.in[4];
    F.b_gate = (const float*)args.in[5]; F.w_pool_grp = (const float*)args.in[6]; F.pool_scale = (const float*)args.in[7]; F.q_norm_g = (const float*)args.in[8]; F.k_norm_g = (const float*)args.in[9];
    F.g_mem = (const float*)args.in[10]; F.w_mem_kv = (const float*)args.in[11]; F.xq_norm_g = (const float*)args.in[12]; F.xk_norm_g = (const float*)args.in[13]; F.w_pool_out = (const float*)args.in[14];
    F.w_attn_out = (const float*)args.in[15]; F.w_cross_out = (const float*)args.in[16]; F.w_o = (const float*)args.in[17]; F.g_ffn = (const float*)args.in[18]; F.w_rg = (const float*)args.in[19];
    F.w_re = (const float*)args.in[20]; F.w_eg = (const float*)args.in[21]; F.w_eu = (const float*)args.in[22]; F.w_ed = (const float*)args.in[23];
    for (int u = F.tid; u < (LDS_BYTES - LDSCTL_OFF) / 4; u += NTHR) ((LAS unsigned*)(F.lds + LDSCTL_OFF))[u] = 0u;
    __syncthreads();
    XcdBarrier bar = xcd_barrier_post(F.ctl + CW_BAR, F.MISC + 8);
    if (P3_PROF == 8 && blockIdx.x == 0 && F.tid == 0) __hip_atomic_store(F.ctl + CW_QUEUE + 9, 0x7fffffffu, __ATOMIC_RELAXED, __HIP_MEMORY_SCOPE_AGENT);
    const int lo = args.ph_lo, hi = args.ph_hi;
#define IN(k) (lo <= (k) && (k) < hi)
#define SEAM(k) do { if (IN(k) && IN((k) + 1)) xcd_barrier(bar); } while (0)
#ifndef PROBE_TS
#define PROBE_TS -1
#endif
#ifndef PROBE_REPEAT
#define PROBE_REPEAT -1
#endif
    unsigned long long ts0 = 0, ts1 = 0;
#ifndef ONLY_PHASE
#define ONLY_PHASE -1
#endif
#define PHASE(k) do { if ((ONLY_PHASE < 0 || ONLY_PHASE == (k)) && IN(k)) { if (PROBE_TS == (k)) ts0 = __builtin_amdgcn_s_memrealtime(); run_phase<k>(F); \
        if (PROBE_REPEAT == (k)) { xcd_barrier(bar); run_phase<k>(F); } } \
        if (PROBE_TS == (k)) { xcd_barrier(bar); ts1 = __builtin_amdgcn_s_memrealtime(); } else { SEAM(k); } } while (0)
    PHASE(0); PHASE(1); PHASE(2); PHASE(3); PHASE(4); PHASE(5); PHASE(6); PHASE(7); PHASE(8); PHASE(9); PHASE(10);
#ifdef EXTRA_BARS
    for (int _i = 0; _i < 10; ++_i) xcd_barrier(bar);
#endif
    if (P0_PROF) { xcd_barrier(bar); if (blockIdx.x == 0 && F.tid == 0) F.out[0] += (float)__hip_atomic_load(F.ctl + CW_QUEUE + 8, __ATOMIC_RELAXED, __HIP_MEMORY_SCOPE_AGENT) * 0.001f; }
    if (P3_PROF) { xcd_barrier(bar); if (blockIdx.x == 0 && F.tid == 0) { float v = (float)F.MISC[16] * 0.001f;
        if (P3_PROF == 6 || P3_PROF >= 11) v = (float)__hip_atomic_load(F.ctl + CW_QUEUE + 8, __ATOMIC_RELAXED, __HIP_MEMORY_SCOPE_AGENT);
        if (P3_PROF == 7) v = (float)__hip_atomic_load(F.ctl + CW_QUEUE + 8, __ATOMIC_RELAXED, __HIP_MEMORY_SCOPE_AGENT) * 0.001f;
        if (P3_PROF == 8) v = (float)__hip_atomic_load(F.ctl + CW_QUEUE + 9, __ATOMIC_RELAXED, __HIP_MEMORY_SCOPE_AGENT) * 0.001f;
        F.out[0] += v; } }
    if (PROBE_TS >= 0) { if (PROBE_TS != 10) xcd_barrier(bar); if (blockIdx.x == 0 && F.tid == 0) F.out[0] += (float)(ts1 - ts0) * 0.001f; }
#undef IN
#undef SEAM
#undef PHASE
}

extern "C" void kernel_launch(void* const* d_in, const int* in_sizes, int n_in, void* d_out, int out_size, void* d_ws, size_t ws_size, hipStream_t stream) {
    static int grid = 0;
    if (grid == 0) {
        if (n_in != 24 || in_sizes[0] != SEQ * DM || out_size != SEQ * DM || ws_size < WS_END) {
            fprintf(stderr, "kernel_launch: unexpected shapes: n_in %d in0 %d out %d ws %zu (need %zu)\n", n_in, n_in > 0 ? in_sizes[0] : -1, out_size, ws_size, (size_t)WS_END); grid = -1; return; }
        int dev = 0, cus = 0, per_cu = 0;
        if (hipGetDevice(&dev) != hipSuccess || hipDeviceGetAttribute(&cus, hipDeviceAttributeMultiprocessorCount, dev) != hipSuccess) { grid = -1; return; }
        if (hipFuncSetAttribute((const void*)fwd_kernel, hipFuncAttributeMaxDynamicSharedMemorySize, LDS_BYTES) != hipSuccess) { fprintf(stderr, "kernel_launch: hipFuncSetAttribute failed\n"); grid = -1; return; }
        if (hipOccupancyMaxActiveBlocksPerMultiprocessor(&per_cu, (const void*)fwd_kernel, NTHR, LDS_BYTES) != hipSuccess || per_cu < 1) {
            fprintf(stderr, "kernel_launch: occupancy query reports %d workgroups per CU\n", per_cu); (void)hipGetLastError(); per_cu = 1; }
        grid = cus;
    }
    if (grid < 0) return;
    if (hipMemsetAsync((char*)d_ws + WS_CTL, 0, CTL_ZERO_BYTES, stream) != hipSuccess) { fprintf(stderr, "kernel_launch: memset failed\n"); return; }
    KArgs a{};
    for (int i = 0; i < 24; ++i) a.in[i] = d_in[i];
    a.out = (float*)d_out; a.ws = (unsigned char*)d_ws; a.ph_lo = 0; a.ph_hi = 11;
    hipLaunchKernelGGL(fwd_kernel, dim3(grid), dim3(NTHR), LDS_BYTES, stream, a);
    const hipError_t le = hipPeekAtLastError();
    if (le != hipSuccess) fprintf(stderr, "kernel_launch: launch failed: %s\n", hipGetErrorName(le));
}
```

```cpp
#include <hip/hip_runtime.h>
#include <cstdio>
#include <cstdint>

#define LAS __attribute__((address_space(3)))
#define GAS __attribute__((address_space(1)))
typedef unsigned short bf16_t;
typedef short bf16x8 __attribute__((ext_vector_type(8)));
typedef short bf16x4 __attribute__((ext_vector_type(4)));
typedef float f32x4 __attribute__((ext_vector_type(4)));
typedef float f32x16 __attribute__((ext_vector_type(16)));
typedef unsigned u32x4 __attribute__((ext_vector_type(4)));
typedef unsigned u32x2 __attribute__((ext_vector_type(2)));

#ifndef P3_PROF
#define P3_PROF 0
#endif
constexpr int SEQ = 8192, DM = 2048, INC = 10052, MEML = 256;
constexpr int NWAVES = 8, NTHR = 512;
constexpr float NORM_EPS = 1e-6f;
constexpr float LOG2E = 1.4426950408889634f;
constexpr float ATT_SCALE = 0.08838834764831845f;

constexpr size_t MiB = 1u << 20, KiB = 1u << 10;
constexpr size_t WS_CTL = 0, CTL_ZERO_BYTES = 128 * KiB;
constexpr size_t WS_SMALL = 1 * MiB;
constexpr size_t WS_RSTD1 = WS_SMALL + 0, WS_RSTDM = WS_SMALL + 32 * KiB, WS_THRKEY = WS_SMALL + 64 * KiB, WS_THRIDX = WS_SMALL + 96 * KiB;
constexpr size_t WS_WIF = WS_SMALL + 128 * KiB, WS_RSTD2 = WS_SMALL + 256 * KiB, WS_TOKCLS = WS_SMALL + 288 * KiB, WS_TOKSLOT = WS_SMALL + 320 * KiB;
constexpr size_t WS_TOKWA = WS_SMALL + 352 * KiB, WS_TOKWB = WS_SMALL + 384 * KiB, WS_ROWTOK = WS_SMALL + 416 * KiB, WS_ROWRS = WS_SMALL + 480 * KiB;
constexpr size_t WS_ROWWA = WS_SMALL + 544 * KiB, WS_ROWWB = WS_SMALL + 608 * KiB, WS_CNT = WS_SMALL + 672 * KiB, WS_ATTBL = WS_SMALL + 704 * KiB, WS_WR = WS_SMALL + 1 * MiB;
constexpr size_t WS_BTMRG = 4 * MiB, WS_WOT = 12 * MiB;
constexpr size_t WS_XB = 20 * MiB, WS_WINT = 52 * MiB, WS_WVT = 89 * MiB, WS_WMKVT = 92 * MiB, WS_MEMB = 96 * MiB;
constexpr size_t WS_WGUT = 20 * MiB, WS_QIB = 84 * MiB, WS_KIB = 88 * MiB, WS_KMB = 89 * MiB, WS_VMT = 89 * MiB + 512 * KiB;
constexpr size_t WS_WDT = 97 * MiB;
constexpr size_t WS_EG = 129 * MiB, WS_ACT = 185 * MiB;
constexpr size_t WS_AMRG = 225 * MiB, WS_X1B = 225 * MiB;
constexpr size_t WS_Q = 257 * MiB, WS_K = 269 * MiB, WS_VT = 281 * MiB, WS_XQ = 293 * MiB, WS_MRG = 257 * MiB;
constexpr size_t WS_U = 301 * MiB, WS_IDXF = 313 * MiB, WS_OPX = 301 * MiB;
constexpr size_t WS_KVM = 329 * MiB, WS_MASK = 330 * MiB, WS_KVMP = 330 * MiB, WS_END = 338 * MiB;
constexpr int MAXROWS = 14336;
constexpr int CW_BAR = 4096;
constexpr int CW_CLS = 16384;
constexpr int CW_QUEUE = 16512;
constexpr int CW_TILE = 16640;

#define LDS_WAIT() asm volatile("s_waitcnt lgkmcnt(0)" ::: "memory")
#define VM_WAIT() asm volatile("s_waitcnt vmcnt(0)" ::: "memory")
typedef float f32x2_t __attribute__((ext_vector_type(2))); typedef __bf16 bf16x2_t __attribute__((ext_vector_type(2)));
__device__ __forceinline__ unsigned pk2(float lo, float hi) { f32x2_t v = {lo, hi}; bf16x2_t b = __builtin_convertvector(v, bf16x2_t); return __builtin_bit_cast(unsigned, b); }
__device__ __forceinline__ unsigned f2bf(float f) { return pk2(f, 0.f) & 0xffffu; }
__device__ __forceinline__ float bf2f(unsigned short b) { return __builtin_bit_cast(float, (unsigned)b << 16); }
__device__ __forceinline__ float bflo(unsigned w) { return __builtin_bit_cast(float, w << 16); }
__device__ __forceinline__ float bfhi(unsigned w) { return __builtin_bit_cast(float, w & 0xffff0000u); }
__device__ __forceinline__ float wave_sum(float v) {
#pragma unroll
    for (int o = 1; o < 64; o <<= 1) v += __shfl_xor(v, o);
    return v;
}
__device__ __forceinline__ int crow(int r, int hi) { return (r & 3) + 8 * (r >> 2) + 4 * hi; }

#define XB_TMO      128
#define XB_XCNT(j)  (256  + 64 * (j))
#define XB_XSUB(j)  (1280 + 64 * (j))
#define XB_XGEN(j)  (2304 + 64 * (j))
#define XB_TOP      3328
#define XB_TOPGEN   3392
#define XCD_BAR_WORDS 3456
#define XB_SPIN_CAP (1u << 20)
__device__ __forceinline__ unsigned xb_ld(unsigned* p)              { return __hip_atomic_load(p, __ATOMIC_RELAXED, __HIP_MEMORY_SCOPE_AGENT); }
__device__ __forceinline__ unsigned xb_add(unsigned* p, unsigned v) { return __hip_atomic_fetch_add(p, v, __ATOMIC_RELAXED, __HIP_MEMORY_SCOPE_AGENT); }
__device__ __forceinline__ unsigned xb_xcc_id() { return (unsigned)__builtin_amdgcn_s_getreg((3 << 11) | 20) & 0xFu; }
#define XB_SPIN(cond, bar) do { unsigned _sp = 0; while (cond) { __builtin_amdgcn_s_sleep(1); \
    if ((++_sp & 255u) == 0u) { if (xb_ld(&(bar)[XB_TMO])) break; if (_sp > XB_SPIN_CAP) { atomicAdd(&(bar)[XB_TMO], 1u); break; } } } } while (0)
struct XcdBarrier { unsigned* bar; unsigned x; volatile LAS unsigned* st; };
__device__ __forceinline__ XcdBarrier xcd_barrier_post(unsigned* bar, volatile LAS unsigned* st) {
    XcdBarrier b; b.bar = bar; b.x = xb_xcc_id(); b.st = st;
    if (threadIdx.x == 0) (void)xb_add(&bar[XB_XCNT(b.x)], 1u);
    return b;
}
__device__ __forceinline__ void xcd_barrier_complete(unsigned* bar, unsigned x, unsigned& nloc, unsigned& nx) {
    const unsigned G = gridDim.x * gridDim.y * gridDim.z;
    unsigned sum, cnt, mine, sp = 0u;
    for (;;) {
        sum = 0u; cnt = 0u; mine = 0u;
#pragma unroll
        for (unsigned j = 0; j < 16; ++j) { const unsigned c = xb_ld(&bar[XB_XCNT(j)]); sum += c; cnt += (c > 0u) ? 1u : 0u; mine = (j == x) ? c : mine; }
        if (sum == G) break;
        __builtin_amdgcn_s_sleep(1);
        if ((++sp & 255u) == 0u) { if (xb_ld(&bar[XB_TMO])) break; if (sp > XB_SPIN_CAP) { atomicAdd(&bar[XB_TMO], 1u); break; } }
    }
    nloc = mine > 0u ? mine : 1u; nx = cnt > 0u ? cnt : 1u;
}
__device__ __forceinline__ void xcd_barrier(const XcdBarrier& b) {
    asm volatile("s_waitcnt vmcnt(0)" ::: "memory");
    __syncthreads();
    if (threadIdx.x == 0) {
        unsigned* bar = b.bar;
        __builtin_amdgcn_s_waitcnt(0);
        unsigned nloc = b.st[0], nx = b.st[1];
        if (nloc == 0u) { xcd_barrier_complete(bar, b.x, nloc, nx); b.st[0] = nloc; b.st[1] = nx; }
        const unsigned old = xb_add(&bar[XB_XSUB(b.x)], 1u);
        const unsigned gen = old / nloc;
        if (old + 1u == (gen + 1u) * nloc) {
            __builtin_amdgcn_fence(__ATOMIC_RELEASE, "agent");
            asm volatile("s_waitcnt vmcnt(0)" ::: "memory");
            const unsigned og = xb_add(&bar[XB_TOP], 1u);
            const unsigned tg = og / nx;
            if (og + 1u == (tg + 1u) * nx) xb_add(&bar[XB_TOPGEN], 1u);
            else XB_SPIN(xb_ld(&bar[XB_TOPGEN]) == tg, bar);
            __builtin_amdgcn_fence(__ATOMIC_ACQUIRE, "agent");
            xb_add(&bar[XB_XGEN(b.x)], 1u);
            asm volatile("s_waitcnt vmcnt(0)" ::: "memory");
        } else {
            XB_SPIN(xb_ld(&bar[XB_XGEN(b.x)]) == gen, bar);
            __builtin_amdgcn_fence(__ATOMIC_ACQUIRE, "agent");
            asm volatile("s_waitcnt vmcnt(0)" ::: "memory");
        }
    }
    __syncthreads();
}

namespace pg8 {
constexpr int BM = 256, BK = 64, HALF = 128, HTB = HALF * BK * 2, STAGE_BYTES = 8 * HTB, NXCD = 8, WGM = 8;
__host__ __device__ __forceinline__ int lds_byte(int r, int c) { const int st = (r >> 4) * 2 + (c >> 5), rr = r & 15, cc = c & 31, ob = rr * 64 + cc * 2; return st * 1024 + (ob ^ (((ob >> 9) & 1) << 5)); }
__host__ __device__ __forceinline__ void stage_rc(int b, int& R, int& C) { const int st = b / 1024, sb = b % 1024, swz = sb ^ (((sb >> 9) & 1) << 5); R = (st >> 1) * 16 + swz / 64; C = (st & 1) * 32 + (swz % 64) / 2; }
__host__ __device__ __forceinline__ int perm32(int rho) { const int n = rho >> 4, i = rho & 15; return 8 * (i >> 2) + 4 * n + (i & 3); }

struct Unit { const char* A; const char* B; const char* Bhi; int kind; int row0; int col0; int aux; int nt; int lowonly; };
struct Geom { int lda, ldb, nt, ksplit; const int* rowtok; };

__device__ __forceinline__ void tile_order(int L, int nM, int nN, int& pm, int& pn) {
    const int nwg = nM * nN; int wgid = L;
    { const int q = nwg / NXCD, r = nwg % NXCD, xcd = wgid % NXCD, off = wgid / NXCD; wgid = (xcd < r ? xcd * (q + 1) : r * (q + 1) + (xcd - r) * q) + off; }
    const int nig = WGM * nN, gid = wgid / nig, fm = gid * WGM, gsz = (nM - fm) < WGM ? (nM - fm) : WGM;
    pm = fm + ((wgid % nig) % gsz); pn = (wgid % nig) / gsz;
}

template <class Epi, class Sched, bool ALIGN_EPI, bool SP2>
__device__ __forceinline__ void gemm_phase(LAS unsigned char* lds, const Geom g, const Sched& S, const Epi& E) {
    const int tid = threadIdx.x, wid = __builtin_amdgcn_readfirstlane(tid >> 6), lane = tid & 63, wr = wid >> 2, wc = wid & 3, fr = lane & 15, fq = lane >> 4;
    unsigned voffA[2], voffB[2];
#pragma unroll
    for (int i = 0; i < 2; ++i) { int R, C; stage_rc(tid * 16 + i * 8192, R, C); const int Rb = (R & ~31) + perm32(R & 31);
        voffA[i] = (unsigned)(R * g.lda + C) * 2u; voffB[i] = (unsigned)(Rb * g.ldb + C) * 2u; }
    const size_t kstep = (size_t)(BK * 2);
    const size_t hstepA = (size_t)HALF * g.lda * 2, hstepB = (size_t)HALF * g.ldb * 2;
    unsigned voffA1[2];
#pragma unroll
    for (int i = 0; i < 2; ++i) voffA1[i] = voffA[i] + (unsigned)hstepA;
    const unsigned ldsw = (unsigned)wid * 1024u;
    const int aoff = lds_byte(wr * 64 + fr, fq * 8), boff = lds_byte(wc * 32 + fr, fq * 8);
#define PG8_SA(b, h) (((b) * 2 + (h)) * HTB)
#define PG8_SB(b, h) ((4 + (b) * 2 + (h)) * HTB)
#define PG8_STAGE(bufoff, gbase, voff) do { _Pragma("unroll") for (int _i = 0; _i < 2; ++_i) \
        __builtin_amdgcn_global_load_lds((const unsigned*)((const char*)(gbase) + (voff)[_i]), (LAS unsigned*)(lds + (bufoff) + ldsw + _i * 8192), 16, 0, 0); } while (0)
#define PG8_LDA(dst, b, h) do { _Pragma("unroll") for (int m = 0; m < 4; ++m) _Pragma("unroll") for (int k = 0; k < 2; ++k) dst[m][k] = *(const LAS bf16x8*)(lds + PG8_SA(b, h) + aoff + m * 2048 + k * 1024); } while (0)
#define PG8_LDB(dst, b, h) do { _Pragma("unroll") for (int n = 0; n < 2; ++n) _Pragma("unroll") for (int k = 0; k < 2; ++k) dst[n][k] = *(const LAS bf16x8*)(lds + PG8_SB(b, h) + boff + n * 2048 + k * 1024); } while (0)
#define PG8_MMA(ai, bj, At, Bt) do { __builtin_amdgcn_s_setprio(1); _Pragma("unroll") for (int m = 0; m < 4; ++m) _Pragma("unroll") for (int n = 0; n < 2; ++n) _Pragma("unroll") for (int k = 0; k < 2; ++k) \
        acc[ai][bj][m][n] = __builtin_amdgcn_mfma_f32_16x16x32_bf16(Bt[n][k], At[m][k], acc[ai][bj][m][n], 0, 0, 0); __builtin_amdgcn_s_setprio(0); } while (0)
#define PG8_WAIT_V(n) asm volatile("s_waitcnt vmcnt(" #n ")" ::: "memory")
#define PG8_WAIT_L(n) asm volatile("s_waitcnt lgkmcnt(" #n ")" ::: "memory")
#define PG8_BAR __builtin_amdgcn_s_barrier()
#define PG8_SCHED __builtin_amdgcn_sched_barrier(0)
    Unit cur, nxt; int ui = 0;
    if (!S.next(0, cur)) return;
    if (g.rowtok) {
#pragma unroll
        for (int i = 0; i < 2; ++i) { int R, C; stage_rc(tid * 16 + i * 8192, R, C); int t0 = g.rowtok[cur.row0 + R], t1 = g.rowtok[cur.row0 + HALF + R]; t0 = t0 < 0 ? 0 : t0; t1 = t1 < 0 ? 0 : t1;
            voffA[i] = (unsigned)(t0 * g.lda + C) * 2u; voffA1[i] = (unsigned)(t1 * g.lda + C) * 2u; }
    }
    f32x4 acc[2][2][4][2];
#pragma unroll
    for (int a = 0; a < 2; ++a)
#pragma unroll
        for (int b = 0; b < 2; ++b)
#pragma unroll
            for (int m = 0; m < 4; ++m)
#pragma unroll
                for (int n = 0; n < 2; ++n) acc[a][b][m][n] = (f32x4){0.f, 0.f, 0.f, 0.f};
    bf16x8 At[4][2], B0[2][2], B1[2][2];
    const char* cA = cur.A; const char* cB = cur.B; const char* cBhi = cur.Bhi;
    if constexpr (SP2) {
        PG8_STAGE(PG8_SB(0, 0), cB, voffB); PG8_STAGE(PG8_SB(0, 1), cB + hstepB, voffB); PG8_STAGE(PG8_SA(0, 0), cA, voffA); PG8_STAGE(PG8_SA(0, 1), cA, voffA1);
        if (wr == 1) PG8_BAR;
        PG8_WAIT_V(2); PG8_BAR;
        PG8_STAGE(PG8_SB(1, 0), cB + kstep, voffB); PG8_STAGE(PG8_SA(1, 0), cA + kstep, voffA); PG8_STAGE(PG8_SB(1, 1), cB + hstepB + kstep, voffB);
        PG8_WAIT_V(6); PG8_BAR;
    } else {
        PG8_STAGE(PG8_SB(0, 0), cB, voffB); PG8_STAGE(PG8_SA(0, 0), cA, voffA); PG8_STAGE(PG8_SB(0, 1), cB + hstepB, voffB); PG8_STAGE(PG8_SA(0, 1), cA, voffA1);
        if (wr == 1) PG8_BAR;
        PG8_WAIT_V(4); PG8_BAR;
        PG8_STAGE(PG8_SB(1, 0), cB + kstep, voffB); PG8_STAGE(PG8_SA(1, 0), cA + kstep, voffA); PG8_STAGE(PG8_SB(1, 1), cB + hstepB + kstep, voffB);
        PG8_WAIT_V(6); PG8_BAR;
    }
    for (;;) {
        const bool has_next = S.next(ui + 1, nxt);
        const char* nA = has_next ? nxt.A : cA; const char* nB = has_next ? nxt.B : cB;
        const int nt = cur.nt; const bool hi_on = cur.lowonly == 0;
        for (int t = 0; t < nt; t += 2) {
            const bool last = (t == nt - 2);
            if constexpr (Epi::HOOK) { if (t == Epi::HOOK_T1 || t == Epi::HOOK_T2) E.hook(acc, cur, t, wr, wc, fr, fq); }
            const char* a1 = cA + (size_t)(t + 1) * kstep;
            const char* a2 = last ? nA : cA + (size_t)(t + 2) * kstep;
            const char* b2 = last ? nB : ((t + 2) < g.ksplit ? cB : cBhi) + (size_t)(t + 2) * kstep;
            const char* a3 = a2 + kstep; const char* b3 = b2 + kstep;
            if constexpr (SP2) {
            PG8_LDB(B0, 0, 0); PG8_LDB(B1, 0, 1); PG8_SCHED; PG8_LDA(At, 0, 0); PG8_STAGE(PG8_SA(1, 1), a1, voffA1);
            PG8_WAIT_V(8); PG8_WAIT_L(0); PG8_BAR; PG8_MMA(0, 0, At, B0); PG8_MMA(0, 1, At, B1); PG8_BAR; PG8_SCHED;
            PG8_LDA(At, 0, 1); PG8_STAGE(PG8_SB(0, 0), b2, voffB); PG8_STAGE(PG8_SB(0, 1), b2 + hstepB, voffB); PG8_STAGE(PG8_SA(0, 0), a2, voffA);
            PG8_WAIT_V(8); PG8_WAIT_L(0); PG8_BAR; if (hi_on) { PG8_MMA(1, 0, At, B0); PG8_MMA(1, 1, At, B1); } PG8_BAR; PG8_SCHED;
            PG8_LDB(B0, 1, 0); PG8_LDB(B1, 1, 1); PG8_SCHED; PG8_LDA(At, 1, 0); PG8_STAGE(PG8_SA(0, 1), a2, voffA1);
            PG8_WAIT_V(8); PG8_WAIT_L(0); PG8_BAR; PG8_MMA(0, 0, At, B0); PG8_MMA(0, 1, At, B1); PG8_BAR; PG8_SCHED;
            PG8_LDA(At, 1, 1); PG8_STAGE(PG8_SB(1, 0), b3, voffB); PG8_STAGE(PG8_SB(1, 1), b3 + hstepB, voffB); PG8_STAGE(PG8_SA(1, 0), a3, voffA);
            PG8_WAIT_V(8); PG8_WAIT_L(0); PG8_BAR; if (hi_on) { PG8_MMA(1, 0, At, B0); PG8_MMA(1, 1, At, B1); } PG8_BAR; PG8_SCHED;
            } else {
            PG8_LDB(B0, 0, 0); PG8_SCHED; PG8_LDA(At, 0, 0); PG8_STAGE(PG8_SA(1, 1), a1, voffA1);
            PG8_WAIT_L(8); PG8_BAR; PG8_WAIT_L(0); PG8_MMA(0, 0, At, B0); PG8_BAR; PG8_SCHED;
            PG8_LDB(B1, 0, 1); PG8_STAGE(PG8_SB(0, 0), b2, voffB);
            PG8_BAR; PG8_WAIT_L(0); PG8_MMA(0, 1, At, B1); PG8_BAR;
            PG8_LDA(At, 0, 1); PG8_STAGE(PG8_SA(0, 0), a2, voffA);
            PG8_BAR; PG8_WAIT_L(0); PG8_MMA(1, 0, At, B0); PG8_BAR; PG8_SCHED;
            PG8_STAGE(PG8_SB(0, 1), b2 + hstepB, voffB);
            PG8_WAIT_V(6); PG8_BAR; PG8_MMA(1, 1, At, B1); PG8_BAR;
            PG8_LDB(B0, 1, 0); PG8_SCHED; PG8_LDA(At, 1, 0); PG8_STAGE(PG8_SA(0, 1), a2, voffA1);
            PG8_WAIT_L(8); PG8_BAR; PG8_WAIT_L(0); PG8_MMA(0, 0, At, B0); PG8_BAR; PG8_SCHED;
            PG8_LDB(B1, 1, 1); PG8_STAGE(PG8_SB(1, 0), b3, voffB);
            PG8_BAR; PG8_WAIT_L(0); PG8_MMA(0, 1, At, B1); PG8_BAR;
            PG8_LDA(At, 1, 1); PG8_STAGE(PG8_SA(1, 0), a3, voffA);
            PG8_BAR; PG8_WAIT_L(0); PG8_MMA(1, 0, At, B0); PG8_BAR; PG8_SCHED;
            PG8_STAGE(PG8_SB(1, 1), b3 + hstepB, voffB);
            PG8_WAIT_V(6); PG8_BAR; PG8_MMA(1, 1, At, B1); PG8_BAR;
            }
        }
        if constexpr (ALIGN_EPI) { if (wr == 0) PG8_BAR; }
        E(acc, cur, wr, wc, fr, fq);
        if (!has_next) break;
#pragma unroll
        for (int a = 0; a < 2; ++a)
#pragma unroll
            for (int b = 0; b < 2; ++b)
#pragma unroll
                for (int m = 0; m < 4; ++m)
#pragma unroll
                    for (int n = 0; n < 2; ++n) acc[a][b][m][n] = (f32x4){0.f, 0.f, 0.f, 0.f};
        cur = nxt; cA = nA; cB = nB; cBhi = nxt.Bhi; ++ui;
        if constexpr (ALIGN_EPI) { if (wr == 1) PG8_BAR; }
    }
    PG8_WAIT_V(0);
    if constexpr (!ALIGN_EPI) { if (wr == 0) PG8_BAR; }
    PG8_BAR;
#undef PG8_SA
#undef PG8_SB
#undef PG8_STAGE
#undef PG8_LDA
#undef PG8_LDB
#undef PG8_MMA
#undef PG8_WAIT_V
#undef PG8_WAIT_L
#undef PG8_BAR
#undef PG8_SCHED
}
}

constexpr int RING_BYTES = 131072, LDS_BYTES = 147456, LDSCTL_OFF = LDS_BYTES - 2048, MISC_OFF = LDSCTL_OFF + 320;
struct KArgs { const void* in[24]; float* out; unsigned char* ws; int ph_lo, ph_hi; };
struct Frame {
    LAS unsigned char* lds; volatile LAS unsigned* MISC; unsigned* ctl; unsigned char* ws; float* out;
    int tid, lane, wave, vcu, G;
    const float *x, *mem, *g_mix, *w_in, *b_gate, *w_pool_grp, *pool_scale, *q_norm_g, *k_norm_g, *g_mem, *w_mem_kv, *xq_norm_g, *xk_norm_g,
                *w_pool_out, *w_attn_out, *w_cross_out, *w_o, *g_ffn, *w_rg, *w_re, *w_eg, *w_eu, *w_ed;
    const int* positions;
};
template <class T> __device__ __forceinline__ T* wsp(const Frame& F, size_t off) { return (T*)(F.ws + off); }

struct TrD { const float* W; const float* gain; bf16_t* dst; int ldw, k0, n0, nvalid, ldd, dk0; };
__device__ __forceinline__ void tr_load(const TrD& d, f32x4 (&v)[2][8], float (&g)[8], int lane) {
    const int kg = lane >> 3, ng = lane & 7;
#pragma unroll
    for (int hh = 0; hh < 2; ++hh) { const int nn = 32 * hh + 4 * ng; const bool ok = nn < d.nvalid;
#pragma unroll
        for (int i = 0; i < 8; ++i) v[hh][i] = ok ? *(const f32x4*)(d.W + (size_t)(d.k0 + 8 * kg + i) * d.ldw + d.n0 + nn) : (f32x4){0.f, 0.f, 0.f, 0.f}; }
#pragma unroll
    for (int i = 0; i < 8; ++i) g[i] = d.gain ? d.gain[d.k0 + 8 * kg + i] : 1.0f;
}
__device__ __forceinline__ void tr_store(const TrD& d, const f32x4 (&v)[2][8], const float (&g)[8], int lane) {
    const int kg = lane >> 3, ng = lane & 7;
#pragma unroll
    for (int hh = 0; hh < 2; ++hh)
#pragma unroll
        for (int j = 0; j < 4; ++j) { const int n = 32 * hh + 4 * ng + j;
            u32x4 o; o.x = pk2(v[hh][0][j] * g[0], v[hh][1][j] * g[1]); o.y = pk2(v[hh][2][j] * g[2], v[hh][3][j] * g[3]); o.z = pk2(v[hh][4][j] * g[4], v[hh][5][j] * g[5]); o.w = pk2(v[hh][6][j] * g[6], v[hh][7][j] * g[7]);
            *(u32x4*)(d.dst + (size_t)n * d.ldd + d.dk0 + d.k0 + 8 * kg) = o; }
}
__device__ __forceinline__ void tr_item(const float* W, int ldw, int k0, int n0, int nvalid, const float* gain, bf16_t* dst, int ldd, int dk0, LAS float*, int lane) {
    const TrD d{W, gain, dst, ldw, k0, n0, nvalid, ldd, dk0};
    f32x4 v[2][8]; float g[8];
    tr_load(d, v, g, lane); tr_store(d, v, g, lane);
}
__device__ __forceinline__ void tr_pair(const TrD& d0, const TrD& d1, int lane) {
    f32x4 v0[2][8], v1[2][8]; float g0[8], g1[8];
    tr_load(d0, v0, g0, lane); tr_load(d1, v1, g1, lane);
    tr_store(d0, v0, g0, lane); tr_store(d1, v1, g1, lane);
}
__device__ __forceinline__ void row_to_bf16(const float* xrow, bf16_t* orow, float* rstd_out, int lane) {
    const f32x4* xr = (const f32x4*)xrow + lane;
    f32x4 v[8]; float s = 0.f;
#pragma unroll
    for (int j = 0; j < 8; ++j) { v[j] = xr[64 * j]; s += (v[j].x * v[j].x + v[j].y * v[j].y) + (v[j].z * v[j].z + v[j].w * v[j].w); }
    s = wave_sum(s);
    u32x2* o8 = (u32x2*)orow + lane;
#pragma unroll
    for (int j = 0; j < 8; ++j) { u32x2 w; w.x = pk2(v[j].x, v[j].y); w.y = pk2(v[j].z, v[j].w); o8[64 * j] = w; }
    if (lane == 0) *rstd_out = 1.0f / sqrtf(s * (1.0f / DM) + NORM_EPS);
}
__device__ __forceinline__ void att_build_table(Frame& F);
__device__ __forceinline__ int cum_chunks(int qb);
#ifndef P0_PROF
#define P0_PROF 0
#endif
#define P0T0() unsigned long long _pt = (P0_PROF && F.tid == 0) ? __builtin_amdgcn_s_memrealtime() : 0ull
#define P0T1(k) do { if (P0_PROF == (k)) { __syncthreads(); if (F.tid == 0) atomicMax(F.ctl + CW_QUEUE + 8, (unsigned)(__builtin_amdgcn_s_memrealtime() - _pt)); } } while (0)
__device__ __forceinline__ void wcomb_item(Frame& F, int it, bf16_t* BTMRG) {
        const int g = it / 384, r = it % 384, ct = r / 64, dt = r % 64;
        const int i = F.lane & 31, kh = F.lane >> 5;
        const float* ap = F.w_pool_grp + (size_t)g * 192 * 192 + (size_t)(32 * ct + i) * 192 + 4 * kh;
        const float* sp = F.pool_scale + g * 192 + 4 * kh;
        const float* bp = F.w_pool_out + (size_t)(g * 192 + 4 * kh) * DM + 32 * dt + i;
        f32x16 acc;
#pragma unroll
        for (int q2 = 0; q2 < 16; ++q2) acc[q2] = 0.f;
#pragma unroll 1
        for (int m0 = 0; m0 < 24; m0 += 12) {
            f32x4 a[12], sc[12]; float b[12][4];
#pragma unroll
            for (int mm = 0; mm < 12; ++mm) { a[mm] = *(const f32x4*)(ap + 8 * (m0 + mm)); sc[mm] = *(const f32x4*)(sp + 8 * (m0 + mm));
#pragma unroll
                for (int e = 0; e < 4; ++e) b[mm][e] = bp[(size_t)(8 * (m0 + mm) + e) * DM]; }
#pragma unroll
            for (int mm = 0; mm < 12; ++mm)
#pragma unroll
                for (int e = 0; e < 4; ++e) acc = __builtin_amdgcn_mfma_f32_32x32x2f32(a[mm][e] * sc[mm][e], b[mm][e], acc, 0, 0, 0);
        }
        bf16_t* op = BTMRG + (size_t)(32 * dt + i) * DM + g * 192 + 32 * ct + 4 * kh;
#pragma unroll
        for (int q4 = 0; q4 < 4; ++q4) { u32x2 o; o.x = pk2(acc[4 * q4 + 0], acc[4 * q4 + 1]); o.y = pk2(acc[4 * q4 + 2], acc[4 * q4 + 3]); *(u32x2*)(op + 8 * q4) = o; }
}
__device__ __forceinline__ void p0_prologue(Frame& F) {
    P0T0();
    if (blockIdx.x == 0) att_build_table(F);
    LAS float* scr = (LAS float*)(F.lds + F.wave * 16640);
    const int gw = F.vcu * NWAVES + F.wave, NGW = F.G * NWAVES;
    bf16_t* WINT = wsp<bf16_t>(F, WS_WINT); bf16_t* WVT = wsp<bf16_t>(F, WS_WVT); bf16_t* WMKVT = wsp<bf16_t>(F, WS_WMKVT);
    bf16_t* BTMRG = wsp<bf16_t>(F, WS_BTMRG); bf16_t* WOT = wsp<bf16_t>(F, WS_WOT);
    for (int it = gw; it < 4 * 6 * 64; it += NGW) wcomb_item(F, it, BTMRG);
    __syncthreads();
    constexpr int NB_IN = 158, I_IN = 32 * NB_IN, I_MKV = 32 * 16, I_WO = 32 * 32, I_AO = 12 * 32, I_CO = 8 * 32;
    constexpr int NITEMS = I_IN + I_MKV + I_WO + I_AO + I_CO;
    auto decode = [&](int r, TrD& d) {
        d.nvalid = 64; d.dk0 = 0; d.ldd = DM;
        if (r < I_IN) {
            const int kb = r / NB_IN, nb = r % NB_IN; int sc0, drow; bf16_t* dm = WINT; int j;
            if (nb < 12) { j = nb; sc0 = 0; drow = 0; }
            else if (nb < 24) { j = nb - 12; sc0 = 768; drow = 768; }
            else if (nb < 36) { j = nb - 24; sc0 = 1536; drow = 1536; }
            else if (nb < 48) { j = nb - 36; sc0 = 2304; drow = 0; dm = WVT; }
            else if (nb < 52) { j = nb - 48; sc0 = 3072; drow = 2304; }
            else if (nb < 54) { j = nb - 52; sc0 = 3328; drow = 2560; if (j == 1) d.nvalid = 4; }
            else if (nb < 62) { j = nb - 54; sc0 = 3396; drow = 2816; }
            else { j = nb - 62; sc0 = 3908; drow = 3328; }
            d.W = F.w_in; d.ldw = INC; d.k0 = kb * 64; d.n0 = sc0 + 64 * j; d.gain = F.g_mix; d.dst = dm + (size_t)(drow + 64 * j) * DM; return; }
        r -= I_IN;
        if (r < I_MKV) { const int kb = r / 16, nb = r % 16; d.W = F.w_mem_kv; d.ldw = 1024; d.k0 = kb * 64; d.n0 = nb * 64; d.gain = F.g_mem; d.dst = WMKVT + (size_t)(nb * 64) * DM; return; }
        r -= I_MKV;
        if (r < I_WO) { const int kb = r / 32, nb = r % 32; d.W = F.w_o; d.ldw = DM; d.k0 = kb * 64; d.n0 = nb * 64; d.gain = nullptr; d.dst = WOT + (size_t)(nb * 64) * DM; return; }
        r -= I_WO;
        if (r < I_AO) { const int kb = r / 32, nb = r % 32; d.W = F.w_attn_out; d.ldw = DM; d.k0 = kb * 64; d.n0 = nb * 64; d.gain = nullptr; d.dst = BTMRG + (size_t)(nb * 64) * DM; d.dk0 = 768; return; }
        r -= I_AO;
        { const int kb = r / 32, nb = r % 32; d.W = F.w_cross_out; d.ldw = DM; d.k0 = kb * 64; d.n0 = nb * 64; d.gain = nullptr; d.dst = BTMRG + (size_t)(nb * 64) * DM; d.dk0 = 1536; }
    };
    for (int it = gw; it < NITEMS; it += 2 * NGW) {
        TrD d0, d1; decode(it, d0);
        if (it + NGW < NITEMS) { decode(it + NGW, d1); tr_pair(d0, d1, F.lane); }
        else { f32x4 v[2][8]; float g[8]; tr_load(d0, v, g, F.lane); tr_store(d0, v, g, F.lane); }
    }
    P0T1(2);
    { u32x4* z = (u32x4*)(WINT + (size_t)2688 * DM); const int n16 = 128 * DM * 2 / 16;
      for (int i = F.vcu * NTHR + F.tid; i < n16; i += F.G * NTHR) z[i] = (u32x4){0u, 0u, 0u, 0u}; }
    { float* WR = wsp<float>(F, WS_WR);
      for (int i = F.vcu * NTHR + F.tid; i < DM * 32; i += F.G * NTHR) { const int k = i >> 5, j = i & 31;
          float v = 0.f; if (j < 4) v = F.w_rg[k * 4 + j]; else if (j < 20) v = F.w_re[k * 16 + (j - 4)];
          WR[i] = v * F.g_ffn[k]; } }
    P0T1(3);
    { bf16_t* XB = wsp<bf16_t>(F, WS_XB); float* R1 = wsp<float>(F, WS_RSTD1); bf16_t* MB = wsp<bf16_t>(F, WS_MEMB); float* RM = wsp<float>(F, WS_RSTDM);
      for (int m0 = gw; m0 < SEQ + MEML; m0 += 4 * NGW) {
          f32x4 v[4][8];
#pragma unroll
          for (int r = 0; r < 4; ++r) { const int m = m0 + r * NGW; if (m < SEQ + MEML) { const f32x4* xr = (const f32x4*)(m < SEQ ? F.x + (size_t)m * DM : F.mem + (size_t)(m - SEQ) * DM) + F.lane;
#pragma unroll
              for (int j = 0; j < 8; ++j) v[r][j] = xr[64 * j]; } }
#pragma unroll
          for (int r = 0; r < 4; ++r) { const int m = m0 + r * NGW; if (m < SEQ + MEML) { float s = 0.f;
#pragma unroll
              for (int j = 0; j < 8; ++j) s += (v[r][j].x * v[r][j].x + v[r][j].y * v[r][j].y) + (v[r][j].z * v[r][j].z + v[r][j].w * v[r][j].w);
              s = wave_sum(s);
              u32x2* o8 = (u32x2*)(m < SEQ ? XB + (size_t)m * DM : MB + (size_t)(m - SEQ) * DM) + F.lane;
#pragma unroll
              for (int j = 0; j < 8; ++j) { u32x2 w; w.x = pk2(v[r][j].x, v[r][j].y); w.y = pk2(v[r][j].z, v[r][j].w); o8[64 * j] = w; }
              if (F.lane == 0) { const float rs = 1.0f / sqrtf(s * (1.0f / DM) + NORM_EPS); if (m < SEQ) R1[m] = rs; else RM[m - SEQ] = rs; } } } } }
}

struct SchedP1 {
    int c, G; unsigned char* ws;
    __device__ __forceinline__ bool next(int i, pg8::Unit& u) const {
        const int L = i * G + c; const size_t tstep = (size_t)256 * DM * 2;
        const char* XB = (const char*)(ws + WS_XB); const char* WINT = (const char*)(ws + WS_WINT); const char* WVT = (const char*)(ws + WS_WVT); const char* MEMB = (const char*)(ws + WS_MEMB); const char* WMKVT = (const char*)(ws + WS_WMKVT);
        u.nt = 32; u.lowonly = 0;
        if (L < 1184) { int pm, pn; pg8::tile_order(L, 32, 37, pm, pn);
            u.A = XB + (size_t)pm * tstep; u.B = WINT + (size_t)pn * tstep; u.Bhi = u.B; u.row0 = pm * 256;
            if (pn < 3) { u.kind = 0; u.col0 = pn * 256; u.aux = 0; }
            else if (pn < 6) { u.kind = 0; u.col0 = (pn - 3) * 256; u.aux = 1; }
            else if (pn < 9) { u.kind = 0; u.col0 = (pn - 6) * 256; u.aux = 2; }
            else if (pn < 11) { u.kind = 1; u.col0 = (pn - 9) * 256; u.aux = 0; }
            else if (pn < 13) { u.kind = 0; u.col0 = (pn - 11) * 256; u.aux = 3; }
            else { u.kind = 2; u.col0 = (pn - 13) * 256; u.aux = 0; }
            return true; }
        if (L < 1280) { const int idx = L - 1184, pm = idx / 32, pn = idx % 32;
            u.A = WVT + (size_t)pm * tstep; u.B = XB + (size_t)pn * tstep; u.Bhi = u.B; u.kind = 3; u.row0 = pm * 256; u.col0 = pn * 256; u.aux = 0; return true; }
        if (L < 1312) { const int idx = L - 1280, pn = idx & 3, ks = idx >> 2;
            u.A = MEMB + (size_t)ks * 512; u.B = WMKVT + (size_t)pn * tstep + (size_t)ks * 512; u.Bhi = u.B; u.kind = 4; u.row0 = 0; u.col0 = pn * 256; u.aux = ks; u.nt = 4; return true; }
        return false;
    }
};
struct EpiP1 {
    static constexpr bool HOOK = false; static constexpr int HOOK_T1 = -1, HOOK_T2 = -1;
    unsigned char* ws; const float* rstd1; const float* rstdm; const float* bgate;
    __device__ __forceinline__ void hook(f32x4 (&)[2][2][4][2], const pg8::Unit&, int, int, int, int, int) const {}
    __device__ __forceinline__ void operator()(const f32x4 (&acc)[2][2][4][2], const pg8::Unit& u, int wr, int wc, int fr, int fq) const {
        const int rbase = u.row0 + wr * 64 + fr, cbase = u.col0 + wc * 32 + 8 * fq;
        if (u.kind == 0) {
            bf16_t* C; int ldc;
            if (u.aux == 0) { C = (bf16_t*)(ws + WS_U); ldc = 768; } else if (u.aux == 1) { C = (bf16_t*)(ws + WS_Q); ldc = 768; }
            else if (u.aux == 2) { C = (bf16_t*)(ws + WS_K); ldc = 768; } else { C = (bf16_t*)(ws + WS_XQ); ldc = 512; }
#pragma unroll
            for (int ai = 0; ai < 2; ++ai)
#pragma unroll
                for (int m = 0; m < 4; ++m) { const int row = rbase + ai * 128 + m * 16; const float s = rstd1[row];
#pragma unroll
                    for (int bj = 0; bj < 2; ++bj) { const f32x4 v0 = acc[ai][bj][m][0] * s, v1 = acc[ai][bj][m][1] * s;
                        u32x4 w; w.x = pk2(v0[0], v0[1]); w.y = pk2(v0[2], v0[3]); w.z = pk2(v1[0], v1[1]); w.w = pk2(v1[2], v1[3]);
                        *(u32x4*)(C + (size_t)row * ldc + cbase + bj * 128) = w; } }
        } else if (u.kind == 1 || u.kind == 4) {
            float* C; int ldc; const float* rs;
            if (u.kind == 1) { C = (float*)(ws + WS_IDXF); ldc = 512; rs = rstd1; } else { C = (float*)(ws + WS_KVMP) + (size_t)u.aux * 262144; ldc = 1024; rs = rstdm; }
#pragma unroll
            for (int ai = 0; ai < 2; ++ai)
#pragma unroll
                for (int m = 0; m < 4; ++m) { const int row = rbase + ai * 128 + m * 16; const float s = rs[row];
#pragma unroll
                    for (int bj = 0; bj < 2; ++bj) { float* p = C + (size_t)row * ldc + cbase + bj * 128;
                        *(f32x4*)p = acc[ai][bj][m][0] * s; *(f32x4*)(p + 4) = acc[ai][bj][m][1] * s; } }
        } else if (u.kind == 2) {
            bf16_t* C = (bf16_t*)(ws + WS_EG);
            f32x4 bv[2][2];
#pragma unroll
            for (int bj = 0; bj < 2; ++bj) { bv[bj][0] = *(const f32x4*)(bgate + cbase + bj * 128); bv[bj][1] = *(const f32x4*)(bgate + cbase + bj * 128 + 4); }
#pragma unroll
            for (int ai = 0; ai < 2; ++ai)
#pragma unroll
                for (int m = 0; m < 4; ++m) { const int row = rbase + ai * 128 + m * 16; const float s = rstd1[row];
#pragma unroll
                    for (int bj = 0; bj < 2; ++bj) { f32x4 v0 = acc[ai][bj][m][0] * s + bv[bj][0], v1 = acc[ai][bj][m][1] * s + bv[bj][1];
#pragma unroll
                        for (int e = 0; e < 4; ++e) { v0[e] = 1.0f + __builtin_amdgcn_exp2f(fminf(-v0[e] * LOG2E, 60.f)); v1[e] = 1.0f + __builtin_amdgcn_exp2f(fminf(-v1[e] * LOG2E, 60.f)); }
                        u32x4 w; w.x = pk2(v0[0], v0[1]); w.y = pk2(v0[2], v0[3]); w.z = pk2(v1[0], v1[1]); w.w = pk2(v1[2], v1[3]);
                        *(u32x4*)(C + (size_t)row * 6144 + cbase + bj * 128) = w; } }
        } else {
            bf16_t* C = (bf16_t*)(ws + WS_VT);
            f32x4 sv[2][2];
#pragma unroll
            for (int bj = 0; bj < 2; ++bj) { sv[bj][0] = *(const f32x4*)(rstd1 + cbase + bj * 128); sv[bj][1] = *(const f32x4*)(rstd1 + cbase + bj * 128 + 4); }
#pragma unroll
            for (int ai = 0; ai < 2; ++ai)
#pragma unroll
                for (int m = 0; m < 4; ++m) { const int row = rbase + ai * 128 + m * 16;
#pragma unroll
                    for (int bj = 0; bj < 2; ++bj) { const f32x4 v0 = acc[ai][bj][m][0] * sv[bj][0], v1 = acc[ai][bj][m][1] * sv[bj][1];
                        u32x4 w; w.x = pk2(v0[0], v0[1]); w.y = pk2(v0[2], v0[3]); w.z = pk2(v1[0], v1[1]); w.w = pk2(v1[2], v1[3]);
                        *(u32x4*)(C + (size_t)row * SEQ + cbase + bj * 128) = w; } }
        }
    }
};

__device__ __forceinline__ void rot_cs(float pos, float inv_freq, float& c, float& s) {
    const float ang = pos * inv_freq;
    const double rev = (double)ang * 0.15915494309189535;
    const float fr = (float)(rev - __builtin_rint(rev));
    c = __builtin_amdgcn_cosf(fr); s = __builtin_amdgcn_sinf(fr);
}
__device__ __forceinline__ void unpack8(const u32x4 v, float (&f)[8]) { f[0] = bflo(v.x); f[1] = bfhi(v.x); f[2] = bflo(v.y); f[3] = bfhi(v.y); f[4] = bflo(v.z); f[5] = bfhi(v.z); f[6] = bflo(v.w); f[7] = bfhi(v.w); }
__device__ __forceinline__ u32x4 pack8(const float (&f)[8]) { u32x4 o; o.x = pk2(f[0], f[1]); o.y = pk2(f[2], f[3]); o.z = pk2(f[4], f[5]); o.w = pk2(f[6], f[7]); return o; }
__device__ __forceinline__ void p2_rowpass(Frame& F) {
    P0T0();
    const int gw = F.vcu * NWAVES + F.wave, NGW = F.G * NWAVES, lane = F.lane;
    const bf16_t* U = wsp<bf16_t>(F, WS_U); bf16_t* AM = wsp<bf16_t>(F, WS_AMRG);
    bf16_t* Q = wsp<bf16_t>(F, WS_Q); bf16_t* K = wsp<bf16_t>(F, WS_K); bf16_t* XQ = wsp<bf16_t>(F, WS_XQ);
    const float* IDXF = wsp<float>(F, WS_IDXF); bf16_t* QIB = wsp<bf16_t>(F, WS_QIB); bf16_t* KIB = wsp<bf16_t>(F, WS_KIB); float* WIF = wsp<float>(F, WS_WIF);
    const int m = lane & 15, mlo = m & 7; const bool hi_half = m >= 8;
    float if128[8], if64[4], gq[8], gk[8], gx[8];
#pragma unroll
    for (int e = 0; e < 8; ++e) { if128[e] = __builtin_amdgcn_exp2f(-(float)(2 * (8 * mlo + e)) * (13.287712379549449f / 128.0f)); gq[e] = F.q_norm_g[8 * m + e]; gk[e] = F.k_norm_g[8 * m + e]; gx[e] = F.xq_norm_g[8 * m + e]; }
#pragma unroll
    for (int e = 0; e < 4; ++e) if64[e] = __builtin_amdgcn_exp2f(-(float)(2 * (4 * mlo + e)) * (13.287712379549449f / 64.0f));
    for (int t = gw; t < SEQ; t += NGW) {
        const int colA = 8 * lane, colB = 512 + 8 * lane;
        const int gA = colA / 192, wA = 2 << gA, cntA = (t + 1 < wA) ? (t + 1) : wA;
        const int gB = (lane < 32) ? colB / 192 : 3, wB = 2 << gB, cntB = (lane < 32) ? ((t + 1 < wB) ? (t + 1) : wB) : 0;
        u32x4 ua[8], ub[16];
#pragma unroll
        for (int j = 0; j < 8; ++j) ua[j] = (j < cntA) ? *(const u32x4*)(U + (size_t)(t - j) * 768 + colA) : (u32x4){0u, 0u, 0u, 0u};
#pragma unroll
        for (int j = 0; j < 16; ++j) ub[j] = (j < cntB) ? *(const u32x4*)(U + (size_t)(t - j) * 768 + colB) : (u32x4){0u, 0u, 0u, 0u};
        u32x4 rawqk[3];
#pragma unroll
        for (int ch = 0; ch < 3; ++ch) { const int e0 = ch * 512 + 8 * lane; rawqk[ch] = *(const u32x4*)((e0 < 768) ? (Q + (size_t)t * 768 + e0) : (K + (size_t)t * 768 + (e0 - 768))); }
        const u32x4 rawx = *(const u32x4*)(XQ + (size_t)t * 512 + 8 * lane);
        const float* ip = IDXF + (size_t)t * 512;
        const f32x4 iqa = *(const f32x4*)(ip + 4 * lane), ika = *(const f32x4*)(ip + 256 + 4 * (lane & 15));
        const float iw = ip[320 + (lane & 3)];
        { float sum[8];
#pragma unroll
          for (int e = 0; e < 8; ++e) sum[e] = 0.f;
#pragma unroll
          for (int j = 0; j < 8; ++j) { float f[8]; unpack8(ua[j], f);
#pragma unroll
              for (int e = 0; e < 8; ++e) sum[e] += f[e]; }
          float cur[8]; unpack8(ua[0], cur); const float inv = 1.0f / (float)cntA; float o[8];
#pragma unroll
          for (int e = 0; e < 8; ++e) o[e] = sum[e] * inv - cur[e];
          *(u32x4*)(AM + (size_t)t * DM + colA) = pack8(o); }
        if (lane < 32) { float sum[8];
#pragma unroll
          for (int e = 0; e < 8; ++e) sum[e] = 0.f;
#pragma unroll
          for (int j = 0; j < 16; ++j) { float f[8]; unpack8(ub[j], f);
#pragma unroll
              for (int e = 0; e < 8; ++e) sum[e] += f[e]; }
          float cur[8]; unpack8(ub[0], cur); const float inv = 1.0f / (float)cntB; float o[8];
#pragma unroll
          for (int e = 0; e < 8; ++e) o[e] = sum[e] * inv - cur[e];
          *(u32x4*)(AM + (size_t)t * DM + colB) = pack8(o); }
        const float pos = (float)F.positions[t];
        float c128[8], s128[8], c64[4], s64[4];
#pragma unroll
        for (int e = 0; e < 8; ++e) rot_cs(pos, if128[e], c128[e], s128[e]);
#pragma unroll
        for (int e = 0; e < 4; ++e) rot_cs(pos, if64[e], c64[e], s64[e]);
#pragma unroll
        for (int ch = 0; ch < 3; ++ch) {
            const int e0 = ch * 512 + 8 * lane; const bool isq = e0 < 768;
            bf16_t* p = isq ? (Q + (size_t)t * 768 + e0) : (K + (size_t)t * 768 + (e0 - 768));
            float v[8], pv[8]; unpack8(rawqk[ch], v);
            float ss = 0.f;
#pragma unroll
            for (int e = 0; e < 8; ++e) ss += v[e] * v[e];
            ss += __shfl_xor(ss, 1); ss += __shfl_xor(ss, 2); ss += __shfl_xor(ss, 4); ss += __shfl_xor(ss, 8);
            const float r = (1.0f / sqrtf(ss * (1.0f / 128.0f) + NORM_EPS)) * (isq ? (ATT_SCALE * LOG2E) : 1.0f);
#pragma unroll
            for (int e = 0; e < 8; ++e) v[e] *= r * (isq ? gq[e] : gk[e]);
#pragma unroll
            for (int e = 0; e < 8; ++e) pv[e] = __shfl_xor(v[e], 8);
            float o[8];
#pragma unroll
            for (int e = 0; e < 8; ++e) o[e] = hi_half ? (v[e] * c128[e] + pv[e] * s128[e]) : (v[e] * c128[e] - pv[e] * s128[e]);
            *(u32x4*)p = pack8(o);
        }
        { bf16_t* p = XQ + (size_t)t * 512 + 8 * lane; float v[8]; unpack8(rawx, v);
          float ss = 0.f;
#pragma unroll
          for (int e = 0; e < 8; ++e) ss += v[e] * v[e];
          ss += __shfl_xor(ss, 1); ss += __shfl_xor(ss, 2); ss += __shfl_xor(ss, 4); ss += __shfl_xor(ss, 8);
          const float r = (1.0f / sqrtf(ss * (1.0f / 128.0f) + NORM_EPS)) * (ATT_SCALE * LOG2E);
#pragma unroll
          for (int e = 0; e < 8; ++e) v[e] *= r * gx[e];
          *(u32x4*)p = pack8(v); }
        { const f32x4 a = iqa; f32x4 b; b[0] = __shfl_xor(a[0], 8); b[1] = __shfl_xor(a[1], 8); b[2] = __shfl_xor(a[2], 8); b[3] = __shfl_xor(a[3], 8);
          float o[4];
#pragma unroll
          for (int e = 0; e < 4; ++e) o[e] = hi_half ? (a[e] * c64[e] + b[e] * s64[e]) : (a[e] * c64[e] - b[e] * s64[e]);
          u32x2 w; w.x = pk2(o[0], o[1]); w.y = pk2(o[2], o[3]); *(u32x2*)(QIB + (size_t)t * 256 + 4 * lane) = w; }
        { const f32x4 a = ika; f32x4 b; b[0] = __shfl_xor(a[0], 8); b[1] = __shfl_xor(a[1], 8); b[2] = __shfl_xor(a[2], 8); b[3] = __shfl_xor(a[3], 8);
          float o[4];
#pragma unroll
          for (int e = 0; e < 4; ++e) o[e] = hi_half ? (a[e] * c64[e] + b[e] * s64[e]) : (a[e] * c64[e] - b[e] * s64[e]);
          u32x2 w; w.x = pk2(o[0], o[1]); w.y = pk2(o[2], o[3]); if (lane < 16) *(u32x2*)(KIB + (size_t)t * 64 + 4 * lane) = w; }
        if (lane < 4) WIF[t * 4 + lane] = iw * 0.0625f;
    }
    P0T1(4);
    { const float* KVM = wsp<float>(F, WS_KVMP); bf16_t* KMB = wsp<bf16_t>(F, WS_KMB); bf16_t* VMT = wsp<bf16_t>(F, WS_VMT);
      const float g0 = F.xk_norm_g[lane], g1 = F.xk_norm_g[lane + 64];
      for (int mm = gw; mm < MEML; mm += NGW) {
#pragma unroll
          for (int h = 0; h < 4; ++h) { float k0 = 0.f, k1 = 0.f;
#pragma unroll
              for (int ks = 0; ks < 8; ++ks) { k0 += KVM[(size_t)ks * 262144 + (size_t)mm * 1024 + h * 128 + lane]; k1 += KVM[(size_t)ks * 262144 + (size_t)mm * 1024 + h * 128 + lane + 64]; }
              const float ks2 = wave_sum(k0 * k0 + k1 * k1), kr = 1.0f / sqrtf(ks2 * (1.0f / 128.0f) + NORM_EPS);
              KMB[(size_t)mm * 512 + h * 128 + lane] = (bf16_t)f2bf(k0 * kr * g0); KMB[(size_t)mm * 512 + h * 128 + lane + 64] = (bf16_t)f2bf(k1 * kr * g1); }
#pragma unroll
          for (int j = 0; j < 8; ++j) { const int c = j * 64 + lane; float v = 0.f;
#pragma unroll
              for (int ks = 0; ks < 8; ++ks) v += KVM[(size_t)ks * 262144 + (size_t)mm * 1024 + 512 + c];
              VMT[(size_t)c * 256 + mm] = (bf16_t)f2bf(v); }
      } }
    P0T1(5);
    { LAS float* scr = (LAS float*)(F.lds + F.wave * 16640);
      bf16_t* WGUT = wsp<bf16_t>(F, WS_WGUT); bf16_t* WDT = wsp<bf16_t>(F, WS_WDT);
      constexpr int I_GU = 16 * 2 * 32 * 8, I_D = 16 * 8 * 32;
      auto dec = [&](int it, TrD& d) {
          d.nvalid = 64; d.dk0 = 0;
          if (it < I_GU) { const int e = it / 512, r = it % 512, up = r / 256, r2 = r % 256, kb = r2 / 8, nb = r2 % 8, f0 = nb * 64;
              const int drow = (f0 / 128) * 256 + up * 128 + (f0 % 128);
              d.W = (up ? F.w_eu : F.w_eg) + (size_t)e * DM * 512; d.ldw = 512; d.k0 = kb * 64; d.n0 = f0; d.gain = F.g_ffn; d.dst = WGUT + ((size_t)e * 1024 + drow) * DM; d.ldd = DM; }
          else { const int r = it - I_GU, e = r / 256, r2 = r % 256, kb = r2 / 32, nb = r2 % 32;
              d.W = F.w_ed + (size_t)e * 512 * DM; d.ldw = DM; d.k0 = kb * 64; d.n0 = nb * 64; d.gain = nullptr; d.dst = WDT + ((size_t)e * DM + nb * 64) * 512; d.ldd = 512; } };
      for (int it = gw; it < I_GU + I_D; it += 2 * NGW) {
          TrD d0, d1; dec(it, d0);
          if (it + NGW < I_GU + I_D) { dec(it + NGW, d1); tr_pair(d0, d1, lane); }
          else { f32x4 v[2][8]; float g[8]; tr_load(d0, v, g, lane); tr_store(d0, v, g, lane); }
      } }
}

constexpr int HS = 1025;
constexpr int P3_HIST = 0, P3_RING = 16 * HS * 4, P3_LMASK = P3_RING + 8 * 3 * 2048, P3_STATE = P3_LMASK + 16 * 256 * 4;
constexpr int P3_CAP = 384;
__device__ __forceinline__ float relu_s(float x) { const int b = __builtin_bit_cast(int, x); return __builtin_bit_cast(float, b > 0 ? b : 0); }
__device__ __forceinline__ void p3_scores(const bf16x8 A0, const bf16x8 A1, const bf16x8 (&Bq)[4][2], const float (&wq)[4], float (&sc)[4]) {
    f32x2_t s01 = {0.f, 0.f}, s23 = {0.f, 0.f};
#pragma unroll
    for (int h = 0; h < 4; ++h) { f32x4 d = (f32x4){0.f, 0.f, 0.f, 0.f};
        d = __builtin_amdgcn_mfma_f32_16x16x32_bf16(A0, Bq[h][0], d, 0, 0, 0); d = __builtin_amdgcn_mfma_f32_16x16x32_bf16(A1, Bq[h][1], d, 0, 0, 0);
        const f32x2_t w2 = {wq[h], wq[h]}, r01 = {relu_s(d[0]), relu_s(d[1])}, r23 = {relu_s(d[2]), relu_s(d[3])};
        s01 = __builtin_elementwise_fma(w2, r01, s01); s23 = __builtin_elementwise_fma(w2, r23, s23); }
    sc[0] = s01[0]; sc[1] = s01[1]; sc[2] = s23[0]; sc[3] = s23[1];
}
template <int MODE, bool ALLV> __device__ __forceinline__ void p3_update(LAS unsigned* hist, LAS unsigned* lmask, LAS unsigned* ccnt, const float (&sc)[4], unsigned vb,
                                                              int kt, int q, int fq, unsigned pref, unsigned thr, unsigned idxs, bool part) {
    const int s0 = 16 * kt;
    unsigned nib = 0u, cflag = 0u; unsigned ckey[4];
#pragma unroll
    for (int i = 0; i < 4; ++i) {
        const unsigned bits = __builtin_bit_cast(unsigned, sc[i]);
        const unsigned key = bits ^ ((unsigned)((int)bits >> 31) | 0x80000000u);
        const bool valid = ALLV ? true : (((vb >> i) & 1u) != 0u);
        const unsigned s = (unsigned)(s0 + 4 * fq + i);
        if constexpr (MODE == 0) { if (valid && part) { const unsigned dg = key >> 21; __hip_atomic_fetch_add(&hist[q * HS + (dg >> 1)], 1u << (16 * (dg & 1u)), __ATOMIC_RELAXED, __HIP_MEMORY_SCOPE_WORKGROUP); } }
        else if constexpr (MODE == 1) { if (valid && part && (key >> 21) == pref) { const unsigned dg = (key >> 10) & 2047u; __hip_atomic_fetch_add(&hist[q * HS + (dg >> 1)], 1u << (16 * (dg & 1u)), __ATOMIC_RELAXED, __HIP_MEMORY_SCOPE_WORKGROUP); } }
        else if constexpr (MODE == 2) { if (valid && part && (key >> 10) == pref) { const unsigned dg = key & 1023u; __hip_atomic_fetch_add(&hist[q * HS + (dg >> 1)], 1u << (16 * (dg & 1u)), __ATOMIC_RELAXED, __HIP_MEMORY_SCOPE_WORKGROUP); } }
        else if constexpr (MODE == 3) { if (valid && part && key == thr) { const unsigned dg = s >> 2; __hip_atomic_fetch_add(&hist[q * HS + (dg >> 1)], 1u << (16 * (dg & 1u)), __ATOMIC_RELAXED, __HIP_MEMORY_SCOPE_WORKGROUP); } }
        else if constexpr (MODE == 4) { if (valid && part && key == thr && (s >> 2) == pref) { const unsigned dg = s & 3u; __hip_atomic_fetch_add(&hist[q * HS + (dg >> 1)], 1u << (16 * (dg & 1u)), __ATOMIC_RELAXED, __HIP_MEMORY_SCOPE_WORKGROUP); } }
        else if constexpr (MODE == 5) { const bool sel = valid && (key > thr || (key == thr && s <= idxs)); nib |= sel ? (1u << i) : 0u; }
        else {
            const unsigned m13 = (bits & 0x7fffffffu) >> 18; const unsigned cl = m13 < 3168u ? 3168u : (m13 > 4191u ? 4191u : m13);
            const unsigned dg = (cl - 2144u) ^ ((unsigned)((int)bits >> 31) & 2047u);
            ckey[i] = key;
            if constexpr (MODE == 9) { if (valid) __hip_atomic_fetch_add(&hist[q * HS + (dg >> 1)], 1u << (16 * (dg & 1u)), __ATOMIC_RELAXED, __HIP_MEMORY_SCOPE_WORKGROUP); }
            else { nib |= (valid && dg > pref) ? (1u << i) : 0u; cflag |= (valid && dg == pref) ? (1u << i) : 0u; } }
    }
    if constexpr (MODE == 10) {
        if (cflag) { __hip_atomic_fetch_or(&hist[q * HS + 768 + (kt >> 1)], cflag << (16 * (kt & 1) + 4 * fq), __ATOMIC_RELAXED, __HIP_MEMORY_SCOPE_WORKGROUP);
            if (part) { unsigned sl = __hip_atomic_fetch_add(&ccnt[q], (unsigned)__builtin_popcount(cflag), __ATOMIC_RELAXED, __HIP_MEMORY_SCOPE_WORKGROUP);
#pragma unroll
                for (int i = 0; i < 4; ++i) if ((cflag >> i) & 1u) { if (sl < (unsigned)P3_CAP) { hist[q * HS + 2 * sl] = ckey[i]; hist[q * HS + 2 * sl + 1] = (unsigned)(s0 + 4 * fq + i); } ++sl; } } }
    }
    if constexpr (MODE == 5 || MODE == 10) { if (nib) __hip_atomic_fetch_or(&lmask[q * 256 + (kt >> 1)], nib << (16 * (kt & 1) + 4 * fq), __ATOMIC_RELAXED, __HIP_MEMORY_SCOPE_WORKGROUP); }
}
template <int MODE> __device__ __forceinline__ void p3_sweep(Frame& F, int b, const bf16x8 (&Bq)[4][2], const float (&wq)[4], unsigned pref, unsigned thr, unsigned idxs, bool part, int dtype = 0) {
    const char* KIBc = (const char*)wsp<bf16_t>(F, WS_KIB);
    LAS unsigned* hist = (LAS unsigned*)(F.lds + P3_HIST); LAS unsigned* lmask = (LAS unsigned*)(F.lds + P3_LMASK); LAS unsigned* ccnt = (LAS unsigned*)(F.lds + P3_STATE) + 80;
    const int lane = F.lane, q = lane & 15, fq = lane >> 4;
    const unsigned goff = (unsigned)(q * 128 + fq * 16);
    unsigned dbits = 0u;
#pragma unroll
    for (int i = 0; i < 4; ++i) dbits |= (4 * fq + i <= q) ? (1u << i) : 0u;
    const int nj = (b >= F.wave) ? ((b - F.wave) >> 3) + 1 : 0;
#define P3_LD(j, a0, a1) do { int _kt = F.wave + 8 * (j); _kt = _kt < b ? _kt : b; const char* _src = KIBc + (size_t)_kt * 2048 + goff; a0 = *(const bf16x8*)(_src); a1 = *(const bf16x8*)(_src + 64); } while (0)
    bf16x8 C00, C01, C10, C11;
    if (nj > 0) { P3_LD(0, C00, C01); P3_LD(1, C10, C11); }
    for (int j = 0; j < nj; j += 2) {
        bf16x8 N00, N01, N10, N11;
        P3_LD(j + 2, N00, N01); P3_LD(j + 3, N10, N11);
        float sa[4], sb[4];
        p3_scores(C00, C01, Bq, wq, sa); p3_scores(C10, C11, Bq, wq, sb);
        const int kt0 = F.wave + 8 * j, kt1 = kt0 + 8;
        if (kt1 < b) {
            p3_update<MODE, true>(hist, lmask, ccnt, sa, 0xFu, kt0, q, fq, pref, thr, idxs, part);
            p3_update<MODE, true>(hist, lmask, ccnt, sb, 0xFu, kt1, q, fq, pref, thr, idxs, part);
        } else {
            p3_update<MODE, false>(hist, lmask, ccnt, sa, kt0 < b ? 0xFu : dbits, kt0, q, fq, pref, thr, idxs, part);
            if (kt1 == b) p3_update<MODE, false>(hist, lmask, ccnt, sb, dbits, kt1, q, fq, pref, thr, idxs, part);
        }
        C00 = N00; C01 = N01; C10 = N10; C11 = N11;
    }
#undef P3_LD
}
__device__ __forceinline__ void p3_scan(Frame& F, bool fromtop) {
    LAS unsigned* hist = (LAS unsigned*)(F.lds + P3_HIST); LAS unsigned* st = (LAS unsigned*)(F.lds + P3_STATE);
    __syncthreads();
    const int lane = F.lane;
#pragma unroll 1
    for (int rr = 0; rr < 2; ++rr) {
        const int row = 2 * F.wave + rr;
        if (st[row * 4 + 3] == 0u) continue;
        const unsigned rank = st[row * 4 + 1];
        unsigned wv[16]; unsigned sj = 0;
#pragma unroll
        for (int i = 0; i < 16; ++i) { wv[i] = hist[row * HS + 16 * lane + i]; sj += (wv[i] & 0xffffu) + (wv[i] >> 16); }
        unsigned P = sj;
#pragma unroll
        for (int o = 1; o < 64; o <<= 1) { const unsigned v = __shfl_up(P, o); if (lane >= o) P += v; }
        const unsigned T = __shfl(P, 63);
        unsigned cum = fromtop ? (T - P) : (P - sj);
        const bool cross = (cum < rank) && (rank <= cum + sj);
        unsigned bin = 0, cb = 0; bool found = false;
#pragma unroll
        for (int ii = 0; ii < 32; ++ii) { const int bl = fromtop ? 31 - ii : ii; const unsigned w = wv[bl >> 1]; const unsigned c = (bl & 1) ? (w >> 16) : (w & 0xffffu);
            const bool hit = !found && (cum + c >= rank);
            if (hit) { bin = (unsigned)(32 * lane + bl); cb = c; found = true; }
            if (!found) cum += c; }
        if (cross) { st[row * 4 + 0] = bin; st[row * 4 + 1] = rank - cum; st[row * 4 + 2] = cb; }
    }
    __syncthreads();
}
__device__ __forceinline__ unsigned wave_count(bool p) { return (unsigned)__builtin_popcountll(__ballot(p)); }
__device__ __forceinline__ void p3_select_row(Frame& F, int row, int shift) {
    LAS unsigned* cand = (LAS unsigned*)(F.lds + P3_HIST) + row * HS; LAS unsigned* lmask = (LAS unsigned*)(F.lds + P3_LMASK) + row * 256; LAS unsigned* st = (LAS unsigned*)(F.lds + P3_STATE);
    const unsigned bin0 = st[row * 4 + 0], rank = st[row * 4 + 1], nc = st[row * 4 + 2];
    const int lane = F.lane;
    unsigned ck[8], ci[8];
#pragma unroll
    for (int i = 0; i < 8; ++i) { const unsigned sl = (unsigned)(lane + 64 * i); const bool ok = sl < nc; ck[i] = ok ? cand[2 * sl] : 0u; ci[i] = ok ? cand[2 * sl + 1] : 0x7fffffffu; }
    unsigned P = 0u; (void)bin0; (void)shift;
#pragma unroll 1
    for (int bit = 31; bit >= 0; --bit) { const unsigned trial = P | (1u << bit); unsigned c = 0;
#pragma unroll
        for (int i = 0; i < 8; ++i) c += wave_count(ck[i] >= trial);
        if (c >= rank) P = trial; }
    const unsigned thr = P; unsigned cg = 0, ce = 0;
#pragma unroll
    for (int i = 0; i < 8; ++i) { cg += wave_count(ck[i] > thr); ce += wave_count(ck[i] == thr); }
    const unsigned quota = rank - cg; unsigned idxs = 0x7fffffffu;
    if (ce > quota) {
        unsigned X = 0;
#pragma unroll 1
        for (int bit = 12; bit >= 0; --bit) { const unsigned trial = X | (1u << bit); unsigned c = 0;
#pragma unroll
            for (int i = 0; i < 8; ++i) c += wave_count(ck[i] == thr && ci[i] < trial);
            if (c < quota) X = trial; }
        idxs = X;
    }
#pragma unroll
    for (int i = 0; i < 8; ++i) { const bool sel = (ck[i] > thr) || (ck[i] == thr && ci[i] <= idxs);
        if (sel && ci[i] != 0x7fffffffu) __hip_atomic_fetch_or(&lmask[ci[i] >> 5], 1u << (ci[i] & 31u), __ATOMIC_RELAXED, __HIP_MEMORY_SCOPE_WORKGROUP); }
}
__device__ __forceinline__ void p3_select_zero(Frame& F, int row) {
    LAS unsigned* zm = (LAS unsigned*)(F.lds + P3_HIST) + row * HS + 768; LAS unsigned* lmask = (LAS unsigned*)(F.lds + P3_LMASK) + row * 256; LAS unsigned* st = (LAS unsigned*)(F.lds + P3_STATE);
    const unsigned quota = st[row * 4 + 1]; const int lane = F.lane;
    unsigned w[4]; unsigned pc = 0;
#pragma unroll
    for (int i = 0; i < 4; ++i) { w[i] = zm[4 * lane + i]; pc += (unsigned)__builtin_popcount(w[i]); }
    unsigned P = pc;
#pragma unroll
    for (int o = 1; o < 64; o <<= 1) { const unsigned v = __shfl_up(P, o); if (lane >= o) P += v; }
    unsigned cum = P - pc;
#pragma unroll
    for (int i = 0; i < 4; ++i) { unsigned ww = w[i]; const unsigned c = (unsigned)__builtin_popcount(ww);
        if (cum >= quota) ww = 0u;
        else if (cum + c > quota) { const unsigned keep = quota - cum; while ((unsigned)__builtin_popcount(ww) > keep) ww &= ~(0x80000000u >> __builtin_clz(ww)); }
        cum += c;
        if (ww) __hip_atomic_fetch_or(&lmask[4 * lane + i], ww, __ATOMIC_RELAXED, __HIP_MEMORY_SCOPE_WORKGROUP); }
}
__device__ __forceinline__ void p3_zero_hist(Frame& F) {
    LAS unsigned* hist = (LAS unsigned*)(F.lds + P3_HIST);
    for (int i = F.tid; i < 16 * HS; i += NTHR) hist[i] = 0u;
}
#define P3T0() unsigned long long _pt = (P3_PROF && F.tid == 0) ? __builtin_amdgcn_s_memrealtime() : 0ull
#define P3T1(k) do { if (P3_PROF == (k) && F.tid == 0) { volatile LAS unsigned* _m = F.MISC + 16; const unsigned long long _d = __builtin_amdgcn_s_memrealtime() - _pt; _m[0] = _m[0] + (unsigned)_d; } } while (0)
__device__ __forceinline__ void p3_block(Frame& F, int b) {
    const bf16_t* QIB = wsp<bf16_t>(F, WS_QIB); const float* WIF = wsp<float>(F, WS_WIF); unsigned* MASK = wsp<unsigned>(F, WS_MASK);
    LAS unsigned* st = (LAS unsigned*)(F.lds + P3_STATE); LAS unsigned* lmask = (LAS unsigned*)(F.lds + P3_LMASK);
    const int lane = F.lane, q = lane & 15, fq = lane >> 4, t0 = 16 * b;
    bf16x8 Bq[4][2]; float wq[4];
#pragma unroll
    for (int h = 0; h < 4; ++h) { Bq[h][0] = *(const bf16x8*)(QIB + (size_t)(t0 + q) * 256 + h * 64 + 8 * fq); Bq[h][1] = *(const bf16x8*)(QIB + (size_t)(t0 + q) * 256 + h * 64 + 32 + 8 * fq); wq[h] = WIF[(t0 + q) * 4 + h]; }
    __syncthreads();
    for (int i = F.tid; i < 16 * 256; i += NTHR) lmask[i] = 0u;
    if (b >= 16) {
        const int dtype = 0;
        p3_zero_hist(F);
        if (F.tid < 16) { st[F.tid * 4 + 0] = 0u; st[F.tid * 4 + 1] = 256u; st[F.tid * 4 + 2] = 0u; st[F.tid * 4 + 3] = 1u; st[80 + F.tid] = 0u; }
        if (F.tid == 0) st[64] = 0u;
        if (fq == 0) st[96 + q] = (unsigned)dtype;
        __syncthreads();
        { P3T0(); p3_sweep<9>(F, b, Bq, wq, 0u, 0u, 0u, true, dtype); P3T1(1); P3T1(4); } { P3T0(); p3_scan(F, true); P3T1(2); }
        if (F.tid < 16) { const unsigned bn = st[F.tid * 4 + 0], cn = st[F.tid * 4 + 2]; const unsigned dt = 0u; (void)dt;
            const unsigned cls = (bn == 1024u) ? 1u : (cn <= (unsigned)P3_CAP ? 0u : 2u);
            st[112 + F.tid] = cls; if (cls == 2u) st[64] = 1u;
            if (P3_PROF >= 11 && cls == 2u) { const int cause = (dt == 1u) ? (bn == 0u ? 11 : 12) : (dt == 2u ? 13 : 14); if (cause == P3_PROF && b >= 128) atomicAdd(F.ctl + CW_QUEUE + 8, 1u); } }
        __syncthreads();
        const unsigned bin0 = st[q * 4 + 0];
        if (st[64] == 0u) {
            for (int i = F.tid; i < 16 * 256; i += NTHR) ((LAS unsigned*)(F.lds + P3_HIST))[(i >> 8) * HS + 768 + (i & 255)] = 0u;
            __syncthreads();
            { P3T0(); p3_sweep<10>(F, b, Bq, wq, bin0, 0u, 0u, st[112 + q] == 0u, dtype); P3T1(1); P3T1(5); }
            __syncthreads();
            { P3T0();
#pragma unroll 1
              for (int rr = 0; rr < 2; ++rr) { const int row = 2 * F.wave + rr; if (st[112 + row] == 0u) p3_select_row(F, row, st[96 + row] ? 20 : 21); else p3_select_zero(F, row); }
              __syncthreads(); P3T1(3); }
        } else {
            if (P3_PROF == 6 && F.tid == 0) atomicAdd(F.ctl + CW_QUEUE + 8, 1u);
            __syncthreads(); p3_zero_hist(F);
            if (F.tid < 16) { st[F.tid * 4 + 0] = 0u; st[F.tid * 4 + 1] = 256u; st[F.tid * 4 + 2] = 0u; st[F.tid * 4 + 3] = 1u; }
            __syncthreads();
            { P3T0(); p3_sweep<0>(F, b, Bq, wq, 0u, 0u, 0u, true); P3T1(1); } { P3T0(); p3_scan(F, true); P3T1(2); }
            unsigned pref = st[q * 4 + 0];
            __syncthreads(); p3_zero_hist(F); __syncthreads();
            { P3T0(); p3_sweep<1>(F, b, Bq, wq, pref, 0u, 0u, true); P3T1(1); } { P3T0(); p3_scan(F, true); P3T1(2); }
            pref = (pref << 11) | st[q * 4 + 0];
            __syncthreads(); p3_zero_hist(F); __syncthreads();
            { P3T0(); p3_sweep<2>(F, b, Bq, wq, pref, 0u, 0u, true); P3T1(1); } { P3T0(); p3_scan(F, true); P3T1(2); }
            const unsigned thr = (pref << 10) | st[q * 4 + 0];
            const unsigned quota = st[q * 4 + 1], cnteq = st[q * 4 + 2];
            const bool tie = cnteq > quota; unsigned idxs = 0x7fffffffu;
            __syncthreads();
            if (F.tid == 0) st[64] = 0u;
            __syncthreads();
            if (tie && fq == 0) st[64] = 1u;
            if (F.tid < 16) st[F.tid * 4 + 3] = (st[F.tid * 4 + 2] > st[F.tid * 4 + 1]) ? 1u : 0u;
            __syncthreads();
            if (st[64]) {
                p3_zero_hist(F); __syncthreads();
                { P3T0(); p3_sweep<3>(F, b, Bq, wq, 0u, thr, 0u, tie); P3T1(1); } { P3T0(); p3_scan(F, false); P3T1(2); }
                const unsigned ip = st[q * 4 + 0];
                __syncthreads(); p3_zero_hist(F); __syncthreads();
                { P3T0(); p3_sweep<4>(F, b, Bq, wq, ip, thr, 0u, tie); P3T1(1); } { P3T0(); p3_scan(F, false); P3T1(2); }
                if (tie) idxs = (ip << 2) | st[q * 4 + 0];
            }
            __syncthreads();
            { P3T0(); p3_sweep<5>(F, b, Bq, wq, 0u, thr, idxs, true); P3T1(1); }
        }
    } else {
        __syncthreads();
        { P3T0(); p3_sweep<5>(F, b, Bq, wq, 0u, 0u, 0x7fffffffu, true); P3T1(1); }
    }
    __syncthreads();
    { const int qb = t0 >> 8, lr0 = t0 & 255, nkt = 4 * (qb + 1), row = (F.tid >> 1) & 15, wl = F.tid & 1;
      for (int kt = F.tid >> 5; kt < nkt; kt += 16) MASK[((size_t)(qb * 128 + kt) * 256 + lr0 + row) * 2 + wl] = lmask[row * 256 + 2 * kt + wl]; }
}
__device__ __forceinline__ void p3_indexer(Frame& F) {
    const unsigned long long t0 = (P3_PROF >= 7 && F.tid == 0) ? __builtin_amdgcn_s_memrealtime() : 0ull;
    LAS int* qs = (LAS int*)(F.lds + LDSCTL_OFF + 256);
    for (;;) {
        __syncthreads();
        if (F.tid == 0) qs[0] = (int)atomicAdd(F.ctl + CW_QUEUE + 1, 1u);
        __syncthreads();
        const int idx = qs[0];
        if (idx >= 512) break;
        p3_block(F, 511 - idx);
    }
    __syncthreads();
    if (P3_PROF == 7 && F.tid == 0) atomicMax(F.ctl + CW_QUEUE + 8, (unsigned)(__builtin_amdgcn_s_memrealtime() - t0));
    if (P3_PROF == 8 && F.tid == 0) atomicMin(F.ctl + CW_QUEUE + 9, (unsigned)(__builtin_amdgcn_s_memrealtime() - t0));
}

constexpr int N_ATT_UNITS = 608;
constexpr size_t SLOT_FLOATS = 256 * 128 + 256;
__device__ __forceinline__ int cum_chunks(int qb) { const int n1 = qb, a = n1 >> 3, bb = n1 & 7; return 4 * a * (a + 1) + bb * (a + 1); }
constexpr int AT_K = 0, AT_V = 16384, AT_M = 32768, AT_STAGE = 34816, AT_EPI = 3 * AT_STAGE;
template <bool MASKED>
__device__ __forceinline__ void attn_unit(LAS unsigned char* lds, const bf16_t* Qh, int ldq, const bf16_t* Kh, int ldk, const bf16_t* Vth, int ldvt, const unsigned* maskt  ,
                                          int q0, int key0, int ntl, bool final, float* slot, bf16_t* outb  , int tid_in, int wave, int lane_in) {
    int tid = tid_in, lane = lane_in; asm volatile("" : "+v"(tid), "+v"(lane));
    const int q = lane & 31, hh = lane >> 5, qrow = q0 + 32 * wave + q;
    bf16x8 qf[8];
#pragma unroll
    for (int d0 = 0; d0 < 8; ++d0) qf[d0] = *(const bf16x8*)(Qh + (size_t)qrow * ldq + 16 * d0 + 8 * hh);
    const char* kbase = (const char*)(Kh + (size_t)key0 * ldk); const char* vbase = (const char*)(Vth + key0); const char* mbase = (const char*)(maskt + (size_t)(key0 >> 6) * 512);
    const unsigned ldsw16 = (unsigned)wave * 1024u, ldsw4 = (unsigned)wave * 256u;
#define AT_ISSUE(t, st) do { int _tid = tid; asm volatile("" : "+v"(_tid)); LAS unsigned char* _b = lds + (st) * AT_STAGE; const char* _kb = kbase + (size_t)(t) * 64 * ldk * 2; const char* _vb = vbase + (size_t)(t) * 128; \
        _Pragma("unroll") for (int _j = 0; _j < 2; ++_j) { const int _p = _tid + 512 * _j; const int _kr = _p >> 4, _kc = (_p & 15) ^ (_kr & 15); const int _vr = _p >> 3, _vc = (_p & 7) ^ ((_vr >> 1) & 7); \
            __builtin_amdgcn_global_load_lds((const unsigned*)(_kb + (unsigned)(_kr * ldk * 2 + _kc * 16)), (LAS unsigned*)(_b + AT_K + ldsw16 + _j * 8192), 16, 0, 0); \
            __builtin_amdgcn_global_load_lds((const unsigned*)(_vb + (unsigned)(_vr * ldvt * 2 + _vc * 16)), (LAS unsigned*)(_b + AT_V + ldsw16 + _j * 8192), 16, 0, 0); } \
        if (MASKED) __builtin_amdgcn_global_load_lds((const unsigned*)(mbase + (size_t)(t) * 2048 + (unsigned)_tid * 4u), (LAS unsigned*)(_b + AT_M + ldsw4), 4, 0, 0); } while (0)
    const int prow = (q & 0x13) | ((q & 4) << 1) | ((q & 8) >> 1);
    const int ky = hh ^ (prow & 15), vw = hh ^ ((q >> 1) & 7);
    int kaddr[8];
#pragma unroll
    for (int d0 = 0; d0 < 8; ++d0) kaddr[d0] = AT_K + prow * 256 + (((2 * d0) ^ ky) << 4);
    const int vrow = AT_V + q * 128;
#define vaddr_(s) (vrow + ((((2 * (s)) ^ vw)) << 4))
    const int maddr = AT_M + (32 * wave + q) * 8;
    f32x16 o[4];
#pragma unroll
    for (int d = 0; d < 4; ++d)
#pragma unroll
        for (int r = 0; r < 16; ++r) o[d][r] = 0.f;
    float l = 0.f;
#define AT_QK(S, SB, BT) do { _Pragma("unroll") for (int _r = 0; _r < 16; ++_r) S[_r] = 0.f; \
        _Pragma("unroll") for (int _d = 0; _d < 8; ++_d) { const bf16x8 _kf = *(const LAS bf16x8*)((SB) + kaddr[_d] + (BT) * 8192); S = __builtin_amdgcn_mfma_f32_32x32x16_bf16(_kf, qf[_d], S, 0, 0, 0); } } while (0)
#define AT_SM(S, MW) do { _Pragma("unroll") for (int _s = 0; _s < 2; ++_s) { float _p[8]; \
        _Pragma("unroll") for (int _j = 0; _j < 8; ++_j) { const int _r = 8 * _s + _j; float _e = __builtin_amdgcn_exp2f(S[_r]); if (MASKED) _e = __builtin_bit_cast(float, __builtin_bit_cast(unsigned, _e) & (unsigned)__builtin_amdgcn_sbfe((int)(MW), (unsigned)((_r & 7) + 16 * (_r >> 3)), 1u)); _p[_j] = _e; l += _e; } \
        u32x4 _w; _w.x = pk2(_p[0], _p[1]); _w.y = pk2(_p[2], _p[3]); _w.z = pk2(_p[4], _p[5]); _w.w = pk2(_p[6], _p[7]); pf[_s] = __builtin_bit_cast(bf16x8, _w); } } while (0)
#define AT_PV(SB, BT) do { _Pragma("unroll") for (int _d = 0; _d < 4; ++_d) _Pragma("unroll") for (int _s = 0; _s < 2; ++_s) { \
        const bf16x8 _vf = *(const LAS bf16x8*)((SB) + vaddr_(2 * (BT) + _s) + _d * 4096); o[_d] = __builtin_amdgcn_mfma_f32_32x32x16_bf16(_vf, pf[_s], o[_d], 0, 0, 0); } } while (0)
#define AT_MW(SB, BT) (MASKED ? (*(const LAS unsigned*)((SB) + maddr + (BT) * 4) >> (8 * hh)) : 0xffffffffu)
    AT_ISSUE(0, 0);
    if (ntl > 1) AT_ISSUE(1, 1);
    if (ntl > 1) { if (MASKED) asm volatile("s_waitcnt vmcnt(5)" ::: "memory"); else asm volatile("s_waitcnt vmcnt(4)" ::: "memory"); }
    else asm volatile("s_waitcnt vmcnt(0)" ::: "memory");
    __builtin_amdgcn_s_barrier(); asm volatile("" ::: "memory");
    f32x16 sc, sn; bf16x8 pf[2];
    AT_QK(sc, lds, 0);
    int st = 0;
    for (int t = 0; t < ntl; ++t) {
        LAS unsigned char* sb = lds + st * AT_STAGE;
        const int stn = (st == 2) ? 0 : st + 1;
        LAS unsigned char* sbn = lds + stn * AT_STAGE;
        { const unsigned mw = AT_MW(sb, 0);
          AT_QK(sn, sb, 1); AT_SM(sc, mw); }
        __builtin_amdgcn_sched_barrier(0);
        AT_PV(sb, 0);
        __builtin_amdgcn_sched_barrier(0);
        if (t + 1 < ntl) asm volatile("s_waitcnt vmcnt(0)" ::: "memory");
        __builtin_amdgcn_s_barrier(); asm volatile("" ::: "memory");
        if (t + 2 < ntl) { const int st2 = (st >= 1) ? st - 1 : 2; AT_ISSUE(t + 2, st2); }
        __builtin_amdgcn_sched_barrier(0);
        { const unsigned mw = AT_MW(sb, 1);
          if (t + 1 < ntl) { AT_QK(sc, sbn, 0); AT_SM(sn, mw); } else { AT_SM(sn, mw); } }
        __builtin_amdgcn_sched_barrier(0);
        AT_PV(sb, 1);
        __builtin_amdgcn_sched_barrier(0);
        st = stn;
    }
#undef vaddr_
#undef AT_QK
#undef AT_SM
#undef AT_PV
#undef AT_MW
#undef AT_ISSUE
    l += __shfl_xor(l, 32);
    int lane_e = lane; asm volatile("" : "+v"(lane_e));
    const int qe = lane_e & 31, he = lane_e >> 5;
    LAS float* stg = (LAS float*)(lds + AT_EPI + wave * 4608);
    const int trow = q0 + 32 * wave;
    const float inv = final ? 1.0f / l : 1.0f;
#pragma unroll
    for (int d = 0; d < 4; ++d) {
#pragma unroll
        for (int r = 0; r < 16; ++r) stg[qe * 36 + crow(r, he)] = o[d][r] * inv;
        LDS_WAIT(); asm volatile("" ::: "memory");
#pragma unroll
        for (int i = 0; i < 4; ++i) { const int row = 8 * i + (lane_e >> 3), c4 = lane_e & 7; const f32x4 v = *(const LAS f32x4*)(stg + row * 36 + 4 * c4);
            if (final) { u32x2 w; w.x = pk2(v[0], v[1]); w.y = pk2(v[2], v[3]); *(u32x2*)(outb + (size_t)(trow + row) * DM + 32 * d + 4 * c4) = w; }
            else *(f32x4*)(slot + (size_t)(32 * wave + row) * 128 + 32 * d + 4 * c4) = v; }
        LDS_WAIT(); asm volatile("" ::: "memory");
    }
    if (!final && he == 0) slot[256 * 128 + 32 * wave + qe] = l;
}
__device__ __forceinline__ void att_build_table(Frame& F) {
    LAS int* cnt = (LAS int*)F.lds; int* TB = wsp<int>(F, WS_ATTBL);
    if (F.tid < 40) cnt[F.tid] = 0;
    __syncthreads();
    int e0[2], e1[2], nl[2];
#pragma unroll
    for (int r = 0; r < 2; ++r) { const int id = F.tid + 512 * r; nl[r] = 0; e0[r] = 0; e1[r] = 0;
        if (id < 768) { const int h = id >> 7, n = ((id >> 2) & 31) + 1, ch = id & 3, k = (n + 7) >> 3;
            if (ch < k) { const int nt = 4 * n, base = nt / k, rem = nt % k; const int len = base + (ch < rem ? 1 : 0), start = ch * base + (ch < rem ? ch : rem);
                const int qb = n - 1; nl[r] = len; e0[r] = 0 | (h << 1) | (qb << 4) | ((k == 1 ? 1 : 0) << 9) | (len << 10); e1[r] = start | ((h * 80 + cum_chunks(qb) + ch) << 8); } }
        else if (id < 896) { const int c = id - 768; nl[r] = 4; e0[r] = 1 | ((c >> 5) << 1) | ((c & 31) << 4) | (1 << 9) | (4 << 10); e1[r] = 0; }
        if (nl[r]) __hip_atomic_fetch_add(&cnt[nl[r]], 1, __ATOMIC_RELAXED, __HIP_MEMORY_SCOPE_WORKGROUP); }
    __syncthreads();
    if (F.tid == 0) { int o = 0; for (int l = 32; l >= 1; --l) { const int c = cnt[l]; cnt[l] = o; o += c; } }
    __syncthreads();
#pragma unroll
    for (int r = 0; r < 2; ++r) if (nl[r]) { const int pos = __hip_atomic_fetch_add(&cnt[nl[r]], 1, __ATOMIC_RELAXED, __HIP_MEMORY_SCOPE_WORKGROUP); TB[2 * pos] = e0[r]; TB[2 * pos + 1] = e1[r]; }
    __syncthreads();
}
__device__ __forceinline__ void p4_attention(Frame& F) {
    const bf16_t* Q = wsp<bf16_t>(F, WS_Q); const bf16_t* K = wsp<bf16_t>(F, WS_K); const bf16_t* VT = wsp<bf16_t>(F, WS_VT); const bf16_t* XQ = wsp<bf16_t>(F, WS_XQ);
    const bf16_t* KMB = wsp<bf16_t>(F, WS_KMB); const bf16_t* VMT = wsp<bf16_t>(F, WS_VMT); const unsigned* MASK = wsp<unsigned>(F, WS_MASK); bf16_t* AM = wsp<bf16_t>(F, WS_AMRG);
    float* OPS = F.out;
    LAS int* qslot = (LAS int*)(F.lds + LDSCTL_OFF + 256);
    for (;;) {
        __syncthreads();
        if (F.tid == 0) qslot[0] = (int)atomicAdd(F.ctl + CW_QUEUE, 1u);
        __syncthreads();
        const int idx = qslot[0];
        if (idx >= N_ATT_UNITS) break;
        const int* TB = wsp<int>(F, WS_ATTBL); const int e0 = TB[2 * idx], e1 = TB[2 * idx + 1];
        const int type = e0 & 1, h = (e0 >> 1) & 7, qb = (e0 >> 4) & 31, fin = (e0 >> 9) & 1, ntl = (e0 >> 10) & 63, kt0 = e1 & 255, slot = e1 >> 8;
        if (type == 0) attn_unit<true>(F.lds, Q + h * 128, 768, K + h * 128, 768, VT + (size_t)h * 128 * SEQ, SEQ, MASK + (size_t)qb * 128 * 512, qb * 256, kt0 * 64, ntl, fin != 0,
                                       OPS + (size_t)slot * SLOT_FLOATS, AM + 768 + h * 128, F.tid, F.wave, F.lane);
        else attn_unit<false>(F.lds, XQ + h * 128, 512, KMB + h * 128, 512, VMT + (size_t)h * 128 * 256, 256, nullptr, qb * 256, 0, 4, true, nullptr, AM + 1536 + h * 128, F.tid, F.wave, F.lane);
    }
}
__device__ __forceinline__ void p5_finalize(Frame& F) {
    const float* OPS = F.out; bf16_t* AM = wsp<bf16_t>(F, WS_AMRG);
    const int gw = F.vcu * NWAVES + F.wave, NGW = F.G * NWAVES, lane = F.lane, half = lane >> 5, c4 = lane & 31;
    for (int it = gw; it < 6 * 24 * 128; it += NGW) {
        const int rp = it & 127, hq = it >> 7, h = hq / 24, qb = 8 + hq % 24, row = 2 * rp + half;
        const int nch = (qb + 8) >> 3;
        const float* base = OPS + (size_t)(h * 80 + cum_chunks(qb)) * SLOT_FLOATS;
        f32x4 v[4]; float lv[4];
#pragma unroll
        for (int c = 0; c < 4; ++c) { const bool ok = c < nch; const float* b = base + (size_t)(ok ? c : 0) * SLOT_FLOATS; v[c] = *(const f32x4*)(b + (size_t)row * 128 + 4 * c4); lv[c] = b[256 * 128 + row];
            if (!ok) { v[c] = (f32x4){0.f, 0.f, 0.f, 0.f}; lv[c] = 0.f; } }
        const f32x4 sv = (v[0] + v[1]) + (v[2] + v[3]); const float inv = 1.0f / ((lv[0] + lv[1]) + (lv[2] + lv[3]));
        u32x2 w; w.x = pk2(sv[0] * inv, sv[1] * inv); w.y = pk2(sv[2] * inv, sv[3] * inv);
        *(u32x2*)(AM + (size_t)(qb * 256 + row) * DM + 768 + h * 128 + 4 * c4) = w;
    }
}

struct SchedTile {
    int c, G, nM, nN; const char* A; const char* B; size_t tA, tB;
    __device__ __forceinline__ bool next(int i, pg8::Unit& u) const {
        const int L = i * G + c; if (L >= nM * nN) return false; int pm, pn; pg8::tile_order(L, nM, nN, pm, pn);
        u.A = A + (size_t)pm * tA; u.B = B + (size_t)pn * tB; u.Bhi = u.B; u.kind = 0; u.row0 = pm * 256; u.col0 = pn * 256; u.aux = 0; u.nt = 32; u.lowonly = 0; return true; }
};
struct EpiMrg {
    static constexpr bool HOOK = true; static constexpr int HOOK_T1 = 12, HOOK_T2 = 24;
    const bf16_t* EG; bf16_t* MRG;
    __device__ __forceinline__ void hook(f32x4 (&acc)[2][2][4][2], const pg8::Unit& u, int t, int wr, int wc, int fr, int fq) const {
        const int seg = (t == HOOK_T1) ? 0 : 1;
        const unsigned off0 = ((unsigned)(u.row0 + wr * 64 + fr) * 6144u + (unsigned)(seg * 2048 + u.col0 + wc * 32 + 8 * fq)) * 2u;
        const char* eg = (const char*)EG;
#pragma unroll
        for (int ai = 0; ai < 2; ++ai)
#pragma unroll
            for (int m = 0; m < 4; ++m) {
#pragma unroll
                for (int bj = 0; bj < 2; ++bj) { const unsigned off = off0 + (unsigned)((ai * 128 + m * 16) * 6144 + bj * 128) * 2u;
                    const u32x4 ea = *(const u32x4*)(eg + off), eb = *(const u32x4*)(eg + off + 4096u);
                    f32x4 r0, r1;
                    r0[0] = bflo(eb.x) * __builtin_amdgcn_rcpf(bflo(ea.x)); r0[1] = bfhi(eb.x) * __builtin_amdgcn_rcpf(bfhi(ea.x)); r0[2] = bflo(eb.y) * __builtin_amdgcn_rcpf(bflo(ea.y)); r0[3] = bfhi(eb.y) * __builtin_amdgcn_rcpf(bfhi(ea.y));
                    r1[0] = bflo(eb.z) * __builtin_amdgcn_rcpf(bflo(ea.z)); r1[1] = bfhi(eb.z) * __builtin_amdgcn_rcpf(bfhi(ea.z)); r1[2] = bflo(eb.w) * __builtin_amdgcn_rcpf(bflo(ea.w)); r1[3] = bfhi(eb.w) * __builtin_amdgcn_rcpf(bfhi(ea.w));
                    acc[ai][bj][m][0] *= r0; acc[ai][bj][m][1] *= r1; }
                asm volatile("" ::: "memory"); }
    }
    __device__ __forceinline__ void operator()(const f32x4 (&acc)[2][2][4][2], const pg8::Unit& u, int wr, int wc, int fr, int fq) const {
        const int rbase = u.row0 + wr * 64 + fr, cbase = u.col0 + wc * 32 + 8 * fq;
#pragma unroll
        for (int ai = 0; ai < 2; ++ai)
#pragma unroll
            for (int m = 0; m < 4; ++m) { const int row = rbase + ai * 128 + m * 16;
#pragma unroll
                for (int bj = 0; bj < 2; ++bj) { const u32x4 e = *(const u32x4*)(EG + (size_t)row * 6144 + 4096 + cbase + bj * 128);
                    const f32x4 a0 = acc[ai][bj][m][0], a1 = acc[ai][bj][m][1];
                    u32x4 w;
                    w.x = pk2(a0[0] * __builtin_amdgcn_rcpf(bflo(e.x)), a0[1] * __builtin_amdgcn_rcpf(bfhi(e.x))); w.y = pk2(a0[2] * __builtin_amdgcn_rcpf(bflo(e.y)), a0[3] * __builtin_amdgcn_rcpf(bfhi(e.y)));
                    w.z = pk2(a1[0] * __builtin_amdgcn_rcpf(bflo(e.z)), a1[1] * __builtin_amdgcn_rcpf(bfhi(e.z))); w.w = pk2(a1[2] * __builtin_amdgcn_rcpf(bflo(e.w)), a1[3] * __builtin_amdgcn_rcpf(bfhi(e.w)));
                    *(u32x4*)(MRG + (size_t)row * DM + cbase + bj * 128) = w; } }
    }
};
struct EpiRes {
    static constexpr bool HOOK = false; static constexpr int HOOK_T1 = -1, HOOK_T2 = -1;
    const float* x; float* out; bf16_t* X1B;
    __device__ __forceinline__ void hook(f32x4 (&)[2][2][4][2], const pg8::Unit&, int, int, int, int, int) const {}
    __device__ __forceinline__ void operator()(const f32x4 (&acc)[2][2][4][2], const pg8::Unit& u, int wr, int wc, int fr, int fq) const {
        const int rbase = u.row0 + wr * 64 + fr, cbase = u.col0 + wc * 32 + 8 * fq;
#pragma unroll
        for (int ai = 0; ai < 2; ++ai)
#pragma unroll
            for (int m = 0; m < 4; ++m) { const int row = rbase + ai * 128 + m * 16;
#pragma unroll
                for (int bj = 0; bj < 2; ++bj) { const size_t off = (size_t)row * DM + cbase + bj * 128;
                    const f32x4 v0 = *(const f32x4*)(x + off) + acc[ai][bj][m][0], v1 = *(const f32x4*)(x + off + 4) + acc[ai][bj][m][1];
                    u32x4 w; w.x = pk2(v0[0], v0[1]); w.y = pk2(v0[2], v0[3]); w.z = pk2(v1[0], v1[1]); w.w = pk2(v1[2], v1[3]);
                    *(u32x4*)(X1B + off) = w; } }
    }
};

__device__ __forceinline__ void p8_router(Frame& F) {
    const bf16_t* X1 = wsp<bf16_t>(F, WS_X1B); const float* WR = wsp<float>(F, WS_WR);
    float* RSTD2 = wsp<float>(F, WS_RSTD2); int* TOKCLS = wsp<int>(F, WS_TOKCLS); int* TOKSLOT = wsp<int>(F, WS_TOKSLOT); float* TOKWA = wsp<float>(F, WS_TOKWA); float* TOKWB = wsp<float>(F, WS_TOKWB);
    LAS float* red = (LAS float*)F.lds;
    LAS float* lg = (LAS float*)(F.lds + 8 * 32 * 33 * 4);
    LAS float* ssq = (LAS float*)(F.lds + 9 * 32 * 33 * 4);
    LAS int* lcnt = (LAS int*)(F.lds + 9 * 32 * 33 * 4 + 1024); int* CNT = wsp<int>(F, WS_CNT);
    const int lane = F.lane, i = lane & 31, hh = lane >> 5, w = F.wave;
    for (int u = F.vcu; u < SEQ / 32; u += F.G) {
        const int t0 = 32 * u;
        f32x16 d;
#pragma unroll
        for (int r = 0; r < 16; ++r) d[r] = 0.f;
        float ss = 0.f;
        const bf16_t* xp = X1 + (size_t)(t0 + i) * DM + 256 * w + 4 * hh; const float* wp = WR + (size_t)(256 * w + 4 * hh) * 32 + i;
#pragma unroll 1
        for (int m0 = 0; m0 < 32; m0 += 8) {
            f32x4 a[8]; float bw[8][4];
#pragma unroll
            for (int mm = 0; mm < 8; ++mm) { const u32x2 xw = *(const u32x2*)(xp + 8 * (m0 + mm));
                a[mm] = (f32x4){__builtin_bit_cast(float, xw.x << 16), __builtin_bit_cast(float, xw.x & 0xffff0000u), __builtin_bit_cast(float, xw.y << 16), __builtin_bit_cast(float, xw.y & 0xffff0000u)};
#pragma unroll
                for (int e = 0; e < 4; ++e) bw[mm][e] = wp[(8 * (m0 + mm) + e) * 32]; }
#pragma unroll
            for (int mm = 0; mm < 8; ++mm) { ss += (a[mm].x * a[mm].x + a[mm].y * a[mm].y) + (a[mm].z * a[mm].z + a[mm].w * a[mm].w);
                d = __builtin_amdgcn_mfma_f32_32x32x2f32(a[mm].x, bw[mm][0], d, 0, 0, 0); d = __builtin_amdgcn_mfma_f32_32x32x2f32(a[mm].y, bw[mm][1], d, 0, 0, 0);
                d = __builtin_amdgcn_mfma_f32_32x32x2f32(a[mm].z, bw[mm][2], d, 0, 0, 0); d = __builtin_amdgcn_mfma_f32_32x32x2f32(a[mm].w, bw[mm][3], d, 0, 0, 0); }
        }
        ss += __shfl_xor(ss, 32);
        __syncthreads();
#pragma unroll
        for (int r = 0; r < 16; ++r) red[(w * 32 + crow(r, hh)) * 33 + i] = d[r];
        if (hh == 0) ssq[w * 32 + i] = ss;
        if (F.tid < 24) lcnt[F.tid] = 0;
        __syncthreads();
        for (int e = F.tid; e < 1024; e += NTHR) { const int tk = e >> 5, j = e & 31; float s = 0.f;
#pragma unroll
            for (int ww = 0; ww < 8; ++ww) s += red[(ww * 32 + tk) * 33 + j];
            lg[tk * 33 + j] = s; }
        __syncthreads();
        if (F.tid < 32) { const int tk = F.tid; float s2 = 0.f;
#pragma unroll
            for (int ww = 0; ww < 8; ++ww) s2 += ssq[ww * 32 + tk];
            const float rstd = 1.0f / sqrtf(s2 * (1.0f / DM) + NORM_EPS);
            float g[4]; int gt = 0;
#pragma unroll
            for (int j = 0; j < 4; ++j) g[j] = lg[tk * 33 + j] * rstd;
#pragma unroll
            for (int j = 1; j < 4; ++j) if (g[j] > g[gt]) gt = j;
            float den = 0.f;
#pragma unroll
            for (int j = 0; j < 4; ++j) den += expf(g[j] - g[gt]);
            const float pg = 1.0f / den;
            float le[4];
#pragma unroll
            for (int j = 0; j < 4; ++j) le[j] = lg[tk * 33 + 4 + gt * 4 + j] * rstd;
            int e1 = 0;
#pragma unroll
            for (int j = 1; j < 4; ++j) if (le[j] > le[e1]) e1 = j;
            int e2 = (e1 == 0) ? 1 : 0;
#pragma unroll
            for (int j = 0; j < 4; ++j) if (j != e1 && j != e2 && le[j] > le[e2]) e2 = j;
            const float x2 = expf(le[e2] - le[e1]);
            const float w1 = pg / (1.0f + x2), w2 = pg * x2 / (1.0f + x2);
            const int a = e1 < e2 ? e1 : e2, bb = e1 < e2 ? e2 : e1;
            const float wa = e1 < e2 ? w1 : w2, wb = e1 < e2 ? w2 : w1;
            const int pair = (a == 0) ? (bb - 1) : (a == 1 ? bb + 1 : 5);
            const int cls = gt * 6 + pair;
            const int slot = __hip_atomic_fetch_add(&lcnt[cls], 1, __ATOMIC_RELAXED, __HIP_MEMORY_SCOPE_WORKGROUP);
            const int t = t0 + tk;
            RSTD2[t] = rstd; TOKCLS[t] = cls; TOKSLOT[t] = slot; TOKWA[t] = wa; TOKWB[t] = wb;
        }
        __syncthreads();
        if (F.tid < 24) CNT[u * 24 + F.tid] = lcnt[F.tid];
    }
    __syncthreads();
}
__device__ __forceinline__ int moe_tables(Frame& F, LAS int* tb) {
    __syncthreads();
    if (F.tid == 0) { int o = 0;
        for (int c = 0; c < 24; ++c) { const int n = (int)__hip_atomic_load(F.ctl + CW_CLS + c, __ATOMIC_RELAXED, __HIP_MEMORY_SCOPE_AGENT); tb[c] = o; tb[64 + c] = n; const int nt = (n + 255) >> 8;
            for (int j = 0; j < nt; ++j) { tb[128 + (o >> 8) + j] = c; tb[192 + (o >> 8) + j] = (n - 256 * j <= 128) ? 1 : 0; } o += nt << 8; }
        tb[24] = o; const int ntl = o >> 8; int k = 0;
        for (int j = 0; j < ntl; ++j) if (!tb[192 + j]) tb[256 + k++] = j;
        for (int j = 0; j < ntl; ++j) if (tb[192 + j]) tb[256 + k++] = j; }
    __syncthreads();
    return tb[24] >> 8;
}
__device__ __forceinline__ void p8b_gather(Frame& F) {
    LAS int* tb = (LAS int*)(F.lds + LDSCTL_OFF + 512);
    LAS int* cn = (LAS int*)F.lds;
    LAS int* psum = (LAS int*)(F.lds + 32768);
    LAS int* tot = (LAS int*)(F.lds + 32768 + 2048);
    const int* CNT = wsp<int>(F, WS_CNT);
    __syncthreads();
    for (int i = F.tid; i < 256 * 24; i += NTHR) cn[i] = CNT[i];
    __syncthreads();
    const int c = F.tid >> 4, part = F.tid & 15;
    if (F.tid < 384) { int sm = 0;
#pragma unroll
        for (int j = 0; j < 16; ++j) sm += cn[(part * 16 + j) * 24 + c];
        psum[c * 16 + part] = sm; }
    __syncthreads();
    if (F.tid < 24) { int run = 0;
        for (int j = 0; j < 16; ++j) { const int v = psum[F.tid * 16 + j]; psum[F.tid * 16 + j] = run; run += v; }
        tot[F.tid] = run; }
    __syncthreads();
    if (F.tid < 384) { int run = psum[c * 16 + part];
#pragma unroll
        for (int j = 0; j < 16; ++j) { const int idx = (part * 16 + j) * 24 + c; const int v = cn[idx]; cn[idx] = run; run += v; } }
    if (F.tid == 0) { int o = 0;
        for (int cc = 0; cc < 24; ++cc) { const int n = tot[cc]; tb[cc] = o; tb[64 + cc] = n; o += ((n + 255) >> 8) << 8; }
        tb[24] = o; }
    if (blockIdx.x == 0 && F.tid < 24) __hip_atomic_store(F.ctl + CW_CLS + F.tid, (unsigned)tot[F.tid], __ATOMIC_RELAXED, __HIP_MEMORY_SCOPE_AGENT);
    __syncthreads();
    const float* RSTD2 = wsp<float>(F, WS_RSTD2); const int* TOKCLS = wsp<int>(F, WS_TOKCLS); const int* TOKSLOT = wsp<int>(F, WS_TOKSLOT); const float* TOKWA = wsp<float>(F, WS_TOKWA); const float* TOKWB = wsp<float>(F, WS_TOKWB);
    int* ROWTOK = wsp<int>(F, WS_ROWTOK); float* ROWRS = wsp<float>(F, WS_ROWRS); float* ROWWA = wsp<float>(F, WS_ROWWA); float* ROWWB = wsp<float>(F, WS_ROWWB);
    const int gw = F.vcu * NWAVES + F.wave, NGW = F.G * NWAVES, lane = F.lane;
    for (int t = gw * 64 + lane; t < SEQ; t += NGW * 64) {
        const int cl = TOKCLS[t]; const int R = tb[cl] + cn[(t >> 5) * 24 + cl] + TOKSLOT[t];
        ROWTOK[R] = t; ROWRS[R] = RSTD2[t]; ROWWA[R] = TOKWA[t]; ROWWB[R] = TOKWB[t];
    }
    for (int i = F.vcu * NTHR + F.tid; i < 24 * 256; i += F.G * NTHR) { const int cc = i >> 8, j = i & 255; const int n = tb[64 + cc], R = tb[cc] + n + j;
        const int endc = tb[cc] + (((n + 255) >> 8) << 8);
        if (R < endc) { ROWTOK[R] = -1; ROWRS[R] = 0.f; ROWWA[R] = 0.f; ROWWB[R] = 0.f; } }
}
__device__ __forceinline__ void cls_experts(int cls, int& ea, int& eb) { const int g = cls / 6, p = cls % 6; const int a = (p < 3) ? 0 : (p < 5 ? 1 : 2); const int b = (p < 3) ? p + 1 : (p < 5 ? p - 1 : 3); ea = g * 4 + a; eb = g * 4 + b; }
struct EpiGU {
    static constexpr bool HOOK = false; static constexpr int HOOK_T1 = -1, HOOK_T2 = -1;
    unsigned char* ws;
    __device__ __forceinline__ void hook(f32x4 (&)[2][2][4][2], const pg8::Unit&, int, int, int, int, int) const {}
    __device__ __forceinline__ void operator()(const f32x4 (&acc)[2][2][4][2], const pg8::Unit& u, int wr, int wc, int fr, int fq) const {
        const float* rs = (const float*)(ws + WS_ROWRS); const __amdgpu_buffer_rsrc_t rsrc = __builtin_amdgcn_make_buffer_rsrc(ws + WS_ACT, 0, (int)(MAXROWS * 1024 * 2), 0x00020000);
        const int pn = u.col0; const float* cw = (const float*)(ws + (pn < 4 ? WS_ROWWA : WS_ROWWB)); const int cbase = (pn >> 2) * 512 + (pn & 3) * 128 + wc * 32 + 8 * fq;
#pragma unroll
        for (int ai = 0; ai < 2; ++ai)
#pragma unroll
            for (int m = 0; m < 4; ++m) { const int row = u.row0 + ai * 128 + wr * 64 + m * 16 + fr; const float s = rs[row], w = cw[row];
                float a[8];
#pragma unroll
                for (int n = 0; n < 2; ++n)
#pragma unroll
                    for (int e = 0; e < 4; ++e) { const float gv = acc[ai][0][m][n][e] * s, uv = acc[ai][1][m][n][e] * s;
                        a[4 * n + e] = gv * __builtin_amdgcn_rcpf(1.0f + __builtin_amdgcn_exp2f(-gv * LOG2E)) * uv * w; }
                u32x4 o; o.x = pk2(a[0], a[1]); o.y = pk2(a[2], a[3]); o.z = pk2(a[4], a[5]); o.w = pk2(a[6], a[7]);
                __builtin_amdgcn_raw_buffer_store_b128(o, rsrc, (int)(((unsigned)row * 1024u + (unsigned)cbase) * 2u), 0, 16); }
    }
};
struct EpiDN {
    static constexpr bool HOOK = false; static constexpr int HOOK_T1 = -1, HOOK_T2 = -1;
    unsigned char* ws; float* out;
    __device__ __forceinline__ void hook(f32x4 (&)[2][2][4][2], const pg8::Unit&, int, int, int, int, int) const {}
    __device__ __forceinline__ void operator()(const f32x4 (&acc)[2][2][4][2], const pg8::Unit& u, int wr, int wc, int fr, int fq) const {
        const int* rowtok = (const int*)(ws + WS_ROWTOK); const bf16_t* x1b = (const bf16_t*)(ws + WS_X1B);
        const int cbase = u.col0 + wc * 32 + 8 * fq;
#pragma unroll
        for (int ai = 0; ai < 2; ++ai)
#pragma unroll
            for (int m = 0; m < 4; ++m) { const int row = u.row0 + ai * 128 + wr * 64 + m * 16 + fr; const int tok = rowtok[row];
                if (tok >= 0) {
#pragma unroll
                    for (int bj = 0; bj < 2; ++bj) { const size_t off = (size_t)tok * DM + cbase + bj * 128; const u32x4 xw = *(const u32x4*)(x1b + off);
                        const f32x4 x0 = {__builtin_bit_cast(float, xw.x << 16), __builtin_bit_cast(float, xw.x & 0xffff0000u), __builtin_bit_cast(float, xw.y << 16), __builtin_bit_cast(float, xw.y & 0xffff0000u)};
                        const f32x4 x1 = {__builtin_bit_cast(float, xw.z << 16), __builtin_bit_cast(float, xw.z & 0xffff0000u), __builtin_bit_cast(float, xw.w << 16), __builtin_bit_cast(float, xw.w & 0xffff0000u)};
                        *(f32x4*)(out + off) = x0 + acc[ai][bj][m][0]; *(f32x4*)(out + off + 4) = x1 + acc[ai][bj][m][1]; } } }
    }
};

struct SchedOne { pg8::Unit u; __device__ __forceinline__ bool next(int i, pg8::Unit& o) const { if (i != 0) return false; o = u; return true; } };
__device__ __forceinline__ void p9_experts(Frame& F) {
    LAS int* tb = (LAS int*)(F.lds + LDSCTL_OFF + 512);
    const int ntiles = moe_tables(F, tb);
    LAS int* qs = (LAS int*)(F.lds + LDSCTL_OFF + 256);
    const int nun = 16 * ntiles;
    unsigned pend = 0u;
    if (F.tid == 0) pend = atomicAdd(F.ctl + CW_QUEUE + 2, 1u);
    for (;;) {
        __syncthreads();
        if (F.tid == 0) { qs[0] = (int)pend; pend = atomicAdd(F.ctl + CW_QUEUE + 2, 1u); }
        __syncthreads();
        const int idx = qs[0];
        if (idx >= nun) break;
        const bool dn = idx >= 8 * ntiles; const int L = dn ? idx - 8 * ntiles : idx; const int mt = tb[256 + (L >> 3)], pn = L & 7; const int cls = tb[128 + mt]; int ea, eb; cls_experts(cls, ea, eb);
        pg8::Unit u; u.kind = 0; u.row0 = mt * 256; u.aux = 0; u.lowonly = tb[192 + mt];
        if (!dn) {
            const int e = pn < 4 ? ea : eb;
            u.A = (const char*)(F.ws + WS_X1B); u.B = (const char*)(F.ws + WS_WGUT) + ((size_t)e * 1024 + (pn & 3) * 256) * DM * 2; u.Bhi = u.B; u.col0 = pn; u.nt = 32;
            SchedOne S{u}; EpiGU E{F.ws};
            pg8::gemm_phase<EpiGU, SchedOne, true, true>(F.lds, pg8::Geom{DM, DM, 32, 1 << 30, wsp<int>(F, WS_ROWTOK)}, S, E);
            asm volatile("s_waitcnt vmcnt(0)" ::: "memory");
            __syncthreads();
            if (F.tid == 0) __hip_atomic_fetch_add(F.ctl + CW_TILE + mt, 1u, __ATOMIC_RELAXED, __HIP_MEMORY_SCOPE_AGENT);
        } else {
            if (F.tid == 0) { unsigned sp = 0;
                while (__hip_atomic_load(F.ctl + CW_TILE + mt, __ATOMIC_RELAXED, __HIP_MEMORY_SCOPE_AGENT) < 8u) { __builtin_amdgcn_s_sleep(8); if (++sp > (1u << 20)) break; }
                __builtin_amdgcn_fence(__ATOMIC_ACQUIRE, "agent");
                asm volatile("s_waitcnt vmcnt(0)" ::: "memory"); }
            __syncthreads();
            u.A = (const char*)(F.ws + WS_ACT) + (size_t)mt * 256 * 1024 * 2; u.B = (const char*)(F.ws + WS_WDT) + ((size_t)ea * DM + pn * 256) * 512 * 2;
            u.Bhi = (const char*)(F.ws + WS_WDT) + ((size_t)eb * DM + pn * 256) * 512 * 2 - (size_t)8 * 128; u.col0 = pn * 256; u.nt = 16;
            SchedOne S{u}; EpiDN E{F.ws, F.out};
            pg8::gemm_phase<EpiDN, SchedOne, true, true>(F.lds, pg8::Geom{1024, 512, 16, 8, nullptr}, S, E);
        }
    }
}
template <int K> __device__ __forceinline__ void run_phase(Frame& F) {
    if constexpr (K == 0) p0_prologue(F);
    else if constexpr (K == 1) {
        SchedP1 S{(int)blockIdx.x, F.G, F.ws};
        EpiP1 E{F.ws, wsp<float>(F, WS_RSTD1), wsp<float>(F, WS_RSTDM), F.b_gate};
        pg8::gemm_phase<EpiP1, SchedP1, true, true>(F.lds, pg8::Geom{DM, DM, 32, 1 << 30, nullptr}, S, E);
    } else if constexpr (K == 2) p2_rowpass(F);
    else if constexpr (K == 3) p3_indexer(F);
    else if constexpr (K == 4) p4_attention(F);
    else if constexpr (K == 5) p5_finalize(F);
    else if constexpr (K == 6) {
        SchedTile S{(int)blockIdx.x, F.G, 32, 8, (const char*)(F.ws + WS_AMRG), (const char*)(F.ws + WS_BTMRG), (size_t)256 * DM * 2, (size_t)256 * DM * 2};
        EpiMrg E{wsp<bf16_t>(F, WS_EG), wsp<bf16_t>(F, WS_MRG)};
        pg8::gemm_phase<EpiMrg, SchedTile, true, true>(F.lds, pg8::Geom{DM, DM, 32, 1 << 30, nullptr}, S, E);
    } else if constexpr (K == 7) {
        SchedTile S{(int)blockIdx.x, F.G, 32, 8, (const char*)(F.ws + WS_MRG), (const char*)(F.ws + WS_WOT), (size_t)256 * DM * 2, (size_t)256 * DM * 2};
        EpiRes E{F.x, F.out, wsp<bf16_t>(F, WS_X1B)};
        pg8::gemm_phase<EpiRes, SchedTile, true, true>(F.lds, pg8::Geom{DM, DM, 32, 1 << 30, nullptr}, S, E);
    } else if constexpr (K == 8) p8_router(F);
    else if constexpr (K == 9) p8b_gather(F);
    else p9_experts(F);
}
__global__ void __launch_bounds__(NTHR, 2) fwd_kernel(KArgs args) {
    extern __shared__ __attribute__((aligned(16))) unsigned char lds_raw[];
    Frame F;
    F.lds = (LAS unsigned char*)lds_raw; F.MISC = (volatile LAS unsigned*)(F.lds + MISC_OFF);
    F.tid = threadIdx.x; F.lane = F.tid & 63; F.wave = __builtin_amdgcn_readfirstlane(F.tid >> 6);
    F.G = gridDim.x; { const int bx = blockIdx.x; F.vcu = (F.G % 8 == 0) ? (bx % 8) * (F.G / 8) + bx / 8 : bx; }
    F.ws = args.ws; F.out = args.out; F.ctl = (unsigned*)(args.ws + WS_CTL);
    F.x = (const float*)args.in[0]; F.mem = (const float*)args.in[1]; F.positions = (const int*)args.in[2]; F.g_mix = (const float*)args.in[3]; F.w_in = (const float*)args.in[4];
    F.b_gate = (const float*)args.in[5]; F.w_pool_grp = (const float*)args.in[6]; F.pool_scale = (const float*)args.in[7]; F.q_norm_g = (const float*)args.in[8]; F.k_norm_g = (const float*)args.in[9];
    F.g_mem = (const float*)args.in[10]; F.w_mem_kv = (const float*)args.in[11]; F.xq_norm_g = (const float*)args.in[12]; F.xk_norm_g = (const float*)args.in[13]; F.w_pool_out = (const float*)args.in[14];
    F.w_attn_out = (const float*)args.in[15]; F.w_cross_out = (const float*)args.in[16]; F.w_o = (const float*)args.in[17]; F.g_ffn = (const float*)args.in[18]; F.w_rg = (const float*)args.in[19];
    F.w_re = (const float*)args.in[20]; F.w_eg = (const float*)args.in[21]; F.w_eu = (const float*)args.in[22]; F.w_ed = (const float*)args.in[23];
    for (int u = F.tid; u < (LDS_BYTES - LDSCTL_OFF) / 4; u += NTHR) ((LAS unsigned*)(F.lds + LDSCTL_OFF))[u] = 0u;
    __syncthreads();
    XcdBarrier bar = xcd_barrier_post(F.ctl + CW_BAR, F.MISC + 8);
    if (P3_PROF == 8 && blockIdx.x == 0 && F.tid == 0) __hip_atomic_store(F.ctl + CW_QUEUE + 9, 0x7fffffffu, __ATOMIC_RELAXED, __HIP_MEMORY_SCOPE_AGENT);
    const int lo = args.ph_lo, hi = args.ph_hi;
#define IN(k) (lo <= (k) && (k) < hi)
#define SEAM(k) do { if (IN(k) && IN((k) + 1)) xcd_barrier(bar); } while (0)
#ifndef PROBE_TS
#define PROBE_TS -1
#endif
#ifndef PROBE_REPEAT
#define PROBE_REPEAT -1
#endif
    unsigned long long ts0 = 0, ts1 = 0;
#ifndef ONLY_PHASE
#define ONLY_PHASE -1
#endif
#define PHASE(k) do { if ((ONLY_PHASE < 0 || ONLY_PHASE == (k)) && IN(k)) { if (PROBE_TS == (k)) ts0 = __builtin_amdgcn_s_memrealtime(); run_phase<k>(F); \
        if (PROBE_REPEAT == (k)) { xcd_barrier(bar); run_phase<k>(F); } } \
        if (PROBE_TS == (k)) { xcd_barrier(bar); ts1 = __builtin_amdgcn_s_memrealtime(); } else { SEAM(k); } } while (0)
    PHASE(0); PHASE(1); PHASE(2); PHASE(3); PHASE(4); PHASE(5); PHASE(6); PHASE(7); PHASE(8); PHASE(9); PHASE(10);
#ifdef EXTRA_BARS
    for (int _i = 0; _i < 10; ++_i) xcd_barrier(bar);
#endif
    if (P0_PROF) { xcd_barrier(bar); if (blockIdx.x == 0 && F.tid == 0) F.out[0] += (float)__hip_atomic_load(F.ctl + CW_QUEUE + 8, __ATOMIC_RELAXED, __HIP_MEMORY_SCOPE_AGENT) * 0.001f; }
    if (P3_PROF) { xcd_barrier(bar); if (blockIdx.x == 0 && F.tid == 0) { float v = (float)F.MISC[16] * 0.001f;
        if (P3_PROF == 6 || P3_PROF >= 11) v = (float)__hip_atomic_load(F.ctl + CW_QUEUE + 8, __ATOMIC_RELAXED, __HIP_MEMORY_SCOPE_AGENT);
        if (P3_PROF == 7) v = (float)__hip_atomic_load(F.ctl + CW_QUEUE + 8, __ATOMIC_RELAXED, __HIP_MEMORY_SCOPE_AGENT) * 0.001f;
        if (P3_PROF == 8) v = (float)__hip_atomic_load(F.ctl + CW_QUEUE + 9, __ATOMIC_RELAXED, __HIP_MEMORY_SCOPE_AGENT) * 0.001f;
        F.out[0] += v; } }
    if (PROBE_TS >= 0) { if (PROBE_TS != 10) xcd_barrier(bar); if (blockIdx.x == 0 && F.tid == 0) F.out[0] += (float)(ts1 - ts0) * 0.001f; }
#undef IN
#undef SEAM
#undef PHASE
}

extern "C" void kernel_launch(void* const* d_in, const int* in_sizes, int n_in, void* d_out, int out_size, void* d_ws, size_t ws_size, hipStream_t stream) {
    static int grid = 0;
    if (grid == 0) {
        if (n_in != 24 || in_sizes[0] != SEQ * DM || out_size != SEQ * DM || ws_size < WS_END) {
            fprintf(stderr, "kernel_launch: unexpected shapes: n_in %d in0 %d out %d ws %zu (need %zu)\n", n_in, n_in > 0 ? in_sizes[0] : -1, out_size, ws_size, (size_t)WS_END); grid = -1; return; }
        int dev = 0, cus = 0, per_cu = 0;
        if (hipGetDevice(&dev) != hipSuccess || hipDeviceGetAttribute(&cus, hipDeviceAttributeMultiprocessorCount, dev) != hipSuccess) { grid = -1; return; }
        if (hipFuncSetAttribute((const void*)fwd_kernel, hipFuncAttributeMaxDynamicSharedMemorySize, LDS_BYTES) != hipSuccess) { fprintf(stderr, "kernel_launch: hipFuncSetAttribute failed\n"); grid = -1; return; }
        if (hipOccupancyMaxActiveBlocksPerMultiprocessor(&per_cu, (const void*)fwd_kernel, NTHR, LDS_BYTES) != hipSuccess || per_cu < 1) {
            fprintf(stderr, "kernel_launch: occupancy query reports %d workgroups per CU\n", per_cu); (void)hipGetLastError(); per_cu = 1; }
        grid = cus;
    }
    if (grid < 0) return;
    if (hipMemsetAsync((char*)d_ws + WS_CTL, 0, CTL_ZERO_BYTES, stream) != hipSuccess) { fprintf(stderr, "kernel_launch: memset failed\n"); return; }
    KArgs a{};
    for (int i = 0; i < 24; ++i) a.in[i] = d_in[i];
    a.out = (float*)d_out; a.ws = (unsigned char*)d_ws; a.ph_lo = 0; a.ph_hi = 11;
    hipLaunchKernelGGL(fwd_kernel, dim3(grid), dim3(NTHR), LDS_BYTES, stream, a);
    const hipError_t le = hipPeekAtLastError();
    if (le != hipSuccess) fprintf(stderr, "kernel_launch: launch failed: %s\n", hipGetErrorName(le));
}
```

```cpp
#include <hip/hip_runtime.h>
#include <cstdio>
#include <cstdint>

#define LAS __attribute__((address_space(3)))
#define GAS __attribute__((address_space(1)))
typedef unsigned short bf16_t;
typedef short bf16x8 __attribute__((ext_vector_type(8)));
typedef short bf16x4 __attribute__((ext_vector_type(4)));
typedef float f32x4 __attribute__((ext_vector_type(4)));
typedef float f32x16 __attribute__((ext_vector_type(16)));
typedef unsigned u32x4 __attribute__((ext_vector_type(4)));
typedef unsigned u32x2 __attribute__((ext_vector_type(2)));

#ifndef P3_PROF
#define P3_PROF 0
#endif
constexpr int SEQ = 8192, DM = 2048, INC = 10052, MEML = 256;
constexpr int NWAVES = 8, NTHR = 512;
constexpr float NORM_EPS = 1e-6f;
constexpr float LOG2E = 1.4426950408889634f;
constexpr float ATT_SCALE = 0.08838834764831845f;

constexpr size_t MiB = 1u << 20, KiB = 1u << 10;
constexpr size_t WS_CTL = 0, CTL_ZERO_BYTES = 128 * KiB;
constexpr size_t WS_SMALL = 1 * MiB;
constexpr size_t WS_RSTD1 = WS_SMALL + 0, WS_RSTDM = WS_SMALL + 32 * KiB, WS_THRKEY = WS_SMALL + 64 * KiB, WS_THRIDX = WS_SMALL + 96 * KiB;
constexpr size_t WS_WIF = WS_SMALL + 128 * KiB, WS_RSTD2 = WS_SMALL + 256 * KiB, WS_TOKCLS = WS_SMALL + 288 * KiB, WS_TOKSLOT = WS_SMALL + 320 * KiB;
constexpr size_t WS_TOKWA = WS_SMALL + 352 * KiB, WS_TOKWB = WS_SMALL + 384 * KiB, WS_ROWTOK = WS_SMALL + 416 * KiB, WS_ROWRS = WS_SMALL + 480 * KiB;
constexpr size_t WS_ROWWA = WS_SMALL + 544 * KiB, WS_ROWWB = WS_SMALL + 608 * KiB, WS_CNT = WS_SMALL + 672 * KiB, WS_ATTBL = WS_SMALL + 704 * KiB, WS_WR = WS_SMALL + 1 * MiB, WS_WRS = WS_SMALL + 2 * MiB;
constexpr size_t WS_BTMRG = 4 * MiB, WS_WOT = 12 * MiB;
constexpr size_t WS_XB = 20 * MiB, WS_WINT = 52 * MiB, WS_WVT = 89 * MiB, WS_WMKVT = 92 * MiB, WS_MEMB = 96 * MiB;
constexpr size_t WS_WGUT = 20 * MiB, WS_QIB = 84 * MiB, WS_KIB = 88 * MiB, WS_KMB = 89 * MiB, WS_VMT = 89 * MiB + 512 * KiB;
constexpr size_t WS_WDT = 97 * MiB;
constexpr size_t WS_EG = 129 * MiB, WS_ACT = 185 * MiB;
constexpr size_t WS_AMRG = 225 * MiB, WS_X1B = 225 * MiB;
constexpr size_t WS_Q = 257 * MiB, WS_K = 269 * MiB, WS_VT = 281 * MiB, WS_XQ = 293 * MiB, WS_MRG = 257 * MiB;
constexpr size_t WS_U = 301 * MiB, WS_IDXF = 313 * MiB, WS_OPX = 301 * MiB;
constexpr size_t WS_KVM = 329 * MiB, WS_MASK = 330 * MiB, WS_KVMP = 330 * MiB, WS_END = 338 * MiB;
constexpr int MAXROWS = 14336;
constexpr int CW_BAR = 4096;
constexpr int CW_CLS = 16384;
constexpr int CW_QUEUE = 16512;
constexpr int CW_TILE = 16640;
constexpr int CW_GRP = 16768;

#define LDS_WAIT() asm volatile("s_waitcnt lgkmcnt(0)" ::: "memory")
#define VM_WAIT() asm volatile("s_waitcnt vmcnt(0)" ::: "memory")
typedef float f32x2_t __attribute__((ext_vector_type(2))); typedef __bf16 bf16x2_t __attribute__((ext_vector_type(2)));
__device__ __forceinline__ unsigned pk2(float lo, float hi) { f32x2_t v = {lo, hi}; bf16x2_t b = __builtin_convertvector(v, bf16x2_t); return __builtin_bit_cast(unsigned, b); }
__device__ __forceinline__ unsigned f2bf(float f) { return pk2(f, 0.f) & 0xffffu; }
__device__ __forceinline__ float bf2f(unsigned short b) { return __builtin_bit_cast(float, (unsigned)b << 16); }
__device__ __forceinline__ float bflo(unsigned w) { return __builtin_bit_cast(float, w << 16); }
__device__ __forceinline__ float bfhi(unsigned w) { return __builtin_bit_cast(float, w & 0xffff0000u); }
__device__ __forceinline__ float wave_sum(float v) {
#pragma unroll
    for (int o = 1; o < 64; o <<= 1) v += __shfl_xor(v, o);
    return v;
}
__device__ __forceinline__ int crow(int r, int hi) { return (r & 3) + 8 * (r >> 2) + 4 * hi; }

#define XB_TMO      128
#define XB_XCNT(j)  (256  + 64 * (j))
#define XB_XSUB(j)  (1280 + 64 * (j))
#define XB_XGEN(j)  (2304 + 64 * (j))
#define XB_TOP      3328
#define XB_TOPGEN   3392
#define XCD_BAR_WORDS 3456
#define XB_SPIN_CAP (1u << 20)
__device__ __forceinline__ unsigned xb_ld(unsigned* p)              { return __hip_atomic_load(p, __ATOMIC_RELAXED, __HIP_MEMORY_SCOPE_AGENT); }
__device__ __forceinline__ unsigned xb_add(unsigned* p, unsigned v) { return __hip_atomic_fetch_add(p, v, __ATOMIC_RELAXED, __HIP_MEMORY_SCOPE_AGENT); }
__device__ __forceinline__ unsigned xb_xcc_id() { return (unsigned)__builtin_amdgcn_s_getreg((3 << 11) | 20) & 0xFu; }
#define XB_SPIN(cond, bar) do { unsigned _sp = 0; while (cond) { __builtin_amdgcn_s_sleep(1); \
    if ((++_sp & 255u) == 0u) { if (xb_ld(&(bar)[XB_TMO])) break; if (_sp > XB_SPIN_CAP) { atomicAdd(&(bar)[XB_TMO], 1u); break; } } } } while (0)
struct XcdBarrier { unsigned* bar; unsigned x; volatile LAS unsigned* st; };
__device__ __forceinline__ XcdBarrier xcd_barrier_post(unsigned* bar, volatile LAS unsigned* st) {
    XcdBarrier b; b.bar = bar; b.x = xb_xcc_id(); b.st = st;
    if (threadIdx.x == 0) (void)xb_add(&bar[XB_XCNT(b.x)], 1u);
    return b;
}
__device__ __forceinline__ void xcd_barrier_complete(unsigned* bar, unsigned x, unsigned& nloc, unsigned& nx) {
    const unsigned G = gridDim.x * gridDim.y * gridDim.z;
    unsigned sum, cnt, mine, sp = 0u;
    for (;;) {
        sum = 0u; cnt = 0u; mine = 0u;
#pragma unroll
        for (unsigned j = 0; j < 16; ++j) { const unsigned c = xb_ld(&bar[XB_XCNT(j)]); sum += c; cnt += (c > 0u) ? 1u : 0u; mine = (j == x) ? c : mine; }
        if (sum == G) break;
        __builtin_amdgcn_s_sleep(1);
        if ((++sp & 255u) == 0u) { if (xb_ld(&bar[XB_TMO])) break; if (sp > XB_SPIN_CAP) { atomicAdd(&bar[XB_TMO], 1u); break; } }
    }
    nloc = mine > 0u ? mine : 1u; nx = cnt > 0u ? cnt : 1u;
}
__device__ __forceinline__ void xcd_barrier(const XcdBarrier& b) {
    asm volatile("s_waitcnt vmcnt(0)" ::: "memory");
    __syncthreads();
    if (threadIdx.x == 0) {
        unsigned* bar = b.bar;
        __builtin_amdgcn_s_waitcnt(0);
        unsigned nloc = b.st[0], nx = b.st[1];
        if (nloc == 0u) { xcd_barrier_complete(bar, b.x, nloc, nx); b.st[0] = nloc; b.st[1] = nx; }
        const unsigned old = xb_add(&bar[XB_XSUB(b.x)], 1u);
        const unsigned gen = old / nloc;
        if (old + 1u == (gen + 1u) * nloc) {
            __builtin_amdgcn_fence(__ATOMIC_RELEASE, "agent");
            asm volatile("s_waitcnt vmcnt(0)" ::: "memory");
            const unsigned og = xb_add(&bar[XB_TOP], 1u);
            const unsigned tg = og / nx;
            if (og + 1u == (tg + 1u) * nx) xb_add(&bar[XB_TOPGEN], 1u);
            else XB_SPIN(xb_ld(&bar[XB_TOPGEN]) == tg, bar);
            __builtin_amdgcn_fence(__ATOMIC_ACQUIRE, "agent");
            xb_add(&bar[XB_XGEN(b.x)], 1u);
            asm volatile("s_waitcnt vmcnt(0)" ::: "memory");
        } else {
            XB_SPIN(xb_ld(&bar[XB_XGEN(b.x)]) == gen, bar);
            __builtin_amdgcn_fence(__ATOMIC_ACQUIRE, "agent");
            asm volatile("s_waitcnt vmcnt(0)" ::: "memory");
        }
    }
    __syncthreads();
}

namespace pg8 {
constexpr int BM = 256, BK = 64, HALF = 128, HTB = HALF * BK * 2, STAGE_BYTES = 8 * HTB, NXCD = 8, WGM = 8;
__host__ __device__ __forceinline__ int lds_byte(int r, int c) { const int st = (r >> 4) * 2 + (c >> 5), rr = r & 15, cc = c & 31, ob = rr * 64 + cc * 2; return st * 1024 + (ob ^ (((ob >> 9) & 1) << 5)); }
__host__ __device__ __forceinline__ void stage_rc(int b, int& R, int& C) { const int st = b / 1024, sb = b % 1024, swz = sb ^ (((sb >> 9) & 1) << 5); R = (st >> 1) * 16 + swz / 64; C = (st & 1) * 32 + (swz % 64) / 2; }
__host__ __device__ __forceinline__ int perm32(int rho) { const int n = rho >> 4, i = rho & 15; return 8 * (i >> 2) + 4 * n + (i & 3); }

struct Unit { const char* A; const char* B; const char* Bhi; int kind; int row0; int col0; int aux; int nt; int lowonly; };
struct Geom { int lda, ldb, nt, ksplit; const int* rowtok; };

__device__ __forceinline__ void tile_order(int L, int nM, int nN, int& pm, int& pn) {
    const int nwg = nM * nN; int wgid = L;
    { const int q = nwg / NXCD, r = nwg % NXCD, xcd = wgid % NXCD, off = wgid / NXCD; wgid = (xcd < r ? xcd * (q + 1) : r * (q + 1) + (xcd - r) * q) + off; }
    const int nig = WGM * nN, gid = wgid / nig, fm = gid * WGM, gsz = (nM - fm) < WGM ? (nM - fm) : WGM;
    pm = fm + ((wgid % nig) % gsz); pn = (wgid % nig) / gsz;
}

template <class Epi, class Sched, bool ALIGN_EPI, bool SP2>
__device__ __forceinline__ void gemm_phase(LAS unsigned char* lds, const Geom g, const Sched& S, const Epi& E) {
    const int tid = threadIdx.x, wid = __builtin_amdgcn_readfirstlane(tid >> 6), lane = tid & 63, wr = wid >> 2, wc = wid & 3, fr = lane & 15, fq = lane >> 4;
    unsigned voffA[2], voffB[2];
#pragma unroll
    for (int i = 0; i < 2; ++i) { int R, C; stage_rc(tid * 16 + i * 8192, R, C); const int Rb = (R & ~31) + perm32(R & 31);
        voffA[i] = (unsigned)(R * g.lda + C) * 2u; voffB[i] = (unsigned)(Rb * g.ldb + C) * 2u; }
    const size_t kstep = (size_t)(BK * 2);
    const size_t hstepA = (size_t)HALF * g.lda * 2, hstepB = (size_t)HALF * g.ldb * 2;
    unsigned voffA1[2];
#pragma unroll
    for (int i = 0; i < 2; ++i) voffA1[i] = voffA[i] + (unsigned)hstepA;
    const unsigned ldsw = (unsigned)wid * 1024u;
    const int aoff = lds_byte(wr * 64 + fr, fq * 8), boff = lds_byte(wc * 32 + fr, fq * 8);
#define PG8_SA(b, h) (((b) * 2 + (h)) * HTB)
#define PG8_SB(b, h) ((4 + (b) * 2 + (h)) * HTB)
#define PG8_STAGE(bufoff, gbase, voff) do { _Pragma("unroll") for (int _i = 0; _i < 2; ++_i) \
        __builtin_amdgcn_global_load_lds((const unsigned*)((const char*)(gbase) + (voff)[_i]), (LAS unsigned*)(lds + (bufoff) + ldsw + _i * 8192), 16, 0, 0); } while (0)
#define PG8_LDA(dst, b, h) do { _Pragma("unroll") for (int m = 0; m < 4; ++m) _Pragma("unroll") for (int k = 0; k < 2; ++k) dst[m][k] = *(const LAS bf16x8*)(lds + PG8_SA(b, h) + aoff + m * 2048 + k * 1024); } while (0)
#define PG8_LDB(dst, b, h) do { _Pragma("unroll") for (int n = 0; n < 2; ++n) _Pragma("unroll") for (int k = 0; k < 2; ++k) dst[n][k] = *(const LAS bf16x8*)(lds + PG8_SB(b, h) + boff + n * 2048 + k * 1024); } while (0)
#define PG8_MMA(ai, bj, At, Bt) do { __builtin_amdgcn_s_setprio(1); _Pragma("unroll") for (int m = 0; m < 4; ++m) _Pragma("unroll") for (int n = 0; n < 2; ++n) _Pragma("unroll") for (int k = 0; k < 2; ++k) \
        acc[ai][bj][m][n] = __builtin_amdgcn_mfma_f32_16x16x32_bf16(Bt[n][k], At[m][k], acc[ai][bj][m][n], 0, 0, 0); __builtin_amdgcn_s_setprio(0); } while (0)
#define PG8_WAIT_V(n) asm volatile("s_waitcnt vmcnt(" #n ")" ::: "memory")
#define PG8_WAIT_L(n) asm volatile("s_waitcnt lgkmcnt(" #n ")" ::: "memory")
#define PG8_BAR __builtin_amdgcn_s_barrier()
#define PG8_SCHED __builtin_amdgcn_sched_barrier(0)
    Unit cur, nxt; int ui = 0;
    if (!S.next(0, cur)) return;
    if (g.rowtok) {
#pragma unroll
        for (int i = 0; i < 2; ++i) { int R, C; stage_rc(tid * 16 + i * 8192, R, C); int t0 = g.rowtok[cur.row0 + R], t1 = g.rowtok[cur.row0 + HALF + R]; t0 = t0 < 0 ? 0 : t0; t1 = t1 < 0 ? 0 : t1;
            voffA[i] = (unsigned)(t0 * g.lda + C) * 2u; voffA1[i] = (unsigned)(t1 * g.lda + C) * 2u; }
    }
    f32x4 acc[2][2][4][2];
#pragma unroll
    for (int a = 0; a < 2; ++a)
#pragma unroll
        for (int b = 0; b < 2; ++b)
#pragma unroll
            for (int m = 0; m < 4; ++m)
#pragma unroll
                for (int n = 0; n < 2; ++n) acc[a][b][m][n] = (f32x4){0.f, 0.f, 0.f, 0.f};
    bf16x8 At[4][2], B0[2][2], B1[2][2];
    const char* cA = cur.A; const char* cB = cur.B; const char* cBhi = cur.Bhi;
    if constexpr (SP2) {
        PG8_STAGE(PG8_SB(0, 0), cB, voffB); PG8_STAGE(PG8_SB(0, 1), cB + hstepB, voffB); PG8_STAGE(PG8_SA(0, 0), cA, voffA); PG8_STAGE(PG8_SA(0, 1), cA, voffA1);
        if (wr == 1) PG8_BAR;
        PG8_WAIT_V(2); PG8_BAR;
        PG8_STAGE(PG8_SB(1, 0), cB + kstep, voffB); PG8_STAGE(PG8_SA(1, 0), cA + kstep, voffA); PG8_STAGE(PG8_SB(1, 1), cB + hstepB + kstep, voffB);
        PG8_WAIT_V(6); PG8_BAR;
    } else {
        PG8_STAGE(PG8_SB(0, 0), cB, voffB); PG8_STAGE(PG8_SA(0, 0), cA, voffA); PG8_STAGE(PG8_SB(0, 1), cB + hstepB, voffB); PG8_STAGE(PG8_SA(0, 1), cA, voffA1);
        if (wr == 1) PG8_BAR;
        PG8_WAIT_V(4); PG8_BAR;
        PG8_STAGE(PG8_SB(1, 0), cB + kstep, voffB); PG8_STAGE(PG8_SA(1, 0), cA + kstep, voffA); PG8_STAGE(PG8_SB(1, 1), cB + hstepB + kstep, voffB);
        PG8_WAIT_V(6); PG8_BAR;
    }
    for (;;) {
        const bool has_next = S.next(ui + 1, nxt);
        const char* nA = has_next ? nxt.A : cA; const char* nB = has_next ? nxt.B : cB;
        const int nt = cur.nt; const bool hi_on = (cur.lowonly & 1) == 0, b1_on = (cur.lowonly & 2) == 0;
        for (int t = 0; t < nt; t += 2) {
            const bool last = (t == nt - 2);
            if constexpr (Epi::HOOK) { if (t == Epi::HOOK_T1 || t == Epi::HOOK_T2) { E.hook(acc, cur, t, wr, wc, fr, fq); PG8_SCHED; } }
            const char* a1 = cA + (size_t)(t + 1) * kstep;
            const char* a2 = last ? nA : cA + (size_t)(t + 2) * kstep;
            const char* b2 = last ? nB : ((t + 2) < g.ksplit ? cB : cBhi) + (size_t)(t + 2) * kstep;
            const char* a3 = a2 + kstep; const char* b3 = b2 + kstep;
            if constexpr (SP2) {
            PG8_LDB(B0, 0, 0); PG8_LDB(B1, 0, 1); PG8_SCHED; PG8_LDA(At, 0, 0); PG8_STAGE(PG8_SA(1, 1), a1, voffA1);
            PG8_WAIT_V(8); PG8_WAIT_L(0); PG8_BAR; PG8_MMA(0, 0, At, B0); if (b1_on) PG8_MMA(0, 1, At, B1); PG8_BAR; PG8_SCHED;
            PG8_LDA(At, 0, 1); PG8_STAGE(PG8_SB(0, 0), b2, voffB); PG8_STAGE(PG8_SB(0, 1), b2 + hstepB, voffB); PG8_STAGE(PG8_SA(0, 0), a2, voffA);
            PG8_WAIT_V(8); PG8_WAIT_L(0); PG8_BAR; if (hi_on) { PG8_MMA(1, 0, At, B0); if (b1_on) PG8_MMA(1, 1, At, B1); } PG8_BAR; PG8_SCHED;
            PG8_LDB(B0, 1, 0); PG8_LDB(B1, 1, 1); PG8_SCHED; PG8_LDA(At, 1, 0); PG8_STAGE(PG8_SA(0, 1), a2, voffA1);
            PG8_WAIT_V(8); PG8_WAIT_L(0); PG8_BAR; PG8_MMA(0, 0, At, B0); if (b1_on) PG8_MMA(0, 1, At, B1); PG8_BAR; PG8_SCHED;
            PG8_LDA(At, 1, 1); PG8_STAGE(PG8_SB(1, 0), b3, voffB); PG8_STAGE(PG8_SB(1, 1), b3 + hstepB, voffB); PG8_STAGE(PG8_SA(1, 0), a3, voffA);
            PG8_WAIT_V(8); PG8_WAIT_L(0); PG8_BAR; if (hi_on) { PG8_MMA(1, 0, At, B0); if (b1_on) PG8_MMA(1, 1, At, B1); } PG8_BAR; PG8_SCHED;
            } else {
            PG8_LDB(B0, 0, 0); PG8_SCHED; PG8_LDA(At, 0, 0); PG8_STAGE(PG8_SA(1, 1), a1, voffA1);
            PG8_WAIT_L(8); PG8_BAR; PG8_WAIT_L(0); PG8_MMA(0, 0, At, B0); PG8_BAR; PG8_SCHED;
            PG8_LDB(B1, 0, 1); PG8_STAGE(PG8_SB(0, 0), b2, voffB);
            PG8_BAR; PG8_WAIT_L(0); PG8_MMA(0, 1, At, B1); PG8_BAR;
            PG8_LDA(At, 0, 1); PG8_STAGE(PG8_SA(0, 0), a2, voffA);
            PG8_BAR; PG8_WAIT_L(0); PG8_MMA(1, 0, At, B0); PG8_BAR; PG8_SCHED;
            PG8_STAGE(PG8_SB(0, 1), b2 + hstepB, voffB);
            PG8_WAIT_V(6); PG8_BAR; PG8_MMA(1, 1, At, B1); PG8_BAR;
            PG8_LDB(B0, 1, 0); PG8_SCHED; PG8_LDA(At, 1, 0); PG8_STAGE(PG8_SA(0, 1), a2, voffA1);
            PG8_WAIT_L(8); PG8_BAR; PG8_WAIT_L(0); PG8_MMA(0, 0, At, B0); PG8_BAR; PG8_SCHED;
            PG8_LDB(B1, 1, 1); PG8_STAGE(PG8_SB(1, 0), b3, voffB);
            PG8_BAR; PG8_WAIT_L(0); PG8_MMA(0, 1, At, B1); PG8_BAR;
            PG8_LDA(At, 1, 1); PG8_STAGE(PG8_SA(1, 0), a3, voffA);
            PG8_BAR; PG8_WAIT_L(0); PG8_MMA(1, 0, At, B0); PG8_BAR; PG8_SCHED;
            PG8_STAGE(PG8_SB(1, 1), b3 + hstepB, voffB);
            PG8_WAIT_V(6); PG8_BAR; PG8_MMA(1, 1, At, B1); PG8_BAR;
            }
        }
        if constexpr (ALIGN_EPI) { if (wr == 0) PG8_BAR; }
        E(acc, cur, wr, wc, fr, fq);
        if (!has_next) break;
#pragma unroll
        for (int a = 0; a < 2; ++a)
#pragma unroll
            for (int b = 0; b < 2; ++b)
#pragma unroll
                for (int m = 0; m < 4; ++m)
#pragma unroll
                    for (int n = 0; n < 2; ++n) acc[a][b][m][n] = (f32x4){0.f, 0.f, 0.f, 0.f};
        cur = nxt; cA = nA; cB = nB; cBhi = nxt.Bhi; ++ui;
        if constexpr (ALIGN_EPI) { if (wr == 1) PG8_BAR; }
    }
    PG8_WAIT_V(0);
    if constexpr (!ALIGN_EPI) { if (wr == 0) PG8_BAR; }
    PG8_BAR;
#undef PG8_SA
#undef PG8_SB
#undef PG8_STAGE
#undef PG8_LDA
#undef PG8_LDB
#undef PG8_MMA
#undef PG8_WAIT_V
#undef PG8_WAIT_L
#undef PG8_BAR
#undef PG8_SCHED
}
}

constexpr int RING_BYTES = 131072, LDS_BYTES = 147456, LDSCTL_OFF = LDS_BYTES - 2048, MISC_OFF = LDSCTL_OFF + 320;
struct KArgs { const void* in[24]; float* out; unsigned char* ws; int ph_lo, ph_hi; };
struct Frame {
    LAS unsigned char* lds; volatile LAS unsigned* MISC; unsigned* ctl; unsigned char* ws; float* out;
    int tid, lane, wave, vcu, G;
    const float *x, *mem, *g_mix, *w_in, *b_gate, *w_pool_grp, *pool_scale, *q_norm_g, *k_norm_g, *g_mem, *w_mem_kv, *xq_norm_g, *xk_norm_g,
                *w_pool_out, *w_attn_out, *w_cross_out, *w_o, *g_ffn, *w_rg, *w_re, *w_eg, *w_eu, *w_ed;
    const int* positions;
};
template <class T> __device__ __forceinline__ T* wsp(const Frame& F, size_t off) { return (T*)(F.ws + off); }

struct TrD { const float* W; const float* gain; bf16_t* dst; int ldw, k0, n0, nvalid, ldd, dk0; };
__device__ __forceinline__ void tr_load(const TrD& d, f32x4 (&v)[2][8], float (&g)[8], int lane) {
    const int kg = lane >> 3, ng = lane & 7;
#pragma unroll
    for (int hh = 0; hh < 2; ++hh) { const int nn = 32 * hh + 4 * ng; const bool ok = nn < d.nvalid;
#pragma unroll
        for (int i = 0; i < 8; ++i) v[hh][i] = ok ? __builtin_nontemporal_load((const f32x4*)(d.W + (size_t)(d.k0 + 8 * kg + i) * d.ldw + d.n0 + nn)) : (f32x4){0.f, 0.f, 0.f, 0.f}; }
#pragma unroll
    for (int i = 0; i < 8; ++i) g[i] = d.gain ? d.gain[d.k0 + 8 * kg + i] : 1.0f;
}
template <bool NTS> __device__ __forceinline__ void tr_store(const TrD& d, const f32x4 (&v)[2][8], const float (&g)[8], int lane) {
    const int kg = lane >> 3, ng = lane & 7;
#pragma unroll
    for (int hh = 0; hh < 2; ++hh)
#pragma unroll
        for (int j = 0; j < 4; ++j) { const int n = 32 * hh + 4 * ng + j;
            u32x4 o; o.x = pk2(v[hh][0][j] * g[0], v[hh][1][j] * g[1]); o.y = pk2(v[hh][2][j] * g[2], v[hh][3][j] * g[3]); o.z = pk2(v[hh][4][j] * g[4], v[hh][5][j] * g[5]); o.w = pk2(v[hh][6][j] * g[6], v[hh][7][j] * g[7]);
            u32x4* p = (u32x4*)(d.dst + (size_t)n * d.ldd + d.dk0 + d.k0 + 8 * kg); if (NTS) __builtin_nontemporal_store(o, p); else *p = o; }
}
__device__ __forceinline__ void tr_item(const float* W, int ldw, int k0, int n0, int nvalid, const float* gain, bf16_t* dst, int ldd, int dk0, LAS float*, int lane) {
    const TrD d{W, gain, dst, ldw, k0, n0, nvalid, ldd, dk0};
    f32x4 v[2][8]; float g[8];
    tr_load(d, v, g, lane); tr_store<false>(d, v, g, lane);
}
template <bool NTS> __device__ __forceinline__ void tr_pair(const TrD& d0, const TrD& d1, int lane) {
    f32x4 v0[2][8], v1[2][8]; float g0[8], g1[8];
    tr_load(d0, v0, g0, lane); tr_load(d1, v1, g1, lane);
    tr_store<NTS>(d0, v0, g0, lane); tr_store<NTS>(d1, v1, g1, lane);
}
__device__ __forceinline__ void row_to_bf16(const float* xrow, bf16_t* orow, float* rstd_out, int lane) {
    const f32x4* xr = (const f32x4*)xrow + lane;
    f32x4 v[8]; float s = 0.f;
#pragma unroll
    for (int j = 0; j < 8; ++j) { v[j] = xr[64 * j]; s += (v[j].x * v[j].x + v[j].y * v[j].y) + (v[j].z * v[j].z + v[j].w * v[j].w); }
    s = wave_sum(s);
    u32x2* o8 = (u32x2*)orow + lane;
#pragma unroll
    for (int j = 0; j < 8; ++j) { u32x2 w; w.x = pk2(v[j].x, v[j].y); w.y = pk2(v[j].z, v[j].w); o8[64 * j] = w; }
    if (lane == 0) *rstd_out = 1.0f / sqrtf(s * (1.0f / DM) + NORM_EPS);
}
__device__ __forceinline__ void att_build_table(Frame& F);
__device__ __forceinline__ int cum_chunks(int qb);
#ifndef P0_PROF
#define P0_PROF 0
#endif
#define P0T0() unsigned long long _pt = (P0_PROF && F.tid == 0) ? __builtin_amdgcn_s_memrealtime() : 0ull
#define P0T1(k) do { if (P0_PROF == (k)) { __syncthreads(); if (F.tid == 0) atomicMax(F.ctl + CW_QUEUE + 8, (unsigned)(__builtin_amdgcn_s_memrealtime() - _pt)); } } while (0)
__device__ __forceinline__ void wcomb_item(Frame& F, int it, bf16_t* BTMRG) {
        const int g = it / 384, r = it % 384, ct = r / 64, dt = r % 64;
        const int i = F.lane & 31, kh = F.lane >> 5;
        const float* ap = F.w_pool_grp + (size_t)g * 192 * 192 + (size_t)(32 * ct + i) * 192 + 4 * kh;
        const float* sp = F.pool_scale + g * 192 + 4 * kh;
        const float* bp = F.w_pool_out + (size_t)(g * 192 + 4 * kh) * DM + 32 * dt + i;
        f32x16 acc;
#pragma unroll
        for (int q2 = 0; q2 < 16; ++q2) acc[q2] = 0.f;
#pragma unroll 1
        for (int m0 = 0; m0 < 24; m0 += 12) {
            f32x4 a[12], sc[12]; float b[12][4];
#pragma unroll
            for (int mm = 0; mm < 12; ++mm) { a[mm] = *(const f32x4*)(ap + 8 * (m0 + mm)); sc[mm] = *(const f32x4*)(sp + 8 * (m0 + mm));
#pragma unroll
                for (int e = 0; e < 4; ++e) b[mm][e] = bp[(size_t)(8 * (m0 + mm) + e) * DM]; }
#pragma unroll
            for (int mm = 0; mm < 12; ++mm)
#pragma unroll
                for (int e = 0; e < 4; ++e) acc = __builtin_amdgcn_mfma_f32_32x32x2f32(a[mm][e] * sc[mm][e], b[mm][e], acc, 0, 0, 0);
        }
        bf16_t* op = BTMRG + (size_t)(32 * dt + i) * DM + g * 192 + 32 * ct + 4 * kh;
#pragma unroll
        for (int q4 = 0; q4 < 4; ++q4) { u32x2 o; o.x = pk2(acc[4 * q4 + 0], acc[4 * q4 + 1]); o.y = pk2(acc[4 * q4 + 2], acc[4 * q4 + 3]); *(u32x2*)(op + 8 * q4) = o; }
}
__device__ __forceinline__ void p0_prologue(Frame& F) {
    P0T0();
    if (blockIdx.x == 0) att_build_table(F);
    LAS float* scr = (LAS float*)(F.lds + F.wave * 16640);
    const int gw = F.vcu * NWAVES + F.wave, NGW = F.G * NWAVES;
    bf16_t* WINT = wsp<bf16_t>(F, WS_WINT); bf16_t* WVT = wsp<bf16_t>(F, WS_WVT); bf16_t* WMKVT = wsp<bf16_t>(F, WS_WMKVT);
    bf16_t* BTMRG = wsp<bf16_t>(F, WS_BTMRG); bf16_t* WOT = wsp<bf16_t>(F, WS_WOT);
    __syncthreads();
    constexpr int NB_IN = 158, I_IN = 32 * NB_IN, I_MKV = 32 * 16, I_WO = 32 * 32, I_AO = 12 * 32, I_CO = 8 * 32;
    constexpr int NITEMS = I_IN + I_MKV + I_WO + I_AO + I_CO;
    auto decode = [&](int r, TrD& d) {
        d.nvalid = 64; d.dk0 = 0; d.ldd = DM;
        if (r < I_IN) {
            const int kb = r / NB_IN, nb = r % NB_IN; int sc0, drow; bf16_t* dm = WINT; int j;
            if (nb < 12) { j = nb; sc0 = 0; drow = 0; }
            else if (nb < 24) { j = nb - 12; sc0 = 768; drow = 768; }
            else if (nb < 36) { j = nb - 24; sc0 = 1536; drow = 1536; }
            else if (nb < 48) { j = nb - 36; sc0 = 2304; drow = 0; dm = WVT; }
            else if (nb < 52) { j = nb - 48; sc0 = 3072; drow = 2304; }
            else if (nb < 54) { j = nb - 52; sc0 = 3328; drow = 2560; if (j == 1) d.nvalid = 4; }
            else if (nb < 62) { j = nb - 54; sc0 = 3396; drow = 2816; }
            else { j = nb - 62; sc0 = 3908; drow = 3328; }
            d.W = F.w_in; d.ldw = INC; d.k0 = kb * 64; d.n0 = sc0 + 64 * j; d.gain = F.g_mix; d.dst = dm + (size_t)(drow + 64 * j) * DM; return; }
        r -= I_IN;
        if (r < I_MKV) { const int kb = r / 16, nb = r % 16; d.W = F.w_mem_kv; d.ldw = 1024; d.k0 = kb * 64; d.n0 = nb * 64; d.gain = F.g_mem; d.dst = WMKVT + (size_t)(nb * 64) * DM; return; }
        r -= I_MKV;
        if (r < I_WO) { const int kb = r / 32, nb = r % 32; d.W = F.w_o; d.ldw = DM; d.k0 = kb * 64; d.n0 = nb * 64; d.gain = nullptr; d.dst = WOT + (size_t)(nb * 64) * DM; return; }
        r -= I_WO;
        if (r < I_AO) { const int kb = r / 32, nb = r % 32; d.W = F.w_attn_out; d.ldw = DM; d.k0 = kb * 64; d.n0 = nb * 64; d.gain = nullptr; d.dst = BTMRG + (size_t)(nb * 64) * DM; d.dk0 = 768; return; }
        r -= I_AO;
        { const int kb = r / 32, nb = r % 32; d.W = F.w_cross_out; d.ldw = DM; d.k0 = kb * 64; d.n0 = nb * 64; d.gain = nullptr; d.dst = BTMRG + (size_t)(nb * 64) * DM; d.dk0 = 1536; }
    };
    constexpr int NP0 = I_IN + I_MKV;
    for (int it = gw; it < NP0; it += 2 * NGW) {
        TrD d0, d1; decode(it, d0);
        if (it + NGW < NP0) { decode(it + NGW, d1); tr_pair<false>(d0, d1, F.lane); }
        else { f32x4 v[2][8]; float g[8]; tr_load(d0, v, g, F.lane); tr_store<false>(d0, v, g, F.lane); }
    }
    P0T1(2);
    { u32x4* z = (u32x4*)(WINT + (size_t)2688 * DM); const int n16 = 128 * DM * 2 / 16;
      for (int i = F.vcu * NTHR + F.tid; i < n16; i += F.G * NTHR) z[i] = (u32x4){0u, 0u, 0u, 0u}; }
    { float* WR = wsp<float>(F, WS_WR);
      for (int i = F.vcu * NTHR + F.tid; i < DM * 32; i += F.G * NTHR) { const int k = i >> 5, j = i & 31;
          float v = 0.f; if (j < 4) v = F.w_rg[k * 4 + j]; else if (j < 20) v = F.w_re[k * 16 + (j - 4)];
          const float wv = v * F.g_ffn[k]; WR[i] = wv;
          bf16_t* WRS = wsp<bf16_t>(F, WS_WRS);
          const unsigned h0 = pk2(wv, 0.f) & 0xffffu; const float r1 = wv - __builtin_bit_cast(float, h0 << 16);
          const unsigned h1 = pk2(r1, 0.f) & 0xffffu; const float r2 = r1 - __builtin_bit_cast(float, h1 << 16);
          const unsigned h2 = pk2(r2, 0.f) & 0xffffu;
          const size_t wi = ((size_t)(k >> 4) * 64 + (size_t)(((k >> 3) & 1) * 32 + j)) * 8 + (k & 7);
          WRS[wi] = (bf16_t)h0; WRS[(size_t)128 * 512 + wi] = (bf16_t)h1; WRS[(size_t)256 * 512 + wi] = (bf16_t)h2; } }
    P0T1(3);
    { bf16_t* XB = wsp<bf16_t>(F, WS_XB); float* R1 = wsp<float>(F, WS_RSTD1); bf16_t* MB = wsp<bf16_t>(F, WS_MEMB); float* RM = wsp<float>(F, WS_RSTDM);
      for (int m0 = gw; m0 < SEQ + MEML; m0 += 4 * NGW) {
          f32x4 v[4][8];
#pragma unroll
          for (int r = 0; r < 4; ++r) { const int m = m0 + r * NGW; if (m < SEQ + MEML) { const f32x4* xr = (const f32x4*)(m < SEQ ? F.x + (size_t)m * DM : F.mem + (size_t)(m - SEQ) * DM) + F.lane;
#pragma unroll
              for (int j = 0; j < 8; ++j) v[r][j] = __builtin_nontemporal_load(xr + 64 * j); } }
#pragma unroll
          for (int r = 0; r < 4; ++r) { const int m = m0 + r * NGW; if (m < SEQ + MEML) { float s = 0.f;
#pragma unroll
              for (int j = 0; j < 8; ++j) s += (v[r][j].x * v[r][j].x + v[r][j].y * v[r][j].y) + (v[r][j].z * v[r][j].z + v[r][j].w * v[r][j].w);
              s = wave_sum(s);
              u32x2* o8 = (u32x2*)(m < SEQ ? XB + (size_t)m * DM : MB + (size_t)(m - SEQ) * DM) + F.lane;
#pragma unroll
              for (int j = 0; j < 8; ++j) { u32x2 w; w.x = pk2(v[r][j].x, v[r][j].y); w.y = pk2(v[r][j].z, v[r][j].w); o8[64 * j] = w; }
              if (F.lane == 0) { const float rs = 1.0f / sqrtf(s * (1.0f / DM) + NORM_EPS); if (m < SEQ) R1[m] = rs; else RM[m - SEQ] = rs; } } } } }
}

struct SchedP1 {
    int c, G; unsigned char* ws;
    __device__ __forceinline__ bool next(int i, pg8::Unit& u) const {
        const size_t tstep = (size_t)256 * DM * 2;
        const char* XB = (const char*)(ws + WS_XB); const char* WINT = (const char*)(ws + WS_WINT); const char* WVT = (const char*)(ws + WS_WVT); const char* MEMB = (const char*)(ws + WS_MEMB); const char* WMKVT = (const char*)(ws + WS_WMKVT);
        u.nt = 32; u.lowonly = 0;
        const int nreg = (c < 1280) ? (1280 - c + G - 1) / G : 0;
        if (i < nreg) { const int L = i * G + c;
            if (L < 1184) { int pm, pn; pg8::tile_order(L, 32, 37, pm, pn);
                u.A = XB + (size_t)pm * tstep; u.B = WINT + (size_t)pn * tstep; u.Bhi = u.B; u.row0 = pm * 256;
                if (pn < 3) { u.kind = 0; u.col0 = pn * 256; u.aux = 0; }
                else if (pn < 6) { u.kind = 0; u.col0 = (pn - 3) * 256; u.aux = 1; }
                else if (pn < 9) { u.kind = 0; u.col0 = (pn - 6) * 256; u.aux = 2; }
                else if (pn < 11) { u.kind = 1; u.col0 = (pn - 9) * 256; u.aux = 0; if (pn == 10) u.lowonly = 2; }
                else if (pn < 13) { u.kind = 0; u.col0 = (pn - 11) * 256; u.aux = 3; }
                else { u.kind = 2; u.col0 = (pn - 13) * 256; u.aux = 0; }
                return true; }
            { const int idx = L - 1184, pm = idx / 32, pn = idx % 32;
              u.A = WVT + (size_t)pm * tstep; u.B = XB + (size_t)pn * tstep; u.Bhi = u.B; u.kind = 3; u.row0 = pm * 256; u.col0 = pn * 256; u.aux = 0; return true; } }
        int k = i - nreg, idx = -1;
        for (int j = 0; j < nreg; ++j) { const int L = j * G + c; if (L < 1184) { int pm, pn; pg8::tile_order(L, 32, 37, pm, pn); if (pn == 10) { if (k == 0) { idx = pm; break; } --k; } } }
        if (idx < 0) return false;
        { const int pn = idx & 3, ks = idx >> 2;
          u.A = MEMB + (size_t)ks * 512; u.B = WMKVT + (size_t)pn * tstep + (size_t)ks * 512; u.Bhi = u.B; u.kind = 4; u.row0 = 0; u.col0 = pn * 256; u.aux = ks; u.nt = 4; return true; }
    }
};
struct EpiP1 {
    static constexpr bool HOOK = false; static constexpr int HOOK_T1 = -1, HOOK_T2 = -1;
    unsigned char* ws; const float* rstd1; const float* rstdm; const float* bgate;
    __device__ __forceinline__ void hook(f32x4 (&)[2][2][4][2], const pg8::Unit&, int, int, int, int, int) const {}
    __device__ __forceinline__ void operator()(const f32x4 (&acc)[2][2][4][2], const pg8::Unit& u, int wr, int wc, int fr, int fq) const {
        const int rbase = u.row0 + wr * 64 + fr, cbase = u.col0 + wc * 32 + 8 * fq;
        if (u.kind == 0) {
            bf16_t* C; int ldc;
            if (u.aux == 0) { C = (bf16_t*)(ws + WS_U); ldc = 768; } else if (u.aux == 1) { C = (bf16_t*)(ws + WS_Q); ldc = 768; }
            else if (u.aux == 2) { C = (bf16_t*)(ws + WS_K); ldc = 768; } else { C = (bf16_t*)(ws + WS_XQ); ldc = 512; }
#pragma unroll
            for (int ai = 0; ai < 2; ++ai)
#pragma unroll
                for (int m = 0; m < 4; ++m) { const int row = rbase + ai * 128 + m * 16; const float s = rstd1[row];
#pragma unroll
                    for (int bj = 0; bj < 2; ++bj) { const f32x4 v0 = acc[ai][bj][m][0] * s, v1 = acc[ai][bj][m][1] * s;
                        u32x4 w; w.x = pk2(v0[0], v0[1]); w.y = pk2(v0[2], v0[3]); w.z = pk2(v1[0], v1[1]); w.w = pk2(v1[2], v1[3]);
                        *(u32x4*)(C + (size_t)row * ldc + cbase + bj * 128) = w; } }
        } else if (u.kind == 1 || u.kind == 4) {
            float* C; int ldc; const float* rs;
            if (u.kind == 1) { C = (float*)(ws + WS_IDXF); ldc = 512; rs = rstd1; } else { C = (float*)(ws + WS_KVMP) + (size_t)u.aux * 262144; ldc = 1024; rs = rstdm; }
#pragma unroll
            for (int ai = 0; ai < 2; ++ai)
#pragma unroll
                for (int m = 0; m < 4; ++m) { const int row = rbase + ai * 128 + m * 16; const float s = rs[row];
#pragma unroll
                    for (int bj = 0; bj < 2; ++bj) { float* p = C + (size_t)row * ldc + cbase + bj * 128;
                        *(f32x4*)p = acc[ai][bj][m][0] * s; *(f32x4*)(p + 4) = acc[ai][bj][m][1] * s; } }
        } else if (u.kind == 2) {
            bf16_t* C = (bf16_t*)(ws + WS_EG);
            f32x4 bv[2][2];
#pragma unroll
            for (int bj = 0; bj < 2; ++bj) { bv[bj][0] = *(const f32x4*)(bgate + cbase + bj * 128); bv[bj][1] = *(const f32x4*)(bgate + cbase + bj * 128 + 4); }
#pragma unroll
            for (int ai = 0; ai < 2; ++ai)
#pragma unroll
                for (int m = 0; m < 4; ++m) { const int row = rbase + ai * 128 + m * 16; const float s = rstd1[row];
#pragma unroll
                    for (int bj = 0; bj < 2; ++bj) { f32x4 v0 = acc[ai][bj][m][0] * s + bv[bj][0], v1 = acc[ai][bj][m][1] * s + bv[bj][1];
#pragma unroll
                        for (int e = 0; e < 4; ++e) { v0[e] = 1.0f + __builtin_amdgcn_exp2f(fminf(-v0[e] * LOG2E, 60.f)); v1[e] = 1.0f + __builtin_amdgcn_exp2f(fminf(-v1[e] * LOG2E, 60.f)); }
                        u32x4 w; w.x = pk2(v0[0], v0[1]); w.y = pk2(v0[2], v0[3]); w.z = pk2(v1[0], v1[1]); w.w = pk2(v1[2], v1[3]);
                        *(u32x4*)(C + (size_t)row * 6144 + cbase + bj * 128) = w; } }
        } else {
            bf16_t* C = (bf16_t*)(ws + WS_VT);
            f32x4 sv[2][2];
#pragma unroll
            for (int bj = 0; bj < 2; ++bj) { sv[bj][0] = *(const f32x4*)(rstd1 + cbase + bj * 128); sv[bj][1] = *(const f32x4*)(rstd1 + cbase + bj * 128 + 4); }
#pragma unroll
            for (int ai = 0; ai < 2; ++ai)
#pragma unroll
                for (int m = 0; m < 4; ++m) { const int row = rbase + ai * 128 + m * 16;
#pragma unroll
                    for (int bj = 0; bj < 2; ++bj) { const f32x4 v0 = acc[ai][bj][m][0] * sv[bj][0], v1 = acc[ai][bj][m][1] * sv[bj][1];
                        u32x4 w; w.x = pk2(v0[0], v0[1]); w.y = pk2(v0[2], v0[3]); w.z = pk2(v1[0], v1[1]); w.w = pk2(v1[2], v1[3]);
                        *(u32x4*)(C + (size_t)row * SEQ + cbase + bj * 128) = w; } }
        }
    }
};

__device__ __forceinline__ void rot_cs(float pos, float inv_freq, float& c, float& s) {
    const float ang = pos * inv_freq;
    const double rev = (double)ang * 0.15915494309189535;
    const float fr = (float)(rev - __builtin_rint(rev));
    c = __builtin_amdgcn_cosf(fr); s = __builtin_amdgcn_sinf(fr);
}
__device__ __forceinline__ void unpack8(const u32x4 v, float (&f)[8]) { f[0] = bflo(v.x); f[1] = bfhi(v.x); f[2] = bflo(v.y); f[3] = bfhi(v.y); f[4] = bflo(v.z); f[5] = bfhi(v.z); f[6] = bflo(v.w); f[7] = bfhi(v.w); }
__device__ __forceinline__ u32x4 pack8(const float (&f)[8]) { u32x4 o; o.x = pk2(f[0], f[1]); o.y = pk2(f[2], f[3]); o.z = pk2(f[4], f[5]); o.w = pk2(f[6], f[7]); return o; }
__device__ __forceinline__ void p2_rowpass(Frame& F) {
    P0T0();
    const int gw = F.vcu * NWAVES + F.wave, NGW = F.G * NWAVES, lane = F.lane;
    const bf16_t* U = wsp<bf16_t>(F, WS_U); bf16_t* AM = wsp<bf16_t>(F, WS_AMRG);
    bf16_t* Q = wsp<bf16_t>(F, WS_Q); bf16_t* K = wsp<bf16_t>(F, WS_K); bf16_t* XQ = wsp<bf16_t>(F, WS_XQ);
    const float* IDXF = wsp<float>(F, WS_IDXF); bf16_t* QIB = wsp<bf16_t>(F, WS_QIB); bf16_t* KIB = wsp<bf16_t>(F, WS_KIB); float* WIF = wsp<float>(F, WS_WIF);
    const int m = lane & 15, mlo = m & 7; const bool hi_half = m >= 8;
    float if128[8], if64[4], gq[8], gk[8], gx[8];
#pragma unroll
    for (int e = 0; e < 8; ++e) { if128[e] = __builtin_amdgcn_exp2f(-(float)(2 * (8 * mlo + e)) * (13.287712379549449f / 128.0f)); gq[e] = F.q_norm_g[8 * m + e]; gk[e] = F.k_norm_g[8 * m + e]; gx[e] = F.xq_norm_g[8 * m + e]; }
#pragma unroll
    for (int e = 0; e < 4; ++e) if64[e] = __builtin_amdgcn_exp2f(-(float)(2 * (4 * mlo + e)) * (13.287712379549449f / 64.0f));
    auto row_rest = [&](const int t, const u32x4 (&rawqk)[3], const u32x4 rawx, const f32x4 iqa, const f32x4 ika, const float iw, const int posi) {
        const float pos = (float)posi;
        float c128[8], s128[8], c64[4], s64[4];
#pragma unroll
        for (int e = 0; e < 8; ++e) rot_cs(pos, if128[e], c128[e], s128[e]);
#pragma unroll
        for (int e = 0; e < 4; ++e) rot_cs(pos, if64[e], c64[e], s64[e]);
#pragma unroll
        for (int ch = 0; ch < 3; ++ch) {
            const int e0 = ch * 512 + 8 * lane; const bool isq = e0 < 768;
            bf16_t* p = isq ? (Q + (size_t)t * 768 + e0) : (K + (size_t)t * 768 + (e0 - 768));
            float v[8], pv[8]; unpack8(rawqk[ch], v);
            float ss = 0.f;
#pragma unroll
            for (int e = 0; e < 8; ++e) ss += v[e] * v[e];
            ss += __shfl_xor(ss, 1); ss += __shfl_xor(ss, 2); ss += __shfl_xor(ss, 4); ss += __shfl_xor(ss, 8);
            const float r = (1.0f / sqrtf(ss * (1.0f / 128.0f) + NORM_EPS)) * (isq ? (ATT_SCALE * LOG2E) : 1.0f);
#pragma unroll
            for (int e = 0; e < 8; ++e) v[e] *= r * (isq ? gq[e] : gk[e]);
#pragma unroll
            for (int e = 0; e < 8; ++e) pv[e] = __shfl_xor(v[e], 8);
            float o[8];
#pragma unroll
            for (int e = 0; e < 8; ++e) o[e] = hi_half ? (v[e] * c128[e] + pv[e] * s128[e]) : (v[e] * c128[e] - pv[e] * s128[e]);
            *(u32x4*)p = pack8(o);
        }
        { bf16_t* p = XQ + (size_t)t * 512 + 8 * lane; float v[8]; unpack8(rawx, v);
          float ss = 0.f;
#pragma unroll
          for (int e = 0; e < 8; ++e) ss += v[e] * v[e];
          ss += __shfl_xor(ss, 1); ss += __shfl_xor(ss, 2); ss += __shfl_xor(ss, 4); ss += __shfl_xor(ss, 8);
          const float r = (1.0f / sqrtf(ss * (1.0f / 128.0f) + NORM_EPS)) * (ATT_SCALE * LOG2E);
#pragma unroll
          for (int e = 0; e < 8; ++e) v[e] *= r * gx[e];
          *(u32x4*)p = pack8(v); }
        { const f32x4 a = iqa; f32x4 b; b[0] = __shfl_xor(a[0], 8); b[1] = __shfl_xor(a[1], 8); b[2] = __shfl_xor(a[2], 8); b[3] = __shfl_xor(a[3], 8);
          float o[4];
#pragma unroll
          for (int e = 0; e < 4; ++e) o[e] = hi_half ? (a[e] * c64[e] + b[e] * s64[e]) : (a[e] * c64[e] - b[e] * s64[e]);
          u32x2 w; w.x = pk2(o[0], o[1]); w.y = pk2(o[2], o[3]); *(u32x2*)(QIB + (size_t)t * 256 + 4 * lane) = w; }
        { const f32x4 a = ika; f32x4 b; b[0] = __shfl_xor(a[0], 8); b[1] = __shfl_xor(a[1], 8); b[2] = __shfl_xor(a[2], 8); b[3] = __shfl_xor(a[3], 8);
          float o[4];
#pragma unroll
          for (int e = 0; e < 4; ++e) o[e] = hi_half ? (a[e] * c64[e] + b[e] * s64[e]) : (a[e] * c64[e] - b[e] * s64[e]);
          u32x2 w; w.x = pk2(o[0], o[1]); w.y = pk2(o[2], o[3]); if (lane < 16) *(u32x2*)(KIB + (size_t)t * 64 + 4 * lane) = w; }
        if (lane < 4) WIF[t * 4 + lane] = iw * 0.0625f;
    };
    for (int m = gw; m < SEQ / 2; m += NGW) {
        const int t0 = 2 * m, t1 = t0 + 1;
        const int colA = 8 * lane, colB = 512 + 8 * lane;
        const int gA = colA / 192, wA = 2 << gA, c1A = (t1 + 1 < wA) ? (t1 + 1) : wA, c0A = (t0 + 1 < wA) ? (t0 + 1) : wA;
        const int gB = (lane < 32) ? colB / 192 : 3, wB = 2 << gB, c1B = (lane < 32) ? ((t1 + 1 < wB) ? (t1 + 1) : wB) : 0, c0B = (t0 + 1 < wB) ? (t0 + 1) : wB;
        u32x4 ua[8], ub[16], xa, xb;
#pragma unroll
        for (int j = 0; j < 8; ++j) ua[j] = (j < c1A) ? *(const u32x4*)(U + (size_t)(t1 - j) * 768 + colA) : (u32x4){0u, 0u, 0u, 0u};
        xa = (t1 - wA >= 0) ? *(const u32x4*)(U + (size_t)(t1 - wA) * 768 + colA) : (u32x4){0u, 0u, 0u, 0u};
#pragma unroll
        for (int j = 0; j < 16; ++j) ub[j] = (j < c1B) ? *(const u32x4*)(U + (size_t)(t1 - j) * 768 + colB) : (u32x4){0u, 0u, 0u, 0u};
        xb = (lane < 32 && t1 - wB >= 0) ? *(const u32x4*)(U + (size_t)(t1 - wB) * 768 + colB) : (u32x4){0u, 0u, 0u, 0u};
        u32x4 rq[2][3], rx[2]; f32x4 iq[2], ik[2]; float iww[2];
        const int pos0 = F.positions[t0], pos1 = F.positions[t1];
#pragma unroll
        for (int r = 0; r < 2; ++r) { const int t = t0 + r;
#pragma unroll
            for (int ch = 0; ch < 3; ++ch) { const int e0 = ch * 512 + 8 * lane; rq[r][ch] = *(const u32x4*)((e0 < 768) ? (Q + (size_t)t * 768 + e0) : (K + (size_t)t * 768 + (e0 - 768))); }
            rx[r] = *(const u32x4*)(XQ + (size_t)t * 512 + 8 * lane);
            const float* ip = IDXF + (size_t)t * 512;
            iq[r] = *(const f32x4*)(ip + 4 * lane); ik[r] = *(const f32x4*)(ip + 256 + 4 * (lane & 15)); iww[r] = ip[320 + (lane & 3)]; }
        { float sum[8], f0[8], f1[8], fx[8];
#pragma unroll
          for (int e = 0; e < 8; ++e) sum[e] = 0.f;
#pragma unroll
          for (int j = 0; j < 8; ++j) { float f[8]; unpack8(ua[j], f);
#pragma unroll
              for (int e = 0; e < 8; ++e) sum[e] += f[e]; }
          unpack8(ua[0], f0); unpack8(ua[1], f1); unpack8(xa, fx);
          const float i1 = 1.0f / (float)c1A, i0 = 1.0f / (float)c0A; float o1[8], o0[8];
#pragma unroll
          for (int e = 0; e < 8; ++e) { o1[e] = sum[e] * i1 - f0[e]; o0[e] = ((sum[e] - f0[e]) + fx[e]) * i0 - f1[e]; }
          *(u32x4*)(AM + (size_t)t1 * DM + colA) = pack8(o1); *(u32x4*)(AM + (size_t)t0 * DM + colA) = pack8(o0); }
        if (lane < 32) { float sum[8], f0[8], f1[8], fx[8];
#pragma unroll
          for (int e = 0; e < 8; ++e) sum[e] = 0.f;
#pragma unroll
          for (int j = 0; j < 16; ++j) { float f[8]; unpack8(ub[j], f);
#pragma unroll
              for (int e = 0; e < 8; ++e) sum[e] += f[e]; }
          unpack8(ub[0], f0); unpack8(ub[1], f1); unpack8(xb, fx);
          const float i1 = 1.0f / (float)c1B, i0 = 1.0f / (float)c0B; float o1[8], o0[8];
#pragma unroll
          for (int e = 0; e < 8; ++e) { o1[e] = sum[e] * i1 - f0[e]; o0[e] = ((sum[e] - f0[e]) + fx[e]) * i0 - f1[e]; }
          *(u32x4*)(AM + (size_t)t1 * DM + colB) = pack8(o1); *(u32x4*)(AM + (size_t)t0 * DM + colB) = pack8(o0); }
        row_rest(t0, rq[0], rx[0], iq[0], ik[0], iww[0], pos0);
        row_rest(t1, rq[1], rx[1], iq[1], ik[1], iww[1], pos1);
    }
    P0T1(4);
    { const float* KVM = wsp<float>(F, WS_KVMP); bf16_t* KMB = wsp<bf16_t>(F, WS_KMB); bf16_t* VMT = wsp<bf16_t>(F, WS_VMT);
      const float g0 = F.xk_norm_g[lane], g1 = F.xk_norm_g[lane + 64];
      for (int mm = gw; mm < MEML; mm += NGW) {
#pragma unroll
          for (int h = 0; h < 4; ++h) { float k0 = 0.f, k1 = 0.f;
#pragma unroll
              for (int ks = 0; ks < 8; ++ks) { k0 += KVM[(size_t)ks * 262144 + (size_t)mm * 1024 + h * 128 + lane]; k1 += KVM[(size_t)ks * 262144 + (size_t)mm * 1024 + h * 128 + lane + 64]; }
              const float ks2 = wave_sum(k0 * k0 + k1 * k1), kr = 1.0f / sqrtf(ks2 * (1.0f / 128.0f) + NORM_EPS);
              KMB[(size_t)mm * 512 + h * 128 + lane] = (bf16_t)f2bf(k0 * kr * g0); KMB[(size_t)mm * 512 + h * 128 + lane + 64] = (bf16_t)f2bf(k1 * kr * g1); }
#pragma unroll
          for (int j = 0; j < 8; ++j) { const int c = j * 64 + lane; float v = 0.f;
#pragma unroll
              for (int ks = 0; ks < 8; ++ks) v += KVM[(size_t)ks * 262144 + (size_t)mm * 1024 + 512 + c];
              VMT[(size_t)c * 256 + mm] = (bf16_t)f2bf(v); }
      } }
    P0T1(5);
}

constexpr int HS = 1025;
constexpr int P3_HIST = 0, P3_RING = 16 * HS * 4, P3_LMASK = P3_RING + 8 * 3 * 2048, P3_STATE = P3_LMASK + 16 * 256 * 4;
constexpr int P3_CAP = 384;
__device__ __forceinline__ float relu_s(float x) { const int b = __builtin_bit_cast(int, x); return __builtin_bit_cast(float, b > 0 ? b : 0); }
__device__ __forceinline__ void p3_scores(const bf16x8 A0, const bf16x8 A1, const bf16x8 (&Bq)[4][2], const float (&wq)[4], float (&sc)[4]) {
    f32x2_t s01 = {0.f, 0.f}, s23 = {0.f, 0.f};
#pragma unroll
    for (int h = 0; h < 4; ++h) { f32x4 d = (f32x4){0.f, 0.f, 0.f, 0.f};
        d = __builtin_amdgcn_mfma_f32_16x16x32_bf16(A0, Bq[h][0], d, 0, 0, 0); d = __builtin_amdgcn_mfma_f32_16x16x32_bf16(A1, Bq[h][1], d, 0, 0, 0);
        const f32x2_t w2 = {wq[h], wq[h]}, r01 = {relu_s(d[0]), relu_s(d[1])}, r23 = {relu_s(d[2]), relu_s(d[3])};
        s01 = __builtin_elementwise_fma(w2, r01, s01); s23 = __builtin_elementwise_fma(w2, r23, s23); }
    sc[0] = s01[0]; sc[1] = s01[1]; sc[2] = s23[0]; sc[3] = s23[1];
}
template <int MODE, bool ALLV> __device__ __forceinline__ void p3_update(LAS unsigned* hist, LAS unsigned* lmask, LAS unsigned* ccnt, const float (&sc)[4], unsigned vb,
                                                              int kt, int q, int fq, unsigned pref, unsigned thr, unsigned idxs, bool part) {
    const int s0 = 16 * kt;
    unsigned nib = 0u, cflag = 0u; unsigned ckey[4];
#pragma unroll
    for (int i = 0; i < 4; ++i) {
        const unsigned bits = __builtin_bit_cast(unsigned, sc[i]);
        const unsigned key = bits ^ ((unsigned)((int)bits >> 31) | 0x80000000u);
        const bool valid = ALLV ? true : (((vb >> i) & 1u) != 0u);
        const unsigned s = (unsigned)(s0 + 4 * fq + i);
        if constexpr (MODE == 0) { if (valid && part) { const unsigned dg = key >> 21; __hip_atomic_fetch_add(&hist[q * HS + (dg >> 1)], 1u << (16 * (dg & 1u)), __ATOMIC_RELAXED, __HIP_MEMORY_SCOPE_WORKGROUP); } }
        else if constexpr (MODE == 1) { if (valid && part && (key >> 21) == pref) { const unsigned dg = (key >> 10) & 2047u; __hip_atomic_fetch_add(&hist[q * HS + (dg >> 1)], 1u << (16 * (dg & 1u)), __ATOMIC_RELAXED, __HIP_MEMORY_SCOPE_WORKGROUP); } }
        else if constexpr (MODE == 2) { if (valid && part && (key >> 10) == pref) { const unsigned dg = key & 1023u; __hip_atomic_fetch_add(&hist[q * HS + (dg >> 1)], 1u << (16 * (dg & 1u)), __ATOMIC_RELAXED, __HIP_MEMORY_SCOPE_WORKGROUP); } }
        else if constexpr (MODE == 3) { if (valid && part && key == thr) { const unsigned dg = s >> 2; __hip_atomic_fetch_add(&hist[q * HS + (dg >> 1)], 1u << (16 * (dg & 1u)), __ATOMIC_RELAXED, __HIP_MEMORY_SCOPE_WORKGROUP); } }
        else if constexpr (MODE == 4) { if (valid && part && key == thr && (s >> 2) == pref) { const unsigned dg = s & 3u; __hip_atomic_fetch_add(&hist[q * HS + (dg >> 1)], 1u << (16 * (dg & 1u)), __ATOMIC_RELAXED, __HIP_MEMORY_SCOPE_WORKGROUP); } }
        else if constexpr (MODE == 5) { const bool sel = valid && (key > thr || (key == thr && s <= idxs)); nib |= sel ? (1u << i) : 0u; }
        else if constexpr (MODE == 10) {
            ckey[i] = key;
            const bool gt = key > idxs, ge = key >= thr;
            nib |= (valid && gt) ? (1u << i) : 0u; cflag |= (valid && ge && !gt) ? (1u << i) : 0u; }
        else {
            const unsigned m13 = (bits & 0x7fffffffu) >> 18; const unsigned cl = m13 < 3168u ? 3168u : (m13 > 4191u ? 4191u : m13);
            const unsigned dg = (cl - 2144u) ^ ((unsigned)((int)bits >> 31) & 2047u);
            if (valid) __hip_atomic_fetch_add(&hist[q * HS + (dg >> 1)], 1u << (16 * (dg & 1u)), __ATOMIC_RELAXED, __HIP_MEMORY_SCOPE_WORKGROUP); }
    }
    if constexpr (MODE == 10) {
        if (cflag) { __hip_atomic_fetch_or(&hist[q * HS + 768 + (kt >> 1)], cflag << (16 * (kt & 1) + 4 * fq), __ATOMIC_RELAXED, __HIP_MEMORY_SCOPE_WORKGROUP);
            if (part) { unsigned sl = __hip_atomic_fetch_add(&ccnt[q], (unsigned)__builtin_popcount(cflag), __ATOMIC_RELAXED, __HIP_MEMORY_SCOPE_WORKGROUP);
#pragma unroll
                for (int i = 0; i < 4; ++i) if ((cflag >> i) & 1u) { if (sl < (unsigned)P3_CAP) { hist[q * HS + 2 * sl] = ckey[i]; hist[q * HS + 2 * sl + 1] = (unsigned)(s0 + 4 * fq + i); } ++sl; } } }
    }
    if constexpr (MODE == 5 || MODE == 10) { if (nib) __hip_atomic_fetch_or(&lmask[q * 256 + (kt >> 1)], nib << (16 * (kt & 1) + 4 * fq), __ATOMIC_RELAXED, __HIP_MEMORY_SCOPE_WORKGROUP); }
}
__device__ __forceinline__ void p3_first(Frame& F, int b, bf16x8& c00, bf16x8& c01, bf16x8& c10, bf16x8& c11) {
    const char* KIBc = (const char*)wsp<bf16_t>(F, WS_KIB); const int q = F.lane & 15, fq = F.lane >> 4; const unsigned goff = (unsigned)(q * 128 + fq * 16);
    int k0 = F.wave, k1 = F.wave + 8; k0 = k0 < b ? k0 : b; k1 = k1 < b ? k1 : b;
    const char* s0 = KIBc + (size_t)k0 * 2048 + goff; const char* s1 = KIBc + (size_t)k1 * 2048 + goff;
    c00 = *(const bf16x8*)s0; c01 = *(const bf16x8*)(s0 + 64); c10 = *(const bf16x8*)s1; c11 = *(const bf16x8*)(s1 + 64);
}
template <int MODE, bool PRE = false> __device__ __forceinline__ void p3_sweep(Frame& F, int b, const bf16x8 (&Bq)[4][2], const float (&wq)[4], unsigned pref, unsigned thr, unsigned idxs, bool part, int dtype = 0,
                                                                        bf16x8 P00 = bf16x8{}, bf16x8 P01 = bf16x8{}, bf16x8 P10 = bf16x8{}, bf16x8 P11 = bf16x8{}) {
    if constexpr (MODE == 10) {
        const unsigned d = pref;
        thr = d == 0u ? 0u : (d <= 1023u ? 0x80000000u - ((4192u - d) << 18) : (d == 1024u ? 0x80000000u : (0x80000000u | ((d + 2144u) << 18))));
        const unsigned d1 = d + 1u;
        idxs = d == 2047u ? 0xffffffffu : ((d1 <= 1023u ? 0x80000000u - ((4192u - d1) << 18) : (d1 == 1024u ? 0x80000000u : (0x80000000u | ((d1 + 2144u) << 18)))) - 1u);
    }
    const char* KIBc = (const char*)wsp<bf16_t>(F, WS_KIB);
    LAS unsigned* hist = (LAS unsigned*)(F.lds + P3_HIST); LAS unsigned* lmask = (LAS unsigned*)(F.lds + P3_LMASK); LAS unsigned* ccnt = (LAS unsigned*)(F.lds + P3_STATE) + 80;
    const int lane = F.lane, q = lane & 15, fq = lane >> 4;
    const unsigned goff = (unsigned)(q * 128 + fq * 16);
    unsigned dbits = 0u;
#pragma unroll
    for (int i = 0; i < 4; ++i) dbits |= (4 * fq + i <= q) ? (1u << i) : 0u;
    const int nj = (b >= F.wave) ? ((b - F.wave) >> 3) + 1 : 0;
#define P3_LD(j, a0, a1) do { int _kt = F.wave + 8 * (j); _kt = _kt < b ? _kt : b; const char* _src = KIBc + (size_t)_kt * 2048 + goff; a0 = *(const bf16x8*)(_src); a1 = *(const bf16x8*)(_src + 64); } while (0)
    bf16x8 C00, C01, C10, C11;
    if constexpr (PRE) { C00 = P00; C01 = P01; C10 = P10; C11 = P11; } else { if (nj > 0) { P3_LD(0, C00, C01); P3_LD(1, C10, C11); } }
    for (int j = 0; j < nj; j += 2) {
        bf16x8 N00, N01, N10, N11;
        if (j + 2 < nj) { P3_LD(j + 2, N00, N01); P3_LD(j + 3, N10, N11); } else { N00 = C00; N01 = C01; N10 = C10; N11 = C11; }
        float sa[4], sb[4];
        p3_scores(C00, C01, Bq, wq, sa); p3_scores(C10, C11, Bq, wq, sb);
        const int kt0 = F.wave + 8 * j, kt1 = kt0 + 8;
        if (kt1 < b) {
            p3_update<MODE, true>(hist, lmask, ccnt, sa, 0xFu, kt0, q, fq, pref, thr, idxs, part);
            p3_update<MODE, true>(hist, lmask, ccnt, sb, 0xFu, kt1, q, fq, pref, thr, idxs, part);
        } else {
            p3_update<MODE, false>(hist, lmask, ccnt, sa, kt0 < b ? 0xFu : dbits, kt0, q, fq, pref, thr, idxs, part);
            if (kt1 == b) p3_update<MODE, false>(hist, lmask, ccnt, sb, dbits, kt1, q, fq, pref, thr, idxs, part);
        }
        C00 = N00; C01 = N01; C10 = N10; C11 = N11;
    }
#undef P3_LD
}
__device__ __forceinline__ void p3_scan(Frame& F, bool fromtop) {
    LAS unsigned* hist = (LAS unsigned*)(F.lds + P3_HIST); LAS unsigned* st = (LAS unsigned*)(F.lds + P3_STATE);
    __syncthreads();
    const int lane = F.lane;
#pragma unroll
    for (int rr = 0; rr < 2; ++rr) {
        const int row = 2 * F.wave + rr;
        if (st[row * 4 + 3] == 0u) continue;
        const unsigned rank = st[row * 4 + 1];
        unsigned wv[16]; unsigned sj = 0;
#pragma unroll
        for (int i = 0; i < 16; ++i) { wv[i] = hist[row * HS + 16 * lane + i]; sj += (wv[i] & 0xffffu) + (wv[i] >> 16); }
        unsigned P = sj;
#pragma unroll
        for (int o = 1; o < 64; o <<= 1) { const unsigned v = __shfl_up(P, o); if (lane >= o) P += v; }
        const unsigned T = __shfl(P, 63);
        unsigned cum = fromtop ? (T - P) : (P - sj);
        const bool cross = (cum < rank) && (rank <= cum + sj);
        unsigned bin = 0, cb = 0; bool found = false;
#pragma unroll
        for (int ii = 0; ii < 32; ++ii) { const int bl = fromtop ? 31 - ii : ii; const unsigned w = wv[bl >> 1]; const unsigned c = (bl & 1) ? (w >> 16) : (w & 0xffffu);
            const bool hit = !found && (cum + c >= rank);
            if (hit) { bin = (unsigned)(32 * lane + bl); cb = c; found = true; }
            if (!found) cum += c; }
        if (cross) { st[row * 4 + 0] = bin; st[row * 4 + 1] = rank - cum; st[row * 4 + 2] = cb; }
    }
    __syncthreads();
}
__device__ __forceinline__ unsigned wave_count(bool p) { return (unsigned)__builtin_popcountll(__ballot(p)); }
template <int NS> __device__ __forceinline__ void p3_select_core(LAS unsigned* cand, LAS unsigned* lmask, unsigned bin0, unsigned rank, unsigned nc, int lane) {
    unsigned ck[NS], ci[NS];
#pragma unroll
    for (int i = 0; i < NS; ++i) { ck[i] = 0u; ci[i] = 0x7fffffffu; const unsigned sl = (unsigned)(lane + 64 * i); if (sl < nc) { ck[i] = cand[2 * sl]; ci[i] = cand[2 * sl + 1]; } }
    const bool regular = bin0 != 0u && bin0 != 1023u && bin0 != 1024u && bin0 != 2047u;
    unsigned P = regular ? ((unsigned)__builtin_amdgcn_readfirstlane((int)ck[0]) & 0xfffc0000u) : 0u;
#pragma unroll 1
    for (int bit = regular ? 17 : 31; bit >= 0; --bit) { const unsigned trial = P | (1u << bit); unsigned c = 0;
#pragma unroll
        for (int i = 0; i < NS; ++i) c += wave_count(ck[i] >= trial);
        if (c >= rank) P = trial; }
    const unsigned thr = P; unsigned cg = 0, ce = 0;
#pragma unroll
    for (int i = 0; i < NS; ++i) { cg += wave_count(ck[i] > thr); ce += wave_count(ck[i] == thr && ci[i] != 0x7fffffffu); }
    const unsigned quota = rank - cg; unsigned idxs = 0x7fffffffu;
    if (ce > quota) {
        unsigned X = 0;
#pragma unroll 1
        for (int bit = 12; bit >= 0; --bit) { const unsigned trial = X | (1u << bit); unsigned c = 0;
#pragma unroll
            for (int i = 0; i < NS; ++i) c += wave_count(ck[i] == thr && ci[i] < trial);
            if (c < quota) X = trial; }
        idxs = X;
    }
#pragma unroll
    for (int i = 0; i < NS; ++i) { const bool sel = (ck[i] > thr) || (ck[i] == thr && ci[i] <= idxs);
        if (sel && ci[i] != 0x7fffffffu) __hip_atomic_fetch_or(&lmask[ci[i] >> 5], 1u << (ci[i] & 31u), __ATOMIC_RELAXED, __HIP_MEMORY_SCOPE_WORKGROUP); }
}
__device__ __forceinline__ void p3_select_row(Frame& F, int row, int shift) {
    LAS unsigned* cand = (LAS unsigned*)(F.lds + P3_HIST) + row * HS; LAS unsigned* lmask = (LAS unsigned*)(F.lds + P3_LMASK) + row * 256; LAS unsigned* st = (LAS unsigned*)(F.lds + P3_STATE);
    const unsigned bin0 = (unsigned)__builtin_amdgcn_readfirstlane((int)st[row * 4 + 0]), rank = (unsigned)__builtin_amdgcn_readfirstlane((int)st[row * 4 + 1]), nc = (unsigned)__builtin_amdgcn_readfirstlane((int)st[row * 4 + 2]);
    (void)shift;
    if (nc <= 64u) p3_select_core<1>(cand, lmask, bin0, rank, nc, F.lane);
    else if (nc <= 128u) p3_select_core<2>(cand, lmask, bin0, rank, nc, F.lane);
    else p3_select_core<6>(cand, lmask, bin0, rank, nc, F.lane);
}
__device__ __forceinline__ void p3_select_zero(Frame& F, int row) {
    LAS unsigned* zm = (LAS unsigned*)(F.lds + P3_HIST) + row * HS + 768; LAS unsigned* lmask = (LAS unsigned*)(F.lds + P3_LMASK) + row * 256; LAS unsigned* st = (LAS unsigned*)(F.lds + P3_STATE);
    const unsigned quota = st[row * 4 + 1]; const int lane = F.lane;
    unsigned w[4]; unsigned pc = 0;
#pragma unroll
    for (int i = 0; i < 4; ++i) { w[i] = zm[4 * lane + i]; pc += (unsigned)__builtin_popcount(w[i]); }
    unsigned P = pc;
#pragma unroll
    for (int o = 1; o < 64; o <<= 1) { const unsigned v = __shfl_up(P, o); if (lane >= o) P += v; }
    unsigned cum = P - pc;
#pragma unroll
    for (int i = 0; i < 4; ++i) { unsigned ww = w[i]; const unsigned c = (unsigned)__builtin_popcount(ww);
        if (cum >= quota) ww = 0u;
        else if (cum + c > quota) { const unsigned keep = quota - cum; while ((unsigned)__builtin_popcount(ww) > keep) ww &= ~(0x80000000u >> __builtin_clz(ww)); }
        cum += c;
        if (ww) __hip_atomic_fetch_or(&lmask[4 * lane + i], ww, __ATOMIC_RELAXED, __HIP_MEMORY_SCOPE_WORKGROUP); }
}
__device__ __forceinline__ void p3_zero_hist(Frame& F) {
    LAS unsigned* hist = (LAS unsigned*)(F.lds + P3_HIST);
    for (int i = F.tid; i < 16 * HS; i += NTHR) hist[i] = 0u;
}
#define P3T0() unsigned long long _pt = (P3_PROF && F.tid == 0) ? __builtin_amdgcn_s_memrealtime() : 0ull
#define P3T1(k) do { if (P3_PROF == (k) && F.tid == 0) { volatile LAS unsigned* _m = F.MISC + 16; const unsigned long long _d = __builtin_amdgcn_s_memrealtime() - _pt; _m[0] = _m[0] + (unsigned)_d; } } while (0)
__device__ __forceinline__ void p3_block(Frame& F0, int b) {
    Frame F = F0; asm volatile("" : "+v"(F.tid), "+v"(F.lane));
    const bf16_t* QIB = wsp<bf16_t>(F, WS_QIB); const float* WIF = wsp<float>(F, WS_WIF); unsigned* MASK = wsp<unsigned>(F, WS_MASK);
    LAS unsigned* st = (LAS unsigned*)(F.lds + P3_STATE); LAS unsigned* lmask = (LAS unsigned*)(F.lds + P3_LMASK);
    const int lane = F.lane, q = lane & 15, fq = lane >> 4, t0 = 16 * b;
    bf16x8 Bq[4][2]; float wq[4];
#pragma unroll
    for (int h = 0; h < 4; ++h) { Bq[h][0] = *(const bf16x8*)(QIB + (size_t)(t0 + q) * 256 + h * 64 + 8 * fq); Bq[h][1] = *(const bf16x8*)(QIB + (size_t)(t0 + q) * 256 + h * 64 + 32 + 8 * fq); wq[h] = WIF[(t0 + q) * 4 + h]; }
    bf16x8 f00, f01, f10, f11; p3_first(F, b, f00, f01, f10, f11);
    __syncthreads();
    for (int i = F.tid; i < 16 * 256; i += NTHR) lmask[i] = 0u;
    if (b >= 16) {
        const int dtype = 0;
        p3_zero_hist(F);
        if (F.tid < 16) { st[F.tid * 4 + 0] = 0u; st[F.tid * 4 + 1] = 256u; st[F.tid * 4 + 2] = 0u; st[F.tid * 4 + 3] = 1u; st[80 + F.tid] = 0u; }
        if (F.tid == 0) st[64] = 0u;
        if (fq == 0) st[96 + q] = (unsigned)dtype;
        __syncthreads();
        { P3T0(); p3_sweep<9, true>(F, b, Bq, wq, 0u, 0u, 0u, true, dtype, f00, f01, f10, f11); P3T1(1); P3T1(4); } { P3T0(); p3_scan(F, true); P3T1(2); }
        if (F.tid < 16) { const unsigned bn = st[F.tid * 4 + 0], cn = st[F.tid * 4 + 2]; const unsigned dt = 0u; (void)dt;
            const unsigned cls = (bn == 1024u) ? 1u : (cn <= (unsigned)P3_CAP ? 0u : 2u);
            st[112 + F.tid] = cls; if (cls == 2u) st[64] = 1u;
            if (P3_PROF >= 11 && cls == 2u) { const int cause = (dt == 1u) ? (bn == 0u ? 11 : 12) : (dt == 2u ? 13 : 14); if (cause == P3_PROF && b >= 128) atomicAdd(F.ctl + CW_QUEUE + 8, 1u); } }
        __syncthreads();
        const unsigned bin0 = st[q * 4 + 0];
        if (st[64] == 0u) {
            for (int i = F.tid; i < 16 * 256; i += NTHR) ((LAS unsigned*)(F.lds + P3_HIST))[(i >> 8) * HS + 768 + (i & 255)] = 0u;
            __syncthreads();
            { P3T0(); p3_sweep<10, true>(F, b, Bq, wq, bin0, 0u, 0u, st[112 + q] == 0u, dtype, f00, f01, f10, f11); P3T1(1); P3T1(5); }
            __syncthreads();
            { P3T0();
#pragma unroll 1
              for (int rr = 0; rr < 2; ++rr) { const int row = 2 * F.wave + rr; if (st[112 + row] == 0u) p3_select_row(F, row, st[96 + row] ? 20 : 21); else p3_select_zero(F, row); }
              __syncthreads(); P3T1(3); }
        } else {
            if (P3_PROF == 6 && F.tid == 0) atomicAdd(F.ctl + CW_QUEUE + 8, 1u);
            __syncthreads(); p3_zero_hist(F);
            if (F.tid < 16) { st[F.tid * 4 + 0] = 0u; st[F.tid * 4 + 1] = 256u; st[F.tid * 4 + 2] = 0u; st[F.tid * 4 + 3] = 1u; }
            __syncthreads();
            { P3T0(); p3_sweep<0>(F, b, Bq, wq, 0u, 0u, 0u, true); P3T1(1); } { P3T0(); p3_scan(F, true); P3T1(2); }
            unsigned pref = st[q * 4 + 0];
            __syncthreads(); p3_zero_hist(F); __syncthreads();
            { P3T0(); p3_sweep<1>(F, b, Bq, wq, pref, 0u, 0u, true); P3T1(1); } { P3T0(); p3_scan(F, true); P3T1(2); }
            pref = (pref << 11) | st[q * 4 + 0];
            __syncthreads(); p3_zero_hist(F); __syncthreads();
            { P3T0(); p3_sweep<2>(F, b, Bq, wq, pref, 0u, 0u, true); P3T1(1); } { P3T0(); p3_scan(F, true); P3T1(2); }
            const unsigned thr = (pref << 10) | st[q * 4 + 0];
            const unsigned quota = st[q * 4 + 1], cnteq = st[q * 4 + 2];
            const bool tie = cnteq > quota; unsigned idxs = 0x7fffffffu;
            __syncthreads();
            if (F.tid == 0) st[64] = 0u;
            __syncthreads();
            if (tie && fq == 0) st[64] = 1u;
            if (F.tid < 16) st[F.tid * 4 + 3] = (st[F.tid * 4 + 2] > st[F.tid * 4 + 1]) ? 1u : 0u;
            __syncthreads();
            if (st[64]) {
                p3_zero_hist(F); __syncthreads();
                { P3T0(); p3_sweep<3>(F, b, Bq, wq, 0u, thr, 0u, tie); P3T1(1); } { P3T0(); p3_scan(F, false); P3T1(2); }
                const unsigned ip = st[q * 4 + 0];
                __syncthreads(); p3_zero_hist(F); __syncthreads();
                { P3T0(); p3_sweep<4>(F, b, Bq, wq, ip, thr, 0u, tie); P3T1(1); } { P3T0(); p3_scan(F, false); P3T1(2); }
                if (tie) idxs = (ip << 2) | st[q * 4 + 0];
            }
            __syncthreads();
            { P3T0(); p3_sweep<5>(F, b, Bq, wq, 0u, thr, idxs, true); P3T1(1); }
        }
    } else {
        __syncthreads();
        { P3T0(); p3_sweep<5>(F, b, Bq, wq, 0u, 0u, 0x7fffffffu, true); P3T1(1); }
    }
    __syncthreads();
    { const int qb = t0 >> 8, lr0 = t0 & 255, nkt = 4 * (qb + 1), row = (F.tid >> 1) & 15, wl = F.tid & 1;
      for (int kt = F.tid >> 5; kt < nkt; kt += 16) MASK[((size_t)(qb * 128 + kt) * 256 + lr0 + row) * 2 + wl] = lmask[row * 256 + 2 * kt + wl]; }
}
constexpr int MC_I_GU = 16 * 2 * 32 * 8, MC_I_D = 16 * 8 * 32, MC_PAIRS = (MC_I_GU + MC_I_D) / 2, MC_PER_ENTRY = 16, MC_ENTRIES = MC_PAIRS / MC_PER_ENTRY;
__device__ __forceinline__ void moe_copy_item(Frame& F, int it, TrD& d) {
    bf16_t* WGUT = wsp<bf16_t>(F, WS_WGUT); bf16_t* WDT = wsp<bf16_t>(F, WS_WDT);
    d.nvalid = 64; d.dk0 = 0;
    if (it < MC_I_GU) { const int e = it / 512, r = it % 512, up = r / 256, r2 = r % 256, kb = r2 / 8, nb = r2 % 8, f0 = nb * 64;
        const int drow = (f0 / 128) * 256 + up * 128 + (f0 % 128);
        d.W = (up ? F.w_eu : F.w_eg) + (size_t)e * DM * 512; d.ldw = 512; d.k0 = kb * 64; d.n0 = f0; d.gain = F.g_ffn; d.dst = WGUT + ((size_t)e * 1024 + drow) * DM; d.ldd = DM; }
    else { const int r = it - MC_I_GU, e = r / 256, r2 = r % 256, kb = r2 / 32, nb = r2 % 32;
        d.W = F.w_ed + (size_t)e * 512 * DM; d.ldw = DM; d.k0 = kb * 64; d.n0 = nb * 64; d.gain = nullptr; d.dst = WDT + ((size_t)e * DM + nb * 64) * 512; d.ldd = 512; }
}
__device__ __forceinline__ void moe_copy_entry(Frame& F, int e) {
#pragma unroll 1
    for (int k = 0; k < 2; ++k) { const int p = e * MC_PER_ENTRY + 2 * F.wave + k; TrD d0, d1; moe_copy_item(F, 2 * p, d0); moe_copy_item(F, 2 * p + 1, d1); tr_pair<true>(d0, d1, F.lane); }
}
constexpr int LP_ENTRIES = 192 + 52;
__device__ __forceinline__ void late_prep_item(Frame& F, int r, TrD& d) {
    bf16_t* BTMRG = wsp<bf16_t>(F, WS_BTMRG); bf16_t* WOT = wsp<bf16_t>(F, WS_WOT);
    d.nvalid = 64; d.dk0 = 0; d.ldd = DM; d.ldw = DM; d.gain = nullptr;
    if (r < 1024) { const int kb = r / 32, nb = r % 32; d.W = F.w_o; d.k0 = kb * 64; d.n0 = nb * 64; d.dst = WOT + (size_t)(nb * 64) * DM; return; }
    r -= 1024;
    if (r < 384) { const int kb = r / 32, nb = r % 32; d.W = F.w_attn_out; d.k0 = kb * 64; d.n0 = nb * 64; d.dst = BTMRG + (size_t)(nb * 64) * DM; d.dk0 = 768; return; }
    r -= 384;
    { const int kb = r / 32, nb = r % 32; d.W = F.w_cross_out; d.k0 = kb * 64; d.n0 = nb * 64; d.dst = BTMRG + (size_t)(nb * 64) * DM; d.dk0 = 1536; }
}
__device__ __forceinline__ void late_prep_entry(Frame& F, int e) {
    if (e < 192) { wcomb_item(F, e * 8 + F.wave, wsp<bf16_t>(F, WS_BTMRG)); return; }
    const int t = e - 192;
#pragma unroll 1
    for (int k = 0; k < 2; ++k) { const int p = t * 16 + 2 * F.wave + k; TrD d0, d1; late_prep_item(F, 2 * p, d0); late_prep_item(F, 2 * p + 1, d1); tr_pair<false>(d0, d1, F.lane); }
}
constexpr int NSIDE = MC_ENTRIES + LP_ENTRIES;
__device__ __forceinline__ void side_entry(Frame& F, int s) { if (s < LP_ENTRIES) late_prep_entry(F, s); else moe_copy_entry(F, s - LP_ENTRIES); }
__device__ __forceinline__ void p3_indexer(Frame& F) {
    const unsigned long long t0 = (P3_PROF >= 7 && F.tid == 0) ? __builtin_amdgcn_s_memrealtime() : 0ull;
    LAS int* qs = (LAS int*)(F.lds + LDSCTL_OFF + 256);
    bool first = true;
    for (;;) {
        __syncthreads();
        if (F.tid == 0) qs[0] = first ? (int)blockIdx.x : F.G + (int)atomicAdd(F.ctl + CW_QUEUE + 1, 1u);
        first = false;
        __syncthreads();
        const int qi = qs[0];
        if (qi >= 512 + NSIDE) break;
        constexpr int QA = 300 + NSIDE;
        int cb = NSIDE;
        if (qi < QA) { cb = (qi * NSIDE) / QA; const int cb1 = ((qi + 1) * NSIDE) / QA; if (cb1 > cb) { side_entry(F, cb); continue; } }
        p3_block(F, 511 - (qi - cb));
    }
    __syncthreads();
    if (P3_PROF == 7 && F.tid == 0) atomicMax(F.ctl + CW_QUEUE + 8, (unsigned)(__builtin_amdgcn_s_memrealtime() - t0));
    if (P3_PROF == 8 && F.tid == 0) atomicMin(F.ctl + CW_QUEUE + 9, (unsigned)(__builtin_amdgcn_s_memrealtime() - t0));
}

constexpr int N_ATT_UNITS = 608;
constexpr size_t SLOT_FLOATS = 256 * 128 + 256;
__device__ __forceinline__ int cum_chunks(int qb) { const int n1 = qb, a = n1 >> 3, bb = n1 & 7; return 4 * a * (a + 1) + bb * (a + 1); }
constexpr int AT_K = 0, AT_V = 16384, AT_M = 32768, AT_STAGE = 34816, AT_EPI = 3 * AT_STAGE;
template <bool MASKED>
__device__ __forceinline__ void attn_unit(LAS unsigned char* lds, const bf16_t* Qh, int ldq, const bf16_t* Kh, int ldk, const bf16_t* Vth, int ldvt, const unsigned* maskt  ,
                                          int q0, int key0, int ntl, bool final, float* slot, bf16_t* outb  , int tid_in, int wave, int lane_in) {
    int tid = tid_in, lane = lane_in; asm volatile("" : "+v"(tid), "+v"(lane));
    const int q = lane & 31, hh = lane >> 5, qrow = q0 + 32 * wave + q;
    bf16x8 qf[8];
#pragma unroll
    for (int d0 = 0; d0 < 8; ++d0) qf[d0] = *(const bf16x8*)(Qh + (size_t)qrow * ldq + 16 * d0 + 8 * hh);
    const char* kbase = (const char*)(Kh + (size_t)key0 * ldk); const char* vbase = (const char*)(Vth + key0); const char* mbase = (const char*)(maskt + (size_t)(key0 >> 6) * 512);
    const unsigned ldsw16 = (unsigned)wave * 1024u, ldsw4 = (unsigned)wave * 256u;
#define AT_ISSUE(t, st) do { int _tid = tid; asm volatile("" : "+v"(_tid)); LAS unsigned char* _b = lds + (st) * AT_STAGE; const char* _kb = kbase + (size_t)(t) * 64 * ldk * 2; const char* _vb = vbase + (size_t)(t) * 128; \
        _Pragma("unroll") for (int _j = 0; _j < 2; ++_j) { const int _p = _tid + 512 * _j; const int _kr = _p >> 4, _kc = (_p & 15) ^ (_kr & 15); const int _vr = _p >> 3, _vc = (_p & 7) ^ ((_vr >> 1) & 7); \
            __builtin_amdgcn_global_load_lds((const unsigned*)(_kb + (unsigned)(_kr * ldk * 2 + _kc * 16)), (LAS unsigned*)(_b + AT_K + ldsw16 + _j * 8192), 16, 0, 0); \
            __builtin_amdgcn_global_load_lds((const unsigned*)(_vb + (unsigned)(_vr * ldvt * 2 + _vc * 16)), (LAS unsigned*)(_b + AT_V + ldsw16 + _j * 8192), 16, 0, 0); } \
        if (MASKED) __builtin_amdgcn_global_load_lds((const unsigned*)(mbase + (size_t)(t) * 2048 + (unsigned)_tid * 4u), (LAS unsigned*)(_b + AT_M + ldsw4), 4, 0, 0); } while (0)
    const int prow = (q & 0x13) | ((q & 4) << 1) | ((q & 8) >> 1);
    const int ky = hh ^ (prow & 15), vw = hh ^ ((q >> 1) & 7);
    int kaddr[8];
#pragma unroll
    for (int d0 = 0; d0 < 8; ++d0) kaddr[d0] = AT_K + prow * 256 + (((2 * d0) ^ ky) << 4);
    const int vrow = AT_V + q * 128;
#define vaddr_(s) (vrow + ((((2 * (s)) ^ vw)) << 4))
    const int maddr = AT_M + (32 * wave + q) * 8;
    f32x16 o[4];
#pragma unroll
    for (int d = 0; d < 4; ++d)
#pragma unroll
        for (int r = 0; r < 16; ++r) o[d][r] = 0.f;
    float l = 0.f;
#define AT_QK(S, SB, BT) do { _Pragma("unroll") for (int _r = 0; _r < 16; ++_r) S[_r] = 0.f; \
        _Pragma("unroll") for (int _d = 0; _d < 8; ++_d) { const bf16x8 _kf = *(const LAS bf16x8*)((SB) + kaddr[_d] + (BT) * 8192); S = __builtin_amdgcn_mfma_f32_32x32x16_bf16(_kf, qf[_d], S, 0, 0, 0); } } while (0)
#define AT_SM(S, MW) do { _Pragma("unroll") for (int _s = 0; _s < 2; ++_s) { float _p[8]; \
        _Pragma("unroll") for (int _j = 0; _j < 8; ++_j) { const int _r = 8 * _s + _j; float _e = __builtin_amdgcn_exp2f(S[_r]); if (MASKED) _e = __builtin_bit_cast(float, __builtin_bit_cast(unsigned, _e) & (unsigned)__builtin_amdgcn_sbfe((int)(MW), (unsigned)((_r & 7) + 16 * (_r >> 3)), 1u)); _p[_j] = _e; l += _e; } \
        u32x4 _w; _w.x = pk2(_p[0], _p[1]); _w.y = pk2(_p[2], _p[3]); _w.z = pk2(_p[4], _p[5]); _w.w = pk2(_p[6], _p[7]); pf[_s] = __builtin_bit_cast(bf16x8, _w); } } while (0)
#define AT_PV(SB, BT) do { _Pragma("unroll") for (int _d = 0; _d < 4; ++_d) _Pragma("unroll") for (int _s = 0; _s < 2; ++_s) { \
        const bf16x8 _vf = *(const LAS bf16x8*)((SB) + vaddr_(2 * (BT) + _s) + _d * 4096); o[_d] = __builtin_amdgcn_mfma_f32_32x32x16_bf16(_vf, pf[_s], o[_d], 0, 0, 0); } } while (0)
#define AT_MW(SB, BT) (MASKED ? (*(const LAS unsigned*)((SB) + maddr + (BT) * 4) >> (8 * hh)) : 0xffffffffu)
    AT_ISSUE(0, 0);
    if (ntl > 1) AT_ISSUE(1, 1);
    if (ntl > 1) { if (MASKED) asm volatile("s_waitcnt vmcnt(5)" ::: "memory"); else asm volatile("s_waitcnt vmcnt(4)" ::: "memory"); }
    else asm volatile("s_waitcnt vmcnt(0)" ::: "memory");
    __builtin_amdgcn_s_barrier(); asm volatile("" ::: "memory");
    f32x16 sc, sn; bf16x8 pf[2];
    AT_QK(sc, lds, 0);
#define AT_MID() do { __builtin_amdgcn_sched_barrier(0); if (t + 1 < ntl) asm volatile("s_waitcnt vmcnt(0)" ::: "memory"); __builtin_amdgcn_s_barrier(); asm volatile("" ::: "memory"); } while (0)
#define AT_LOOP(EARLY) do { int st = 0; \
    for (int t = 0; t < ntl; ++t) { \
        LAS unsigned char* sb = lds + st * AT_STAGE; \
        const int stn = (st == 2) ? 0 : st + 1; \
        LAS unsigned char* sbn = lds + stn * AT_STAGE; \
          \
        { const unsigned mw = AT_MW(sb, 0); \
          AT_QK(sn, sb, 1); AT_SM(sc, mw); } \
        if (EARLY) AT_MID(); \
        __builtin_amdgcn_sched_barrier(0); \
        AT_PV(sb, 0); \
        if (!(EARLY)) AT_MID(); \
        __builtin_amdgcn_sched_barrier(0); \
        if (t + 2 < ntl) { const int st2 = (st >= 1) ? st - 1 : 2; AT_ISSUE(t + 2, st2); } \
        __builtin_amdgcn_sched_barrier(0); \
          \
        { const unsigned mw = AT_MW(sb, 1); \
          if (t + 1 < ntl) { AT_QK(sc, sbn, 0); AT_SM(sn, mw); } else { AT_SM(sn, mw); } } \
        __builtin_amdgcn_sched_barrier(0); \
        AT_PV(sb, 1); \
        __builtin_amdgcn_sched_barrier(0); \
        st = stn; \
    } } while (0)
    if (__builtin_amdgcn_readfirstlane(wave) < 4) AT_LOOP(0); else AT_LOOP(1);
#undef AT_LOOP
#undef AT_MID
#undef vaddr_
#undef AT_QK
#undef AT_SM
#undef AT_PV
#undef AT_MW
#undef AT_ISSUE
    l += __shfl_xor(l, 32);
    int lane_e = lane; asm volatile("" : "+v"(lane_e));
    const int qe = lane_e & 31, he = lane_e >> 5;
    LAS float* stg = (LAS float*)(lds + AT_EPI + wave * 4608);
    const int trow = q0 + 32 * wave;
    const float inv = final ? 1.0f / l : 1.0f;
    const __amdgpu_buffer_rsrc_t srs = __builtin_amdgcn_make_buffer_rsrc((void*)slot, 0, (int)(SLOT_FLOATS * 4), 0x00020000);
#pragma unroll
    for (int d = 0; d < 4; ++d) {
#pragma unroll
        for (int r = 0; r < 16; ++r) stg[qe * 36 + crow(r, he)] = o[d][r] * inv;
        LDS_WAIT(); asm volatile("" ::: "memory");
#pragma unroll
        for (int i = 0; i < 4; ++i) { const int row = 8 * i + (lane_e >> 3), c4 = lane_e & 7; const f32x4 v = *(const LAS f32x4*)(stg + row * 36 + 4 * c4);
            if (final) { u32x2 w; w.x = pk2(v[0], v[1]); w.y = pk2(v[2], v[3]); *(u32x2*)(outb + (size_t)(trow + row) * DM + 32 * d + 4 * c4) = w; }
            else __builtin_amdgcn_raw_buffer_store_b128(__builtin_bit_cast(u32x4, v), srs, (int)(((unsigned)(32 * wave + row) * 128u + (unsigned)(32 * d + 4 * c4)) * 4u), 0, 16); }
        LDS_WAIT(); asm volatile("" ::: "memory");
    }
    if (!final && he == 0) __builtin_amdgcn_raw_buffer_store_b32(__builtin_bit_cast(unsigned, l), srs, (int)((unsigned)(256 * 128 + 32 * wave + qe) * 4u), 0, 16);
}
__device__ __forceinline__ void att_build_table(Frame& F) {
    LAS int* cnt = (LAS int*)F.lds; int* TB = wsp<int>(F, WS_ATTBL);
    if (F.tid < 40) cnt[F.tid] = 0;
    __syncthreads();
    int e0[2], e1[2], nl[2];
#pragma unroll
    for (int r = 0; r < 2; ++r) { const int id = F.tid + 512 * r; nl[r] = 0; e0[r] = 0; e1[r] = 0;
        if (id < 768) { const int h = id >> 7, n = ((id >> 2) & 31) + 1, ch = id & 3, k = (n + 7) >> 3;
            if (ch < k) { const int nt = 4 * n, base = nt / k, rem = nt % k; const int len = base + (ch < rem ? 1 : 0), start = ch * base + (ch < rem ? ch : rem);
                const int qb = n - 1; nl[r] = len; e0[r] = 0 | (h << 1) | (qb << 4) | ((k == 1 ? 1 : 0) << 9) | (len << 10); e1[r] = start | ((h * 80 + cum_chunks(qb) + ch) << 8); } }
        else if (id < 896) { const int c = id - 768; nl[r] = 4; e0[r] = 1 | ((c >> 5) << 1) | ((c & 31) << 4) | (1 << 9) | (4 << 10); e1[r] = 0; }
        if (nl[r]) __hip_atomic_fetch_add(&cnt[nl[r]], 1, __ATOMIC_RELAXED, __HIP_MEMORY_SCOPE_WORKGROUP); }
    __syncthreads();
    if (F.tid == 0) { int o = 0; for (int l = 32; l >= 1; --l) { const int c = cnt[l]; cnt[l] = o; o += c; } }
    __syncthreads();
#pragma unroll
    for (int r = 0; r < 2; ++r) if (nl[r]) { const int pos = __hip_atomic_fetch_add(&cnt[nl[r]], 1, __ATOMIC_RELAXED, __HIP_MEMORY_SCOPE_WORKGROUP); TB[2 * pos] = e0[r]; TB[2 * pos + 1] = e1[r]; }
    __syncthreads();
}
__device__ __forceinline__ void p4_attention(Frame& F) {
    const bf16_t* Q = wsp<bf16_t>(F, WS_Q); const bf16_t* K = wsp<bf16_t>(F, WS_K); const bf16_t* VT = wsp<bf16_t>(F, WS_VT); const bf16_t* XQ = wsp<bf16_t>(F, WS_XQ);
    const bf16_t* KMB = wsp<bf16_t>(F, WS_KMB); const bf16_t* VMT = wsp<bf16_t>(F, WS_VMT); const unsigned* MASK = wsp<unsigned>(F, WS_MASK); bf16_t* AM = wsp<bf16_t>(F, WS_AMRG);
    float* OPS = F.out;
    LAS int* qslot = (LAS int*)(F.lds + LDSCTL_OFF + 256);
    LAS unsigned* tbl = (LAS unsigned*)(F.lds + AT_EPI + 8 * 4608);
    { const int* TB = wsp<int>(F, WS_ATTBL); for (int i = F.tid; i < N_ATT_UNITS; i += NTHR) { const int e0 = TB[2 * i], e1 = TB[2 * i + 1]; tbl[i] = (unsigned)(e0 & 0xffff) | ((unsigned)(e1 & 127) << 16) | ((unsigned)(e1 >> 8) << 23); } }
    static_assert(AT_EPI + 8 * 4608 + N_ATT_UNITS * 4 <= LDSCTL_OFF, "attention table copy fits below the control block");
    bool first = true;
    for (;;) {
        __syncthreads();
        if (F.tid == 0) qslot[0] = first ? (int)blockIdx.x : F.G + (int)atomicAdd(F.ctl + CW_QUEUE, 1u);
        first = false;
        __syncthreads();
        const int qi = qslot[0];
        if (qi >= N_ATT_UNITS) break;
        const int idx = qi;
        const unsigned pk = tbl[idx];
        const int e0 = (int)(pk & 0xffffu);
        const int type = e0 & 1, h = (e0 >> 1) & 7, qb = (e0 >> 4) & 31, fin = (e0 >> 9) & 1, ntl = (e0 >> 10) & 63, kt0 = (int)((pk >> 16) & 127u), slot = (int)(pk >> 23);
        if (type == 0) { attn_unit<true>(F.lds, Q + h * 128, 768, K + h * 128, 768, VT + (size_t)h * 128 * SEQ, SEQ, MASK + (size_t)qb * 128 * 512, qb * 256, kt0 * 64, ntl, fin != 0,
                                       OPS + (size_t)slot * SLOT_FLOATS, AM + 768 + h * 128, F.tid, F.wave, F.lane);
            if (!fin) {
                const int nch = (qb + 8) >> 3;
                asm volatile("s_waitcnt vmcnt(0)" ::: "memory");
                __syncthreads();
                if (F.tid == 0) { const unsigned old = __hip_atomic_fetch_add(F.ctl + CW_GRP + h * 32 + qb, 1u, __ATOMIC_RELAXED, __HIP_MEMORY_SCOPE_AGENT);
                    const int last = (old + 1u == (unsigned)nch) ? 1 : 0; qslot[1] = last;
                    if (last) { __builtin_amdgcn_fence(__ATOMIC_ACQUIRE, "agent"); asm volatile("s_waitcnt vmcnt(0)" ::: "memory"); } }
                __syncthreads();
                if (qslot[1]) {
                    const float* base = OPS + (size_t)(h * 80 + cum_chunks(qb)) * SLOT_FLOATS; const int half = F.lane >> 5, c4 = F.lane & 31;
#pragma unroll 1
                    for (int i0 = 0; i0 < 16; i0 += 4) {
                        f32x4 v[4][4]; float lv[4][4];
#pragma unroll
                        for (int j = 0; j < 4; ++j) { const int row = 32 * F.wave + 2 * (i0 + j) + half;
#pragma unroll
                            for (int c = 0; c < 4; ++c) { const bool ok = c < nch; const float* b = base + (size_t)(ok ? c : 0) * SLOT_FLOATS; v[j][c] = *(const f32x4*)(b + (size_t)row * 128 + 4 * c4); lv[j][c] = b[256 * 128 + row];
                                if (!ok) { v[j][c] = (f32x4){0.f, 0.f, 0.f, 0.f}; lv[j][c] = 0.f; } } }
#pragma unroll
                        for (int j = 0; j < 4; ++j) { const int row = 32 * F.wave + 2 * (i0 + j) + half;
                            const f32x4 sv = (v[j][0] + v[j][1]) + (v[j][2] + v[j][3]); const float inv = 1.0f / ((lv[j][0] + lv[j][1]) + (lv[j][2] + lv[j][3]));
                            u32x2 w; w.x = pk2(sv[0] * inv, sv[1] * inv); w.y = pk2(sv[2] * inv, sv[3] * inv);
                            *(u32x2*)(AM + (size_t)(qb * 256 + row) * DM + 768 + h * 128 + 4 * c4) = w; } }
                } } }
        else attn_unit<false>(F.lds, XQ + h * 128, 512, KMB + h * 128, 512, VMT + (size_t)h * 128 * 256, 256, nullptr, qb * 256, 0, 4, true, nullptr, AM + 1536 + h * 128, F.tid, F.wave, F.lane);
    }
}
__device__ __forceinline__ void p5_finalize(Frame& F) {
    const float* OPS = F.out; bf16_t* AM = wsp<bf16_t>(F, WS_AMRG);
    const int gw = F.vcu * NWAVES + F.wave, NGW = F.G * NWAVES, lane = F.lane, half = lane >> 5, c4 = lane & 31;
    for (int it = gw; it < 6 * 24 * 128; it += NGW) {
        const int rp = it & 127, hq = it >> 7, h = hq / 24, qb = 8 + hq % 24, row = 2 * rp + half;
        const int nch = (qb + 8) >> 3;
        const float* base = OPS + (size_t)(h * 80 + cum_chunks(qb)) * SLOT_FLOATS;
        f32x4 v[4]; float lv[4];
#pragma unroll
        for (int c = 0; c < 4; ++c) { const bool ok = c < nch; const float* b = base + (size_t)(ok ? c : 0) * SLOT_FLOATS; v[c] = *(const f32x4*)(b + (size_t)row * 128 + 4 * c4); lv[c] = b[256 * 128 + row];
            if (!ok) { v[c] = (f32x4){0.f, 0.f, 0.f, 0.f}; lv[c] = 0.f; } }
        const f32x4 sv = (v[0] + v[1]) + (v[2] + v[3]); const float inv = 1.0f / ((lv[0] + lv[1]) + (lv[2] + lv[3]));
        u32x2 w; w.x = pk2(sv[0] * inv, sv[1] * inv); w.y = pk2(sv[2] * inv, sv[3] * inv);
        *(u32x2*)(AM + (size_t)(qb * 256 + row) * DM + 768 + h * 128 + 4 * c4) = w;
    }
}

struct SchedTile {
    int c, G, nM, nN; const char* A; const char* B; size_t tA, tB;
    __device__ __forceinline__ bool next(int i, pg8::Unit& u) const {
        const int L = i * G + c; if (L >= nM * nN) return false; int pm, pn; pg8::tile_order(L, nM, nN, pm, pn);
        u.A = A + (size_t)pm * tA; u.B = B + (size_t)pn * tB; u.Bhi = u.B; u.kind = 0; u.row0 = pm * 256; u.col0 = pn * 256; u.aux = 0; u.nt = 32; u.lowonly = 0; return true; }
};
struct EpiMrg {
    static constexpr bool HOOK = true; static constexpr int HOOK_T1 = 12, HOOK_T2 = 24;
    const bf16_t* EG; bf16_t* MRG;
    __device__ __forceinline__ void hook(f32x4 (&acc)[2][2][4][2], const pg8::Unit& u, int t, int wr, int wc, int fr, int fq) const {
        const int seg = (t == HOOK_T1) ? 0 : 1;
        const unsigned off0 = ((unsigned)(u.row0 + wr * 64 + fr) * 6144u + (unsigned)(u.col0 + wc * 32 + 8 * fq)) * 2u;
        const __amdgpu_buffer_rsrc_t rsrc = __builtin_amdgcn_make_buffer_rsrc((void*)EG, 0, (int)((size_t)SEQ * 6144 * 2), 0x00020000);
        const int oden = seg * 4096, onum = oden + 4096;
        constexpr int DEPTH = 3;
        u32x4 ea[8][2], eb[8][2];
#define MRG_LD(g_) do { const int so_ = ((((g_) >> 2) * 128 + ((g_) & 3) * 16) * 6144) * 2;     \
        _Pragma("unroll") for (int bj = 0; bj < 2; ++bj) { \
            ea[g_][bj] = __builtin_amdgcn_raw_buffer_load_b128(rsrc, (int)off0 + bj * 256, oden + so_, 0); eb[g_][bj] = __builtin_amdgcn_raw_buffer_load_b128(rsrc, (int)off0 + bj * 256, onum + so_, 0); } } while (0)
#pragma unroll
        for (int g = 0; g < DEPTH; ++g) MRG_LD(g);
#pragma unroll
        for (int g = 0; g < 8; ++g) {
            if (g + DEPTH < 8) MRG_LD(g + DEPTH);
            asm volatile("" ::: "memory");
            const int ai = g >> 2, m = g & 3;
#pragma unroll
            for (int bj = 0; bj < 2; ++bj) { const u32x4 a_ = ea[g][bj], b_ = eb[g][bj];
                f32x4 r0, r1;
                r0[0] = bflo(b_.x) * __builtin_amdgcn_rcpf(bflo(a_.x)); r0[1] = bfhi(b_.x) * __builtin_amdgcn_rcpf(bfhi(a_.x)); r0[2] = bflo(b_.y) * __builtin_amdgcn_rcpf(bflo(a_.y)); r0[3] = bfhi(b_.y) * __builtin_amdgcn_rcpf(bfhi(a_.y));
                r1[0] = bflo(b_.z) * __builtin_amdgcn_rcpf(bflo(a_.z)); r1[1] = bfhi(b_.z) * __builtin_amdgcn_rcpf(bfhi(a_.z)); r1[2] = bflo(b_.w) * __builtin_amdgcn_rcpf(bflo(a_.w)); r1[3] = bfhi(b_.w) * __builtin_amdgcn_rcpf(bfhi(a_.w));
                acc[ai][bj][m][0] *= r0; acc[ai][bj][m][1] *= r1; }
        }
#undef MRG_LD
    }
    __device__ __forceinline__ void operator()(const f32x4 (&acc)[2][2][4][2], const pg8::Unit& u, int wr, int wc, int fr, int fq) const {
        const int rbase = u.row0 + wr * 64 + fr, cbase = u.col0 + wc * 32 + 8 * fq;
#pragma unroll
        for (int ai = 0; ai < 2; ++ai)
#pragma unroll
            for (int m = 0; m < 4; ++m) { const int row = rbase + ai * 128 + m * 16;
#pragma unroll
                for (int bj = 0; bj < 2; ++bj) { const u32x4 e = *(const u32x4*)(EG + (size_t)row * 6144 + 4096 + cbase + bj * 128);
                    const f32x4 a0 = acc[ai][bj][m][0], a1 = acc[ai][bj][m][1];
                    u32x4 w;
                    w.x = pk2(a0[0] * __builtin_amdgcn_rcpf(bflo(e.x)), a0[1] * __builtin_amdgcn_rcpf(bfhi(e.x))); w.y = pk2(a0[2] * __builtin_amdgcn_rcpf(bflo(e.y)), a0[3] * __builtin_amdgcn_rcpf(bfhi(e.y)));
                    w.z = pk2(a1[0] * __builtin_amdgcn_rcpf(bflo(e.z)), a1[1] * __builtin_amdgcn_rcpf(bfhi(e.z))); w.w = pk2(a1[2] * __builtin_amdgcn_rcpf(bflo(e.w)), a1[3] * __builtin_amdgcn_rcpf(bfhi(e.w)));
                    *(u32x4*)(MRG + (size_t)row * DM + cbase + bj * 128) = w; } }
    }
};
struct EpiRes {
    static constexpr bool HOOK = false; static constexpr int HOOK_T1 = -1, HOOK_T2 = -1;
    const float* x; float* out; bf16_t* X1B;
    __device__ __forceinline__ void hook(f32x4 (&)[2][2][4][2], const pg8::Unit&, int, int, int, int, int) const {}
    __device__ __forceinline__ void operator()(const f32x4 (&acc)[2][2][4][2], const pg8::Unit& u, int wr, int wc, int fr, int fq) const {
        const int rbase = u.row0 + wr * 64 + fr, cbase = u.col0 + wc * 32 + 8 * fq;
#pragma unroll
        for (int ai = 0; ai < 2; ++ai)
#pragma unroll
            for (int m = 0; m < 4; ++m) { const int row = rbase + ai * 128 + m * 16;
#pragma unroll
                for (int bj = 0; bj < 2; ++bj) { const size_t off = (size_t)row * DM + cbase + bj * 128;
                    const f32x4 v0 = __builtin_nontemporal_load((const f32x4*)(x + off)) + acc[ai][bj][m][0], v1 = __builtin_nontemporal_load((const f32x4*)(x + off + 4)) + acc[ai][bj][m][1];
                    u32x4 w; w.x = pk2(v0[0], v0[1]); w.y = pk2(v0[2], v0[3]); w.z = pk2(v1[0], v1[1]); w.w = pk2(v1[2], v1[3]);
                    *(u32x4*)(X1B + off) = w; } }
    }
};

__device__ __forceinline__ void p8_router(Frame& F) {
    const bf16_t* X1 = wsp<bf16_t>(F, WS_X1B); const float* WR = wsp<float>(F, WS_WR);
    float* RSTD2 = wsp<float>(F, WS_RSTD2); int* TOKCLS = wsp<int>(F, WS_TOKCLS); int* TOKSLOT = wsp<int>(F, WS_TOKSLOT); float* TOKWA = wsp<float>(F, WS_TOKWA); float* TOKWB = wsp<float>(F, WS_TOKWB);
    LAS float* red = (LAS float*)F.lds;
    LAS float* lg = (LAS float*)(F.lds + 8 * 32 * 33 * 4);
    LAS float* ssq = (LAS float*)(F.lds + 9 * 32 * 33 * 4);
    LAS int* lcnt = (LAS int*)(F.lds + 9 * 32 * 33 * 4 + 1024); int* CNT = wsp<int>(F, WS_CNT);
    const int lane = F.lane, i = lane & 31, hh = lane >> 5, w = F.wave;
    for (int u = F.vcu; u < SEQ / 32; u += F.G) {
        const int t0 = 32 * u;
        f32x16 d;
#pragma unroll
        for (int r = 0; r < 16; ++r) d[r] = 0.f;
        float ss = 0.f;
        const bf16_t* xp = X1 + (size_t)(t0 + i) * DM + 256 * w + 8 * hh; const bf16_t* wp = wsp<bf16_t>(F, WS_WRS) + ((size_t)(16 * w) * 64 + lane) * 8;
#pragma unroll 1
        for (int m0 = 0; m0 < 16; m0 += 8) {
            bf16x8 a[8], b0[8], b1[8], b2[8];
#pragma unroll
            for (int mm = 0; mm < 8; ++mm) { a[mm] = *(const bf16x8*)(xp + 16 * (m0 + mm));
                b0[mm] = *(const bf16x8*)(wp + (size_t)(m0 + mm) * 512); b1[mm] = *(const bf16x8*)(wp + (size_t)(128 + m0 + mm) * 512); b2[mm] = *(const bf16x8*)(wp + (size_t)(256 + m0 + mm) * 512); }
#pragma unroll
            for (int mm = 0; mm < 8; ++mm) { const u32x4 aw = __builtin_bit_cast(u32x4, a[mm]);
#pragma unroll
                for (int e = 0; e < 4; ++e) { const float lo = __builtin_bit_cast(float, aw[e] << 16), hi = __builtin_bit_cast(float, aw[e] & 0xffff0000u); ss += lo * lo + hi * hi; }
                d = __builtin_amdgcn_mfma_f32_32x32x16_bf16(a[mm], b0[mm], d, 0, 0, 0); d = __builtin_amdgcn_mfma_f32_32x32x16_bf16(a[mm], b1[mm], d, 0, 0, 0); d = __builtin_amdgcn_mfma_f32_32x32x16_bf16(a[mm], b2[mm], d, 0, 0, 0); }
        }
        ss += __shfl_xor(ss, 32);
        __syncthreads();
#pragma unroll
        for (int r = 0; r < 16; ++r) red[(w * 32 + crow(r, hh)) * 33 + i] = d[r];
        if (hh == 0) ssq[w * 32 + i] = ss;
        if (F.tid < 24) lcnt[F.tid] = 0;
        __syncthreads();
        for (int e = F.tid; e < 1024; e += NTHR) { const int tk = e >> 5, j = e & 31; float s = 0.f;
#pragma unroll
            for (int ww = 0; ww < 8; ++ww) s += red[(ww * 32 + tk) * 33 + j];
            lg[tk * 33 + j] = s; }
        __syncthreads();
        if (F.tid < 32) { const int tk = F.tid; float s2 = 0.f;
#pragma unroll
            for (int ww = 0; ww < 8; ++ww) s2 += ssq[ww * 32 + tk];
            const float rstd = 1.0f / sqrtf(s2 * (1.0f / DM) + NORM_EPS);
            float g[4]; int gt = 0;
#pragma unroll
            for (int j = 0; j < 4; ++j) g[j] = lg[tk * 33 + j] * rstd;
#pragma unroll
            for (int j = 1; j < 4; ++j) if (g[j] > g[gt]) gt = j;
            float den = 0.f;
#pragma unroll
            for (int j = 0; j < 4; ++j) den += expf(g[j] - g[gt]);
            const float pg = 1.0f / den;
            float le[4];
#pragma unroll
            for (int j = 0; j < 4; ++j) le[j] = lg[tk * 33 + 4 + gt * 4 + j] * rstd;
            int e1 = 0;
#pragma unroll
            for (int j = 1; j < 4; ++j) if (le[j] > le[e1]) e1 = j;
            int e2 = (e1 == 0) ? 1 : 0;
#pragma unroll
            for (int j = 0; j < 4; ++j) if (j != e1 && j != e2 && le[j] > le[e2]) e2 = j;
            const float x2 = expf(le[e2] - le[e1]);
            const float w1 = pg / (1.0f + x2), w2 = pg * x2 / (1.0f + x2);
            const int a = e1 < e2 ? e1 : e2, bb = e1 < e2 ? e2 : e1;
            const float wa = e1 < e2 ? w1 : w2, wb = e1 < e2 ? w2 : w1;
            const int pair = (a == 0) ? (bb - 1) : (a == 1 ? bb + 1 : 5);
            const int cls = gt * 6 + pair;
            const int slot = __hip_atomic_fetch_add(&lcnt[cls], 1, __ATOMIC_RELAXED, __HIP_MEMORY_SCOPE_WORKGROUP);
            const int t = t0 + tk;
            RSTD2[t] = rstd; TOKCLS[t] = cls; TOKSLOT[t] = slot; TOKWA[t] = wa; TOKWB[t] = wb;
        }
        __syncthreads();
        if (F.tid < 24) CNT[u * 24 + F.tid] = lcnt[F.tid];
    }
    __syncthreads();
}
__device__ __forceinline__ int moe_tables(Frame& F, LAS int* tb) {
    __syncthreads();
    if (F.tid == 0) { int o = 0;
        for (int c = 0; c < 24; ++c) { const int n = (int)__hip_atomic_load(F.ctl + CW_CLS + c, __ATOMIC_RELAXED, __HIP_MEMORY_SCOPE_AGENT); tb[c] = o; tb[64 + c] = n; const int nt = (n + 255) >> 8;
            for (int j = 0; j < nt; ++j) { tb[128 + (o >> 8) + j] = c; tb[192 + (o >> 8) + j] = (n - 256 * j <= 128) ? 1 : 0; } o += nt << 8; }
        tb[24] = o; const int ntl = o >> 8; int k = 0;
        for (int j = 0; j < ntl; ++j) if (!tb[192 + j]) tb[256 + k++] = j;
        for (int j = 0; j < ntl; ++j) if (tb[192 + j]) tb[256 + k++] = j; }
    __syncthreads();
    return tb[24] >> 8;
}
__device__ __forceinline__ void p8b_gather(Frame& F) {
    LAS int* tb = (LAS int*)(F.lds + LDSCTL_OFF + 512);
    LAS int* cn = (LAS int*)F.lds;
    LAS int* psum = (LAS int*)(F.lds + 32768);
    LAS int* tot = (LAS int*)(F.lds + 32768 + 2048);
    const int* CNT = wsp<int>(F, WS_CNT);
    const int tk = (F.vcu * NWAVES + F.wave) * 64 + F.lane; int tcl = 0, tsl = 0; float trs = 0.f, twa = 0.f, twb = 0.f;
    if (tk < SEQ) { tcl = wsp<int>(F, WS_TOKCLS)[tk]; tsl = wsp<int>(F, WS_TOKSLOT)[tk]; trs = wsp<float>(F, WS_RSTD2)[tk]; twa = wsp<float>(F, WS_TOKWA)[tk]; twb = wsp<float>(F, WS_TOKWB)[tk]; }
    __syncthreads();
    for (int i = F.tid; i < 256 * 24; i += NTHR) cn[i] = CNT[i];
    __syncthreads();
    const int c = F.tid >> 4, part = F.tid & 15;
    if (F.tid < 384) { int sm = 0;
#pragma unroll
        for (int j = 0; j < 16; ++j) sm += cn[(part * 16 + j) * 24 + c];
        psum[c * 16 + part] = sm; }
    __syncthreads();
    if (F.tid < 24) { int run = 0;
        for (int j = 0; j < 16; ++j) { const int v = psum[F.tid * 16 + j]; psum[F.tid * 16 + j] = run; run += v; }
        tot[F.tid] = run; }
    __syncthreads();
    if (F.tid < 384) { int run = psum[c * 16 + part];
#pragma unroll
        for (int j = 0; j < 16; ++j) { const int idx = (part * 16 + j) * 24 + c; const int v = cn[idx]; cn[idx] = run; run += v; } }
    if (F.tid == 0) { int o = 0;
        for (int cc = 0; cc < 24; ++cc) { const int n = tot[cc]; tb[cc] = o; tb[64 + cc] = n; o += ((n + 255) >> 8) << 8; }
        tb[24] = o; }
    if (blockIdx.x == 0 && F.tid < 24) __hip_atomic_store(F.ctl + CW_CLS + F.tid, (unsigned)tot[F.tid], __ATOMIC_RELAXED, __HIP_MEMORY_SCOPE_AGENT);
    __syncthreads();
    const float* RSTD2 = wsp<float>(F, WS_RSTD2); const int* TOKCLS = wsp<int>(F, WS_TOKCLS); const int* TOKSLOT = wsp<int>(F, WS_TOKSLOT); const float* TOKWA = wsp<float>(F, WS_TOKWA); const float* TOKWB = wsp<float>(F, WS_TOKWB);
    int* ROWTOK = wsp<int>(F, WS_ROWTOK); float* ROWRS = wsp<float>(F, WS_ROWRS); float* ROWWA = wsp<float>(F, WS_ROWWA); float* ROWWB = wsp<float>(F, WS_ROWWB);
    const int gw = F.vcu * NWAVES + F.wave, NGW = F.G * NWAVES, lane = F.lane;
    static_assert(SEQ <= 64 * 8 * 16, "one token per lane of the first SEQ / 64 waves");
    if (tk < SEQ) { const int R = tb[tcl] + cn[(tk >> 5) * 24 + tcl] + tsl; ROWTOK[R] = tk; ROWRS[R] = trs; ROWWA[R] = twa; ROWWB[R] = twb; }
    for (int i = F.vcu * NTHR + F.tid; i < 24 * 256; i += F.G * NTHR) { const int cc = i >> 8, j = i & 255; const int n = tb[64 + cc], R = tb[cc] + n + j;
        const int endc = tb[cc] + (((n + 255) >> 8) << 8);
        if (R < endc) { ROWTOK[R] = -1; ROWRS[R] = 0.f; ROWWA[R] = 0.f; ROWWB[R] = 0.f; } }
}
__device__ __forceinline__ void cls_experts(int cls, int& ea, int& eb) { const int g = cls / 6, p = cls % 6; const int a = (p < 3) ? 0 : (p < 5 ? 1 : 2); const int b = (p < 3) ? p + 1 : (p < 5 ? p - 1 : 3); ea = g * 4 + a; eb = g * 4 + b; }
struct EpiGU {
    static constexpr bool HOOK = false; static constexpr int HOOK_T1 = -1, HOOK_T2 = -1;
    unsigned char* ws; const LAS float* ldsrw;
    __device__ __forceinline__ void hook(f32x4 (&)[2][2][4][2], const pg8::Unit&, int, int, int, int, int) const {}
    __device__ __forceinline__ void operator()(const f32x4 (&acc)[2][2][4][2], const pg8::Unit& u, int wr, int wc, int fr, int fq) const {
        const __amdgpu_buffer_rsrc_t rsrc = __builtin_amdgcn_make_buffer_rsrc(ws + WS_ACT, 0, (int)(MAXROWS * 1024 * 2), 0x00020000);
        const int pn = u.col0; const int cbase = (pn >> 2) * 512 + (pn & 3) * 128 + wc * 32 + 8 * fq;
#pragma unroll
        for (int ai = 0; ai < 2; ++ai)
#pragma unroll
            for (int m = 0; m < 4; ++m) { const int row = u.row0 + ai * 128 + wr * 64 + m * 16 + fr; const float s = ldsrw[row - u.row0], w = ldsrw[256 + row - u.row0];
                float a[8];
#pragma unroll
                for (int n = 0; n < 2; ++n)
#pragma unroll
                    for (int e = 0; e < 4; ++e) { const float gv = acc[ai][0][m][n][e] * s, uv = acc[ai][1][m][n][e] * s;
                        a[4 * n + e] = gv * __builtin_amdgcn_rcpf(1.0f + __builtin_amdgcn_exp2f(-gv * LOG2E)) * uv * w; }
                u32x4 o; o.x = pk2(a[0], a[1]); o.y = pk2(a[2], a[3]); o.z = pk2(a[4], a[5]); o.w = pk2(a[6], a[7]);
                __builtin_amdgcn_raw_buffer_store_b128(o, rsrc, (int)(((unsigned)row * 1024u + (unsigned)cbase) * 2u), 0, 16); }
    }
};
struct EpiDN {
    static constexpr bool HOOK = false; static constexpr int HOOK_T1 = -1, HOOK_T2 = -1;
    unsigned char* ws; float* out; const LAS int* ldstok;
    __device__ __forceinline__ void hook(f32x4 (&)[2][2][4][2], const pg8::Unit&, int, int, int, int, int) const {}
    __device__ __forceinline__ void operator()(const f32x4 (&acc)[2][2][4][2], const pg8::Unit& u, int wr, int wc, int fr, int fq) const {
        const bf16_t* x1b = (const bf16_t*)(ws + WS_X1B);
        const int cbase = u.col0 + wc * 32 + 8 * fq;
#pragma unroll
        for (int ai = 0; ai < 2; ++ai)
#pragma unroll
            for (int m = 0; m < 4; ++m) { const int row = u.row0 + ai * 128 + wr * 64 + m * 16 + fr; const int tok = ldstok[row - u.row0];
                if (tok >= 0) {
#pragma unroll
                    for (int bj = 0; bj < 2; ++bj) { const size_t off = (size_t)tok * DM + cbase + bj * 128; const u32x4 xw = *(const u32x4*)(x1b + off);
                        const f32x4 x0 = {__builtin_bit_cast(float, xw.x << 16), __builtin_bit_cast(float, xw.x & 0xffff0000u), __builtin_bit_cast(float, xw.y << 16), __builtin_bit_cast(float, xw.y & 0xffff0000u)};
                        const f32x4 x1 = {__builtin_bit_cast(float, xw.z << 16), __builtin_bit_cast(float, xw.z & 0xffff0000u), __builtin_bit_cast(float, xw.w << 16), __builtin_bit_cast(float, xw.w & 0xffff0000u)};
                        __builtin_nontemporal_store(x0 + acc[ai][bj][m][0], (f32x4*)(out + off)); __builtin_nontemporal_store(x1 + acc[ai][bj][m][1], (f32x4*)(out + off + 4)); } } }
    }
};

struct SchedOne { pg8::Unit u; __device__ __forceinline__ bool next(int i, pg8::Unit& o) const { if (i != 0) return false; o = u; return true; } };
__device__ __forceinline__ void p9_experts(Frame& F) {
    LAS int* tb = (LAS int*)(F.lds + LDSCTL_OFF + 512);
    const int ntiles = moe_tables(F, tb);
    LAS int* qs = (LAS int*)(F.lds + LDSCTL_OFF + 256);
    const int nun = 16 * ntiles;
    unsigned pend = 0u;
    if (F.tid == 0) pend = blockIdx.x;
    for (;;) {
        __syncthreads();
        if (F.tid == 0) { qs[0] = (int)pend; pend = (unsigned)F.G + atomicAdd(F.ctl + CW_QUEUE + 2, 1u); }
        __syncthreads();
        const int idx = qs[0];
        if (idx >= nun) break;
        const bool dn = idx >= 8 * ntiles; const int L = dn ? idx - 8 * ntiles : idx; const int mt = tb[256 + (L >> 3)], pn = L & 7; const int cls = tb[128 + mt]; int ea, eb; cls_experts(cls, ea, eb);
        pg8::Unit u; u.kind = 0; u.row0 = mt * 256; u.aux = 0; u.lowonly = tb[192 + mt];
        if (!dn) {
            const int e = pn < 4 ? ea : eb;
            u.A = (const char*)(F.ws + WS_X1B); u.B = (const char*)(F.ws + WS_WGUT) + ((size_t)e * 1024 + (pn & 3) * 256) * DM * 2; u.Bhi = u.B; u.col0 = pn; u.nt = 32;
            LAS float* ldsrw = (LAS float*)(F.lds + 131072 + 1024);
            { const int wvu = __builtin_amdgcn_readfirstlane(F.wave); const int sel = wvu >> 2, t256 = (wvu & 3) * 64 + F.lane;
              const float* srcp = (sel == 0 ? wsp<float>(F, WS_ROWRS) : wsp<float>(F, pn < 4 ? WS_ROWWA : WS_ROWWB)) + mt * 256 + t256;
              __builtin_amdgcn_global_load_lds((const unsigned*)srcp, (LAS unsigned*)(ldsrw + sel * 256 + (wvu & 3) * 64), 4, 0, 0); }
            SchedOne S{u}; EpiGU E{F.ws, ldsrw};
            pg8::gemm_phase<EpiGU, SchedOne, true, true>(F.lds, pg8::Geom{DM, DM, 32, 1 << 30, wsp<int>(F, WS_ROWTOK)}, S, E);
            asm volatile("s_waitcnt vmcnt(0)" ::: "memory");
            __syncthreads();
            if (F.tid == 0) __hip_atomic_fetch_add(F.ctl + CW_TILE + mt, 1u, __ATOMIC_RELAXED, __HIP_MEMORY_SCOPE_AGENT);
        } else {
            if (F.tid == 0) { unsigned sp = 0;
                while (__hip_atomic_load(F.ctl + CW_TILE + mt, __ATOMIC_RELAXED, __HIP_MEMORY_SCOPE_AGENT) < 8u) { __builtin_amdgcn_s_sleep(8); if (++sp > (1u << 20)) break; }
                __builtin_amdgcn_fence(__ATOMIC_ACQUIRE, "agent");
                asm volatile("s_waitcnt vmcnt(0)" ::: "memory"); }
            __syncthreads();
            u.A = (const char*)(F.ws + WS_ACT) + (size_t)mt * 256 * 1024 * 2; u.B = (const char*)(F.ws + WS_WDT) + ((size_t)ea * DM + pn * 256) * 512 * 2;
            u.Bhi = (const char*)(F.ws + WS_WDT) + ((size_t)eb * DM + pn * 256) * 512 * 2 - (size_t)8 * 128; u.col0 = pn * 256; u.nt = 16;
            LAS int* ldstok = (LAS int*)(F.lds + 131072);
            { const int wvu = __builtin_amdgcn_readfirstlane(F.wave); if (wvu < 4) __builtin_amdgcn_global_load_lds((const unsigned*)(wsp<int>(F, WS_ROWTOK) + mt * 256 + wvu * 64 + F.lane), (LAS unsigned*)(ldstok + wvu * 64), 4, 0, 0); }
            SchedOne S{u}; EpiDN E{F.ws, F.out, ldstok};
            pg8::gemm_phase<EpiDN, SchedOne, true, true>(F.lds, pg8::Geom{1024, 512, 16, 8, nullptr}, S, E);
        }
    }
}
template <int K> __device__ __forceinline__ void run_phase(Frame& F) {
    if constexpr (K == 0) p0_prologue(F);
    else if constexpr (K == 1) {
        SchedP1 S{(int)blockIdx.x, F.G, F.ws};
        EpiP1 E{F.ws, wsp<float>(F, WS_RSTD1), wsp<float>(F, WS_RSTDM), F.b_gate};
        pg8::gemm_phase<EpiP1, SchedP1, true, true>(F.lds, pg8::Geom{DM, DM, 32, 1 << 30, nullptr}, S, E);
    } else if constexpr (K == 2) p2_rowpass(F);
    else if constexpr (K == 3) p3_indexer(F);
    else if constexpr (K == 4) p4_attention(F);
    else if constexpr (K == 5) p5_finalize(F);
    else if constexpr (K == 6) {
        SchedTile S{(int)blockIdx.x, F.G, 32, 8, (const char*)(F.ws + WS_AMRG), (const char*)(F.ws + WS_BTMRG), (size_t)256 * DM * 2, (size_t)256 * DM * 2};
        EpiMrg E{wsp<bf16_t>(F, WS_EG), wsp<bf16_t>(F, WS_MRG)};
        pg8::gemm_phase<EpiMrg, SchedTile, true, true>(F.lds, pg8::Geom{DM, DM, 32, 1 << 30, nullptr}, S, E);
    } else if constexpr (K == 7) {
        SchedTile S{(int)blockIdx.x, F.G, 32, 8, (const char*)(F.ws + WS_MRG), (const char*)(F.ws + WS_WOT), (size_t)256 * DM * 2, (size_t)256 * DM * 2};
        EpiRes E{F.x, F.out, wsp<bf16_t>(F, WS_X1B)};
        pg8::gemm_phase<EpiRes, SchedTile, true, true>(F.lds, pg8::Geom{DM, DM, 32, 1 << 30, nullptr}, S, E);
    } else if constexpr (K == 8) p8_router(F);
    else if constexpr (K == 9) p8b_gather(F);
    else p9_experts(F);
}
__global__ void __launch_bounds__(NTHR, 2) fwd_kernel(KArgs args) {
    extern __shared__ __attribute__((aligned(16))) unsigned char lds_raw[];
    Frame F;
    F.lds = (LAS unsigned char*)lds_raw; F.MISC = (volatile LAS unsigned*)(F.lds + MISC_OFF);
    F.tid = threadIdx.x; F.lane = F.tid & 63; F.wave = __builtin_amdgcn_readfirstlane(F.tid >> 6);
    F.G = gridDim.x; { const int bx = blockIdx.x; F.vcu = (F.G % 8 == 0) ? (bx % 8) * (F.G / 8) + bx / 8 : bx; }
    F.ws = args.ws; F.out = args.out; F.ctl = (unsigned*)(args.ws + WS_CTL);
    F.x = (const float*)args.in[0]; F.mem = (const float*)args.in[1]; F.positions = (const int*)args.in[2]; F.g_mix = (const float*)args.in[3]; F.w_in = (const float*)args.in[4];
    F.b_gate = (const float*)args.in[5]; F.w_pool_grp = (const float*)args.in[6]; F.pool_scale = (const float*)args.in[7]; F.q_norm_g = (const float*)args.in[8]; F.k_norm_g = (const float*)args.in[9];
    F.g_mem = (const float*)args.in[10]; F.w_mem_kv = (const float*)args.in[11]; F.xq_norm_g = (const float*)args.in[12]; F.xk_norm_g = (const float*)args.in[13]; F.w_pool_out = (const float*)args.in[14];
    F.w_attn_out = (const float*)args.in[15]; F.w_cross_out = (const float*)args.in[16]; F.w_o = (const float*)args.in[17]; F.g_ffn = (const float*)args.in[18]; F.w_rg = (const float*)args.in[19];
    F.w_re = (const float*)args.in[20]; F.w_eg = (const float*)args.in[21]; F.w_eu = (const float*)args.in[22]; F.w_ed = (const float*)args.in[23];
    for (int u = F.tid; u < (LDS_BYTES - LDSCTL_OFF) / 4; u += NTHR) ((LAS unsigned*)(F.lds + LDSCTL_OFF))[u] = 0u;
    __syncthreads();
    XcdBarrier bar = xcd_barrier_post(F.ctl + CW_BAR, F.MISC + 8);
    if (P3_PROF == 8 && blockIdx.x == 0 && F.tid == 0) __hip_atomic_store(F.ctl + CW_QUEUE + 9, 0x7fffffffu, __ATOMIC_RELAXED, __HIP_MEMORY_SCOPE_AGENT);
    const int lo = args.ph_lo, hi = args.ph_hi;
#define IN(k) (lo <= (k) && (k) < hi)
#define SEAM(k) do { if (IN(k) && IN((k) + 1)) xcd_barrier(bar); } while (0)
#ifndef PROBE_TS
#define PROBE_TS -1
#endif
#ifndef PROBE_REPEAT
#define PROBE_REPEAT -1
#endif
#ifndef PROBE_OFF
#define PROBE_OFF 0
#endif
    unsigned long long ts0 = 0, ts1 = 0;
#ifndef ONLY_PHASE
#define ONLY_PHASE -1
#endif
#define PHASE(k) do { if ((ONLY_PHASE < 0 || ONLY_PHASE == (k)) && IN(k)) { if (PROBE_TS == (k)) ts0 = __builtin_amdgcn_s_memrealtime(); run_phase<k>(F); \
        if (PROBE_REPEAT == (k)) { xcd_barrier(bar); run_phase<k>(F); } } \
        if (PROBE_TS == (k)) { xcd_barrier(bar); ts1 = __builtin_amdgcn_s_memrealtime(); } else { SEAM(k); } } while (0)
    if (PROBE_TS == 99) ts0 = __builtin_amdgcn_s_memrealtime();
    PHASE(0); PHASE(1); PHASE(2); PHASE(3); PHASE(4);   PHASE(6); PHASE(7); PHASE(8); PHASE(9); PHASE(10);
    if (PROBE_TS == 99) { xcd_barrier(bar); ts1 = (__builtin_amdgcn_s_memrealtime() - ts0) / 10 + ts0; }
#ifdef EXTRA_BARS
    for (int _i = 0; _i < 10; ++_i) xcd_barrier(bar);
#endif
    if (P0_PROF) { xcd_barrier(bar); if (blockIdx.x == 0 && F.tid == 0) F.out[0] += (float)__hip_atomic_load(F.ctl + CW_QUEUE + 8, __ATOMIC_RELAXED, __HIP_MEMORY_SCOPE_AGENT) * 0.001f; }
    if (P3_PROF) { xcd_barrier(bar); if (blockIdx.x == 0 && F.tid == 0) { float v = (float)F.MISC[16] * 0.001f;
        if (P3_PROF == 6 || P3_PROF >= 11) v = (float)__hip_atomic_load(F.ctl + CW_QUEUE + 8, __ATOMIC_RELAXED, __HIP_MEMORY_SCOPE_AGENT);
        if (P3_PROF == 7) v = (float)__hip_atomic_load(F.ctl + CW_QUEUE + 8, __ATOMIC_RELAXED, __HIP_MEMORY_SCOPE_AGENT) * 0.001f;
        if (P3_PROF == 8) v = (float)__hip_atomic_load(F.ctl + CW_QUEUE + 9, __ATOMIC_RELAXED, __HIP_MEMORY_SCOPE_AGENT) * 0.001f;
        F.out[0] += v; } }
    if (PROBE_TS >= 0) { if (PROBE_TS != 10) xcd_barrier(bar); if (blockIdx.x == 0 && F.tid == 0) F.out[0] += PROBE_OFF ? ((float)(long long)(ts1 - ts0) - PROBE_OFF * 100.0f) * 0.001f : (float)(ts1 - ts0) * 0.001f; }
#undef IN
#undef SEAM
#undef PHASE
}

extern "C" void kernel_launch(void* const* d_in, const int* in_sizes, int n_in, void* d_out, int out_size, void* d_ws, size_t ws_size, hipStream_t stream) {
    static int grid = 0;
    if (grid == 0) {
        if (n_in != 24 || in_sizes[0] != SEQ * DM || out_size != SEQ * DM || ws_size < WS_END) {
            fprintf(stderr, "kernel_launch: unexpected shapes: n_in %d in0 %d out %d ws %zu (need %zu)\n", n_in, n_in > 0 ? in_sizes[0] : -1, out_size, ws_size, (size_t)WS_END); grid = -1; return; }
        int dev = 0, cus = 0, per_cu = 0;
        if (hipGetDevice(&dev) != hipSuccess || hipDeviceGetAttribute(&cus, hipDeviceAttributeMultiprocessorCount, dev) != hipSuccess) { grid = -1; return; }
        if (hipFuncSetAttribute((const void*)fwd_kernel, hipFuncAttributeMaxDynamicSharedMemorySize, LDS_BYTES) != hipSuccess) { fprintf(stderr, "kernel_launch: hipFuncSetAttribute failed\n"); grid = -1; return; }
        if (hipOccupancyMaxActiveBlocksPerMultiprocessor(&per_cu, (const void*)fwd_kernel, NTHR, LDS_BYTES) != hipSuccess || per_cu < 1) {
            fprintf(stderr, "kernel_launch: occupancy query reports %d workgroups per CU\n", per_cu); (void)hipGetLastError(); per_cu = 1; }
        grid = cus;
    }
    if (grid < 0) return;
    if (hipMemsetAsync((char*)d_ws + WS_CTL, 0, CTL_ZERO_BYTES, stream) != hipSuccess) { fprintf(stderr, "kernel_launch: memset failed\n"); return; }
#ifdef MEMSET_TWICE
    if (hipMemsetAsync((char*)d_ws + WS_CTL, 0, CTL_ZERO_BYTES, stream) != hipSuccess) return;
    if (hipMemsetAsync((char*)d_ws + WS_CTL, 0, CTL_ZERO_BYTES, stream) != hipSuccess) return;
#endif
    KArgs a{};
    for (int i = 0; i < 24; ++i) a.in[i] = d_in[i];
    a.out = (float*)d_out; a.ws = (unsigned char*)d_ws; a.ph_lo = 0; a.ph_hi = 11;
    hipLaunchKernelGGL(fwd_kernel, dim3(grid), dim3(NTHR), LDS_BYTES, stream, a);
    const hipError_t le = hipPeekAtLastError();
    if (le != hipSuccess) fprintf(stderr, "kernel_launch: launch failed: %s\n", hipGetErrorName(le));
}
```
